# Optimizing an MI355X kernel written in HIP

```python
import math
import jax
import jax.numpy as jnp
from jax import lax
import numpy as np

D_MODEL = 1024
BATCH = 4
SEQ = 8192
DEPTH = 2

GRID_W = 64
HEAD_DIM = 64
N_BRANCH = 4
BRANCH_W = 256
Q_BLOCK = 128
ROPE_THETA = 10000.0
EPS = 1e-6
NEG_INF = -1e30

MLA_HEADS = 4
MLA_Q_LORA = 256
MLA_KV_LORA = 128
MLA_NOPE = 64
MLA_ROPE = 32
MLA_V = 64

GQA_HEADS = 4
GQA_KV_HEADS = 2

DIL_PATTERNS = ((128, 1), (512, 4), (2048, 16))
DIL_GROUPS = 3
DIL_HEADS = 4

WIN_HEADS = 4
WIN_KV_HEADS = 2
WIN_HALF = 128
WIN_BLOCK = 128

T5_BUCKETS = 32
T5_MAX_DIST = 1024
T5_HEADS = DIL_GROUPS * DIL_HEADS + WIN_HEADS

IN_WIDTHS = (
    MLA_Q_LORA, MLA_KV_LORA, MLA_ROPE,
    GQA_HEADS * HEAD_DIM, GQA_KV_HEADS * HEAD_DIM, GQA_KV_HEADS * HEAD_DIM,
    DIL_GROUPS * DIL_HEADS * HEAD_DIM, DIL_GROUPS * DIL_HEADS * HEAD_DIM, DIL_GROUPS * DIL_HEADS * HEAD_DIM,
    WIN_HEADS * HEAD_DIM, WIN_KV_HEADS * HEAD_DIM, WIN_KV_HEADS * HEAD_DIM,
    N_BRANCH * BRANCH_W,
    N_BRANCH * D_MODEL,
)
IN_WIDTH = sum(IN_WIDTHS)

kernel_name = "hybrid_gated_multi_mixer_encoder"


def rms_norm(x, g):
    xf = x.astype(jnp.float32)
    y = xf * lax.rsqrt(jnp.mean(xf * xf, axis=-1, keepdims=True) + EPS)
    return (y * g.astype(jnp.float32)).astype(x.dtype)


def rope_angles(pos, dim):
    inv = ROPE_THETA ** (-jnp.arange(0, dim, 2, dtype=jnp.float32) / dim)
    return pos.astype(jnp.float32)[:, None] * inv[None, :]


def apply_rope(x, ang):
    half = x.shape[-1] // 2
    xf = x.astype(jnp.float32)
    cos = jnp.cos(ang)[None, :, None, :]
    sin = jnp.sin(ang)[None, :, None, :]
    x1, x2 = xf[..., :half], xf[..., half:]
    return jnp.concatenate([x1 * cos - x2 * sin, x1 * sin + x2 * cos], axis=-1).astype(x.dtype)


def axial_rope(x, ang_row, ang_col):
    half = x.shape[-1] // 2
    return jnp.concatenate([apply_rope(x[..., :half], ang_row), apply_rope(x[..., half:], ang_col)], axis=-1)


def t5_bucket(rel):
    nb = T5_BUCKETS // 2
    max_exact = nb // 2
    n = jnp.abs(rel)
    nf = jnp.maximum(n, 1).astype(jnp.float32)
    large = max_exact + (jnp.log(nf / max_exact) / math.log(T5_MAX_DIST / max_exact)
                         * (nb - max_exact)).astype(jnp.int32)
    large = jnp.minimum(large, nb - 1)
    return jnp.where(rel > 0, nb, 0) + jnp.where(n < max_exact, n, large)


def band_t5_bias(table, block, stride, head_lo, hk, g):
    offs = jnp.arange(3 * block)[None, :] - block - jnp.arange(block)[:, None]
    bias = table[t5_bucket(offs * stride)][..., head_lo:head_lo + hk * g]
    return jnp.transpose(bias, (2, 0, 1)).reshape(hk, g, block, 3 * block).astype(jnp.float32)


def dense_attention(q, k, v):
    b, s, hk, g, d = q.shape
    scale = d ** -0.5
    nblk = s // Q_BLOCK
    qb = jnp.moveaxis(q.reshape(b, nblk, Q_BLOCK, hk, g, d), 1, 0)

    def attend(q_blk):
        logits = jnp.einsum("bqkgd,bskd->bkgqs", q_blk, k).astype(jnp.float32) * scale
        p = jax.nn.softmax(logits, axis=-1).astype(v.dtype)
        return jnp.einsum("bkgqs,bskd->bqkgd", p, v)

    out = lax.map(attend, qb)
    return jnp.moveaxis(out, 0, 1).reshape(b, s, hk, g, v.shape[-1])


def banded_attention(q, k, v, half_window, block, bias, sink):
    b, L, hk, g, d = q.shape
    dv = v.shape[-1]
    scale = d ** -0.5
    nblk = -(-L // block)
    lp = nblk * block
    pad = lp - L
    qp = jnp.pad(q, ((0, 0), (0, pad), (0, 0), (0, 0), (0, 0)))
    kp = jnp.pad(k, ((0, 0), (block, block + pad), (0, 0), (0, 0)))
    vp = jnp.pad(v, ((0, 0), (block, block + pad), (0, 0), (0, 0)))
    valid = jnp.pad(jnp.ones((L,), dtype=bool), (block, block + pad)).reshape(nblk + 2, block)
    kb = kp.reshape(b, nblk + 2, block, hk, d)
    vb = vp.reshape(b, nblk + 2, block, hk, dv)
    kband = jnp.concatenate([kb[:, :-2], kb[:, 1:-1], kb[:, 2:]], axis=2)
    vband = jnp.concatenate([vb[:, :-2], vb[:, 1:-1], vb[:, 2:]], axis=2)
    kvalid = jnp.concatenate([valid[:-2], valid[1:-1], valid[2:]], axis=1)
    offs = jnp.arange(3 * block)[None, :] - block - jnp.arange(block)[:, None]
    mask = (jnp.abs(offs) <= half_window)[None, :, :] & kvalid[:, None, :]
    qb = qp.reshape(b, nblk, block, hk, g, d)
    logits = jnp.einsum("bnqkgd,bnskd->bnkgqs", qb, kband).astype(jnp.float32) * scale + bias
    logits = jnp.where(mask[None, :, None, None], logits, NEG_INF)
    m = jnp.max(logits, axis=-1, keepdims=True)
    if sink is not None:
        sk = sink.astype(jnp.float32)[None, None, :, :, None, None]
        m = jnp.maximum(m, sk)
        e = jnp.exp(logits - m)
        ssum = jnp.sum(e, axis=-1, keepdims=True) + jnp.exp(sk - m)
    else:
        e = jnp.exp(logits - m)
        ssum = jnp.sum(e, axis=-1, keepdims=True)
    p = (e / ssum).astype(v.dtype)
    out = jnp.einsum("bnkgqs,bnskd->bnqkgd", p, vband).reshape(b, lp, hk, g, dv)[:, :L]
    lse = (m + jnp.log(ssum))[..., 0]
    lse = jnp.transpose(lse, (0, 1, 4, 2, 3)).reshape(b, lp, hk, g)[:, :L]
    return out, lse


def dilated_group(q, k, v, dilation, half_steps, bias):
    b, s, h, d = q.shape
    L = s // dilation

    def to_sub(t):
        return t.reshape(b, L, dilation, h, d).transpose(0, 2, 1, 3, 4).reshape(b * dilation, L, h, d)

    out, lse = banded_attention(to_sub(q)[:, :, :, None, :], to_sub(k), to_sub(v),
                                half_steps, half_steps, bias, None)
    out = out[:, :, :, 0].reshape(b, dilation, L, h, d).transpose(0, 2, 1, 3, 4).reshape(b, s, h, d)
    lse = lse[..., 0].reshape(b, dilation, L, h).transpose(0, 2, 1, 3).reshape(b, s, h)
    return out, lse


def setup_inputs(seed: int = 0) -> dict:
    key = jax.random.key(seed)
    ks = jax.random.split(key, 16)
    f32 = jnp.float32

    def nrm(k, shape, scale):
        return jax.random.normal(k, shape, f32) * scale

    def gain(k, shape):
        return 1.0 + 0.05 * jax.random.normal(k, shape, f32)

    return {
        "x": nrm(ks[0], (BATCH, SEQ, D_MODEL), 1.0),
        "norm_g": gain(ks[1], (DEPTH, D_MODEL)),
        "w_in": nrm(ks[2], (DEPTH, D_MODEL, IN_WIDTH), D_MODEL ** -0.5),
        "mla_q_norm_g": gain(ks[3], (DEPTH, MLA_Q_LORA)),
        "mla_kv_norm_g": gain(ks[4], (DEPTH, MLA_KV_LORA)),
        "w_mla_q_up": nrm(ks[5], (DEPTH, MLA_Q_LORA, MLA_HEADS * (MLA_NOPE + MLA_ROPE)), MLA_Q_LORA ** -0.5),
        "w_mla_kv_up": nrm(ks[6], (DEPTH, MLA_KV_LORA, MLA_HEADS * (MLA_NOPE + MLA_V)), MLA_KV_LORA ** -0.5),
        "gqa_q_norm_g": gain(ks[7], (DEPTH, HEAD_DIM)),
        "gqa_k_norm_g": gain(ks[8], (DEPTH, HEAD_DIM)),
        "win_sink": nrm(ks[9], (DEPTH, WIN_HEADS), 0.5),
        "t5_table": nrm(ks[10], (T5_BUCKETS, T5_HEADS), 0.2),
        "w_branch": nrm(ks[11], (DEPTH, N_BRANCH, BRANCH_W, D_MODEL), BRANCH_W ** -0.5),
        "w_out": nrm(ks[12], (DEPTH, D_MODEL, D_MODEL), D_MODEL ** -0.5),
        "final_norm_g": gain(ks[13], (D_MODEL,)),
    }


def reference(x, norm_g, w_in, mla_q_norm_g, mla_kv_norm_g, w_mla_q_up, w_mla_kv_up,
              gqa_q_norm_g, gqa_k_norm_g, win_sink, t5_table, w_branch, w_out, final_norm_g):
    b, s, _ = x.shape
    rows = s // GRID_W
    pos = jnp.arange(s, dtype=jnp.int32)
    row_idx = jnp.repeat(jnp.arange(rows, dtype=jnp.int32), GRID_W)
    col_idx = jnp.tile(jnp.arange(GRID_W, dtype=jnp.int32), rows)
    ang_1d = rope_angles(pos, MLA_ROPE)
    ang_row = rope_angles(row_idx, HEAD_DIM // 2)
    ang_col = rope_angles(col_idx, HEAD_DIM // 2)

    dil_bias = [band_t5_bias(t5_table, w // (2 * r), r, gi * DIL_HEADS, DIL_HEADS, 1)
                for gi, (w, r) in enumerate(DIL_PATTERNS)]
    g_win = WIN_HEADS // WIN_KV_HEADS
    win_bias = band_t5_bias(t5_table, WIN_BLOCK, 1, DIL_GROUPS * DIL_HEADS, WIN_KV_HEADS, g_win)
    split_at = np.cumsum(IN_WIDTHS)[:-1].tolist()
    g_gqa = GQA_HEADS // GQA_KV_HEADS

    for l in range(DEPTH):
        xn = rms_norm(x, norm_g[l])
        proj = xn @ w_in[l]
        (a_q, a_kv, a_kr, b_q, b_k, b_v, c_q, c_k, c_v,
         d_q, d_k, d_v, gate_path, merge_logits) = jnp.split(proj, split_at, axis=-1)

        cq = rms_norm(a_q, mla_q_norm_g[l])
        qa = (cq @ w_mla_q_up[l]).reshape(b, s, MLA_HEADS, MLA_NOPE + MLA_ROPE)
        q_a = jnp.concatenate([qa[..., :MLA_NOPE], apply_rope(qa[..., MLA_NOPE:], ang_1d)], axis=-1)
        ckv = rms_norm(a_kv, mla_kv_norm_g[l])
        kv = (ckv @ w_mla_kv_up[l]).reshape(b, s, MLA_HEADS, MLA_NOPE + MLA_V)
        k_rope = apply_rope(a_kr[:, :, None, :], ang_1d)
        k_a = jnp.concatenate([kv[..., :MLA_NOPE],
                               jnp.broadcast_to(k_rope, (b, s, MLA_HEADS, MLA_ROPE))], axis=-1)
        y_a = dense_attention(q_a[:, :, :, None, :], k_a, kv[..., MLA_NOPE:]).reshape(b, s, MLA_HEADS * MLA_V)

        q_b = axial_rope(rms_norm(b_q.reshape(b, s, GQA_HEADS, HEAD_DIM), gqa_q_norm_g[l]), ang_row, ang_col)
        k_b = axial_rope(rms_norm(b_k.reshape(b, s, GQA_KV_HEADS, HEAD_DIM), gqa_k_norm_g[l]), ang_row, ang_col)
        y_b = dense_attention(q_b.reshape(b, s, GQA_KV_HEADS, g_gqa, HEAD_DIM), k_b,
                              b_v.reshape(b, s, GQA_KV_HEADS, HEAD_DIM)).reshape(b, s, GQA_HEADS * HEAD_DIM)

        cq5 = c_q.reshape(b, s, DIL_GROUPS, DIL_HEADS, HEAD_DIM)
        ck5 = c_k.reshape(b, s, DIL_GROUPS, DIL_HEADS, HEAD_DIM)
        cv5 = c_v.reshape(b, s, DIL_GROUPS, DIL_HEADS, HEAD_DIM)
        outs, lses = [], []
        for gi, (w, r) in enumerate(DIL_PATTERNS):
            o, lse = dilated_group(cq5[:, :, gi], ck5[:, :, gi], cv5[:, :, gi], r, w // (2 * r), dil_bias[gi])
            outs.append(o)
            lses.append(lse)
        alpha = jax.nn.softmax(jnp.stack(lses, axis=0), axis=0)
        y_c = jnp.sum(alpha[..., None] * jnp.stack(outs, axis=0).astype(jnp.float32), axis=0)
        y_c = y_c.astype(x.dtype).reshape(b, s, DIL_HEADS * HEAD_DIM)

        y_d, _ = banded_attention(d_q.reshape(b, s, WIN_KV_HEADS, g_win, HEAD_DIM),
                                  d_k.reshape(b, s, WIN_KV_HEADS, HEAD_DIM),
                                  d_v.reshape(b, s, WIN_KV_HEADS, HEAD_DIM),
                                  WIN_HALF, WIN_BLOCK, win_bias,
                                  win_sink[l].reshape(WIN_KV_HEADS, g_win))
        y_d = y_d.reshape(b, s, WIN_HEADS * HEAD_DIM)

        y = jnp.concatenate([y_a, y_b, y_c, y_d], axis=-1) * jax.nn.silu(gate_path)
        branch = jnp.einsum("bsnc,ncd->bsnd", y.reshape(b, s, N_BRANCH, BRANCH_W), w_branch[l])
        gates = jax.nn.sigmoid(merge_logits.reshape(b, s, N_BRANCH, D_MODEL))
        x = x + jnp.sum(gates * branch, axis=2) @ w_out[l]

    return rms_norm(x, final_norm_g)
```

```cpp
#include <hip/hip_runtime.h>
#include <hip/hip_cooperative_groups.h>
#include <cstdio>
namespace cg = cooperative_groups;

typedef unsigned short bf16_t;
using bf16x8 = __attribute__((ext_vector_type(8))) short;
using f32x4 = __attribute__((ext_vector_type(4))) float;
using u32x4 = __attribute__((ext_vector_type(4))) unsigned;
#define DI __device__ __forceinline__

constexpr int SEQ = 8192;
constexpr int PW = 4864;
constexpr int C_BQ = 0, C_BK = 256, C_BV = 384, C_CQ = 512, C_CK = 1280, C_CV = 2048, C_DQ = 2816, C_DK = 3072,
              C_DV = 3200, C_GATE = 3328, C_AQ = 4352, C_AKV = 4608, C_AKR = 4736;
constexpr int C_MERGED = 512;

struct Params {
  const float* x; const float* norm_g; const float* w_in; const float* q_norm_g; const float* kv_norm_g;
  const float* w_q_up; const float* w_kv_up; const float* gq_g; const float* gk_g; const float* sink;
  const float* t5; const float* w_branch; const float* w_out; const float* final_g;
  float* out;
  bf16_t* W1t; bf16_t* Wmt; bf16_t* Wot; bf16_t* Wbt; bf16_t* Wqt; bf16_t* Wkvt;
  float* rope; float* lutC; float* lutD;
  bf16_t* xn; bf16_t* proj; bf16_t* qa; bf16_t* ka; bf16_t* va;
};

DI unsigned short f2bf(float x) { unsigned u = __float_as_uint(x); u += 0x7fffu + ((u >> 16) & 1u); return (unsigned short)(u >> 16); }
DI float bf2f(unsigned short b) { return __uint_as_float(((unsigned)b) << 16); }
DI unsigned pack2(float a, float b) { return (unsigned)f2bf(a) | ((unsigned)f2bf(b) << 16); }
#define BLO(u) __uint_as_float((u) << 16)
#define BHI(u) __uint_as_float((u) & 0xffff0000u)
DI float wave_sum(float v) {
#pragma unroll
  for (int o = 32; o; o >>= 1) v += __shfl_xor(v, o);
  return v;
}

DI int srccol(int mode, int n) {
  if (mode == 0) return n < 4352 ? n + 416 : (n < 4768 ? n - 4352 : -1);
  if (mode == 1) return 4768 + n;
  if (mode == 2) return n;
  return n < 256 ? (n >> 6) * 96 + (n & 63) : ((n - 256) >> 5) * 96 + 64 + ((n - 256) & 31);
}
DI void conv_tile(const float* __restrict__ src, int ld, int K, bf16_t* __restrict__ dst, int n0, int k0, int mode,
                  const float* __restrict__ rs, float* tile) {
  const int tx = threadIdx.x & 63, ty = threadIdx.x >> 6;
  __syncthreads();
  const int sc = srccol(mode, n0 + tx);
#pragma unroll
  for (int i = 0; i < 16; ++i) {
    int kk = ty + 4 * i;
    float v = sc >= 0 ? src[(size_t)(k0 + kk) * ld + sc] : 0.f;
    if (rs) v *= rs[k0 + kk];
    tile[kk * 65 + tx] = v;
  }
  __syncthreads();
#pragma unroll
  for (int i = 0; i < 16; ++i) {
    int nn = ty + 4 * i;
    dst[(size_t)(n0 + nn) * K + k0 + tx] = f2bf(tile[tx * 65 + nn]);
  }
}

DI int t5_bucket(int rel) {
  int n = rel < 0 ? -rel : rel;
  float nf = (float)(n < 1 ? 1 : n);
  int large = 8 + (int)(logf(nf / 8.0f) / 4.852030263919617f * 8.0f);
  if (large > 15) large = 15;
  return (rel > 0 ? 16 : 0) + (n < 8 ? n : large);
}

DI void prep_item(const Params& p, int item, float* tile) {
  if (item < 5584) {
    int l = item / 2792, r = item % 2792;
    const float* src; int ld, K, mode, t; bf16_t* dst; const float* rs = nullptr;
    if (r < 1216) { t = r; src = p.w_in + (size_t)l * 1024 * 8864; ld = 8864; K = 1024; mode = 0; dst = p.W1t + (size_t)l * 4864 * 1024; }
    else if (r < 2240) { t = r - 1216; src = p.w_in + (size_t)l * 1024 * 8864; ld = 8864; K = 1024; mode = 1; dst = p.Wmt + (size_t)l * 4096 * 1024; }
    else if (r < 2496) { t = r - 2240; src = p.w_out + (size_t)l * 1024 * 1024; ld = 1024; K = 1024; mode = 2; dst = p.Wot + (size_t)l * 1024 * 1024; }
    else if (r < 2752) { t = r - 2496; int n = t >> 6; t &= 63; src = p.w_branch + (size_t)(l * 4 + n) * 256 * 1024; ld = 1024; K = 256; mode = 2; dst = p.Wbt + (size_t)(l * 4 + n) * 1024 * 256; }
    else if (r < 2776) { t = r - 2752; src = p.w_q_up + (size_t)l * 256 * 384; ld = 384; K = 256; mode = 3; dst = p.Wqt + (size_t)l * 384 * 256; rs = p.q_norm_g + l * 256; }
    else { t = r - 2776; src = p.w_kv_up + (size_t)l * 128 * 512; ld = 512; K = 128; mode = 2; dst = p.Wkvt + (size_t)l * 512 * 128; rs = p.kv_norm_g + l * 128; }
    int kt = K / 64;
    conv_tile(src, ld, K, dst, (t / kt) * 64, (t % kt) * 64, mode, rs, tile);
  } else if (item < 5584 + 512) {
    int idx = (item - 5584) * 256 + threadIdx.x;
    int pos = idx >> 4, i = idx & 15;
    double invd = 1.0;
    for (int k = 0; k < i; ++k) invd *= 0.5623413251903491;
    float inv = (float)invd;
    float ang = (float)pos * inv;
    double a = (double)ang;
    double kq = rint(a * 0.15915494309189535);
    double r = a - kq * 6.283185307179586;
    double r2 = r * r, ts = r, tc = 1.0, sn = r, cs = 1.0;
    for (int k = 1; k <= 14; ++k) {
      tc = -tc * r2 / (double)((2 * k - 1) * (2 * k));
      ts = -ts * r2 / (double)((2 * k) * (2 * k + 1));
      cs += tc; sn += ts;
    }
    p.rope[pos * 32 + i] = (float)cs;
    p.rope[pos * 32 + 16 + i] = (float)sn;
  } else {
    for (int e = threadIdx.x; e < 12 * 129; e += 256) {
      int gh = e / 129, off = e % 129 - 64; int g = gh >> 2;
      int r = g == 0 ? 1 : (g == 1 ? 4 : 16);
      p.lutC[e] = p.t5[t5_bucket(off * r) * 16 + gh];
    }
    for (int e = threadIdx.x; e < 4 * 257; e += 256) {
      int hq = e / 257, off = e % 257 - 128;
      p.lutD[e] = p.t5[t5_bucket(off) * 16 + 12 + hq];
    }
  }
}

DI void norm_rows_bf16(const float* __restrict__ src, const float* __restrict__ g, bf16_t* __restrict__ dst, int item) {
  const int lane = threadIdx.x & 63, wid = threadIdx.x >> 6;
  for (int i = 0; i < 8; ++i) {
    size_t row = (size_t)item * 32 + wid * 8 + i;
    const float4* s = (const float4*)(src + row * 1024);
    float4 v[4]; float ss = 0.f;
#pragma unroll
    for (int j = 0; j < 4; ++j) { v[j] = s[lane + 64 * j]; ss += v[j].x * v[j].x + v[j].y * v[j].y + v[j].z * v[j].z + v[j].w * v[j].w; }
    ss = wave_sum(ss);
    float sc = rsqrtf(ss * (1.0f / 1024.0f) + 1e-6f);
#pragma unroll
    for (int j = 0; j < 4; ++j) {
      float4 gg = ((const float4*)g)[lane + 64 * j];
      uint2 o; o.x = pack2(v[j].x * sc * gg.x, v[j].y * sc * gg.y); o.y = pack2(v[j].z * sc * gg.z, v[j].w * sc * gg.w);
      *(uint2*)(dst + row * 1024 + (lane + 64 * j) * 4) = o;
    }
  }
}
DI void norm_rows_f32(float* io, const float* __restrict__ g, int item) {
  const int lane = threadIdx.x & 63, wid = threadIdx.x >> 6;
  for (int i = 0; i < 8; ++i) {
    size_t row = (size_t)item * 32 + wid * 8 + i;
    float4* s = (float4*)(io + row * 1024);
    float4 v[4]; float ss = 0.f;
#pragma unroll
    for (int j = 0; j < 4; ++j) { v[j] = s[lane + 64 * j]; ss += v[j].x * v[j].x + v[j].y * v[j].y + v[j].z * v[j].z + v[j].w * v[j].w; }
    ss = wave_sum(ss);
    float sc = rsqrtf(ss * (1.0f / 1024.0f) + 1e-6f);
#pragma unroll
    for (int j = 0; j < 4; ++j) {
      float4 gg = ((const float4*)g)[lane + 64 * j];
      float4 o; o.x = v[j].x * sc * gg.x; o.y = v[j].y * sc * gg.y; o.z = v[j].z * sc * gg.z; o.w = v[j].w * sc * gg.w;
      s[lane + 64 * j] = o;
    }
  }
}

constexpr int LLD = 72;
template <int NT>
DI void gemm_mainloop(f32x4 (&acc)[4][NT], const bf16_t* A, int lda, const bf16_t* Bt, int ldb, int K, bf16_t* sA, bf16_t* sB) {
  constexpr int NB = NT;
  const int tid = threadIdx.x, lane = tid & 63, wid = tid >> 6;
  const int wm = wid >> 1, wn = wid & 1, fr = lane & 15, fq = lane >> 4;
  u32x4 ra[4], rb[NB];
  const int nk = K >> 6;
#pragma unroll
  for (int i = 0; i < 4; ++i) { int c = tid + 256 * i; ra[i] = *(const u32x4*)(A + (size_t)(c >> 3) * lda + (c & 7) * 8); }
#pragma unroll
  for (int i = 0; i < NB; ++i) { int c = tid + 256 * i; rb[i] = *(const u32x4*)(Bt + (size_t)(c >> 3) * ldb + (c & 7) * 8); }
  for (int kt = 0; kt < nk; ++kt) {
    __syncthreads();
#pragma unroll
    for (int i = 0; i < 4; ++i) { int c = tid + 256 * i; *(u32x4*)(sA + (c >> 3) * LLD + (c & 7) * 8) = ra[i]; }
#pragma unroll
    for (int i = 0; i < NB; ++i) { int c = tid + 256 * i; *(u32x4*)(sB + (c >> 3) * LLD + (c & 7) * 8) = rb[i]; }
    __syncthreads();
    if (kt + 1 < nk) {
      int ko = (kt + 1) * 64;
#pragma unroll
      for (int i = 0; i < 4; ++i) { int c = tid + 256 * i; ra[i] = *(const u32x4*)(A + (size_t)(c >> 3) * lda + ko + (c & 7) * 8); }
#pragma unroll
      for (int i = 0; i < NB; ++i) { int c = tid + 256 * i; rb[i] = *(const u32x4*)(Bt + (size_t)(c >> 3) * ldb + ko + (c & 7) * 8); }
    }
#pragma unroll
    for (int ks = 0; ks < 2; ++ks) {
      bf16x8 af[4], bfr[NT];
#pragma unroll
      for (int mi = 0; mi < 4; ++mi) af[mi] = *(const bf16x8*)(sA + (wm * 64 + mi * 16 + fr) * LLD + ks * 32 + fq * 8);
#pragma unroll
      for (int ni = 0; ni < NT; ++ni) bfr[ni] = *(const bf16x8*)(sB + (wn * NT * 16 + ni * 16 + fr) * LLD + ks * 32 + fq * 8);
#pragma unroll
      for (int mi = 0; mi < 4; ++mi)
#pragma unroll
        for (int ni = 0; ni < NT; ++ni) acc[mi][ni] = __builtin_amdgcn_mfma_f32_16x16x32_bf16(bfr[ni], af[mi], acc[mi][ni], 0, 0, 0);
    }
  }
}
template <int NT>
DI void zero_acc(f32x4 (&acc)[4][NT]) {
#pragma unroll
  for (int mi = 0; mi < 4; ++mi)
#pragma unroll
    for (int ni = 0; ni < NT; ++ni) acc[mi][ni] = f32x4{0.f, 0.f, 0.f, 0.f};
}

DI void inproj_tile(const Params& p, int l, int tile, char* smem) {
  bf16_t* sA = (bf16_t*)smem; bf16_t* sB = sA + 128 * LLD;
  const int mt = tile & 255, nt = tile >> 8;
  f32x4 acc[4][4]; zero_acc<4>(acc);
  gemm_mainloop<4>(acc, p.xn + (size_t)mt * 128 * 1024, 1024, p.W1t + ((size_t)l * 4864 + nt * 128) * 1024, 1024, 1024, sA, sB);
  const int lane = threadIdx.x & 63, wid = threadIdx.x >> 6, wm = wid >> 1, wn = wid & 1, fr = lane & 15, fq = lane >> 4;
#pragma unroll
  for (int mi = 0; mi < 4; ++mi)
#pragma unroll
    for (int ni = 0; ni < 4; ++ni) {
      size_t row = (size_t)mt * 128 + wm * 64 + mi * 16 + fr; int col = nt * 128 + wn * 64 + ni * 16 + fq * 4;
      uint2 o; o.x = pack2(acc[mi][ni][0], acc[mi][ni][1]); o.y = pack2(acc[mi][ni][2], acc[mi][ni][3]);
      *(uint2*)(p.proj + row * PW + col) = o;
    }
}

DI void row_scales(const bf16_t* A, int lda, int K, float* sRow) {
  const int row = threadIdx.x >> 1, half = threadIdx.x & 1;
  const int per = K >> 1;
  const bf16_t* a = A + (size_t)row * lda + half * per;
  float ss = 0.f;
  for (int c = 0; c < per; c += 8) {
    uint4 u = *(const uint4*)(a + c);
    float f;
    f = BLO(u.x); ss += f * f; f = BHI(u.x); ss += f * f; f = BLO(u.y); ss += f * f; f = BHI(u.y); ss += f * f;
    f = BLO(u.z); ss += f * f; f = BHI(u.z); ss += f * f; f = BLO(u.w); ss += f * f; f = BHI(u.w); ss += f * f;
  }
  ss += __shfl_xor(ss, 1);
  if (half == 0) sRow[row] = rsqrtf(ss / (float)K + 1e-6f);
}
DI void mla_item(const Params& p, int l, int item, char* smem) {
  bf16_t* sA = (bf16_t*)smem; bf16_t* sB = sA + 128 * LLD; float* sRow = (float*)(sB + 128 * LLD);
  const int lane = threadIdx.x & 63, wid = threadIdx.x >> 6, wm = wid >> 1, wn = wid & 1, fr = lane & 15, fq = lane >> 4;
  if (item < 768) {
    const int mt = item & 255, nt = item >> 8;
    const bf16_t* A = p.proj + (size_t)mt * 128 * PW + C_AQ;
    __syncthreads();
    row_scales(A, PW, 256, sRow);
    f32x4 acc[4][4]; zero_acc<4>(acc);
    gemm_mainloop<4>(acc, A, PW, p.Wqt + ((size_t)l * 384 + nt * 128) * 256, 256, 256, sA, sB);
    if (nt < 2) {
#pragma unroll
      for (int mi = 0; mi < 4; ++mi)
#pragma unroll
        for (int ni = 0; ni < 4; ++ni) {
          int rl = wm * 64 + mi * 16 + fr; size_t t = (size_t)mt * 128 + rl; float s = sRow[rl];
          int c = nt * 128 + wn * 64 + ni * 16 + fq * 4; int h = c >> 6, d = c & 63;
          uint2 o; o.x = pack2(acc[mi][ni][0] * s, acc[mi][ni][1] * s); o.y = pack2(acc[mi][ni][2] * s, acc[mi][ni][3] * s);
          *(uint2*)(p.qa + t * 384 + h * 96 + d) = o;
        }
    } else {
#pragma unroll
      for (int mi = 0; mi < 4; ++mi)
#pragma unroll
        for (int np = 0; np < 2; ++np) {
          int rl = wm * 64 + mi * 16 + fr; size_t t = (size_t)mt * 128 + rl; float s = sRow[rl];
          int pos = (int)(t & (SEQ - 1)); int h = wn * 2 + np;
          const float* cs = p.rope + pos * 32 + fq * 4;
          float o1[4], o2[4];
#pragma unroll
          for (int j = 0; j < 4; ++j) {
            float x1 = acc[mi][np * 2][j] * s, x2 = acc[mi][np * 2 + 1][j] * s; float c = cs[j], sn = cs[16 + j];
            o1[j] = x1 * c - x2 * sn; o2[j] = x1 * sn + x2 * c;
          }
          uint2 a; a.x = pack2(o1[0], o1[1]); a.y = pack2(o1[2], o1[3]);
          uint2 b; b.x = pack2(o2[0], o2[1]); b.y = pack2(o2[2], o2[3]);
          *(uint2*)(p.qa + t * 384 + h * 96 + 64 + fq * 4) = a;
          *(uint2*)(p.qa + t * 384 + h * 96 + 80 + fq * 4) = b;
        }
    }
  } else if (item < 768 + 1024) {
    const int it = item - 768; const int mt = it & 255, h = it >> 8;
    const bf16_t* A = p.proj + (size_t)mt * 128 * PW + C_AKV;
    __syncthreads();
    row_scales(A, PW, 128, sRow);
    f32x4 acc[4][4]; zero_acc<4>(acc);
    gemm_mainloop<4>(acc, A, PW, p.Wkvt + ((size_t)l * 512 + h * 128) * 128, 128, 128, sA, sB);
#pragma unroll
    for (int mi = 0; mi < 4; ++mi)
#pragma unroll
      for (int ni = 0; ni < 4; ++ni) {
        int rl = wm * 64 + mi * 16 + fr; size_t t = (size_t)mt * 128 + rl; float s = sRow[rl];
        int d = ni * 16 + fq * 4;
        uint2 o; o.x = pack2(acc[mi][ni][0] * s, acc[mi][ni][1] * s); o.y = pack2(acc[mi][ni][2] * s, acc[mi][ni][3] * s);
        if (wn == 0) *(uint2*)(p.ka + t * 384 + h * 96 + d) = o;
        else *(uint2*)(p.va + t * 256 + h * 64 + d) = o;
      }
  } else {
    const int it = item - 1792;
    const int half = lane >> 5, pl = lane & 31;
    for (int i = 0; i < 32; ++i) {
      size_t t = (size_t)it * 128 + wid * 32 + i; int pos = (int)(t & (SEQ - 1));
      bf16_t* row = p.proj + t * PW;
#pragma unroll
      for (int s3 = 0; s3 < 3; ++s3) {
        int slot = s3 * 2 + half;
        bf16_t* hp = row + (slot < 4 ? C_BQ + slot * 64 : C_BK + (slot - 4) * 64);
        const float* g = (slot < 4 ? p.gq_g : p.gk_g) + l * 64;
        int d1, fi, ap;
        if (pl < 16) { d1 = pl; fi = pl; ap = pos >> 6; } else { d1 = 32 + (pl - 16); fi = pl - 16; ap = pos & 63; }
        float x1 = bf2f(hp[d1]), x2 = bf2f(hp[d1 + 16]);
        float ss = x1 * x1 + x2 * x2;
#pragma unroll
        for (int o = 16; o; o >>= 1) ss += __shfl_xor(ss, o);
        float sc = rsqrtf(ss * (1.0f / 64.0f) + 1e-6f);
        x1 = x1 * sc * g[d1]; x2 = x2 * sc * g[d1 + 16];
        float c = p.rope[ap * 32 + fi], sn = p.rope[ap * 32 + 16 + fi];
        hp[d1] = f2bf(x1 * c - x2 * sn); hp[d1 + 16] = f2bf(x1 * sn + x2 * c);
      }
      if (lane < 16) {
        float x1 = bf2f(row[C_AKR + lane]), x2 = bf2f(row[C_AKR + 16 + lane]);
        float c = p.rope[pos * 32 + lane], sn = p.rope[pos * 32 + 16 + lane];
        bf16_t o1 = f2bf(x1 * c - x2 * sn), o2 = f2bf(x1 * sn + x2 * c);
#pragma unroll
        for (int h = 0; h < 4; ++h) { p.ka[t * 384 + h * 96 + 64 + lane] = o1; p.ka[t * 384 + h * 96 + 80 + lane] = o2; }
      }
    }
  }
}

DI void sm_update(float s, float& m, float& l, float (&o)[64], const uint4* vrow) {
  if (s > m) {
    float c = __expf(m - s); l *= c;
#pragma unroll
    for (int d = 0; d < 64; ++d) o[d] *= c;
    m = s;
  }
  float pe = __expf(s - m); l += pe;
#pragma unroll
  for (int c = 0; c < 8; ++c) {
    uint4 u = vrow[c];
    o[c * 8 + 0] += pe * BLO(u.x); o[c * 8 + 1] += pe * BHI(u.x); o[c * 8 + 2] += pe * BLO(u.y); o[c * 8 + 3] += pe * BHI(u.y);
    o[c * 8 + 4] += pe * BLO(u.z); o[c * 8 + 5] += pe * BHI(u.z); o[c * 8 + 6] += pe * BLO(u.w); o[c * 8 + 7] += pe * BHI(u.w);
  }
}
template <int D>
DI void load_q(float (&q)[D], const bf16_t* qp, float scale) {
#pragma unroll
  for (int c = 0; c < D / 8; ++c) {
    uint4 u = *(const uint4*)(qp + c * 8);
    q[c * 8 + 0] = BLO(u.x) * scale; q[c * 8 + 1] = BHI(u.x) * scale; q[c * 8 + 2] = BLO(u.y) * scale; q[c * 8 + 3] = BHI(u.y) * scale;
    q[c * 8 + 4] = BLO(u.z) * scale; q[c * 8 + 5] = BHI(u.z) * scale; q[c * 8 + 6] = BLO(u.w) * scale; q[c * 8 + 7] = BHI(u.w) * scale;
  }
}
template <int D>
DI float dot_q(const float (&q)[D], const uint4* kr) {
  float s = 0.f;
#pragma unroll
  for (int c = 0; c < D / 8; ++c) {
    uint4 u = kr[c];
    s += q[c * 8 + 0] * BLO(u.x) + q[c * 8 + 1] * BHI(u.x) + q[c * 8 + 2] * BLO(u.y) + q[c * 8 + 3] * BHI(u.y) +
         q[c * 8 + 4] * BLO(u.z) + q[c * 8 + 5] * BHI(u.z) + q[c * 8 + 6] * BLO(u.w) + q[c * 8 + 7] * BHI(u.w);
  }
  return s;
}
DI void write_y(const float (&o)[64], float l, bf16_t* gate_io) {
  float inv = 1.0f / l;
#pragma unroll
  for (int c = 0; c < 8; ++c) {
    uint4 u = *(const uint4*)(gate_io + c * 8);
    float g[8] = {BLO(u.x), BHI(u.x), BLO(u.y), BHI(u.y), BLO(u.z), BHI(u.z), BLO(u.w), BHI(u.w)};
    float y[8];
#pragma unroll
    for (int j = 0; j < 8; ++j) y[j] = o[c * 8 + j] * inv * g[j] / (1.0f + __expf(-g[j]));
    uint4 w; w.x = pack2(y[0], y[1]); w.y = pack2(y[2], y[3]); w.z = pack2(y[4], y[5]); w.w = pack2(y[6], y[7]);
    *(uint4*)(gate_io + c * 8) = w;
  }
}
template <int DQK>
DI void attn_dense_naive(const bf16_t* qptr, const bf16_t* Kbase, int ldk, const bf16_t* Vbase, int ldv, float scale,
                         bf16_t* gate_io, char* smem) {
  bf16_t* sK = (bf16_t*)smem; bf16_t* sV = sK + 64 * DQK;
  float q[DQK]; load_q<DQK>(q, qptr, scale);
  float o[64];
#pragma unroll
  for (int d = 0; d < 64; ++d) o[d] = 0.f;
  float m = -1e30f, l = 0.f;
  constexpr int CPR = DQK / 8;
  for (int k0 = 0; k0 < SEQ; k0 += 64) {
    __syncthreads();
    for (int c = threadIdx.x; c < 64 * CPR; c += 256) { int r = c / CPR, cc = c % CPR; *(uint4*)(sK + r * DQK + cc * 8) = *(const uint4*)(Kbase + (size_t)(k0 + r) * ldk + cc * 8); }
    for (int c = threadIdx.x; c < 512; c += 256) { int r = c >> 3, cc = c & 7; *(uint4*)(sV + r * 64 + cc * 8) = *(const uint4*)(Vbase + (size_t)(k0 + r) * ldv + cc * 8); }
    __syncthreads();
    for (int kk = 0; kk < 64; ++kk) {
      float s = dot_q<DQK>(q, (const uint4*)(sK + kk * DQK));
      sm_update(s, m, l, o, (const uint4*)(sV + kk * 64));
    }
  }
  write_y(o, l, gate_io);
}
DI void band_accum(float& m, float& l, float (&o)[64], const float (&q)[64], const bf16_t* kbase, const bf16_t* vbase,
                   int pos, int r, int W, const float* lut) {
  for (int off = -W; off <= W; ++off) {
    int kp = pos + off * r;
    if (kp < 0 || kp >= SEQ) continue;
    float s = dot_q<64>(q, (const uint4*)(kbase + (size_t)kp * PW)) + lut[off + W];
    sm_update(s, m, l, o, (const uint4*)(vbase + (size_t)kp * PW));
  }
}
DI void attn_item(const Params& p, int l, int item, char* smem) {
  const int tid = threadIdx.x;
  if (item < 1024) {
    const int br = item >> 9; const int it = item & 511;
    const int bh = it >> 5, qb = it & 31, b = bh >> 2, h = bh & 3;
    const size_t t = (size_t)b * SEQ + qb * 256 + tid;
    bf16_t* gate_io = p.proj + t * PW + C_GATE + br * 256 + h * 64;
    if (br == 0)
      attn_dense_naive<96>(p.qa + t * 384 + h * 96, p.ka + (size_t)b * SEQ * 384 + h * 96, 384, p.va + (size_t)b * SEQ * 256 + h * 64, 256,
                           0.10206207261596575f, gate_io, smem);
    else
      attn_dense_naive<64>(p.proj + t * PW + C_BQ + h * 64, p.proj + (size_t)b * SEQ * PW + C_BK + (h >> 1) * 64, PW,
                           p.proj + (size_t)b * SEQ * PW + C_BV + (h >> 1) * 64, PW, 0.125f, gate_io, smem);
  } else if (item < 1536) {
    const int it = item - 1024; const int tb = it >> 2, h = it & 3;
    const size_t t = (size_t)tb * 256 + tid; const int b = (int)(t >> 13), pos = (int)(t & (SEQ - 1));
    const bf16_t* base = p.proj + (size_t)b * SEQ * PW;
    float o[64];
#pragma unroll
    for (int d = 0; d < 64; ++d) o[d] = 0.f;
    float m = -1e30f, ll = 0.f;
    for (int g = 0; g < 3; ++g) {
      float q[64]; load_q<64>(q, p.proj + t * PW + C_CQ + g * 256 + h * 64, 0.125f);
      band_accum(m, ll, o, q, base + C_CK + g * 256 + h * 64, base + C_CV + g * 256 + h * 64, pos, g == 0 ? 1 : (g == 1 ? 4 : 16), 64,
                 p.lutC + (g * 4 + h) * 129);
    }
    write_y(o, ll, p.proj + t * PW + C_GATE + 512 + h * 64);
  } else {
    const int it = item - 1536; const int tb = it >> 2, hq = it & 3;
    const size_t t = (size_t)tb * 256 + tid; const int b = (int)(t >> 13), pos = (int)(t & (SEQ - 1));
    const bf16_t* base = p.proj + (size_t)b * SEQ * PW;
    float o[64];
#pragma unroll
    for (int d = 0; d < 64; ++d) o[d] = 0.f;
    float m = p.sink[l * 4 + hq], ll = 1.0f;
    float q[64]; load_q<64>(q, p.proj + t * PW + C_DQ + hq * 64, 0.125f);
    band_accum(m, ll, o, q, base + C_DK + (hq >> 1) * 64, base + C_DV + (hq >> 1) * 64, pos, 1, 128, p.lutD + hq * 257);
    write_y(o, ll, p.proj + t * PW + C_GATE + 768 + hq * 64);
  }
}

DI void merge_tile(const Params& p, int l, int tile, char* smem) {
  bf16_t* sA = (bf16_t*)smem; bf16_t* sB = sA + 128 * LLD;
  const int mt = tile & 255, nt = tile >> 8;
  f32x4 accM[4][2]; zero_acc<2>(accM);
  for (int n = 0; n < 4; ++n) {
    f32x4 accG[4][2]; zero_acc<2>(accG);
    gemm_mainloop<2>(accG, p.xn + (size_t)mt * 128 * 1024, 1024, p.Wmt + ((size_t)l * 4096 + n * 1024 + nt * 64) * 1024, 1024, 1024, sA, sB);
    f32x4 accB[4][2]; zero_acc<2>(accB);
    gemm_mainloop<2>(accB, p.proj + (size_t)mt * 128 * PW + C_GATE + n * 256, PW, p.Wbt + ((size_t)(l * 4 + n) * 1024 + nt * 64) * 256, 256, 256, sA, sB);
#pragma unroll
    for (int mi = 0; mi < 4; ++mi)
#pragma unroll
      for (int ni = 0; ni < 2; ++ni)
#pragma unroll
        for (int j = 0; j < 4; ++j) accM[mi][ni][j] += accB[mi][ni][j] / (1.0f + __expf(-accG[mi][ni][j]));
  }
  const int lane = threadIdx.x & 63, wid = threadIdx.x >> 6, wm = wid >> 1, wn = wid & 1, fr = lane & 15, fq = lane >> 4;
#pragma unroll
  for (int mi = 0; mi < 4; ++mi)
#pragma unroll
    for (int ni = 0; ni < 2; ++ni) {
      size_t row = (size_t)mt * 128 + wm * 64 + mi * 16 + fr; int col = nt * 64 + wn * 32 + ni * 16 + fq * 4;
      uint2 o; o.x = pack2(accM[mi][ni][0], accM[mi][ni][1]); o.y = pack2(accM[mi][ni][2], accM[mi][ni][3]);
      *(uint2*)(p.proj + row * PW + C_MERGED + col) = o;
    }
}

DI void outproj_tile(const Params& p, int l, int tile, char* smem) {
  bf16_t* sA = (bf16_t*)smem; bf16_t* sB = sA + 128 * LLD;
  const int mt = tile & 255, nt = tile >> 8;
  f32x4 acc[4][4]; zero_acc<4>(acc);
  gemm_mainloop<4>(acc, p.proj + (size_t)mt * 128 * PW + C_MERGED, PW, p.Wot + ((size_t)l * 1024 + nt * 128) * 1024, 1024, 1024, sA, sB);
  const float* xin = l == 0 ? p.x : p.out;
  const int lane = threadIdx.x & 63, wid = threadIdx.x >> 6, wm = wid >> 1, wn = wid & 1, fr = lane & 15, fq = lane >> 4;
#pragma unroll
  for (int mi = 0; mi < 4; ++mi)
#pragma unroll
    for (int ni = 0; ni < 4; ++ni) {
      size_t row = (size_t)mt * 128 + wm * 64 + mi * 16 + fr; int col = nt * 128 + wn * 64 + ni * 16 + fq * 4;
      float4 xi = *(const float4*)(xin + row * 1024 + col);
      float4 o; o.x = xi.x + acc[mi][ni][0]; o.y = xi.y + acc[mi][ni][1]; o.z = xi.z + acc[mi][ni][2]; o.w = xi.w + acc[mi][ni][3];
      *(float4*)(p.out + row * 1024 + col) = o;
    }
}

DI void run_phase(const Params& p, int ph, char* smem) {
  const int G = gridDim.x, B = blockIdx.x;
  if (ph == 0) {
    for (int i = B; i < 6097; i += G) prep_item(p, i, (float*)smem);
    for (int i = B; i < 1024; i += G) norm_rows_bf16(p.x, p.norm_g, p.xn, i);
  } else if (ph == 12) {
    for (int i = B; i < 1024; i += G) norm_rows_f32(p.out, p.final_g, i);
  } else if (ph == 6) {
    for (int i = B; i < 1024; i += G) norm_rows_bf16(p.out, p.norm_g + 1024, p.xn, i);
  } else {
    const int l = ph > 6 ? 1 : 0; const int s = ph > 6 ? ph - 7 : ph - 1;
    if (s == 0) { for (int i = B; i < 256 * 38; i += G) inproj_tile(p, l, i, smem); }
    else if (s == 1) { for (int i = B; i < 2048; i += G) mla_item(p, l, i, smem); }
    else if (s == 2) { for (int i = B; i < 2048; i += G) attn_item(p, l, i, smem); }
    else if (s == 3) { for (int i = B; i < 256 * 16; i += G) merge_tile(p, l, i, smem); }
    else { for (int i = B; i < 256 * 8; i += G) outproj_tile(p, l, i, smem); }
  }
}

__global__ void __launch_bounds__(256) mega(Params p, int ph_lo, int ph_hi) {
  __shared__ __attribute__((aligned(16))) char smem[40960];
  cg::grid_group grid = cg::this_grid();
  for (int ph = ph_lo; ph < ph_hi; ++ph) {
    run_phase(p, ph, smem);
    if (ph + 1 < ph_hi) grid.sync();
  }
}

extern "C" void kernel_launch(void* const* d_in, const int* in_sizes, int n_in, void* d_out, int out_size, void* d_ws,
                              size_t ws_size, hipStream_t stream) {
  Params p{};
  p.x = (const float*)d_in[0]; p.norm_g = (const float*)d_in[1]; p.w_in = (const float*)d_in[2];
  p.q_norm_g = (const float*)d_in[3]; p.kv_norm_g = (const float*)d_in[4]; p.w_q_up = (const float*)d_in[5];
  p.w_kv_up = (const float*)d_in[6]; p.gq_g = (const float*)d_in[7]; p.gk_g = (const float*)d_in[8];
  p.sink = (const float*)d_in[9]; p.t5 = (const float*)d_in[10]; p.w_branch = (const float*)d_in[11];
  p.w_out = (const float*)d_in[12]; p.final_g = (const float*)d_in[13];
  p.out = (float*)d_out;
  char* w = (char*)d_ws; size_t off = 0;
  auto take = [&](size_t bytes) { char* r = w + off; off += (bytes + 255) & ~(size_t)255; return r; };
  p.W1t = (bf16_t*)take((size_t)2 * 4864 * 1024 * 2);
  p.Wmt = (bf16_t*)take((size_t)2 * 4096 * 1024 * 2);
  p.Wot = (bf16_t*)take((size_t)2 * 1024 * 1024 * 2);
  p.Wbt = (bf16_t*)take((size_t)2 * 4 * 1024 * 256 * 2);
  p.Wqt = (bf16_t*)take((size_t)2 * 384 * 256 * 2);
  p.Wkvt = (bf16_t*)take((size_t)2 * 512 * 128 * 2);
  p.rope = (float*)take((size_t)8192 * 32 * 4);
  p.lutC = (float*)take(8192);
  p.lutD = (float*)take(8192);
  p.xn = (bf16_t*)take((size_t)32768 * 1024 * 2);
  p.proj = (bf16_t*)take((size_t)32768 * PW * 2);
  p.qa = (bf16_t*)take((size_t)32768 * 384 * 2);
  p.ka = (bf16_t*)take((size_t)32768 * 384 * 2);
  p.va = (bf16_t*)take((size_t)32768 * 256 * 2);
  if (off > ws_size) { fprintf(stderr, "workspace too small: need %zu have %zu\n", off, ws_size); return; }

  static int grid_blocks = 0;
  if (!grid_blocks) {
    int dev = 0, cus = 0, per_cu = 0;
    hipGetDevice(&dev);
    hipDeviceGetAttribute(&cus, hipDeviceAttributeMultiprocessorCount, dev);
    hipOccupancyMaxActiveBlocksPerMultiprocessor(&per_cu, mega, 256, 0);
    if (per_cu < 1) per_cu = 1;
    if (per_cu > 2) per_cu = 2;
    grid_blocks = cus * per_cu;
  }
  int lo = 0, hi = 13;
  void* args[] = {&p, &lo, &hi};
  hipError_t e = hipLaunchCooperativeKernel((void*)mega, dim3(grid_blocks), dim3(256), args, 0, stream);
  if (e != hipSuccess) fprintf(stderr, "cooperative launch failed: %s (grid %d)\n", hipGetErrorString(e), grid_blocks);
}
```

```cpp
#include <hip/hip_runtime.h>
#include <hip/hip_cooperative_groups.h>
#include <cstdio>
namespace cg = cooperative_groups;

typedef unsigned short bf16_t;
using bf16x8 = __attribute__((ext_vector_type(8))) short;
using f32x4 = __attribute__((ext_vector_type(4))) float;
using u32x4 = __attribute__((ext_vector_type(4))) unsigned;
using f32x16 = __attribute__((ext_vector_type(16))) float;
using bf16x4 = __attribute__((ext_vector_type(4))) short;
#define DI __device__ __forceinline__

constexpr int SEQ = 8192;
constexpr int PW = 4864;
constexpr int C_BQ = 0, C_BK = 256, C_BV = 384, C_CQ = 512, C_CK = 1280, C_CV = 2048, C_DQ = 2816, C_DK = 3072,
              C_DV = 3200, C_GATE = 3328, C_AQ = 4352, C_AKV = 4608, C_AKR = 4736;
constexpr int C_MERGED = 512;

struct Params {
  const float* x; const float* norm_g; const float* w_in; const float* q_norm_g; const float* kv_norm_g;
  const float* w_q_up; const float* w_kv_up; const float* gq_g; const float* gk_g; const float* sink;
  const float* t5; const float* w_branch; const float* w_out; const float* final_g;
  float* out;
  bf16_t* W1t; bf16_t* Wmt; bf16_t* Wot; bf16_t* Wbt; bf16_t* Wqt; bf16_t* Wkvt;
  float* rope; float* lutC; float* lutD;
  bf16_t* xn; bf16_t* proj; bf16_t* qa; bf16_t* ka; bf16_t* va;
};

DI unsigned short f2bf(float x) { unsigned u = __float_as_uint(x); u += 0x7fffu + ((u >> 16) & 1u); return (unsigned short)(u >> 16); }
DI float bf2f(unsigned short b) { return __uint_as_float(((unsigned)b) << 16); }
typedef __bf16 bf2_t __attribute__((ext_vector_type(2)));
typedef float f2_t __attribute__((ext_vector_type(2)));
DI unsigned pack2(float a, float b) { f2_t v = {a, b}; bf2_t r = __builtin_convertvector(v, bf2_t); return __builtin_bit_cast(unsigned, r); }
constexpr float LOG2E = 1.4426950408889634f;
constexpr float QS64 = 0.125f * LOG2E;
constexpr float QS96 = 0.10206207261596575f * LOG2E;
#define BLO(u) __uint_as_float((u) << 16)
#define BHI(u) __uint_as_float((u) & 0xffff0000u)
DI float wave_sum(float v) {
#pragma unroll
  for (int o = 32; o; o >>= 1) v += __shfl_xor(v, o);
  return v;
}

DI int srccol(int mode, int n) {
  if (mode == 0) return n < 4352 ? n + 416 : (n < 4768 ? n - 4352 : -1);
  if (mode == 1) return 4768 + n;
  if (mode == 2) return n;
  return n < 256 ? (n >> 6) * 96 + (n & 63) : ((n - 256) >> 5) * 96 + 64 + ((n - 256) & 31);
}
DI void conv_tile(const float* __restrict__ src, int ld, int K, bf16_t* __restrict__ dst, int n0, int k0, int mode,
                  const float* __restrict__ rs, float* tile) {
  const int tx = threadIdx.x & 63, ty = threadIdx.x >> 6;
  __syncthreads();
  const int sc = srccol(mode, n0 + tx);
  const int nq = n0 + tx;
  const float cscale = (mode == 0 && ((nq >= C_CQ && nq < C_CQ + 768) || (nq >= C_DQ && nq < C_DQ + 256))) ? QS64 : 1.0f;
#pragma unroll
  for (int i = 0; i < 16; ++i) {
    int kk = ty + 4 * i;
    float v = sc >= 0 ? src[(size_t)(k0 + kk) * ld + sc] : 0.f;
    if (rs) v *= rs[k0 + kk];
    tile[kk * 65 + tx] = v * cscale;
  }
  __syncthreads();
#pragma unroll
  for (int i = 0; i < 16; ++i) {
    int nn = ty + 4 * i;
    dst[(size_t)(n0 + nn) * K + k0 + tx] = f2bf(tile[tx * 65 + nn]);
  }
}

DI int t5_bucket(int rel) {
  int n = rel < 0 ? -rel : rel;
  float nf = (float)(n < 1 ? 1 : n);
  int large = 8 + (int)(logf(nf / 8.0f) / 4.852030263919617f * 8.0f);
  if (large > 15) large = 15;
  return (rel > 0 ? 16 : 0) + (n < 8 ? n : large);
}

DI void prep_item(const Params& p, int item, float* tile) {
  if (item < 5584) {
    int l = item / 2792, r = item % 2792;
    const float* src; int ld, K, mode, t; bf16_t* dst; const float* rs = nullptr;
    if (r < 1216) { t = r; src = p.w_in + (size_t)l * 1024 * 8864; ld = 8864; K = 1024; mode = 0; dst = p.W1t + (size_t)l * 4864 * 1024; }
    else if (r < 2240) { t = r - 1216; src = p.w_in + (size_t)l * 1024 * 8864; ld = 8864; K = 1024; mode = 1; dst = p.Wmt + (size_t)l * 4096 * 1024; }
    else if (r < 2496) { t = r - 2240; src = p.w_out + (size_t)l * 1024 * 1024; ld = 1024; K = 1024; mode = 2; dst = p.Wot + (size_t)l * 1024 * 1024; }
    else if (r < 2752) { t = r - 2496; int n = t >> 6; t &= 63; src = p.w_branch + (size_t)(l * 4 + n) * 256 * 1024; ld = 1024; K = 256; mode = 2; dst = p.Wbt + (size_t)(l * 4 + n) * 1024 * 256; }
    else if (r < 2776) { t = r - 2752; src = p.w_q_up + (size_t)l * 256 * 384; ld = 384; K = 256; mode = 3; dst = p.Wqt + (size_t)l * 384 * 256; rs = p.q_norm_g + l * 256; }
    else { t = r - 2776; src = p.w_kv_up + (size_t)l * 128 * 512; ld = 512; K = 128; mode = 2; dst = p.Wkvt + (size_t)l * 512 * 128; rs = p.kv_norm_g + l * 128; }
    int kt = K / 64;
    conv_tile(src, ld, K, dst, (t / kt) * 64, (t % kt) * 64, mode, rs, tile);
  } else if (item < 5584 + 512) {
    int idx = (item - 5584) * 256 + threadIdx.x;
    int pos = idx >> 4, i = idx & 15;
    double invd = 1.0;
    for (int k = 0; k < i; ++k) invd *= 0.5623413251903491;
    float inv = (float)invd;
    float ang = (float)pos * inv;
    double a = (double)ang;
    double kq = rint(a * 0.15915494309189535);
    double r = a - kq * 6.283185307179586;
    double r2 = r * r, ts = r, tc = 1.0, sn = r, cs = 1.0;
    for (int k = 1; k <= 14; ++k) {
      tc = -tc * r2 / (double)((2 * k - 1) * (2 * k));
      ts = -ts * r2 / (double)((2 * k) * (2 * k + 1));
      cs += tc; sn += ts;
    }
    p.rope[pos * 32 + i] = (float)cs;
    p.rope[pos * 32 + 16 + i] = (float)sn;
  } else {
    for (int e = threadIdx.x; e < 12 * 129; e += 256) {
      int gh = e / 129, off = e % 129 - 64; int g = gh >> 2;
      int r = g == 0 ? 1 : (g == 1 ? 4 : 16);
      p.lutC[e] = p.t5[t5_bucket(off * r) * 16 + gh] * LOG2E;
    }
    for (int e = threadIdx.x; e < 4 * 257; e += 256) {
      int hq = e / 257, off = e % 257 - 128;
      p.lutD[e] = p.t5[t5_bucket(off) * 16 + 12 + hq] * LOG2E;
    }
  }
}

DI void norm_rows_bf16(const float* __restrict__ src, const float* __restrict__ g, bf16_t* __restrict__ dst, int item) {
  const int lane = threadIdx.x & 63, wid = threadIdx.x >> 6;
  for (int i = 0; i < 8; ++i) {
    size_t row = (size_t)item * 32 + wid * 8 + i;
    const float4* s = (const float4*)(src + row * 1024);
    float4 v[4]; float ss = 0.f;
#pragma unroll
    for (int j = 0; j < 4; ++j) { v[j] = s[lane + 64 * j]; ss += v[j].x * v[j].x + v[j].y * v[j].y + v[j].z * v[j].z + v[j].w * v[j].w; }
    ss = wave_sum(ss);
    float sc = rsqrtf(ss * (1.0f / 1024.0f) + 1e-6f);
#pragma unroll
    for (int j = 0; j < 4; ++j) {
      float4 gg = ((const float4*)g)[lane + 64 * j];
      uint2 o; o.x = pack2(v[j].x * sc * gg.x, v[j].y * sc * gg.y); o.y = pack2(v[j].z * sc * gg.z, v[j].w * sc * gg.w);
      *(uint2*)(dst + row * 1024 + (lane + 64 * j) * 4) = o;
    }
  }
}
DI void norm_rows_f32(float* io, const float* __restrict__ g, int item) {
  const int lane = threadIdx.x & 63, wid = threadIdx.x >> 6;
  for (int i = 0; i < 8; ++i) {
    size_t row = (size_t)item * 32 + wid * 8 + i;
    float4* s = (float4*)(io + row * 1024);
    float4 v[4]; float ss = 0.f;
#pragma unroll
    for (int j = 0; j < 4; ++j) { v[j] = s[lane + 64 * j]; ss += v[j].x * v[j].x + v[j].y * v[j].y + v[j].z * v[j].z + v[j].w * v[j].w; }
    ss = wave_sum(ss);
    float sc = rsqrtf(ss * (1.0f / 1024.0f) + 1e-6f);
#pragma unroll
    for (int j = 0; j < 4; ++j) {
      float4 gg = ((const float4*)g)[lane + 64 * j];
      float4 o; o.x = v[j].x * sc * gg.x; o.y = v[j].y * sc * gg.y; o.z = v[j].z * sc * gg.z; o.w = v[j].w * sc * gg.w;
      s[lane + 64 * j] = o;
    }
  }
}

constexpr int LLD = 72;
template <int NT>
DI void gemm_mainloop(f32x4 (&acc)[4][NT], const bf16_t* A, int lda, const bf16_t* Bt, int ldb, int K, bf16_t* sA, bf16_t* sB) {
  constexpr int NB = NT;
  const int tid = threadIdx.x, lane = tid & 63, wid = tid >> 6;
  const int wm = wid >> 1, wn = wid & 1, fr = lane & 15, fq = lane >> 4;
  u32x4 ra[4], rb[NB];
  const int nk = K >> 6;
#pragma unroll
  for (int i = 0; i < 4; ++i) { int c = tid + 256 * i; ra[i] = *(const u32x4*)(A + (size_t)(c >> 3) * lda + (c & 7) * 8); }
#pragma unroll
  for (int i = 0; i < NB; ++i) { int c = tid + 256 * i; rb[i] = *(const u32x4*)(Bt + (size_t)(c >> 3) * ldb + (c & 7) * 8); }
  for (int kt = 0; kt < nk; ++kt) {
    __syncthreads();
#pragma unroll
    for (int i = 0; i < 4; ++i) { int c = tid + 256 * i; *(u32x4*)(sA + (c >> 3) * LLD + (c & 7) * 8) = ra[i]; }
#pragma unroll
    for (int i = 0; i < NB; ++i) { int c = tid + 256 * i; *(u32x4*)(sB + (c >> 3) * LLD + (c & 7) * 8) = rb[i]; }
    __syncthreads();
    if (kt + 1 < nk) {
      int ko = (kt + 1) * 64;
#pragma unroll
      for (int i = 0; i < 4; ++i) { int c = tid + 256 * i; ra[i] = *(const u32x4*)(A + (size_t)(c >> 3) * lda + ko + (c & 7) * 8); }
#pragma unroll
      for (int i = 0; i < NB; ++i) { int c = tid + 256 * i; rb[i] = *(const u32x4*)(Bt + (size_t)(c >> 3) * ldb + ko + (c & 7) * 8); }
    }
#pragma unroll
    for (int ks = 0; ks < 2; ++ks) {
      bf16x8 af[4], bfr[NT];
#pragma unroll
      for (int mi = 0; mi < 4; ++mi) af[mi] = *(const bf16x8*)(sA + (wm * 64 + mi * 16 + fr) * LLD + ks * 32 + fq * 8);
#pragma unroll
      for (int ni = 0; ni < NT; ++ni) bfr[ni] = *(const bf16x8*)(sB + (wn * NT * 16 + ni * 16 + fr) * LLD + ks * 32 + fq * 8);
#pragma unroll
      for (int mi = 0; mi < 4; ++mi)
#pragma unroll
        for (int ni = 0; ni < NT; ++ni) acc[mi][ni] = __builtin_amdgcn_mfma_f32_16x16x32_bf16(bfr[ni], af[mi], acc[mi][ni], 0, 0, 0);
    }
  }
}
template <int NT>
DI void zero_acc(f32x4 (&acc)[4][NT]) {
#pragma unroll
  for (int mi = 0; mi < 4; ++mi)
#pragma unroll
    for (int ni = 0; ni < NT; ++ni) acc[mi][ni] = f32x4{0.f, 0.f, 0.f, 0.f};
}

DI void inproj_tile(const Params& p, int l, int tile, char* smem) {
  bf16_t* sA = (bf16_t*)smem; bf16_t* sB = sA + 128 * LLD;
  const int mt = tile & 255, nt = tile >> 8;
  f32x4 acc[4][4]; zero_acc<4>(acc);
  gemm_mainloop<4>(acc, p.xn + (size_t)mt * 128 * 1024, 1024, p.W1t + ((size_t)l * 4864 + nt * 128) * 1024, 1024, 1024, sA, sB);
  const int lane = threadIdx.x & 63, wid = threadIdx.x >> 6, wm = wid >> 1, wn = wid & 1, fr = lane & 15, fq = lane >> 4;
#pragma unroll
  for (int mi = 0; mi < 4; ++mi)
#pragma unroll
    for (int ni = 0; ni < 4; ++ni) {
      size_t row = (size_t)mt * 128 + wm * 64 + mi * 16 + fr; int col = nt * 128 + wn * 64 + ni * 16 + fq * 4;
      uint2 o; o.x = pack2(acc[mi][ni][0], acc[mi][ni][1]); o.y = pack2(acc[mi][ni][2], acc[mi][ni][3]);
      *(uint2*)(p.proj + row * PW + col) = o;
    }
}

DI void row_scales(const bf16_t* A, int lda, int K, float* sRow) {
  const int row = threadIdx.x >> 1, half = threadIdx.x & 1;
  const int per = K >> 1;
  const bf16_t* a = A + (size_t)row * lda + half * per;
  float ss = 0.f;
  for (int c = 0; c < per; c += 8) {
    uint4 u = *(const uint4*)(a + c);
    float f;
    f = BLO(u.x); ss += f * f; f = BHI(u.x); ss += f * f; f = BLO(u.y); ss += f * f; f = BHI(u.y); ss += f * f;
    f = BLO(u.z); ss += f * f; f = BHI(u.z); ss += f * f; f = BLO(u.w); ss += f * f; f = BHI(u.w); ss += f * f;
  }
  ss += __shfl_xor(ss, 1);
  if (half == 0) sRow[row] = rsqrtf(ss / (float)K + 1e-6f);
}
DI void mla_item(const Params& p, int l, int item, char* smem) {
  bf16_t* sA = (bf16_t*)smem; bf16_t* sB = sA + 128 * LLD; float* sRow = (float*)(sB + 128 * LLD);
  const int lane = threadIdx.x & 63, wid = threadIdx.x >> 6, wm = wid >> 1, wn = wid & 1, fr = lane & 15, fq = lane >> 4;
  if (item < 768) {
    const int mt = item & 255, nt = item >> 8;
    const bf16_t* A = p.proj + (size_t)mt * 128 * PW + C_AQ;
    __syncthreads();
    row_scales(A, PW, 256, sRow);
    f32x4 acc[4][4]; zero_acc<4>(acc);
    gemm_mainloop<4>(acc, A, PW, p.Wqt + ((size_t)l * 384 + nt * 128) * 256, 256, 256, sA, sB);
    if (nt < 2) {
#pragma unroll
      for (int mi = 0; mi < 4; ++mi)
#pragma unroll
        for (int ni = 0; ni < 4; ++ni) {
          int rl = wm * 64 + mi * 16 + fr; size_t t = (size_t)mt * 128 + rl; float s = sRow[rl] * QS96;
          int c = nt * 128 + wn * 64 + ni * 16 + fq * 4; int h = c >> 6, d = c & 63;
          uint2 o; o.x = pack2(acc[mi][ni][0] * s, acc[mi][ni][1] * s); o.y = pack2(acc[mi][ni][2] * s, acc[mi][ni][3] * s);
          *(uint2*)(p.qa + t * 384 + h * 96 + d) = o;
        }
    } else {
#pragma unroll
      for (int mi = 0; mi < 4; ++mi)
#pragma unroll
        for (int np = 0; np < 2; ++np) {
          int rl = wm * 64 + mi * 16 + fr; size_t t = (size_t)mt * 128 + rl; float s = sRow[rl] * QS96;
          int pos = (int)(t & (SEQ - 1)); int h = wn * 2 + np;
          const float* cs = p.rope + pos * 32 + fq * 4;
          float o1[4], o2[4];
#pragma unroll
          for (int j = 0; j < 4; ++j) {
            float x1 = acc[mi][np * 2][j] * s, x2 = acc[mi][np * 2 + 1][j] * s; float c = cs[j], sn = cs[16 + j];
            o1[j] = x1 * c - x2 * sn; o2[j] = x1 * sn + x2 * c;
          }
          uint2 a; a.x = pack2(o1[0], o1[1]); a.y = pack2(o1[2], o1[3]);
          uint2 b; b.x = pack2(o2[0], o2[1]); b.y = pack2(o2[2], o2[3]);
          *(uint2*)(p.qa + t * 384 + h * 96 + 64 + fq * 4) = a;
          *(uint2*)(p.qa + t * 384 + h * 96 + 80 + fq * 4) = b;
        }
    }
  } else if (item < 768 + 1024) {
    const int it = item - 768; const int mt = it & 255, h = it >> 8;
    const bf16_t* A = p.proj + (size_t)mt * 128 * PW + C_AKV;
    __syncthreads();
    row_scales(A, PW, 128, sRow);
    f32x4 acc[4][4]; zero_acc<4>(acc);
    gemm_mainloop<4>(acc, A, PW, p.Wkvt + ((size_t)l * 512 + h * 128) * 128, 128, 128, sA, sB);
#pragma unroll
    for (int mi = 0; mi < 4; ++mi)
#pragma unroll
      for (int ni = 0; ni < 4; ++ni) {
        int rl = wm * 64 + mi * 16 + fr; size_t t = (size_t)mt * 128 + rl; float s = sRow[rl];
        int d = ni * 16 + fq * 4;
        uint2 o; o.x = pack2(acc[mi][ni][0] * s, acc[mi][ni][1] * s); o.y = pack2(acc[mi][ni][2] * s, acc[mi][ni][3] * s);
        if (wn == 0) *(uint2*)(p.ka + t * 384 + h * 96 + d) = o;
        else *(uint2*)(p.va + t * 256 + h * 64 + d) = o;
      }
  } else {
    const int it = item - 1792;
    const int half = lane >> 5, pl = lane & 31;
    for (int i = 0; i < 32; ++i) {
      size_t t = (size_t)it * 128 + wid * 32 + i; int pos = (int)(t & (SEQ - 1));
      bf16_t* row = p.proj + t * PW;
#pragma unroll
      for (int s3 = 0; s3 < 3; ++s3) {
        int slot = s3 * 2 + half;
        bf16_t* hp = row + (slot < 4 ? C_BQ + slot * 64 : C_BK + (slot - 4) * 64);
        const float* g = (slot < 4 ? p.gq_g : p.gk_g) + l * 64;
        int d1, fi, ap;
        if (pl < 16) { d1 = pl; fi = pl; ap = pos >> 6; } else { d1 = 32 + (pl - 16); fi = pl - 16; ap = pos & 63; }
        float x1 = bf2f(hp[d1]), x2 = bf2f(hp[d1 + 16]);
        float ss = x1 * x1 + x2 * x2;
#pragma unroll
        for (int o = 16; o; o >>= 1) ss += __shfl_xor(ss, o);
        float sc = rsqrtf(ss * (1.0f / 64.0f) + 1e-6f);
        if (slot < 4) sc *= QS64;
        x1 = x1 * sc * g[d1]; x2 = x2 * sc * g[d1 + 16];
        float c = p.rope[ap * 32 + fi], sn = p.rope[ap * 32 + 16 + fi];
        hp[d1] = f2bf(x1 * c - x2 * sn); hp[d1 + 16] = f2bf(x1 * sn + x2 * c);
      }
      if (lane < 16) {
        float x1 = bf2f(row[C_AKR + lane]), x2 = bf2f(row[C_AKR + 16 + lane]);
        float c = p.rope[pos * 32 + lane], sn = p.rope[pos * 32 + 16 + lane];
        bf16_t o1 = f2bf(x1 * c - x2 * sn), o2 = f2bf(x1 * sn + x2 * c);
#pragma unroll
        for (int h = 0; h < 4; ++h) { p.ka[t * 384 + h * 96 + 64 + lane] = o1; p.ka[t * 384 + h * 96 + 80 + lane] = o2; }
      }
    }
  }
}

DI void sm_update(float s, float& m, float& l, float (&o)[64], const uint4* vrow) {
  if (s > m) {
    float c = __builtin_amdgcn_exp2f(m - s); l *= c;
#pragma unroll
    for (int d = 0; d < 64; ++d) o[d] *= c;
    m = s;
  }
  float pe = __builtin_amdgcn_exp2f(s - m); l += pe;
#pragma unroll
  for (int c = 0; c < 8; ++c) {
    uint4 u = vrow[c];
    o[c * 8 + 0] += pe * BLO(u.x); o[c * 8 + 1] += pe * BHI(u.x); o[c * 8 + 2] += pe * BLO(u.y); o[c * 8 + 3] += pe * BHI(u.y);
    o[c * 8 + 4] += pe * BLO(u.z); o[c * 8 + 5] += pe * BHI(u.z); o[c * 8 + 6] += pe * BLO(u.w); o[c * 8 + 7] += pe * BHI(u.w);
  }
}
template <int D>
DI void load_q(float (&q)[D], const bf16_t* qp, float scale) {
#pragma unroll
  for (int c = 0; c < D / 8; ++c) {
    uint4 u = *(const uint4*)(qp + c * 8);
    q[c * 8 + 0] = BLO(u.x) * scale; q[c * 8 + 1] = BHI(u.x) * scale; q[c * 8 + 2] = BLO(u.y) * scale; q[c * 8 + 3] = BHI(u.y) * scale;
    q[c * 8 + 4] = BLO(u.z) * scale; q[c * 8 + 5] = BHI(u.z) * scale; q[c * 8 + 6] = BLO(u.w) * scale; q[c * 8 + 7] = BHI(u.w) * scale;
  }
}
template <int D>
DI float dot_q(const float (&q)[D], const uint4* kr) {
  float s = 0.f;
#pragma unroll
  for (int c = 0; c < D / 8; ++c) {
    uint4 u = kr[c];
    s += q[c * 8 + 0] * BLO(u.x) + q[c * 8 + 1] * BHI(u.x) + q[c * 8 + 2] * BLO(u.y) + q[c * 8 + 3] * BHI(u.y) +
         q[c * 8 + 4] * BLO(u.z) + q[c * 8 + 5] * BHI(u.z) + q[c * 8 + 6] * BLO(u.w) + q[c * 8 + 7] * BHI(u.w);
  }
  return s;
}
DI void write_y(const float (&o)[64], float l, bf16_t* gate_io) {
  float inv = 1.0f / l;
#pragma unroll
  for (int c = 0; c < 8; ++c) {
    uint4 u = *(const uint4*)(gate_io + c * 8);
    float g[8] = {BLO(u.x), BHI(u.x), BLO(u.y), BHI(u.y), BLO(u.z), BHI(u.z), BLO(u.w), BHI(u.w)};
    float y[8];
#pragma unroll
    for (int j = 0; j < 8; ++j) y[j] = o[c * 8 + j] * inv * g[j] / (1.0f + __expf(-g[j]));
    uint4 w; w.x = pack2(y[0], y[1]); w.y = pack2(y[2], y[3]); w.z = pack2(y[4], y[5]); w.w = pack2(y[6], y[7]);
    *(uint4*)(gate_io + c * 8) = w;
  }
}
DI void band_accum(float& m, float& l, float (&o)[64], const float (&q)[64], const bf16_t* kbase, const bf16_t* vbase,
                   int pos, int r, int W, const float* lut) {
  for (int off = -W; off <= W; ++off) {
    int kp = pos + off * r;
    if (kp < 0 || kp >= SEQ) continue;
    float s = dot_q<64>(q, (const uint4*)(kbase + (size_t)kp * PW)) + lut[off + W];
    sm_update(s, m, l, o, (const uint4*)(vbase + (size_t)kp * PW));
  }
}

#define MFMA32(a, b, c) __builtin_amdgcn_mfma_f32_32x32x16_bf16((a), (b), (c), 0, 0, 0)
template <int OFF> DI bf16x4 tr_read(unsigned addr) {
  bf16x4 r; asm volatile("ds_read_b64_tr_b16 %0, %1 offset:%2" : "=&v"(r) : "v"(addr), "i"(OFF) : "memory"); return r;
}
DI float half_swap_max(float v) {
  auto rr = __builtin_amdgcn_permlane32_swap(__float_as_uint(v), __float_as_uint(v), false, false);
  return fmaxf(__uint_as_float(rr[0]), __uint_as_float(rr[1]));
}
DI float half_swap_sum(float v) {
  auto rr = __builtin_amdgcn_permlane32_swap(__float_as_uint(v), __float_as_uint(v), false, false);
  return __uint_as_float(rr[0]) + __uint_as_float(rr[1]);
}
DI bf16x8 pack8(const f32x16& p, int base) {
  u32x4 w = {pack2(p[base + 0], p[base + 1]), pack2(p[base + 2], p[base + 3]), pack2(p[base + 4], p[base + 5]), pack2(p[base + 6], p[base + 7])};
  return __builtin_bit_cast(bf16x8, w);
}
template <int DB, int VLD> DI void pv_block(f32x16& o, unsigned vb, bf16x8 pb0, bf16x8 pb1, bf16x8 pb2, bf16x8 pb3) {
  constexpr int RB = VLD * 2;
  bf16x4 l0 = tr_read<0 * RB + 64 * DB>(vb), h0 = tr_read<8 * RB + 64 * DB>(vb);
  bf16x4 l1 = tr_read<16 * RB + 64 * DB>(vb), h1 = tr_read<24 * RB + 64 * DB>(vb);
  bf16x4 l2 = tr_read<32 * RB + 64 * DB>(vb), h2 = tr_read<40 * RB + 64 * DB>(vb);
  bf16x4 l3 = tr_read<48 * RB + 64 * DB>(vb), h3 = tr_read<56 * RB + 64 * DB>(vb);
  asm volatile("s_waitcnt lgkmcnt(0)" ::: "memory"); __builtin_amdgcn_sched_barrier(0);
  o = MFMA32(__builtin_shufflevector(l0, h0, 0, 1, 2, 3, 4, 5, 6, 7), pb0, o);
  o = MFMA32(__builtin_shufflevector(l1, h1, 0, 1, 2, 3, 4, 5, 6, 7), pb1, o);
  o = MFMA32(__builtin_shufflevector(l2, h2, 0, 1, 2, 3, 4, 5, 6, 7), pb2, o);
  o = MFMA32(__builtin_shufflevector(l3, h3, 0, 1, 2, 3, 4, 5, 6, 7), pb3, o);
}
DI f32x16 splat16(float v) { f32x16 r;
#pragma unroll
  for (int i = 0; i < 16; ++i) r[i] = v;
  return r; }

template <int DQK>
DI void attn_dense_mfma(const bf16_t* Qb, int ldq, const bf16_t* Kb, int ldk, const bf16_t* Vb, int ldv, bf16_t* gate_io, char* smem) {
  constexpr int NS = DQK / 16, KLD = DQK + 8, VLD = 72, CPR = DQK / 8, NKC = (64 * CPR) / 256;
  constexpr int KBYTES = 64 * KLD * 2, VBYTES = 64 * VLD * 2;
  char* sKc = smem; char* sVc = smem + 2 * KBYTES;
  const int tid = threadIdx.x, lane = tid & 63, wid = tid >> 6, r = lane & 31, h = lane >> 5;
  bf16x8 qf[NS];
#pragma unroll
  for (int s = 0; s < NS; ++s) qf[s] = *(const bf16x8*)(Qb + (size_t)(wid * 32 + r) * ldq + 16 * s + 8 * h);
  int krow[NKC], kcc[NKC];
#pragma unroll
  for (int i = 0; i < NKC; ++i) { int c = tid + 256 * i; krow[i] = c / CPR; kcc[i] = c % CPR; }
  const int vrow0 = tid >> 3, vcc = tid & 7;
  u32x4 rk[NKC], rv[2];
#define DLOAD(k0) do { \
    _Pragma("unroll") for (int i = 0; i < NKC; ++i) rk[i] = *(const u32x4*)(Kb + (size_t)((k0) + krow[i]) * ldk + kcc[i] * 8); \
    rv[0] = *(const u32x4*)(Vb + (size_t)((k0) + vrow0) * ldv + vcc * 8); \
    rv[1] = *(const u32x4*)(Vb + (size_t)((k0) + vrow0 + 32) * ldv + vcc * 8); } while (0)
#define DSTORE(st) do { \
    _Pragma("unroll") for (int i = 0; i < NKC; ++i) *(u32x4*)(sKc + (st) * KBYTES + (krow[i] * KLD + kcc[i] * 8) * 2) = rk[i]; \
    *(u32x4*)(sVc + (st) * VBYTES + (vrow0 * VLD + vcc * 8) * 2) = rv[0]; \
    *(u32x4*)(sVc + (st) * VBYTES + ((vrow0 + 32) * VLD + vcc * 8) * 2) = rv[1]; } while (0)
  const unsigned vb0 = (unsigned)(size_t)sVc + (unsigned)(((4 * h + ((lane & 15) >> 2)) * VLD + 16 * ((lane >> 4) & 1) + 4 * (lane & 3)) * 2);
  f32x16 o0 = splat16(0.f), o1 = splat16(0.f), negm = splat16(0.f);
  float m_run = 0.f, l_run = 0.f;
  __syncthreads();
  DLOAD(0); DSTORE(0);
  __syncthreads();
  constexpr int NT = SEQ / 64;
  for (int j = 0; j < NT; ++j) {
    const int cur = j & 1;
    if (j + 1 < NT) DLOAD((j + 1) * 64);
    const bf16_t* sK = (const bf16_t*)(sKc + cur * KBYTES);
    f32x16 p0 = negm, p1 = negm;
#pragma unroll
    for (int s = 0; s < NS; ++s) {
      bf16x8 k0 = *(const bf16x8*)(sK + r * KLD + 16 * s + 8 * h);
      bf16x8 k1 = *(const bf16x8*)(sK + (32 + r) * KLD + 16 * s + 8 * h);
      p0 = MFMA32(k0, qf[s], p0);
      p1 = MFMA32(k1, qf[s], p1);
    }
    float pm = fmaxf(p0[0], p1[0]);
#pragma unroll
    for (int i = 1; i < 16; ++i) pm = fmaxf(pm, fmaxf(p0[i], p1[i]));
    pm = half_swap_max(pm);
    if (j == 0 || __any(pm > 8.0f)) {
      float delta;
      if (j == 0) delta = pm;
      else {
        delta = fmaxf(pm, 0.f);
        float alpha = __builtin_amdgcn_exp2f(-delta);
        l_run *= alpha;
#pragma unroll
        for (int i = 0; i < 16; ++i) { o0[i] *= alpha; o1[i] *= alpha; }
      }
      m_run += delta;
#pragma unroll
      for (int i = 0; i < 16; ++i) { p0[i] -= delta; p1[i] -= delta; }
      negm = splat16(-m_run);
    }
    float ls = 0.f;
#pragma unroll
    for (int i = 0; i < 16; ++i) { p0[i] = __builtin_amdgcn_exp2f(p0[i]); p1[i] = __builtin_amdgcn_exp2f(p1[i]); ls += p0[i] + p1[i]; }
    l_run += ls;
    bf16x8 pb0 = pack8(p0, 0), pb1 = pack8(p0, 8), pb2 = pack8(p1, 0), pb3 = pack8(p1, 8);
    const unsigned vb = vb0 + cur * VBYTES;
    pv_block<0, VLD>(o0, vb, pb0, pb1, pb2, pb3);
    pv_block<1, VLD>(o1, vb, pb0, pb1, pb2, pb3);
    if (j + 1 < NT) DSTORE(cur ^ 1);
    __syncthreads();
  }
#undef DLOAD
#undef DSTORE
  const float inv = 1.0f / half_swap_sum(l_run);
  bf16_t* grow = gate_io + (size_t)(wid * 32 + r) * PW;
#pragma unroll
  for (int db = 0; db < 2; ++db)
#pragma unroll
    for (int g4 = 0; g4 < 4; ++g4) {
      bf16_t* gp = grow + 32 * db + 8 * g4 + 4 * h;
      uint2 u = *(const uint2*)gp;
      float g[4] = {BLO(u.x), BHI(u.x), BLO(u.y), BHI(u.y)};
      float y[4];
#pragma unroll
      for (int e = 0; e < 4; ++e) { float ov = db == 0 ? o0[4 * g4 + e] : o1[4 * g4 + e]; y[e] = ov * inv * g[e] / (1.0f + __expf(-g[e])); }
      uint2 w; w.x = pack2(y[0], y[1]); w.y = pack2(y[2], y[3]);
      *(uint2*)gp = w;
    }
}
DI void dense_item(const Params& p, int combo, int qblk, char* smem) {
  const int br = combo >> 4, bh = combo & 15, b = bh >> 2, h = bh & 3;
  const size_t t0 = (size_t)b * SEQ + qblk * 128;
  bf16_t* gate_io = p.proj + t0 * PW + C_GATE + br * 256 + h * 64;
  if (br == 0)
    attn_dense_mfma<96>(p.qa + t0 * 384 + h * 96, 384, p.ka + (size_t)b * SEQ * 384 + h * 96, 384, p.va + (size_t)b * SEQ * 256 + h * 64, 256, gate_io, smem);
  else
    attn_dense_mfma<64>(p.proj + t0 * PW + C_BQ + h * 64, PW, p.proj + (size_t)b * SEQ * PW + C_BK + (h >> 1) * 64, PW,
                        p.proj + (size_t)b * SEQ * PW + C_BV + (h >> 1) * 64, PW, gate_io, smem);
}

DI void attn_item(const Params& p, int l, int item, char* smem) {
  const int tid = threadIdx.x;
  if (item < 1536) {
    const int it = item - 1024; const int tb = it >> 2, h = it & 3;
    const size_t t = (size_t)tb * 256 + tid; const int b = (int)(t >> 13), pos = (int)(t & (SEQ - 1));
    const bf16_t* base = p.proj + (size_t)b * SEQ * PW;
    float o[64];
#pragma unroll
    for (int d = 0; d < 64; ++d) o[d] = 0.f;
    float m = -1e30f, ll = 0.f;
    for (int g = 0; g < 3; ++g) {
      float q[64]; load_q<64>(q, p.proj + t * PW + C_CQ + g * 256 + h * 64, 1.0f);
      band_accum(m, ll, o, q, base + C_CK + g * 256 + h * 64, base + C_CV + g * 256 + h * 64, pos, g == 0 ? 1 : (g == 1 ? 4 : 16), 64,
                 p.lutC + (g * 4 + h) * 129);
    }
    write_y(o, ll, p.proj + t * PW + C_GATE + 512 + h * 64);
  } else {
    const int it = item - 1536; const int tb = it >> 2, hq = it & 3;
    const size_t t = (size_t)tb * 256 + tid; const int b = (int)(t >> 13), pos = (int)(t & (SEQ - 1));
    const bf16_t* base = p.proj + (size_t)b * SEQ * PW;
    float o[64];
#pragma unroll
    for (int d = 0; d < 64; ++d) o[d] = 0.f;
    float m = p.sink[l * 4 + hq] * LOG2E, ll = 1.0f;
    float q[64]; load_q<64>(q, p.proj + t * PW + C_DQ + hq * 64, 1.0f);
    band_accum(m, ll, o, q, base + C_DK + (hq >> 1) * 64, base + C_DV + (hq >> 1) * 64, pos, 1, 128, p.lutD + hq * 257);
    write_y(o, ll, p.proj + t * PW + C_GATE + 768 + hq * 64);
  }
}

DI void merge_tile(const Params& p, int l, int tile, char* smem) {
  bf16_t* sA = (bf16_t*)smem; bf16_t* sB = sA + 128 * LLD;
  const int mt = tile & 255, nt = tile >> 8;
  f32x4 accM[4][2]; zero_acc<2>(accM);
  for (int n = 0; n < 4; ++n) {
    f32x4 accG[4][2]; zero_acc<2>(accG);
    gemm_mainloop<2>(accG, p.xn + (size_t)mt * 128 * 1024, 1024, p.Wmt + ((size_t)l * 4096 + n * 1024 + nt * 64) * 1024, 1024, 1024, sA, sB);
    f32x4 accB[4][2]; zero_acc<2>(accB);
    gemm_mainloop<2>(accB, p.proj + (size_t)mt * 128 * PW + C_GATE + n * 256, PW, p.Wbt + ((size_t)(l * 4 + n) * 1024 + nt * 64) * 256, 256, 256, sA, sB);
#pragma unroll
    for (int mi = 0; mi < 4; ++mi)
#pragma unroll
      for (int ni = 0; ni < 2; ++ni)
#pragma unroll
        for (int j = 0; j < 4; ++j) accM[mi][ni][j] += accB[mi][ni][j] / (1.0f + __expf(-accG[mi][ni][j]));
  }
  const int lane = threadIdx.x & 63, wid = threadIdx.x >> 6, wm = wid >> 1, wn = wid & 1, fr = lane & 15, fq = lane >> 4;
#pragma unroll
  for (int mi = 0; mi < 4; ++mi)
#pragma unroll
    for (int ni = 0; ni < 2; ++ni) {
      size_t row = (size_t)mt * 128 + wm * 64 + mi * 16 + fr; int col = nt * 64 + wn * 32 + ni * 16 + fq * 4;
      uint2 o; o.x = pack2(accM[mi][ni][0], accM[mi][ni][1]); o.y = pack2(accM[mi][ni][2], accM[mi][ni][3]);
      *(uint2*)(p.proj + row * PW + C_MERGED + col) = o;
    }
}

DI void outproj_tile(const Params& p, int l, int tile, char* smem) {
  bf16_t* sA = (bf16_t*)smem; bf16_t* sB = sA + 128 * LLD;
  const int mt = tile & 255, nt = tile >> 8;
  f32x4 acc[4][4]; zero_acc<4>(acc);
  gemm_mainloop<4>(acc, p.proj + (size_t)mt * 128 * PW + C_MERGED, PW, p.Wot + ((size_t)l * 1024 + nt * 128) * 1024, 1024, 1024, sA, sB);
  const float* xin = l == 0 ? p.x : p.out;
  const int lane = threadIdx.x & 63, wid = threadIdx.x >> 6, wm = wid >> 1, wn = wid & 1, fr = lane & 15, fq = lane >> 4;
#pragma unroll
  for (int mi = 0; mi < 4; ++mi)
#pragma unroll
    for (int ni = 0; ni < 4; ++ni) {
      size_t row = (size_t)mt * 128 + wm * 64 + mi * 16 + fr; int col = nt * 128 + wn * 64 + ni * 16 + fq * 4;
      float4 xi = *(const float4*)(xin + row * 1024 + col);
      float4 o; o.x = xi.x + acc[mi][ni][0]; o.y = xi.y + acc[mi][ni][1]; o.z = xi.z + acc[mi][ni][2]; o.w = xi.w + acc[mi][ni][3];
      *(float4*)(p.out + row * 1024 + col) = o;
    }
}

DI void run_phase(const Params& p, int ph, char* smem) {
  const int G = gridDim.x, B = blockIdx.x;
  if (ph == 0) {
    for (int i = B; i < 6097; i += G) prep_item(p, i, (float*)smem);
    for (int i = B; i < 1024; i += G) norm_rows_bf16(p.x, p.norm_g, p.xn, i);
  } else if (ph == 12) {
    for (int i = B; i < 1024; i += G) norm_rows_f32(p.out, p.final_g, i);
  } else if (ph == 6) {
    for (int i = B; i < 1024; i += G) norm_rows_bf16(p.out, p.norm_g + 1024, p.xn, i);
  } else {
    const int l = ph > 6 ? 1 : 0; const int s = ph > 6 ? ph - 7 : ph - 1;
    if (s == 0) { for (int i = B; i < 256 * 38; i += G) inproj_tile(p, l, i, smem); }
    else if (s == 1) { for (int i = B; i < 2048; i += G) mla_item(p, l, i, smem); }
    else if (s == 2) {
      const int xcd = B & 7, lb = B >> 3, nl = G >> 3;
      for (int w = lb; w < 256; w += nl) dense_item(p, xcd + 8 * (w >> 6), w & 63, smem);
      for (int i = B; i < 1024; i += G) attn_item(p, l, 1024 + i, smem);
    }
    else if (s == 3) { for (int i = B; i < 256 * 16; i += G) merge_tile(p, l, i, smem); }
    else { for (int i = B; i < 256 * 8; i += G) outproj_tile(p, l, i, smem); }
  }
}

__global__ void __launch_bounds__(256) mega(Params p, int ph_lo, int ph_hi) {
  __shared__ __attribute__((aligned(16))) char smem[46080];
  cg::grid_group grid = cg::this_grid();
  for (int ph = ph_lo; ph < ph_hi; ++ph) {
    run_phase(p, ph, smem);
    if (ph + 1 < ph_hi) grid.sync();
  }
}

extern "C" void kernel_launch(void* const* d_in, const int* in_sizes, int n_in, void* d_out, int out_size, void* d_ws,
                              size_t ws_size, hipStream_t stream) {
  Params p{};
  p.x = (const float*)d_in[0]; p.norm_g = (const float*)d_in[1]; p.w_in = (const float*)d_in[2];
  p.q_norm_g = (const float*)d_in[3]; p.kv_norm_g = (const float*)d_in[4]; p.w_q_up = (const float*)d_in[5];
  p.w_kv_up = (const float*)d_in[6]; p.gq_g = (const float*)d_in[7]; p.gk_g = (const float*)d_in[8];
  p.sink = (const float*)d_in[9]; p.t5 = (const float*)d_in[10]; p.w_branch = (const float*)d_in[11];
  p.w_out = (const float*)d_in[12]; p.final_g = (const float*)d_in[13];
  p.out = (float*)d_out;
  char* w = (char*)d_ws; size_t off = 0;
  auto take = [&](size_t bytes) { char* r = w + off; off += (bytes + 255) & ~(size_t)255; return r; };
  p.W1t = (bf16_t*)take((size_t)2 * 4864 * 1024 * 2);
  p.Wmt = (bf16_t*)take((size_t)2 * 4096 * 1024 * 2);
  p.Wot = (bf16_t*)take((size_t)2 * 1024 * 1024 * 2);
  p.Wbt = (bf16_t*)take((size_t)2 * 4 * 1024 * 256 * 2);
  p.Wqt = (bf16_t*)take((size_t)2 * 384 * 256 * 2);
  p.Wkvt = (bf16_t*)take((size_t)2 * 512 * 128 * 2);
  p.rope = (float*)take((size_t)8192 * 32 * 4);
  p.lutC = (float*)take(8192);
  p.lutD = (float*)take(8192);
  p.xn = (bf16_t*)take((size_t)32768 * 1024 * 2);
  p.proj = (bf16_t*)take((size_t)32768 * PW * 2);
  p.qa = (bf16_t*)take((size_t)32768 * 384 * 2);
  p.ka = (bf16_t*)take((size_t)32768 * 384 * 2);
  p.va = (bf16_t*)take((size_t)32768 * 256 * 2);
  if (off > ws_size) { fprintf(stderr, "workspace too small: need %zu have %zu\n", off, ws_size); return; }

  static int grid_blocks = 0;
  if (!grid_blocks) {
    int dev = 0, cus = 0, per_cu = 0;
    hipGetDevice(&dev);
    hipDeviceGetAttribute(&cus, hipDeviceAttributeMultiprocessorCount, dev);
    hipOccupancyMaxActiveBlocksPerMultiprocessor(&per_cu, mega, 256, 0);
    if (per_cu < 1) per_cu = 1;
    if (per_cu > 2) per_cu = 2;
    grid_blocks = cus * per_cu;
  }
  int lo = 0, hi = 13;
  void* args[] = {&p, &lo, &hi};
  hipError_t e = hipLaunchCooperativeKernel((void*)mega, dim3(grid_blocks), dim3(256), args, 0, stream);
  if (e != hipSuccess) fprintf(stderr, "cooperative launch failed: %s (grid %d)\n", hipGetErrorString(e), grid_blocks);
}
```

```cpp
#include <hip/hip_runtime.h>
#include <hip/hip_cooperative_groups.h>
#include <cstdio>
namespace cg = cooperative_groups;

typedef unsigned short bf16_t;
using bf16x8 = __attribute__((ext_vector_type(8))) short;
using f32x4 = __attribute__((ext_vector_type(4))) float;
using u32x4 = __attribute__((ext_vector_type(4))) unsigned;
using f32x16 = __attribute__((ext_vector_type(16))) float;
using bf16x4 = __attribute__((ext_vector_type(4))) short;
#define DI __device__ __forceinline__

constexpr int SEQ = 8192;
constexpr int PW = 4864;
constexpr int C_BQ = 0, C_BK = 256, C_BV = 384, C_CQ = 512, C_CK = 1280, C_CV = 2048, C_DQ = 2816, C_DK = 3072,
              C_DV = 3200, C_GATE = 3328, C_AQ = 4352, C_AKV = 4608, C_AKR = 4736;
constexpr int C_MERGED = 512;

struct Params {
  const float* x; const float* norm_g; const float* w_in; const float* q_norm_g; const float* kv_norm_g;
  const float* w_q_up; const float* w_kv_up; const float* gq_g; const float* gk_g; const float* sink;
  const float* t5; const float* w_branch; const float* w_out; const float* final_g;
  float* out;
  bf16_t* W1t; bf16_t* Wmt; bf16_t* Wot; bf16_t* Wbt; bf16_t* Wqt; bf16_t* Wkvt;
  float* rope; float* lutC; float* lutD;
  bf16_t* xn; bf16_t* proj; bf16_t* qa; bf16_t* ka; bf16_t* va; float* lse;
};

DI unsigned short f2bf(float x) { unsigned u = __float_as_uint(x); u += 0x7fffu + ((u >> 16) & 1u); return (unsigned short)(u >> 16); }
DI float bf2f(unsigned short b) { return __uint_as_float(((unsigned)b) << 16); }
typedef __bf16 bf2_t __attribute__((ext_vector_type(2)));
typedef float f2_t __attribute__((ext_vector_type(2)));
DI unsigned pack2(float a, float b) { f2_t v = {a, b}; bf2_t r = __builtin_convertvector(v, bf2_t); return __builtin_bit_cast(unsigned, r); }
constexpr float LOG2E = 1.4426950408889634f;
constexpr float QS64 = 0.125f * LOG2E;
constexpr float QS96 = 0.10206207261596575f * LOG2E;
#define BLO(u) __uint_as_float((u) << 16)
#define BHI(u) __uint_as_float((u) & 0xffff0000u)
DI float wave_sum(float v) {
#pragma unroll
  for (int o = 32; o; o >>= 1) v += __shfl_xor(v, o);
  return v;
}

DI int srccol(int mode, int n) {
  if (mode == 0) return n < 4352 ? n + 416 : (n < 4768 ? n - 4352 : -1);
  if (mode == 1) return 4768 + n;
  if (mode == 2) return n;
  return n < 256 ? (n >> 6) * 96 + (n & 63) : ((n - 256) >> 5) * 96 + 64 + ((n - 256) & 31);
}
DI void conv_tile(const float* __restrict__ src, int ld, int K, bf16_t* __restrict__ dst, int n0, int k0, int mode,
                  const float* __restrict__ rs, float* tile) {
  const int tx = threadIdx.x & 63, ty = threadIdx.x >> 6;
  __syncthreads();
  const int sc = srccol(mode, n0 + tx);
  const int nq = n0 + tx;
  const float cscale = (mode == 0 && ((nq >= C_CQ && nq < C_CQ + 768) || (nq >= C_DQ && nq < C_DQ + 256))) ? QS64 : 1.0f;
#pragma unroll
  for (int i = 0; i < 16; ++i) {
    int kk = ty + 4 * i;
    float v = sc >= 0 ? src[(size_t)(k0 + kk) * ld + sc] : 0.f;
    if (rs) v *= rs[k0 + kk];
    tile[kk * 65 + tx] = v * cscale;
  }
  __syncthreads();
#pragma unroll
  for (int i = 0; i < 16; ++i) {
    int nn = ty + 4 * i;
    dst[(size_t)(n0 + nn) * K + k0 + tx] = f2bf(tile[tx * 65 + nn]);
  }
}

DI int t5_bucket(int rel) {
  int n = rel < 0 ? -rel : rel;
  float nf = (float)(n < 1 ? 1 : n);
  int large = 8 + (int)(logf(nf / 8.0f) / 4.852030263919617f * 8.0f);
  if (large > 15) large = 15;
  return (rel > 0 ? 16 : 0) + (n < 8 ? n : large);
}

DI void prep_item(const Params& p, int item, float* tile) {
  if (item < 5584) {
    int l = item / 2792, r = item % 2792;
    const float* src; int ld, K, mode, t; bf16_t* dst; const float* rs = nullptr;
    if (r < 1216) { t = r; src = p.w_in + (size_t)l * 1024 * 8864; ld = 8864; K = 1024; mode = 0; dst = p.W1t + (size_t)l * 4864 * 1024; }
    else if (r < 2240) { t = r - 1216; src = p.w_in + (size_t)l * 1024 * 8864; ld = 8864; K = 1024; mode = 1; dst = p.Wmt + (size_t)l * 4096 * 1024; }
    else if (r < 2496) { t = r - 2240; src = p.w_out + (size_t)l * 1024 * 1024; ld = 1024; K = 1024; mode = 2; dst = p.Wot + (size_t)l * 1024 * 1024; }
    else if (r < 2752) { t = r - 2496; int n = t >> 6; t &= 63; src = p.w_branch + (size_t)(l * 4 + n) * 256 * 1024; ld = 1024; K = 256; mode = 2; dst = p.Wbt + (size_t)(l * 4 + n) * 1024 * 256; }
    else if (r < 2776) { t = r - 2752; src = p.w_q_up + (size_t)l * 256 * 384; ld = 384; K = 256; mode = 3; dst = p.Wqt + (size_t)l * 384 * 256; rs = p.q_norm_g + l * 256; }
    else { t = r - 2776; src = p.w_kv_up + (size_t)l * 128 * 512; ld = 512; K = 128; mode = 2; dst = p.Wkvt + (size_t)l * 512 * 128; rs = p.kv_norm_g + l * 128; }
    int kt = K / 64;
    conv_tile(src, ld, K, dst, (t / kt) * 64, (t % kt) * 64, mode, rs, tile);
  } else if (item < 5584 + 512) {
    int idx = (item - 5584) * 256 + threadIdx.x;
    int pos = idx >> 4, i = idx & 15;
    double invd = 1.0;
    for (int k = 0; k < i; ++k) invd *= 0.5623413251903491;
    float inv = (float)invd;
    float ang = (float)pos * inv;
    double a = (double)ang;
    double kq = rint(a * 0.15915494309189535);
    double r = a - kq * 6.283185307179586;
    double r2 = r * r, ts = r, tc = 1.0, sn = r, cs = 1.0;
    for (int k = 1; k <= 14; ++k) {
      tc = -tc * r2 / (double)((2 * k - 1) * (2 * k));
      ts = -ts * r2 / (double)((2 * k) * (2 * k + 1));
      cs += tc; sn += ts;
    }
    p.rope[pos * 32 + i] = (float)cs;
    p.rope[pos * 32 + 16 + i] = (float)sn;
  } else {
    for (int e = threadIdx.x; e < 12 * 129; e += 256) {
      int gh = e / 129, off = e % 129 - 64; int g = gh >> 2;
      int r = g == 0 ? 1 : (g == 1 ? 4 : 16);
      p.lutC[e] = p.t5[t5_bucket(off * r) * 16 + gh] * LOG2E;
    }
    for (int e = threadIdx.x; e < 4 * 257; e += 256) {
      int hq = e / 257, off = e % 257 - 128;
      p.lutD[e] = p.t5[t5_bucket(off) * 16 + 12 + hq] * LOG2E;
    }
  }
}

DI void norm_rows_bf16(const float* __restrict__ src, const float* __restrict__ g, bf16_t* __restrict__ dst, int item) {
  const int lane = threadIdx.x & 63, wid = threadIdx.x >> 6;
  for (int i = 0; i < 8; ++i) {
    size_t row = (size_t)item * 32 + wid * 8 + i;
    const float4* s = (const float4*)(src + row * 1024);
    float4 v[4]; float ss = 0.f;
#pragma unroll
    for (int j = 0; j < 4; ++j) { v[j] = s[lane + 64 * j]; ss += v[j].x * v[j].x + v[j].y * v[j].y + v[j].z * v[j].z + v[j].w * v[j].w; }
    ss = wave_sum(ss);
    float sc = rsqrtf(ss * (1.0f / 1024.0f) + 1e-6f);
#pragma unroll
    for (int j = 0; j < 4; ++j) {
      float4 gg = ((const float4*)g)[lane + 64 * j];
      uint2 o; o.x = pack2(v[j].x * sc * gg.x, v[j].y * sc * gg.y); o.y = pack2(v[j].z * sc * gg.z, v[j].w * sc * gg.w);
      *(uint2*)(dst + row * 1024 + (lane + 64 * j) * 4) = o;
    }
  }
}
DI void norm_rows_f32(float* io, const float* __restrict__ g, int item) {
  const int lane = threadIdx.x & 63, wid = threadIdx.x >> 6;
  for (int i = 0; i < 8; ++i) {
    size_t row = (size_t)item * 32 + wid * 8 + i;
    float4* s = (float4*)(io + row * 1024);
    float4 v[4]; float ss = 0.f;
#pragma unroll
    for (int j = 0; j < 4; ++j) { v[j] = s[lane + 64 * j]; ss += v[j].x * v[j].x + v[j].y * v[j].y + v[j].z * v[j].z + v[j].w * v[j].w; }
    ss = wave_sum(ss);
    float sc = rsqrtf(ss * (1.0f / 1024.0f) + 1e-6f);
#pragma unroll
    for (int j = 0; j < 4; ++j) {
      float4 gg = ((const float4*)g)[lane + 64 * j];
      float4 o; o.x = v[j].x * sc * gg.x; o.y = v[j].y * sc * gg.y; o.z = v[j].z * sc * gg.z; o.w = v[j].w * sc * gg.w;
      s[lane + 64 * j] = o;
    }
  }
}

constexpr int LLD = 72;
template <int NT>
DI void gemm_mainloop(f32x4 (&acc)[4][NT], const bf16_t* A, int lda, const bf16_t* Bt, int ldb, int K, bf16_t* sA, bf16_t* sB) {
  constexpr int NB = NT;
  const int tid = threadIdx.x, lane = tid & 63, wid = tid >> 6;
  const int wm = wid >> 1, wn = wid & 1, fr = lane & 15, fq = lane >> 4;
  u32x4 ra[4], rb[NB];
  const int nk = K >> 6;
#pragma unroll
  for (int i = 0; i < 4; ++i) { int c = tid + 256 * i; ra[i] = *(const u32x4*)(A + (size_t)(c >> 3) * lda + (c & 7) * 8); }
#pragma unroll
  for (int i = 0; i < NB; ++i) { int c = tid + 256 * i; rb[i] = *(const u32x4*)(Bt + (size_t)(c >> 3) * ldb + (c & 7) * 8); }
  for (int kt = 0; kt < nk; ++kt) {
    __syncthreads();
#pragma unroll
    for (int i = 0; i < 4; ++i) { int c = tid + 256 * i; *(u32x4*)(sA + (c >> 3) * LLD + (c & 7) * 8) = ra[i]; }
#pragma unroll
    for (int i = 0; i < NB; ++i) { int c = tid + 256 * i; *(u32x4*)(sB + (c >> 3) * LLD + (c & 7) * 8) = rb[i]; }
    __syncthreads();
    if (kt + 1 < nk) {
      int ko = (kt + 1) * 64;
#pragma unroll
      for (int i = 0; i < 4; ++i) { int c = tid + 256 * i; ra[i] = *(const u32x4*)(A + (size_t)(c >> 3) * lda + ko + (c & 7) * 8); }
#pragma unroll
      for (int i = 0; i < NB; ++i) { int c = tid + 256 * i; rb[i] = *(const u32x4*)(Bt + (size_t)(c >> 3) * ldb + ko + (c & 7) * 8); }
    }
#pragma unroll
    for (int ks = 0; ks < 2; ++ks) {
      bf16x8 af[4], bfr[NT];
#pragma unroll
      for (int mi = 0; mi < 4; ++mi) af[mi] = *(const bf16x8*)(sA + (wm * 64 + mi * 16 + fr) * LLD + ks * 32 + fq * 8);
#pragma unroll
      for (int ni = 0; ni < NT; ++ni) bfr[ni] = *(const bf16x8*)(sB + (wn * NT * 16 + ni * 16 + fr) * LLD + ks * 32 + fq * 8);
#pragma unroll
      for (int mi = 0; mi < 4; ++mi)
#pragma unroll
        for (int ni = 0; ni < NT; ++ni) acc[mi][ni] = __builtin_amdgcn_mfma_f32_16x16x32_bf16(bfr[ni], af[mi], acc[mi][ni], 0, 0, 0);
    }
  }
}
template <int NT>
DI void zero_acc(f32x4 (&acc)[4][NT]) {
#pragma unroll
  for (int mi = 0; mi < 4; ++mi)
#pragma unroll
    for (int ni = 0; ni < NT; ++ni) acc[mi][ni] = f32x4{0.f, 0.f, 0.f, 0.f};
}

DI void inproj_tile(const Params& p, int l, int tile, char* smem) {
  bf16_t* sA = (bf16_t*)smem; bf16_t* sB = sA + 128 * LLD;
  const int mt = tile & 255, nt = tile >> 8;
  f32x4 acc[4][4]; zero_acc<4>(acc);
  gemm_mainloop<4>(acc, p.xn + (size_t)mt * 128 * 1024, 1024, p.W1t + ((size_t)l * 4864 + nt * 128) * 1024, 1024, 1024, sA, sB);
  const int lane = threadIdx.x & 63, wid = threadIdx.x >> 6, wm = wid >> 1, wn = wid & 1, fr = lane & 15, fq = lane >> 4;
#pragma unroll
  for (int mi = 0; mi < 4; ++mi)
#pragma unroll
    for (int ni = 0; ni < 4; ++ni) {
      size_t row = (size_t)mt * 128 + wm * 64 + mi * 16 + fr; int col = nt * 128 + wn * 64 + ni * 16 + fq * 4;
      uint2 o; o.x = pack2(acc[mi][ni][0], acc[mi][ni][1]); o.y = pack2(acc[mi][ni][2], acc[mi][ni][3]);
      *(uint2*)(p.proj + row * PW + col) = o;
    }
}

DI void row_scales(const bf16_t* A, int lda, int K, float* sRow) {
  const int row = threadIdx.x >> 1, half = threadIdx.x & 1;
  const int per = K >> 1;
  const bf16_t* a = A + (size_t)row * lda + half * per;
  float ss = 0.f;
  for (int c = 0; c < per; c += 8) {
    uint4 u = *(const uint4*)(a + c);
    float f;
    f = BLO(u.x); ss += f * f; f = BHI(u.x); ss += f * f; f = BLO(u.y); ss += f * f; f = BHI(u.y); ss += f * f;
    f = BLO(u.z); ss += f * f; f = BHI(u.z); ss += f * f; f = BLO(u.w); ss += f * f; f = BHI(u.w); ss += f * f;
  }
  ss += __shfl_xor(ss, 1);
  if (half == 0) sRow[row] = rsqrtf(ss / (float)K + 1e-6f);
}
DI void mla_item(const Params& p, int l, int item, char* smem) {
  bf16_t* sA = (bf16_t*)smem; bf16_t* sB = sA + 128 * LLD; float* sRow = (float*)(sB + 128 * LLD);
  const int lane = threadIdx.x & 63, wid = threadIdx.x >> 6, wm = wid >> 1, wn = wid & 1, fr = lane & 15, fq = lane >> 4;
  if (item < 768) {
    const int mt = item & 255, nt = item >> 8;
    const bf16_t* A = p.proj + (size_t)mt * 128 * PW + C_AQ;
    __syncthreads();
    row_scales(A, PW, 256, sRow);
    f32x4 acc[4][4]; zero_acc<4>(acc);
    gemm_mainloop<4>(acc, A, PW, p.Wqt + ((size_t)l * 384 + nt * 128) * 256, 256, 256, sA, sB);
    if (nt < 2) {
#pragma unroll
      for (int mi = 0; mi < 4; ++mi)
#pragma unroll
        for (int ni = 0; ni < 4; ++ni) {
          int rl = wm * 64 + mi * 16 + fr; size_t t = (size_t)mt * 128 + rl; float s = sRow[rl] * QS96;
          int c = nt * 128 + wn * 64 + ni * 16 + fq * 4; int h = c >> 6, d = c & 63;
          uint2 o; o.x = pack2(acc[mi][ni][0] * s, acc[mi][ni][1] * s); o.y = pack2(acc[mi][ni][2] * s, acc[mi][ni][3] * s);
          *(uint2*)(p.qa + t * 384 + h * 96 + d) = o;
        }
    } else {
#pragma unroll
      for (int mi = 0; mi < 4; ++mi)
#pragma unroll
        for (int np = 0; np < 2; ++np) {
          int rl = wm * 64 + mi * 16 + fr; size_t t = (size_t)mt * 128 + rl; float s = sRow[rl] * QS96;
          int pos = (int)(t & (SEQ - 1)); int h = wn * 2 + np;
          const float* cs = p.rope + pos * 32 + fq * 4;
          float o1[4], o2[4];
#pragma unroll
          for (int j = 0; j < 4; ++j) {
            float x1 = acc[mi][np * 2][j] * s, x2 = acc[mi][np * 2 + 1][j] * s; float c = cs[j], sn = cs[16 + j];
            o1[j] = x1 * c - x2 * sn; o2[j] = x1 * sn + x2 * c;
          }
          uint2 a; a.x = pack2(o1[0], o1[1]); a.y = pack2(o1[2], o1[3]);
          uint2 b; b.x = pack2(o2[0], o2[1]); b.y = pack2(o2[2], o2[3]);
          *(uint2*)(p.qa + t * 384 + h * 96 + 64 + fq * 4) = a;
          *(uint2*)(p.qa + t * 384 + h * 96 + 80 + fq * 4) = b;
        }
    }
  } else if (item < 768 + 1024) {
    const int it = item - 768; const int mt = it & 255, h = it >> 8;
    const bf16_t* A = p.proj + (size_t)mt * 128 * PW + C_AKV;
    __syncthreads();
    row_scales(A, PW, 128, sRow);
    f32x4 acc[4][4]; zero_acc<4>(acc);
    gemm_mainloop<4>(acc, A, PW, p.Wkvt + ((size_t)l * 512 + h * 128) * 128, 128, 128, sA, sB);
#pragma unroll
    for (int mi = 0; mi < 4; ++mi)
#pragma unroll
      for (int ni = 0; ni < 4; ++ni) {
        int rl = wm * 64 + mi * 16 + fr; size_t t = (size_t)mt * 128 + rl; float s = sRow[rl];
        int d = ni * 16 + fq * 4;
        uint2 o; o.x = pack2(acc[mi][ni][0] * s, acc[mi][ni][1] * s); o.y = pack2(acc[mi][ni][2] * s, acc[mi][ni][3] * s);
        if (wn == 0) *(uint2*)(p.ka + t * 384 + h * 96 + d) = o;
        else *(uint2*)(p.va + t * 256 + h * 64 + d) = o;
      }
  } else {
    const int it = item - 1792;
    const int half = lane >> 5, pl = lane & 31;
    for (int i = 0; i < 32; ++i) {
      size_t t = (size_t)it * 128 + wid * 32 + i; int pos = (int)(t & (SEQ - 1));
      bf16_t* row = p.proj + t * PW;
#pragma unroll
      for (int s3 = 0; s3 < 3; ++s3) {
        int slot = s3 * 2 + half;
        bf16_t* hp = row + (slot < 4 ? C_BQ + slot * 64 : C_BK + (slot - 4) * 64);
        const float* g = (slot < 4 ? p.gq_g : p.gk_g) + l * 64;
        int d1, fi, ap;
        if (pl < 16) { d1 = pl; fi = pl; ap = pos >> 6; } else { d1 = 32 + (pl - 16); fi = pl - 16; ap = pos & 63; }
        float x1 = bf2f(hp[d1]), x2 = bf2f(hp[d1 + 16]);
        float ss = x1 * x1 + x2 * x2;
#pragma unroll
        for (int o = 16; o; o >>= 1) ss += __shfl_xor(ss, o);
        float sc = rsqrtf(ss * (1.0f / 64.0f) + 1e-6f);
        if (slot < 4) sc *= QS64;
        x1 = x1 * sc * g[d1]; x2 = x2 * sc * g[d1 + 16];
        float c = p.rope[ap * 32 + fi], sn = p.rope[ap * 32 + 16 + fi];
        hp[d1] = f2bf(x1 * c - x2 * sn); hp[d1 + 16] = f2bf(x1 * sn + x2 * c);
      }
      if (lane < 16) {
        float x1 = bf2f(row[C_AKR + lane]), x2 = bf2f(row[C_AKR + 16 + lane]);
        float c = p.rope[pos * 32 + lane], sn = p.rope[pos * 32 + 16 + lane];
        bf16_t o1 = f2bf(x1 * c - x2 * sn), o2 = f2bf(x1 * sn + x2 * c);
#pragma unroll
        for (int h = 0; h < 4; ++h) { p.ka[t * 384 + h * 96 + 64 + lane] = o1; p.ka[t * 384 + h * 96 + 80 + lane] = o2; }
      }
    }
  }
}

#define MFMA32(a, b, c) __builtin_amdgcn_mfma_f32_32x32x16_bf16((a), (b), (c), 0, 0, 0)
template <int OFF> DI bf16x4 tr_read(unsigned addr) {
  bf16x4 r; asm volatile("ds_read_b64_tr_b16 %0, %1 offset:%2" : "=&v"(r) : "v"(addr), "i"(OFF) : "memory"); return r;
}
DI float half_swap_max(float v) {
  auto rr = __builtin_amdgcn_permlane32_swap(__float_as_uint(v), __float_as_uint(v), false, false);
  return fmaxf(__uint_as_float(rr[0]), __uint_as_float(rr[1]));
}
DI float half_swap_sum(float v) {
  auto rr = __builtin_amdgcn_permlane32_swap(__float_as_uint(v), __float_as_uint(v), false, false);
  return __uint_as_float(rr[0]) + __uint_as_float(rr[1]);
}
DI bf16x8 pack8(const f32x16& p, int base) {
  u32x4 w = {pack2(p[base + 0], p[base + 1]), pack2(p[base + 2], p[base + 3]), pack2(p[base + 4], p[base + 5]), pack2(p[base + 6], p[base + 7])};
  return __builtin_bit_cast(bf16x8, w);
}
template <int DB, int VLD> DI void pv_block(f32x16& o, unsigned vb, bf16x8 pb0, bf16x8 pb1, bf16x8 pb2, bf16x8 pb3) {
  constexpr int RB = VLD * 2;
  bf16x4 l0 = tr_read<0 * RB + 64 * DB>(vb), h0 = tr_read<8 * RB + 64 * DB>(vb);
  bf16x4 l1 = tr_read<16 * RB + 64 * DB>(vb), h1 = tr_read<24 * RB + 64 * DB>(vb);
  bf16x4 l2 = tr_read<32 * RB + 64 * DB>(vb), h2 = tr_read<40 * RB + 64 * DB>(vb);
  bf16x4 l3 = tr_read<48 * RB + 64 * DB>(vb), h3 = tr_read<56 * RB + 64 * DB>(vb);
  asm volatile("s_waitcnt lgkmcnt(0)" ::: "memory"); __builtin_amdgcn_sched_barrier(0);
  o = MFMA32(__builtin_shufflevector(l0, h0, 0, 1, 2, 3, 4, 5, 6, 7), pb0, o);
  o = MFMA32(__builtin_shufflevector(l1, h1, 0, 1, 2, 3, 4, 5, 6, 7), pb1, o);
  o = MFMA32(__builtin_shufflevector(l2, h2, 0, 1, 2, 3, 4, 5, 6, 7), pb2, o);
  o = MFMA32(__builtin_shufflevector(l3, h3, 0, 1, 2, 3, 4, 5, 6, 7), pb3, o);
}
DI f32x16 splat16(float v) { f32x16 r;
#pragma unroll
  for (int i = 0; i < 16; ++i) r[i] = v;
  return r; }

template <int DQK>
DI void attn_dense_mfma(const bf16_t* Qb, int ldq, const bf16_t* Kb, int ldk, const bf16_t* Vb, int ldv, bf16_t* gate_io, char* smem) {
  constexpr int NS = DQK / 16, KLD = DQK + 8, VLD = 72, CPR = DQK / 8, NKC = (64 * CPR) / 256;
  constexpr int KBYTES = 64 * KLD * 2, VBYTES = 64 * VLD * 2;
  char* sKc = smem; char* sVc = smem + 2 * KBYTES;
  const int tid = threadIdx.x, lane = tid & 63, wid = tid >> 6, r = lane & 31, h = lane >> 5;
  bf16x8 qf[NS];
#pragma unroll
  for (int s = 0; s < NS; ++s) qf[s] = *(const bf16x8*)(Qb + (size_t)(wid * 32 + r) * ldq + 16 * s + 8 * h);
  int krow[NKC], kcc[NKC];
#pragma unroll
  for (int i = 0; i < NKC; ++i) { int c = tid + 256 * i; krow[i] = c / CPR; kcc[i] = c % CPR; }
  const int vrow0 = tid >> 3, vcc = tid & 7;
  u32x4 rk[NKC], rv[2];
#define DLOAD(k0) do { \
    _Pragma("unroll") for (int i = 0; i < NKC; ++i) rk[i] = *(const u32x4*)(Kb + (size_t)((k0) + krow[i]) * ldk + kcc[i] * 8); \
    rv[0] = *(const u32x4*)(Vb + (size_t)((k0) + vrow0) * ldv + vcc * 8); \
    rv[1] = *(const u32x4*)(Vb + (size_t)((k0) + vrow0 + 32) * ldv + vcc * 8); } while (0)
#define DSTORE(st) do { \
    _Pragma("unroll") for (int i = 0; i < NKC; ++i) *(u32x4*)(sKc + (st) * KBYTES + (krow[i] * KLD + kcc[i] * 8) * 2) = rk[i]; \
    *(u32x4*)(sVc + (st) * VBYTES + (vrow0 * VLD + vcc * 8) * 2) = rv[0]; \
    *(u32x4*)(sVc + (st) * VBYTES + ((vrow0 + 32) * VLD + vcc * 8) * 2) = rv[1]; } while (0)
  const unsigned vb0 = (unsigned)(size_t)sVc + (unsigned)(((4 * h + ((lane & 15) >> 2)) * VLD + 16 * ((lane >> 4) & 1) + 4 * (lane & 3)) * 2);
  f32x16 o0 = splat16(0.f), o1 = splat16(0.f), negm = splat16(0.f);
  float m_run = 0.f, l_run = 0.f;
  __syncthreads();
  DLOAD(0); DSTORE(0);
  __syncthreads();
  constexpr int NT = SEQ / 64;
  for (int j = 0; j < NT; ++j) {
    const int cur = j & 1;
    if (j + 1 < NT) DLOAD((j + 1) * 64);
    const bf16_t* sK = (const bf16_t*)(sKc + cur * KBYTES);
    f32x16 p0 = negm, p1 = negm;
#pragma unroll
    for (int s = 0; s < NS; ++s) {
      bf16x8 k0 = *(const bf16x8*)(sK + r * KLD + 16 * s + 8 * h);
      bf16x8 k1 = *(const bf16x8*)(sK + (32 + r) * KLD + 16 * s + 8 * h);
      p0 = MFMA32(k0, qf[s], p0);
      p1 = MFMA32(k1, qf[s], p1);
    }
    float pm = fmaxf(p0[0], p1[0]);
#pragma unroll
    for (int i = 1; i < 16; ++i) pm = fmaxf(pm, fmaxf(p0[i], p1[i]));
    pm = half_swap_max(pm);
    if (j == 0 || __any(pm > 8.0f)) {
      float delta;
      if (j == 0) delta = pm;
      else {
        delta = fmaxf(pm, 0.f);
        float alpha = __builtin_amdgcn_exp2f(-delta);
        l_run *= alpha;
#pragma unroll
        for (int i = 0; i < 16; ++i) { o0[i] *= alpha; o1[i] *= alpha; }
      }
      m_run += delta;
#pragma unroll
      for (int i = 0; i < 16; ++i) { p0[i] -= delta; p1[i] -= delta; }
      negm = splat16(-m_run);
    }
    float ls = 0.f;
#pragma unroll
    for (int i = 0; i < 16; ++i) { p0[i] = __builtin_amdgcn_exp2f(p0[i]); p1[i] = __builtin_amdgcn_exp2f(p1[i]); ls += p0[i] + p1[i]; }
    l_run += ls;
    bf16x8 pb0 = pack8(p0, 0), pb1 = pack8(p0, 8), pb2 = pack8(p1, 0), pb3 = pack8(p1, 8);
    const unsigned vb = vb0 + cur * VBYTES;
    pv_block<0, VLD>(o0, vb, pb0, pb1, pb2, pb3);
    pv_block<1, VLD>(o1, vb, pb0, pb1, pb2, pb3);
    if (j + 1 < NT) DSTORE(cur ^ 1);
    __syncthreads();
  }
#undef DLOAD
#undef DSTORE
  const float inv = 1.0f / half_swap_sum(l_run);
  bf16_t* grow = gate_io + (size_t)(wid * 32 + r) * PW;
#pragma unroll
  for (int db = 0; db < 2; ++db)
#pragma unroll
    for (int g4 = 0; g4 < 4; ++g4) {
      bf16_t* gp = grow + 32 * db + 8 * g4 + 4 * h;
      uint2 u = *(const uint2*)gp;
      float g[4] = {BLO(u.x), BHI(u.x), BLO(u.y), BHI(u.y)};
      float y[4];
#pragma unroll
      for (int e = 0; e < 4; ++e) { float ov = db == 0 ? o0[4 * g4 + e] : o1[4 * g4 + e]; y[e] = ov * inv * g[e] / (1.0f + __expf(-g[e])); }
      uint2 w; w.x = pack2(y[0], y[1]); w.y = pack2(y[2], y[3]);
      *(uint2*)gp = w;
    }
}
DI void dense_item(const Params& p, int combo, int qblk, char* smem) {
  const int br = combo >> 4, bh = combo & 15, b = bh >> 2, h = bh & 3;
  const size_t t0 = (size_t)b * SEQ + qblk * 128;
  bf16_t* gate_io = p.proj + t0 * PW + C_GATE + br * 256 + h * 64;
  if (br == 0)
    attn_dense_mfma<96>(p.qa + t0 * 384 + h * 96, 384, p.ka + (size_t)b * SEQ * 384 + h * 96, 384, p.va + (size_t)b * SEQ * 256 + h * 64, 256, gate_io, smem);
  else
    attn_dense_mfma<64>(p.proj + t0 * PW + C_BQ + h * 64, PW, p.proj + (size_t)b * SEQ * PW + C_BK + (h >> 1) * 64, PW,
                        p.proj + (size_t)b * SEQ * PW + C_BV + (h >> 1) * 64, PW, gate_io, smem);
}

template <int W, bool SINK>
DI void attn_band_mfma(const bf16_t* Qb, size_t ldq, const bf16_t* Kb, const bf16_t* Vb, size_t ldk, int L, int i0,
                       const float* lut_g, float sink2, bf16_t* outp, size_t ldo, float* lse_out, size_t ldl, char* smem) {
  constexpr int NS = 4, KLD = 72, VLD = 72, NTW = (128 + 2 * W) / 64, LUTN = 2 * W + 1;
  constexpr int KBYTES = 64 * KLD * 2, VBYTES = 64 * VLD * 2;
  char* sKc = smem; char* sVc = smem + 2 * KBYTES; float* sLut = (float*)(smem + 2 * KBYTES + 2 * VBYTES);
  const int tid = threadIdx.x, lane = tid & 63, wid = tid >> 6, r = lane & 31, h = lane >> 5;
  __syncthreads();
  for (int e = tid; e < LUTN; e += 256) sLut[e] = lut_g[e];
  const int qi = i0 + wid * 32 + r;
  bf16x8 qf[NS];
#pragma unroll
  for (int s = 0; s < NS; ++s) qf[s] = *(const bf16x8*)(Qb + (size_t)qi * ldq + 16 * s + 8 * h);
  const int srow = tid >> 3, scc = tid & 7;
  u32x4 rk[2], rv[2];
#define BLOAD(k0) do { \
    rk[0] = *(const u32x4*)(Kb + (size_t)((k0) + srow) * ldk + scc * 8); rk[1] = *(const u32x4*)(Kb + (size_t)((k0) + srow + 32) * ldk + scc * 8); \
    rv[0] = *(const u32x4*)(Vb + (size_t)((k0) + srow) * ldk + scc * 8); rv[1] = *(const u32x4*)(Vb + (size_t)((k0) + srow + 32) * ldk + scc * 8); } while (0)
#define BSTORE(st) do { \
    *(u32x4*)(sKc + (st) * KBYTES + (srow * KLD + scc * 8) * 2) = rk[0]; *(u32x4*)(sKc + (st) * KBYTES + ((srow + 32) * KLD + scc * 8) * 2) = rk[1]; \
    *(u32x4*)(sVc + (st) * VBYTES + (srow * VLD + scc * 8) * 2) = rv[0]; *(u32x4*)(sVc + (st) * VBYTES + ((srow + 32) * VLD + scc * 8) * 2) = rv[1]; } while (0)
  const unsigned vb0 = (unsigned)(size_t)sVc + (unsigned)(((4 * h + ((lane & 15) >> 2)) * VLD + 16 * ((lane >> 4) & 1) + 4 * (lane & 3)) * 2);
  f32x16 o0 = splat16(0.f), o1 = splat16(0.f);
  float m_run = SINK ? sink2 : 0.f, l_run = (SINK && h == 0) ? 1.f : 0.f;
  bool seen = SINK;
  f32x16 negm = splat16(-m_run);
  const int lo = (i0 == 0) ? W / 64 : 0, hi = (i0 + 128 >= L) ? NTW - W / 64 : NTW;
  BLOAD(i0 - W + 64 * lo); BSTORE(0);
  __syncthreads();
  for (int j = lo; j < hi; ++j) {
    const int cur = (j - lo) & 1, k0 = i0 - W + 64 * j;
    if (j + 1 < hi) BLOAD(k0 + 64);
    const bf16_t* sK = (const bf16_t*)(sKc + cur * KBYTES);
    f32x16 p0 = negm, p1 = negm;
#pragma unroll
    for (int s = 0; s < NS; ++s) {
      bf16x8 k0f = *(const bf16x8*)(sK + r * KLD + 16 * s + 8 * h);
      bf16x8 k1f = *(const bf16x8*)(sK + (32 + r) * KLD + 16 * s + 8 * h);
      p0 = MFMA32(k0f, qf[s], p0);
      p1 = MFMA32(k1f, qf[s], p1);
    }
    const int offb = k0 + 4 * h - qi + W;
    float pm = -1e30f;
#pragma unroll
    for (int i = 0; i < 16; ++i) {
      int idx0 = offb + (i & 3) + 8 * (i >> 2), idx1 = idx0 + 32;
      int c0 = min(max(idx0, 0), 2 * W), c1 = min(max(idx1, 0), 2 * W);
      float b0 = sLut[c0], b1 = sLut[c1];
      p0[i] = ((unsigned)idx0 <= (unsigned)(2 * W)) ? p0[i] + b0 : -1e30f;
      p1[i] = ((unsigned)idx1 <= (unsigned)(2 * W)) ? p1[i] + b1 : -1e30f;
      pm = fmaxf(pm, fmaxf(p0[i], p1[i]));
    }
    pm = half_swap_max(pm);
    const bool has = pm > -1e29f;
    float delta = 0.f;
    if (has) { if (!seen) delta = pm; else if (pm > 8.0f) delta = pm; }
    if (__any(delta != 0.f)) {
      float alpha = seen ? __builtin_amdgcn_exp2f(-delta) : 1.0f;
      l_run *= alpha; m_run += delta;
#pragma unroll
      for (int i = 0; i < 16; ++i) { o0[i] *= alpha; o1[i] *= alpha; p0[i] -= delta; p1[i] -= delta; }
      negm = splat16(-m_run);
    }
    seen = seen || has;
    float ls = 0.f;
#pragma unroll
    for (int i = 0; i < 16; ++i) { p0[i] = __builtin_amdgcn_exp2f(p0[i]); p1[i] = __builtin_amdgcn_exp2f(p1[i]); ls += p0[i] + p1[i]; }
    l_run += ls;
    bf16x8 pb0 = pack8(p0, 0), pb1 = pack8(p0, 8), pb2 = pack8(p1, 0), pb3 = pack8(p1, 8);
    const unsigned vb = vb0 + cur * VBYTES;
    pv_block<0, VLD>(o0, vb, pb0, pb1, pb2, pb3);
    pv_block<1, VLD>(o1, vb, pb0, pb1, pb2, pb3);
    if (j + 1 < hi) BSTORE(cur ^ 1);
    __syncthreads();
  }
#undef BLOAD
#undef BSTORE
  const float ltot = half_swap_sum(l_run);
  const float inv = 1.0f / ltot;
  bf16_t* orow = outp + (size_t)qi * ldo;
  if (!SINK && h == 0) lse_out[(size_t)qi * ldl] = m_run + __log2f(ltot);
#pragma unroll
  for (int db = 0; db < 2; ++db)
#pragma unroll
    for (int g4 = 0; g4 < 4; ++g4) {
      bf16_t* gp = orow + 32 * db + 8 * g4 + 4 * h;
      float y[4];
      if (SINK) {
        uint2 u = *(const uint2*)gp;
        float g[4] = {BLO(u.x), BHI(u.x), BLO(u.y), BHI(u.y)};
#pragma unroll
        for (int e = 0; e < 4; ++e) { float ov = db == 0 ? o0[4 * g4 + e] : o1[4 * g4 + e]; y[e] = ov * inv * g[e] / (1.0f + __expf(-g[e])); }
      } else {
#pragma unroll
        for (int e = 0; e < 4; ++e) { float ov = db == 0 ? o0[4 * g4 + e] : o1[4 * g4 + e]; y[e] = ov * inv; }
      }
      uint2 w; w.x = pack2(y[0], y[1]); w.y = pack2(y[2], y[3]);
      *(uint2*)gp = w;
    }
}
DI void band_item(const Params& p, int l, int idx, char* smem) {
  if (idx < 3072) {
    const int g = idx >> 10, rem = idx & 1023, h = rem & 3, rem2 = rem >> 2, b = rem2 >> 6, u = rem2 & 63;
    const int sh = 2 * g, rr = 1 << sh;
    const int rho = u & (rr - 1), qblk = u >> sh;
    const size_t tok0 = (size_t)b * SEQ + rho;
    bf16_t* base = p.proj + tok0 * PW + g * 256 + h * 64;
    attn_band_mfma<64, false>(base + C_CQ, (size_t)rr * PW, base + C_CK, base + C_CV, (size_t)rr * PW, SEQ >> sh, qblk * 128,
                              p.lutC + (g * 4 + h) * 129, 0.f, base + C_CQ, (size_t)rr * PW, p.lse + tok0 * 12 + g * 4 + h, (size_t)rr * 12, smem);
  } else {
    const int it = idx - 3072, hq = it & 3, rem = it >> 2, b = rem >> 6, qblk = rem & 63;
    bf16_t* base = p.proj + (size_t)b * SEQ * PW;
    attn_band_mfma<128, true>(base + C_DQ + hq * 64, PW, base + C_DK + (hq >> 1) * 64, base + C_DV + (hq >> 1) * 64, PW, SEQ, qblk * 128,
                              p.lutD + hq * 257, p.sink[l * 4 + hq] * LOG2E, base + C_GATE + 768 + hq * 64, PW, nullptr, 0, smem);
  }
}
DI void combine_c(const Params& p) {
  for (size_t u = (size_t)blockIdx.x * 256 + threadIdx.x; u < (size_t)32768 * 32; u += (size_t)gridDim.x * 256) {
    const size_t t = u >> 5; const int h = (int)(u >> 3) & 3, ch = (int)u & 7;
    const float* ls = p.lse + t * 12 + h;
    float l0 = ls[0], l1 = ls[4], l2 = ls[8];
    float mx = fmaxf(l0, fmaxf(l1, l2));
    float a0 = __builtin_amdgcn_exp2f(l0 - mx), a1 = __builtin_amdgcn_exp2f(l1 - mx), a2 = __builtin_amdgcn_exp2f(l2 - mx);
    float inv = 1.0f / (a0 + a1 + a2); a0 *= inv; a1 *= inv; a2 *= inv;
    const bf16_t* row = p.proj + t * PW;
    uint4 x0 = *(const uint4*)(row + C_CQ + h * 64 + ch * 8), x1 = *(const uint4*)(row + C_CQ + 256 + h * 64 + ch * 8),
          x2 = *(const uint4*)(row + C_CQ + 512 + h * 64 + ch * 8);
    bf16_t* gp = p.proj + t * PW + C_GATE + 512 + h * 64 + ch * 8;
    uint4 gu = *(const uint4*)gp;
    unsigned xa[4] = {x0.x, x0.y, x0.z, x0.w}, xb[4] = {x1.x, x1.y, x1.z, x1.w}, xc[4] = {x2.x, x2.y, x2.z, x2.w}, gg[4] = {gu.x, gu.y, gu.z, gu.w};
    unsigned ov[4];
#pragma unroll
    for (int e = 0; e < 4; ++e) {
      float ylo = a0 * BLO(xa[e]) + a1 * BLO(xb[e]) + a2 * BLO(xc[e]);
      float yhi = a0 * BHI(xa[e]) + a1 * BHI(xb[e]) + a2 * BHI(xc[e]);
      float glo = BLO(gg[e]), ghi = BHI(gg[e]);
      ov[e] = pack2(ylo * glo / (1.0f + __expf(-glo)), yhi * ghi / (1.0f + __expf(-ghi)));
    }
    uint4 w; w.x = ov[0]; w.y = ov[1]; w.z = ov[2]; w.w = ov[3];
    *(uint4*)gp = w;
  }
}

DI void merge_tile(const Params& p, int l, int tile, char* smem) {
  bf16_t* sA = (bf16_t*)smem; bf16_t* sB = sA + 128 * LLD;
  const int mt = tile & 255, nt = tile >> 8;
  f32x4 accM[4][2]; zero_acc<2>(accM);
  for (int n = 0; n < 4; ++n) {
    f32x4 accG[4][2]; zero_acc<2>(accG);
    gemm_mainloop<2>(accG, p.xn + (size_t)mt * 128 * 1024, 1024, p.Wmt + ((size_t)l * 4096 + n * 1024 + nt * 64) * 1024, 1024, 1024, sA, sB);
    f32x4 accB[4][2]; zero_acc<2>(accB);
    gemm_mainloop<2>(accB, p.proj + (size_t)mt * 128 * PW + C_GATE + n * 256, PW, p.Wbt + ((size_t)(l * 4 + n) * 1024 + nt * 64) * 256, 256, 256, sA, sB);
#pragma unroll
    for (int mi = 0; mi < 4; ++mi)
#pragma unroll
      for (int ni = 0; ni < 2; ++ni)
#pragma unroll
        for (int j = 0; j < 4; ++j) accM[mi][ni][j] += accB[mi][ni][j] / (1.0f + __expf(-accG[mi][ni][j]));
  }
  const int lane = threadIdx.x & 63, wid = threadIdx.x >> 6, wm = wid >> 1, wn = wid & 1, fr = lane & 15, fq = lane >> 4;
#pragma unroll
  for (int mi = 0; mi < 4; ++mi)
#pragma unroll
    for (int ni = 0; ni < 2; ++ni) {
      size_t row = (size_t)mt * 128 + wm * 64 + mi * 16 + fr; int col = nt * 64 + wn * 32 + ni * 16 + fq * 4;
      uint2 o; o.x = pack2(accM[mi][ni][0], accM[mi][ni][1]); o.y = pack2(accM[mi][ni][2], accM[mi][ni][3]);
      *(uint2*)(p.proj + row * PW + C_MERGED + col) = o;
    }
}

DI void outproj_tile(const Params& p, int l, int tile, char* smem) {
  bf16_t* sA = (bf16_t*)smem; bf16_t* sB = sA + 128 * LLD;
  const int mt = tile & 255, nt = tile >> 8;
  f32x4 acc[4][4]; zero_acc<4>(acc);
  gemm_mainloop<4>(acc, p.proj + (size_t)mt * 128 * PW + C_MERGED, PW, p.Wot + ((size_t)l * 1024 + nt * 128) * 1024, 1024, 1024, sA, sB);
  const float* xin = l == 0 ? p.x : p.out;
  const int lane = threadIdx.x & 63, wid = threadIdx.x >> 6, wm = wid >> 1, wn = wid & 1, fr = lane & 15, fq = lane >> 4;
#pragma unroll
  for (int mi = 0; mi < 4; ++mi)
#pragma unroll
    for (int ni = 0; ni < 4; ++ni) {
      size_t row = (size_t)mt * 128 + wm * 64 + mi * 16 + fr; int col = nt * 128 + wn * 64 + ni * 16 + fq * 4;
      float4 xi = *(const float4*)(xin + row * 1024 + col);
      float4 o; o.x = xi.x + acc[mi][ni][0]; o.y = xi.y + acc[mi][ni][1]; o.z = xi.z + acc[mi][ni][2]; o.w = xi.w + acc[mi][ni][3];
      *(float4*)(p.out + row * 1024 + col) = o;
    }
}

DI void run_phase(const Params& p, int ph, char* smem) {
  const int G = gridDim.x, B = blockIdx.x;
  if (ph == 0) {
    for (int i = B; i < 6097; i += G) prep_item(p, i, (float*)smem);
    for (int i = B; i < 1024; i += G) norm_rows_bf16(p.x, p.norm_g, p.xn, i);
  } else if (ph == 14) {
    for (int i = B; i < 1024; i += G) norm_rows_f32(p.out, p.final_g, i);
  } else if (ph == 7) {
    for (int i = B; i < 1024; i += G) norm_rows_bf16(p.out, p.norm_g + 1024, p.xn, i);
  } else {
    const int l = ph > 7 ? 1 : 0; const int s = ph > 7 ? ph - 8 : ph - 1;
    if (s == 0) { for (int i = B; i < 256 * 38; i += G) inproj_tile(p, l, i, smem); }
    else if (s == 1) { for (int i = B; i < 2048; i += G) mla_item(p, l, i, smem); }
    else if (s == 2) {
      const int xcd = B & 7, lb = B >> 3, nl = G >> 3;
      for (int w = lb; w < 256; w += nl) dense_item(p, xcd + 8 * (w >> 6), w & 63, smem);
      for (int i = B; i < 4096; i += G) band_item(p, l, i, smem);
    }
    else if (s == 3) { combine_c(p); }
    else if (s == 4) { for (int i = B; i < 256 * 16; i += G) merge_tile(p, l, i, smem); }
    else { for (int i = B; i < 256 * 8; i += G) outproj_tile(p, l, i, smem); }
  }
}

__global__ void __launch_bounds__(256) mega(Params p, int ph_lo, int ph_hi) {
  __shared__ __attribute__((aligned(16))) char smem[47104];
  cg::grid_group grid = cg::this_grid();
  for (int ph = ph_lo; ph < ph_hi; ++ph) {
    run_phase(p, ph, smem);
    if (ph + 1 < ph_hi) grid.sync();
  }
}

extern "C" void kernel_launch(void* const* d_in, const int* in_sizes, int n_in, void* d_out, int out_size, void* d_ws,
                              size_t ws_size, hipStream_t stream) {
  Params p{};
  p.x = (const float*)d_in[0]; p.norm_g = (const float*)d_in[1]; p.w_in = (const float*)d_in[2];
  p.q_norm_g = (const float*)d_in[3]; p.kv_norm_g = (const float*)d_in[4]; p.w_q_up = (const float*)d_in[5];
  p.w_kv_up = (const float*)d_in[6]; p.gq_g = (const float*)d_in[7]; p.gk_g = (const float*)d_in[8];
  p.sink = (const float*)d_in[9]; p.t5 = (const float*)d_in[10]; p.w_branch = (const float*)d_in[11];
  p.w_out = (const float*)d_in[12]; p.final_g = (const float*)d_in[13];
  p.out = (float*)d_out;
  char* w = (char*)d_ws; size_t off = 0;
  auto take = [&](size_t bytes) { char* r = w + off; off += (bytes + 255) & ~(size_t)255; return r; };
  p.W1t = (bf16_t*)take((size_t)2 * 4864 * 1024 * 2);
  p.Wmt = (bf16_t*)take((size_t)2 * 4096 * 1024 * 2);
  p.Wot = (bf16_t*)take((size_t)2 * 1024 * 1024 * 2);
  p.Wbt = (bf16_t*)take((size_t)2 * 4 * 1024 * 256 * 2);
  p.Wqt = (bf16_t*)take((size_t)2 * 384 * 256 * 2);
  p.Wkvt = (bf16_t*)take((size_t)2 * 512 * 128 * 2);
  p.rope = (float*)take((size_t)8192 * 32 * 4);
  p.lutC = (float*)take(8192);
  p.lutD = (float*)take(8192);
  p.xn = (bf16_t*)take((size_t)32768 * 1024 * 2);
  p.proj = (bf16_t*)take((size_t)32768 * PW * 2);
  p.qa = (bf16_t*)take((size_t)32768 * 384 * 2);
  p.ka = (bf16_t*)take((size_t)32768 * 384 * 2);
  p.va = (bf16_t*)take((size_t)32768 * 256 * 2);
  p.lse = (float*)take((size_t)32768 * 12 * 4);
  if (off > ws_size) { fprintf(stderr, "workspace too small: need %zu have %zu\n", off, ws_size); return; }

  static int grid_blocks = 0;
  if (!grid_blocks) {
    int dev = 0, cus = 0, per_cu = 0;
    hipGetDevice(&dev);
    hipDeviceGetAttribute(&cus, hipDeviceAttributeMultiprocessorCount, dev);
    hipOccupancyMaxActiveBlocksPerMultiprocessor(&per_cu, mega, 256, 0);
    if (per_cu < 1) per_cu = 1;
    if (per_cu > 2) per_cu = 2;
    grid_blocks = cus * per_cu;
  }
  int lo = 0, hi = 15;
  void* args[] = {&p, &lo, &hi};
  hipError_t e = hipLaunchCooperativeKernel((void*)mega, dim3(grid_blocks), dim3(256), args, 0, stream);
  if (e != hipSuccess) fprintf(stderr, "cooperative launch failed: %s (grid %d)\n", hipGetErrorString(e), grid_blocks);
}
```

```cpp
#include <hip/hip_runtime.h>
#include <hip/hip_cooperative_groups.h>
#include <cstdio>
namespace cg = cooperative_groups;

typedef unsigned short bf16_t;
using bf16x8 = __attribute__((ext_vector_type(8))) short;
using f32x4 = __attribute__((ext_vector_type(4))) float;
using u32x4 = __attribute__((ext_vector_type(4))) unsigned;
using f32x16 = __attribute__((ext_vector_type(16))) float;
using bf16x4 = __attribute__((ext_vector_type(4))) short;
#define DI __device__ __forceinline__

constexpr int SEQ = 8192;
constexpr int PW = 4864;
constexpr int C_BQ = 0, C_BK = 256, C_BV = 384, C_CQ = 512, C_CK = 1280, C_CV = 2048, C_DQ = 2816, C_DK = 3072,
              C_DV = 3200, C_GATE = 3328, C_AQ = 4352, C_AKV = 4608, C_AKR = 4736;
constexpr int C_MERGED = 512;

struct Params {
  const float* x; const float* norm_g; const float* w_in; const float* q_norm_g; const float* kv_norm_g;
  const float* w_q_up; const float* w_kv_up; const float* gq_g; const float* gk_g; const float* sink;
  const float* t5; const float* w_branch; const float* w_out; const float* final_g;
  float* out; char* ws;
};
constexpr size_t al256(size_t x) { return (x + 255) & ~(size_t)255; }
constexpr size_t OFF_W1T = 0;
constexpr size_t OFF_WMT = OFF_W1T + al256((size_t)2 * 4864 * 1024 * 2);
constexpr size_t OFF_WOT = OFF_WMT + al256((size_t)2 * 4096 * 1024 * 2);
constexpr size_t OFF_WBT = OFF_WOT + al256((size_t)2 * 1024 * 1024 * 2);
constexpr size_t OFF_WQT = OFF_WBT + al256((size_t)2 * 4 * 1024 * 256 * 2);
constexpr size_t OFF_WKVT = OFF_WQT + al256((size_t)2 * 384 * 256 * 2);
constexpr size_t OFF_ROPE = OFF_WKVT + al256((size_t)2 * 512 * 128 * 2);
constexpr size_t OFF_LUTC = OFF_ROPE + al256((size_t)8192 * 32 * 4);
constexpr size_t OFF_LUTD = OFF_LUTC + 8192;
constexpr size_t OFF_XN = OFF_LUTD + 8192;
constexpr size_t OFF_PROJ = OFF_XN + al256((size_t)32768 * 1024 * 2);
constexpr size_t OFF_QA = OFF_PROJ + al256((size_t)32768 * 4864 * 2);
constexpr size_t OFF_KA = OFF_QA + al256((size_t)32768 * 384 * 2);
constexpr size_t OFF_VA = OFF_KA + al256((size_t)32768 * 384 * 2);
constexpr size_t OFF_LSE = OFF_VA + al256((size_t)32768 * 256 * 2);
constexpr size_t WS_NEED = OFF_LSE + al256((size_t)32768 * 12 * 4);
#define WSP(T, OFF) ((T*)(p.ws + (OFF)))
#define P_W1T WSP(bf16_t, OFF_W1T)
#define P_WMT WSP(bf16_t, OFF_WMT)
#define P_WOT WSP(bf16_t, OFF_WOT)
#define P_WBT WSP(bf16_t, OFF_WBT)
#define P_WQT WSP(bf16_t, OFF_WQT)
#define P_WKVT WSP(bf16_t, OFF_WKVT)
#define P_ROPE WSP(float, OFF_ROPE)
#define P_LUTC WSP(float, OFF_LUTC)
#define P_LUTD WSP(float, OFF_LUTD)
#define P_XN WSP(bf16_t, OFF_XN)
#define P_PROJ WSP(bf16_t, OFF_PROJ)
#define P_QA WSP(bf16_t, OFF_QA)
#define P_KA WSP(bf16_t, OFF_KA)
#define P_VA WSP(bf16_t, OFF_VA)
#define P_LSE WSP(float, OFF_LSE)


DI unsigned short f2bf(float x) { unsigned u = __float_as_uint(x); u += 0x7fffu + ((u >> 16) & 1u); return (unsigned short)(u >> 16); }
DI float bf2f(unsigned short b) { return __uint_as_float(((unsigned)b) << 16); }
typedef __bf16 bf2_t __attribute__((ext_vector_type(2)));
typedef float f2_t __attribute__((ext_vector_type(2)));
DI unsigned pack2(float a, float b) { f2_t v = {a, b}; bf2_t r = __builtin_convertvector(v, bf2_t); return __builtin_bit_cast(unsigned, r); }
constexpr float LOG2E = 1.4426950408889634f;
constexpr float QS64 = 0.125f * LOG2E;
constexpr float QS96 = 0.10206207261596575f * LOG2E;
#define BLO(u) __uint_as_float((u) << 16)
#define BHI(u) __uint_as_float((u) & 0xffff0000u)
DI int otid() { int t; asm volatile("v_mov_b32 %0, %1" : "=v"(t) : "v"((int)threadIdx.x)); __builtin_assume(t >= 0 && t < 256); return t; }
DI float wave_sum(float v) {
#pragma unroll
  for (int o = 32; o; o >>= 1) v += __shfl_xor(v, o);
  return v;
}

DI int srccol(int mode, int n) {
  if (mode == 0) return n < 4352 ? n + 416 : (n < 4768 ? n - 4352 : -1);
  if (mode == 1) return 4768 + n;
  if (mode == 2) return n;
  return n < 256 ? (n >> 6) * 96 + (n & 63) : ((n - 256) >> 5) * 96 + 64 + ((n - 256) & 31);
}
DI void conv_tile(const float* __restrict__ src, int ld, int K, bf16_t* __restrict__ dst, int n0, int k0, int mode,
                  const float* __restrict__ rs, float* tile) {
  const int tx = otid() & 63, ty = otid() >> 6;
  __syncthreads();
  const int sc = srccol(mode, n0 + tx);
  const int nq = n0 + tx;
  const float cscale = (mode == 0 && ((nq >= C_CQ && nq < C_CQ + 768) || (nq >= C_DQ && nq < C_DQ + 256))) ? QS64 : 1.0f;
#pragma unroll
  for (int i = 0; i < 16; ++i) {
    int kk = ty + 4 * i;
    float v = sc >= 0 ? src[(size_t)(k0 + kk) * ld + sc] : 0.f;
    if (rs) v *= rs[k0 + kk];
    tile[kk * 65 + tx] = v * cscale;
  }
  __syncthreads();
#pragma unroll
  for (int i = 0; i < 16; ++i) {
    int nn = ty + 4 * i;
    dst[(size_t)(n0 + nn) * K + k0 + tx] = f2bf(tile[tx * 65 + nn]);
  }
}

DI int t5_bucket(int rel) {
  int n = rel < 0 ? -rel : rel;
  float nf = (float)(n < 1 ? 1 : n);
  int large = 8 + (int)(logf(nf / 8.0f) / 4.852030263919617f * 8.0f);
  if (large > 15) large = 15;
  return (rel > 0 ? 16 : 0) + (n < 8 ? n : large);
}

DI void prep_item(const Params& p, int item, float* tile) {
  if (item < 5584) {
    int l = item / 2792, r = item % 2792;
    const float* src; int ld, K, mode, t; bf16_t* dst; const float* rs = nullptr;
    if (r < 1216) { t = r; src = p.w_in + (size_t)l * 1024 * 8864; ld = 8864; K = 1024; mode = 0; dst = P_W1T + (size_t)l * 4864 * 1024; }
    else if (r < 2240) { t = r - 1216; src = p.w_in + (size_t)l * 1024 * 8864; ld = 8864; K = 1024; mode = 1; dst = P_WMT + (size_t)l * 4096 * 1024; }
    else if (r < 2496) { t = r - 2240; src = p.w_out + (size_t)l * 1024 * 1024; ld = 1024; K = 1024; mode = 2; dst = P_WOT + (size_t)l * 1024 * 1024; }
    else if (r < 2752) { t = r - 2496; int n = t >> 6; t &= 63; src = p.w_branch + (size_t)(l * 4 + n) * 256 * 1024; ld = 1024; K = 256; mode = 2; dst = P_WBT + (size_t)(l * 4 + n) * 1024 * 256; }
    else if (r < 2776) { t = r - 2752; src = p.w_q_up + (size_t)l * 256 * 384; ld = 384; K = 256; mode = 3; dst = P_WQT + (size_t)l * 384 * 256; rs = p.q_norm_g + l * 256; }
    else { t = r - 2776; src = p.w_kv_up + (size_t)l * 128 * 512; ld = 512; K = 128; mode = 2; dst = P_WKVT + (size_t)l * 512 * 128; rs = p.kv_norm_g + l * 128; }
    int kt = K / 64;
    conv_tile(src, ld, K, dst, (t / kt) * 64, (t % kt) * 64, mode, rs, tile);
  } else if (item < 5584 + 512) {
    int idx = (item - 5584) * 256 + otid();
    int pos = idx >> 4, i = idx & 15;
    double invd = 1.0;
    for (int k = 0; k < i; ++k) invd *= 0.5623413251903491;
    float inv = (float)invd;
    float ang = (float)pos * inv;
    double a = (double)ang;
    double kq = rint(a * 0.15915494309189535);
    double r = a - kq * 6.283185307179586;
    double r2 = r * r, ts = r, tc = 1.0, sn = r, cs = 1.0;
    for (int k = 1; k <= 14; ++k) {
      tc = -tc * r2 / (double)((2 * k - 1) * (2 * k));
      ts = -ts * r2 / (double)((2 * k) * (2 * k + 1));
      cs += tc; sn += ts;
    }
    P_ROPE[pos * 32 + i] = (float)cs;
    P_ROPE[pos * 32 + 16 + i] = (float)sn;
  } else {
    for (int e = otid(); e < 12 * 129; e += 256) {
      int gh = e / 129, off = e % 129 - 64; int g = gh >> 2;
      int r = g == 0 ? 1 : (g == 1 ? 4 : 16);
      P_LUTC[e] = p.t5[t5_bucket(off * r) * 16 + gh] * LOG2E;
    }
    for (int e = otid(); e < 4 * 257; e += 256) {
      int hq = e / 257, off = e % 257 - 128;
      P_LUTD[e] = p.t5[t5_bucket(off) * 16 + 12 + hq] * LOG2E;
    }
  }
}

DI void norm_rows_bf16(const float* __restrict__ src, const float* __restrict__ g, bf16_t* __restrict__ dst, int item) {
  const int lane = otid() & 63, wid = otid() >> 6;
  for (int i = 0; i < 8; ++i) {
    size_t row = (size_t)item * 32 + wid * 8 + i;
    const float4* s = (const float4*)(src + row * 1024);
    float4 v[4]; float ss = 0.f;
#pragma unroll
    for (int j = 0; j < 4; ++j) { v[j] = s[lane + 64 * j]; ss += v[j].x * v[j].x + v[j].y * v[j].y + v[j].z * v[j].z + v[j].w * v[j].w; }
    ss = wave_sum(ss);
    float sc = rsqrtf(ss * (1.0f / 1024.0f) + 1e-6f);
#pragma unroll
    for (int j = 0; j < 4; ++j) {
      float4 gg = ((const float4*)g)[lane + 64 * j];
      uint2 o; o.x = pack2(v[j].x * sc * gg.x, v[j].y * sc * gg.y); o.y = pack2(v[j].z * sc * gg.z, v[j].w * sc * gg.w);
      *(uint2*)(dst + row * 1024 + (lane + 64 * j) * 4) = o;
    }
  }
}
DI void norm_rows_f32(float* io, const float* __restrict__ g, int item) {
  const int lane = otid() & 63, wid = otid() >> 6;
  for (int i = 0; i < 8; ++i) {
    size_t row = (size_t)item * 32 + wid * 8 + i;
    float4* s = (float4*)(io + row * 1024);
    float4 v[4]; float ss = 0.f;
#pragma unroll
    for (int j = 0; j < 4; ++j) { v[j] = s[lane + 64 * j]; ss += v[j].x * v[j].x + v[j].y * v[j].y + v[j].z * v[j].z + v[j].w * v[j].w; }
    ss = wave_sum(ss);
    float sc = rsqrtf(ss * (1.0f / 1024.0f) + 1e-6f);
#pragma unroll
    for (int j = 0; j < 4; ++j) {
      float4 gg = ((const float4*)g)[lane + 64 * j];
      float4 o; o.x = v[j].x * sc * gg.x; o.y = v[j].y * sc * gg.y; o.z = v[j].z * sc * gg.z; o.w = v[j].w * sc * gg.w;
      s[lane + 64 * j] = o;
    }
  }
}

constexpr int LLD = 72;
template <int NT>
DI void gemm_mainloop(f32x4 (&acc)[4][NT], const bf16_t* A, int lda, const bf16_t* Bt, int ldb, int K, bf16_t* sA, bf16_t* sB) {
  constexpr int NB = NT;
  const int tid = otid(), lane = tid & 63, wid = tid >> 6;
  const int wm = wid >> 1, wn = wid & 1, fr = lane & 15, fq = lane >> 4;
  u32x4 ra[4], rb[NB];
  const int nk = K >> 6;
#pragma unroll
  for (int i = 0; i < 4; ++i) { int c = tid + 256 * i; ra[i] = *(const u32x4*)(A + (size_t)(c >> 3) * lda + (c & 7) * 8); }
#pragma unroll
  for (int i = 0; i < NB; ++i) { int c = tid + 256 * i; rb[i] = *(const u32x4*)(Bt + (size_t)(c >> 3) * ldb + (c & 7) * 8); }
  for (int kt = 0; kt < nk; ++kt) {
    __syncthreads();
#pragma unroll
    for (int i = 0; i < 4; ++i) { int c = tid + 256 * i; *(u32x4*)(sA + (c >> 3) * LLD + (c & 7) * 8) = ra[i]; }
#pragma unroll
    for (int i = 0; i < NB; ++i) { int c = tid + 256 * i; *(u32x4*)(sB + (c >> 3) * LLD + (c & 7) * 8) = rb[i]; }
    __syncthreads();
    if (kt + 1 < nk) {
      int ko = (kt + 1) * 64;
#pragma unroll
      for (int i = 0; i < 4; ++i) { int c = tid + 256 * i; ra[i] = *(const u32x4*)(A + (size_t)(c >> 3) * lda + ko + (c & 7) * 8); }
#pragma unroll
      for (int i = 0; i < NB; ++i) { int c = tid + 256 * i; rb[i] = *(const u32x4*)(Bt + (size_t)(c >> 3) * ldb + ko + (c & 7) * 8); }
    }
#pragma unroll
    for (int ks = 0; ks < 2; ++ks) {
      bf16x8 af[4], bfr[NT];
#pragma unroll
      for (int mi = 0; mi < 4; ++mi) af[mi] = *(const bf16x8*)(sA + (wm * 64 + mi * 16 + fr) * LLD + ks * 32 + fq * 8);
#pragma unroll
      for (int ni = 0; ni < NT; ++ni) bfr[ni] = *(const bf16x8*)(sB + (wn * NT * 16 + ni * 16 + fr) * LLD + ks * 32 + fq * 8);
#pragma unroll
      for (int mi = 0; mi < 4; ++mi)
#pragma unroll
        for (int ni = 0; ni < NT; ++ni) acc[mi][ni] = __builtin_amdgcn_mfma_f32_16x16x32_bf16(bfr[ni], af[mi], acc[mi][ni], 0, 0, 0);
    }
  }
}
template <int NT>
DI void zero_acc(f32x4 (&acc)[4][NT]) {
#pragma unroll
  for (int mi = 0; mi < 4; ++mi)
#pragma unroll
    for (int ni = 0; ni < NT; ++ni) acc[mi][ni] = f32x4{0.f, 0.f, 0.f, 0.f};
}

DI void inproj_tile(const Params& p, int l, int tile, char* smem) {
  bf16_t* sA = (bf16_t*)smem; bf16_t* sB = sA + 128 * LLD;
  const int mt = tile & 255, nt = tile >> 8;
  f32x4 acc[4][4]; zero_acc<4>(acc);
  gemm_mainloop<4>(acc, P_XN + (size_t)mt * 128 * 1024, 1024, P_W1T + ((size_t)l * 4864 + nt * 128) * 1024, 1024, 1024, sA, sB);
  const int lane = otid() & 63, wid = otid() >> 6, wm = wid >> 1, wn = wid & 1, fr = lane & 15, fq = lane >> 4;
#pragma unroll
  for (int mi = 0; mi < 4; ++mi)
#pragma unroll
    for (int ni = 0; ni < 4; ++ni) {
      size_t row = (size_t)mt * 128 + wm * 64 + mi * 16 + fr; int col = nt * 128 + wn * 64 + ni * 16 + fq * 4;
      uint2 o; o.x = pack2(acc[mi][ni][0], acc[mi][ni][1]); o.y = pack2(acc[mi][ni][2], acc[mi][ni][3]);
      *(uint2*)(P_PROJ + row * PW + col) = o;
    }
}

DI void row_scales(const bf16_t* A, int lda, int K, float* sRow) {
  const int row = otid() >> 1, half = otid() & 1;
  const int per = K >> 1;
  const bf16_t* a = A + (size_t)row * lda + half * per;
  float ss = 0.f;
  for (int c = 0; c < per; c += 8) {
    uint4 u = *(const uint4*)(a + c);
    float f;
    f = BLO(u.x); ss += f * f; f = BHI(u.x); ss += f * f; f = BLO(u.y); ss += f * f; f = BHI(u.y); ss += f * f;
    f = BLO(u.z); ss += f * f; f = BHI(u.z); ss += f * f; f = BLO(u.w); ss += f * f; f = BHI(u.w); ss += f * f;
  }
  ss += __shfl_xor(ss, 1);
  if (half == 0) sRow[row] = rsqrtf(ss / (float)K + 1e-6f);
}
DI void mla_item(const Params& p, int l, int item, char* smem) {
  bf16_t* sA = (bf16_t*)smem; bf16_t* sB = sA + 128 * LLD; float* sRow = (float*)(sB + 128 * LLD);
  const int lane = otid() & 63, wid = otid() >> 6, wm = wid >> 1, wn = wid & 1, fr = lane & 15, fq = lane >> 4;
  if (item < 768) {
    const int mt = item & 255, nt = item >> 8;
    const bf16_t* A = P_PROJ + (size_t)mt * 128 * PW + C_AQ;
    __syncthreads();
    row_scales(A, PW, 256, sRow);
    f32x4 acc[4][4]; zero_acc<4>(acc);
    gemm_mainloop<4>(acc, A, PW, P_WQT + ((size_t)l * 384 + nt * 128) * 256, 256, 256, sA, sB);
    if (nt < 2) {
#pragma unroll
      for (int mi = 0; mi < 4; ++mi)
#pragma unroll
        for (int ni = 0; ni < 4; ++ni) {
          int rl = wm * 64 + mi * 16 + fr; size_t t = (size_t)mt * 128 + rl; float s = sRow[rl] * QS96;
          int c = nt * 128 + wn * 64 + ni * 16 + fq * 4; int h = c >> 6, d = c & 63;
          uint2 o; o.x = pack2(acc[mi][ni][0] * s, acc[mi][ni][1] * s); o.y = pack2(acc[mi][ni][2] * s, acc[mi][ni][3] * s);
          *(uint2*)(P_QA + t * 384 + h * 96 + d) = o;
        }
    } else {
#pragma unroll
      for (int mi = 0; mi < 4; ++mi)
#pragma unroll
        for (int np = 0; np < 2; ++np) {
          int rl = wm * 64 + mi * 16 + fr; size_t t = (size_t)mt * 128 + rl; float s = sRow[rl] * QS96;
          int pos = (int)(t & (SEQ - 1)); int h = wn * 2 + np;
          const float* cs = P_ROPE + pos * 32 + fq * 4;
          float o1[4], o2[4];
#pragma unroll
          for (int j = 0; j < 4; ++j) {
            float x1 = acc[mi][np * 2][j] * s, x2 = acc[mi][np * 2 + 1][j] * s; float c = cs[j], sn = cs[16 + j];
            o1[j] = x1 * c - x2 * sn; o2[j] = x1 * sn + x2 * c;
          }
          uint2 a; a.x = pack2(o1[0], o1[1]); a.y = pack2(o1[2], o1[3]);
          uint2 b; b.x = pack2(o2[0], o2[1]); b.y = pack2(o2[2], o2[3]);
          *(uint2*)(P_QA + t * 384 + h * 96 + 64 + fq * 4) = a;
          *(uint2*)(P_QA + t * 384 + h * 96 + 80 + fq * 4) = b;
        }
    }
  } else if (item < 768 + 1024) {
    const int it = item - 768; const int mt = it & 255, h = it >> 8;
    const bf16_t* A = P_PROJ + (size_t)mt * 128 * PW + C_AKV;
    __syncthreads();
    row_scales(A, PW, 128, sRow);
    f32x4 acc[4][4]; zero_acc<4>(acc);
    gemm_mainloop<4>(acc, A, PW, P_WKVT + ((size_t)l * 512 + h * 128) * 128, 128, 128, sA, sB);
#pragma unroll
    for (int mi = 0; mi < 4; ++mi)
#pragma unroll
      for (int ni = 0; ni < 4; ++ni) {
        int rl = wm * 64 + mi * 16 + fr; size_t t = (size_t)mt * 128 + rl; float s = sRow[rl];
        int d = ni * 16 + fq * 4;
        uint2 o; o.x = pack2(acc[mi][ni][0] * s, acc[mi][ni][1] * s); o.y = pack2(acc[mi][ni][2] * s, acc[mi][ni][3] * s);
        if (wn == 0) *(uint2*)(P_KA + t * 384 + h * 96 + d) = o;
        else *(uint2*)(P_VA + t * 256 + h * 64 + d) = o;
      }
  } else {
    const int it = item - 1792;
    const int half = lane >> 5, pl = lane & 31;
    for (int i = 0; i < 32; ++i) {
      size_t t = (size_t)it * 128 + wid * 32 + i; int pos = (int)(t & (SEQ - 1));
      bf16_t* row = P_PROJ + t * PW;
#pragma unroll
      for (int s3 = 0; s3 < 3; ++s3) {
        int slot = s3 * 2 + half;
        bf16_t* hp = row + (slot < 4 ? C_BQ + slot * 64 : C_BK + (slot - 4) * 64);
        const float* g = (slot < 4 ? p.gq_g : p.gk_g) + l * 64;
        int d1, fi, ap;
        if (pl < 16) { d1 = pl; fi = pl; ap = pos >> 6; } else { d1 = 32 + (pl - 16); fi = pl - 16; ap = pos & 63; }
        float x1 = bf2f(hp[d1]), x2 = bf2f(hp[d1 + 16]);
        float ss = x1 * x1 + x2 * x2;
#pragma unroll
        for (int o = 16; o; o >>= 1) ss += __shfl_xor(ss, o);
        float sc = rsqrtf(ss * (1.0f / 64.0f) + 1e-6f);
        if (slot < 4) sc *= QS64;
        x1 = x1 * sc * g[d1]; x2 = x2 * sc * g[d1 + 16];
        float c = P_ROPE[ap * 32 + fi], sn = P_ROPE[ap * 32 + 16 + fi];
        hp[d1] = f2bf(x1 * c - x2 * sn); hp[d1 + 16] = f2bf(x1 * sn + x2 * c);
      }
      if (lane < 16) {
        float x1 = bf2f(row[C_AKR + lane]), x2 = bf2f(row[C_AKR + 16 + lane]);
        float c = P_ROPE[pos * 32 + lane], sn = P_ROPE[pos * 32 + 16 + lane];
        bf16_t o1 = f2bf(x1 * c - x2 * sn), o2 = f2bf(x1 * sn + x2 * c);
#pragma unroll
        for (int h = 0; h < 4; ++h) { P_KA[t * 384 + h * 96 + 64 + lane] = o1; P_KA[t * 384 + h * 96 + 80 + lane] = o2; }
      }
    }
  }
}

#define MFMA32(a, b, c) __builtin_amdgcn_mfma_f32_32x32x16_bf16((a), (b), (c), 0, 0, 0)
template <int OFF> DI bf16x4 tr_read(unsigned addr) {
  bf16x4 r; asm volatile("ds_read_b64_tr_b16 %0, %1 offset:%2" : "=&v"(r) : "v"(addr), "i"(OFF) : "memory"); return r;
}
DI float half_swap_max(float v) {
  auto rr = __builtin_amdgcn_permlane32_swap(__float_as_uint(v), __float_as_uint(v), false, false);
  return fmaxf(__uint_as_float(rr[0]), __uint_as_float(rr[1]));
}
DI float half_swap_sum(float v) {
  auto rr = __builtin_amdgcn_permlane32_swap(__float_as_uint(v), __float_as_uint(v), false, false);
  return __uint_as_float(rr[0]) + __uint_as_float(rr[1]);
}
DI bf16x8 pack8(const f32x16& p, int base) {
  u32x4 w = {pack2(p[base + 0], p[base + 1]), pack2(p[base + 2], p[base + 3]), pack2(p[base + 4], p[base + 5]), pack2(p[base + 6], p[base + 7])};
  return __builtin_bit_cast(bf16x8, w);
}
template <int DB, int VLD> DI void pv_block(f32x16& o, unsigned vb, bf16x8 pb0, bf16x8 pb1, bf16x8 pb2, bf16x8 pb3) {
  constexpr int RB = VLD * 2;
  bf16x4 l0 = tr_read<0 * RB + 64 * DB>(vb), h0 = tr_read<8 * RB + 64 * DB>(vb);
  bf16x4 l1 = tr_read<16 * RB + 64 * DB>(vb), h1 = tr_read<24 * RB + 64 * DB>(vb);
  bf16x4 l2 = tr_read<32 * RB + 64 * DB>(vb), h2 = tr_read<40 * RB + 64 * DB>(vb);
  bf16x4 l3 = tr_read<48 * RB + 64 * DB>(vb), h3 = tr_read<56 * RB + 64 * DB>(vb);
  asm volatile("s_waitcnt lgkmcnt(0)" ::: "memory"); __builtin_amdgcn_sched_barrier(0);
  o = MFMA32(__builtin_shufflevector(l0, h0, 0, 1, 2, 3, 4, 5, 6, 7), pb0, o);
  o = MFMA32(__builtin_shufflevector(l1, h1, 0, 1, 2, 3, 4, 5, 6, 7), pb1, o);
  o = MFMA32(__builtin_shufflevector(l2, h2, 0, 1, 2, 3, 4, 5, 6, 7), pb2, o);
  o = MFMA32(__builtin_shufflevector(l3, h3, 0, 1, 2, 3, 4, 5, 6, 7), pb3, o);
}
DI f32x16 splat16(float v) { f32x16 r;
#pragma unroll
  for (int i = 0; i < 16; ++i) r[i] = v;
  return r; }

template <int DQK>
DI void attn_dense_mfma(const bf16_t* Qb, int ldq, const bf16_t* Kb, int ldk, const bf16_t* Vb, int ldv, bf16_t* gate_io, char* smem) {
  constexpr int NS = DQK / 16, KLD = DQK + 8, VLD = 72, CPR = DQK / 8, NKC = (64 * CPR) / 256;
  constexpr int KBYTES = 64 * KLD * 2, VBYTES = 64 * VLD * 2;
  char* sKc = smem; char* sVc = smem + 2 * KBYTES;
  const int tid = otid(), lane = tid & 63, wid = tid >> 6, r = lane & 31, h = lane >> 5;
  bf16x8 qf[NS];
#pragma unroll
  for (int s = 0; s < NS; ++s) qf[s] = *(const bf16x8*)(Qb + (size_t)(wid * 32 + r) * ldq + 16 * s + 8 * h);
  int krow[NKC], kcc[NKC];
#pragma unroll
  for (int i = 0; i < NKC; ++i) { int c = tid + 256 * i; krow[i] = c / CPR; kcc[i] = c % CPR; }
  const int vrow0 = tid >> 3, vcc = tid & 7;
  u32x4 rk[NKC], rv[2];
#define DLOAD(k0) do { \
    _Pragma("unroll") for (int i = 0; i < NKC; ++i) rk[i] = *(const u32x4*)(Kb + (size_t)((k0) + krow[i]) * ldk + kcc[i] * 8); \
    rv[0] = *(const u32x4*)(Vb + (size_t)((k0) + vrow0) * ldv + vcc * 8); \
    rv[1] = *(const u32x4*)(Vb + (size_t)((k0) + vrow0 + 32) * ldv + vcc * 8); } while (0)
#define DSTORE(st) do { \
    _Pragma("unroll") for (int i = 0; i < NKC; ++i) *(u32x4*)(sKc + (st) * KBYTES + (krow[i] * KLD + kcc[i] * 8) * 2) = rk[i]; \
    *(u32x4*)(sVc + (st) * VBYTES + (vrow0 * VLD + vcc * 8) * 2) = rv[0]; \
    *(u32x4*)(sVc + (st) * VBYTES + ((vrow0 + 32) * VLD + vcc * 8) * 2) = rv[1]; } while (0)
  const unsigned vb0 = (unsigned)(size_t)sVc + (unsigned)(((4 * h + ((lane & 15) >> 2)) * VLD + 16 * ((lane >> 4) & 1) + 4 * (lane & 3)) * 2);
  f32x16 o0 = splat16(0.f), o1 = splat16(0.f);
  float m_run = 0.f, l_run = 0.f;
  __syncthreads();
  DLOAD(0); DSTORE(0);
  __syncthreads();
  constexpr int NT = SEQ / 64;
  for (int j = 0; j < NT; ++j) {
    const int cur = j & 1;
    if (j + 1 < NT) DLOAD((j + 1) * 64);
    const bf16_t* sK = (const bf16_t*)(sKc + cur * KBYTES);
    f32x16 p0 = splat16(0.f), p1 = splat16(0.f);
#pragma unroll
    for (int s = 0; s < NS; ++s) {
      bf16x8 k0 = *(const bf16x8*)(sK + r * KLD + 16 * s + 8 * h);
      bf16x8 k1 = *(const bf16x8*)(sK + (32 + r) * KLD + 16 * s + 8 * h);
      p0 = MFMA32(k0, qf[s], p0);
      p1 = MFMA32(k1, qf[s], p1);
    }
    float pm = fmaxf(p0[0], p1[0]);
#pragma unroll
    for (int i = 1; i < 16; ++i) pm = fmaxf(pm, fmaxf(p0[i], p1[i]));
    pm = half_swap_max(pm) - m_run;
    if (j == 0 || __any(pm > 8.0f)) {
      float delta;
      if (j == 0) delta = pm;
      else {
        delta = fmaxf(pm, 0.f);
        float alpha = __builtin_amdgcn_exp2f(-delta);
        l_run *= alpha;
#pragma unroll
        for (int i = 0; i < 16; ++i) { o0[i] *= alpha; o1[i] *= alpha; }
      }
      m_run += delta;
    }
    float ls = 0.f;
#pragma unroll
    for (int i = 0; i < 16; ++i) { p0[i] = __builtin_amdgcn_exp2f(p0[i] - m_run); p1[i] = __builtin_amdgcn_exp2f(p1[i] - m_run); ls += p0[i] + p1[i]; }
    l_run += ls;
    bf16x8 pb0 = pack8(p0, 0), pb1 = pack8(p0, 8), pb2 = pack8(p1, 0), pb3 = pack8(p1, 8);
    const unsigned vb = vb0 + cur * VBYTES;
    pv_block<0, VLD>(o0, vb, pb0, pb1, pb2, pb3);
    pv_block<1, VLD>(o1, vb, pb0, pb1, pb2, pb3);
    if (j + 1 < NT) DSTORE(cur ^ 1);
    __syncthreads();
  }
#undef DLOAD
#undef DSTORE
  const float inv = 1.0f / half_swap_sum(l_run);
  bf16_t* grow = gate_io + (size_t)(wid * 32 + r) * PW;
#pragma unroll
  for (int db = 0; db < 2; ++db)
#pragma unroll
    for (int g4 = 0; g4 < 4; ++g4) {
      bf16_t* gp = grow + 32 * db + 8 * g4 + 4 * h;
      uint2 u = *(const uint2*)gp;
      float g[4] = {BLO(u.x), BHI(u.x), BLO(u.y), BHI(u.y)};
      float y[4];
#pragma unroll
      for (int e = 0; e < 4; ++e) { float ov = db == 0 ? o0[4 * g4 + e] : o1[4 * g4 + e]; y[e] = ov * inv * g[e] / (1.0f + __expf(-g[e])); }
      uint2 w; w.x = pack2(y[0], y[1]); w.y = pack2(y[2], y[3]);
      *(uint2*)gp = w;
    }
}
DI void dense_item(const Params& p, int combo, int qblk, char* smem) {
  const int br = combo >> 4, bh = combo & 15, b = bh >> 2, h = bh & 3;
  const size_t t0 = (size_t)b * SEQ + qblk * 128;
  bf16_t* gate_io = P_PROJ + t0 * PW + C_GATE + br * 256 + h * 64;
  if (br == 0)
    attn_dense_mfma<96>(P_QA + t0 * 384 + h * 96, 384, P_KA + (size_t)b * SEQ * 384 + h * 96, 384, P_VA + (size_t)b * SEQ * 256 + h * 64, 256, gate_io, smem);
  else
    attn_dense_mfma<64>(P_PROJ + t0 * PW + C_BQ + h * 64, PW, P_PROJ + (size_t)b * SEQ * PW + C_BK + (h >> 1) * 64, PW,
                        P_PROJ + (size_t)b * SEQ * PW + C_BV + (h >> 1) * 64, PW, gate_io, smem);
}

template <int W, bool SINK>
DI void attn_band_mfma(const bf16_t* Qb, size_t ldq, const bf16_t* Kb, const bf16_t* Vb, size_t ldk, int L, int i0,
                       const float* lut_g, float sink2, bf16_t* outp, size_t ldo, float* lse_out, size_t ldl, char* smem) {
  constexpr int NS = 4, KLD = 72, VLD = 72, NTW = (128 + 2 * W) / 64, LUTN = 2 * W + 1;
  constexpr int KBYTES = 64 * KLD * 2, VBYTES = 64 * VLD * 2;
  char* sKc = smem; char* sVc = smem + 2 * KBYTES; float* sLut = (float*)(smem + 2 * KBYTES + 2 * VBYTES);
  const int tid = otid(), lane = tid & 63, wid = tid >> 6, r = lane & 31, h = lane >> 5;
  __syncthreads();
  for (int e = tid; e < LUTN; e += 256) sLut[e] = lut_g[e];
  const int qi = i0 + wid * 32 + r;
  bf16x8 qf[NS];
#pragma unroll
  for (int s = 0; s < NS; ++s) qf[s] = *(const bf16x8*)(Qb + (size_t)qi * ldq + 16 * s + 8 * h);
  const int srow = tid >> 3, scc = tid & 7;
  u32x4 rk[2], rv[2];
#define BLOAD(k0) do { \
    rk[0] = *(const u32x4*)(Kb + (size_t)((k0) + srow) * ldk + scc * 8); rk[1] = *(const u32x4*)(Kb + (size_t)((k0) + srow + 32) * ldk + scc * 8); \
    rv[0] = *(const u32x4*)(Vb + (size_t)((k0) + srow) * ldk + scc * 8); rv[1] = *(const u32x4*)(Vb + (size_t)((k0) + srow + 32) * ldk + scc * 8); } while (0)
#define BSTORE(st) do { \
    *(u32x4*)(sKc + (st) * KBYTES + (srow * KLD + scc * 8) * 2) = rk[0]; *(u32x4*)(sKc + (st) * KBYTES + ((srow + 32) * KLD + scc * 8) * 2) = rk[1]; \
    *(u32x4*)(sVc + (st) * VBYTES + (srow * VLD + scc * 8) * 2) = rv[0]; *(u32x4*)(sVc + (st) * VBYTES + ((srow + 32) * VLD + scc * 8) * 2) = rv[1]; } while (0)
  const unsigned vb0 = (unsigned)(size_t)sVc + (unsigned)(((4 * h + ((lane & 15) >> 2)) * VLD + 16 * ((lane >> 4) & 1) + 4 * (lane & 3)) * 2);
  f32x16 o0 = splat16(0.f), o1 = splat16(0.f);
  float m_run = SINK ? sink2 : 0.f, l_run = (SINK && h == 0) ? 1.f : 0.f;
  bool seen = SINK;
  f32x16 negm = splat16(-m_run);
  const int lo = (i0 == 0) ? W / 64 : 0, hi = (i0 + 128 >= L) ? NTW - W / 64 : NTW;
  BLOAD(i0 - W + 64 * lo); BSTORE(0);
  __syncthreads();
  for (int j = lo; j < hi; ++j) {
    const int cur = (j - lo) & 1, k0 = i0 - W + 64 * j;
    if (j + 1 < hi) BLOAD(k0 + 64);
    const bf16_t* sK = (const bf16_t*)(sKc + cur * KBYTES);
    f32x16 p0 = negm, p1 = negm;
#pragma unroll
    for (int s = 0; s < NS; ++s) {
      bf16x8 k0f = *(const bf16x8*)(sK + r * KLD + 16 * s + 8 * h);
      bf16x8 k1f = *(const bf16x8*)(sK + (32 + r) * KLD + 16 * s + 8 * h);
      p0 = MFMA32(k0f, qf[s], p0);
      p1 = MFMA32(k1f, qf[s], p1);
    }
    const int offb = k0 + 4 * h - qi + W;
    float pm = -1e30f;
#pragma unroll
    for (int i = 0; i < 16; ++i) {
      int idx0 = offb + (i & 3) + 8 * (i >> 2), idx1 = idx0 + 32;
      int c0 = min(max(idx0, 0), 2 * W), c1 = min(max(idx1, 0), 2 * W);
      float b0 = sLut[c0], b1 = sLut[c1];
      p0[i] = ((unsigned)idx0 <= (unsigned)(2 * W)) ? p0[i] + b0 : -1e30f;
      p1[i] = ((unsigned)idx1 <= (unsigned)(2 * W)) ? p1[i] + b1 : -1e30f;
      pm = fmaxf(pm, fmaxf(p0[i], p1[i]));
    }
    pm = half_swap_max(pm);
    const bool has = pm > -1e29f;
    float delta = 0.f;
    if (has) { if (!seen) delta = pm; else if (pm > 8.0f) delta = pm; }
    if (__any(delta != 0.f)) {
      float alpha = seen ? __builtin_amdgcn_exp2f(-delta) : 1.0f;
      l_run *= alpha; m_run += delta;
#pragma unroll
      for (int i = 0; i < 16; ++i) { o0[i] *= alpha; o1[i] *= alpha; p0[i] -= delta; p1[i] -= delta; }
      negm = splat16(-m_run);
    }
    seen = seen || has;
    float ls = 0.f;
#pragma unroll
    for (int i = 0; i < 16; ++i) { p0[i] = __builtin_amdgcn_exp2f(p0[i]); p1[i] = __builtin_amdgcn_exp2f(p1[i]); ls += p0[i] + p1[i]; }
    l_run += ls;
    bf16x8 pb0 = pack8(p0, 0), pb1 = pack8(p0, 8), pb2 = pack8(p1, 0), pb3 = pack8(p1, 8);
    const unsigned vb = vb0 + cur * VBYTES;
    pv_block<0, VLD>(o0, vb, pb0, pb1, pb2, pb3);
    pv_block<1, VLD>(o1, vb, pb0, pb1, pb2, pb3);
    if (j + 1 < hi) BSTORE(cur ^ 1);
    __syncthreads();
  }
#undef BLOAD
#undef BSTORE
  const float ltot = half_swap_sum(l_run);
  const float inv = 1.0f / ltot;
  bf16_t* orow = outp + (size_t)qi * ldo;
  if (!SINK && h == 0) lse_out[(size_t)qi * ldl] = m_run + __log2f(ltot);
#pragma unroll
  for (int db = 0; db < 2; ++db)
#pragma unroll
    for (int g4 = 0; g4 < 4; ++g4) {
      bf16_t* gp = orow + 32 * db + 8 * g4 + 4 * h;
      float y[4];
      if (SINK) {
        uint2 u = *(const uint2*)gp;
        float g[4] = {BLO(u.x), BHI(u.x), BLO(u.y), BHI(u.y)};
#pragma unroll
        for (int e = 0; e < 4; ++e) { float ov = db == 0 ? o0[4 * g4 + e] : o1[4 * g4 + e]; y[e] = ov * inv * g[e] / (1.0f + __expf(-g[e])); }
      } else {
#pragma unroll
        for (int e = 0; e < 4; ++e) { float ov = db == 0 ? o0[4 * g4 + e] : o1[4 * g4 + e]; y[e] = ov * inv; }
      }
      uint2 w; w.x = pack2(y[0], y[1]); w.y = pack2(y[2], y[3]);
      *(uint2*)gp = w;
    }
}
DI void band_item(const Params& p, int l, int idx, char* smem) {
  if (idx < 3072) {
    const int g = idx >> 10, rem = idx & 1023, h = rem & 3, rem2 = rem >> 2, b = rem2 >> 6, u = rem2 & 63;
    const int sh = 2 * g, rr = 1 << sh;
    const int rho = u & (rr - 1), qblk = u >> sh;
    const size_t tok0 = (size_t)b * SEQ + rho;
    bf16_t* base = P_PROJ + tok0 * PW + g * 256 + h * 64;
    attn_band_mfma<64, false>(base + C_CQ, (size_t)rr * PW, base + C_CK, base + C_CV, (size_t)rr * PW, SEQ >> sh, qblk * 128,
                              P_LUTC + (g * 4 + h) * 129, 0.f, base + C_CQ, (size_t)rr * PW, P_LSE + tok0 * 12 + g * 4 + h, (size_t)rr * 12, smem);
  } else {
    const int it = idx - 3072, hq = it & 3, rem = it >> 2, b = rem >> 6, qblk = rem & 63;
    bf16_t* base = P_PROJ + (size_t)b * SEQ * PW;
    attn_band_mfma<128, true>(base + C_DQ + hq * 64, PW, base + C_DK + (hq >> 1) * 64, base + C_DV + (hq >> 1) * 64, PW, SEQ, qblk * 128,
                              P_LUTD + hq * 257, p.sink[l * 4 + hq] * LOG2E, base + C_GATE + 768 + hq * 64, PW, nullptr, 0, smem);
  }
}
DI void combine_c(const Params& p) {
  for (size_t u = (size_t)blockIdx.x * 256 + otid(); u < (size_t)32768 * 32; u += (size_t)gridDim.x * 256) {
    const size_t t = u >> 5; const int h = (int)(u >> 3) & 3, ch = (int)u & 7;
    const float* ls = P_LSE + t * 12 + h;
    float l0 = ls[0], l1 = ls[4], l2 = ls[8];
    float mx = fmaxf(l0, fmaxf(l1, l2));
    float a0 = __builtin_amdgcn_exp2f(l0 - mx), a1 = __builtin_amdgcn_exp2f(l1 - mx), a2 = __builtin_amdgcn_exp2f(l2 - mx);
    float inv = 1.0f / (a0 + a1 + a2); a0 *= inv; a1 *= inv; a2 *= inv;
    const bf16_t* row = P_PROJ + t * PW;
    uint4 x0 = *(const uint4*)(row + C_CQ + h * 64 + ch * 8), x1 = *(const uint4*)(row + C_CQ + 256 + h * 64 + ch * 8),
          x2 = *(const uint4*)(row + C_CQ + 512 + h * 64 + ch * 8);
    bf16_t* gp = P_PROJ + t * PW + C_GATE + 512 + h * 64 + ch * 8;
    uint4 gu = *(const uint4*)gp;
    unsigned xa[4] = {x0.x, x0.y, x0.z, x0.w}, xb[4] = {x1.x, x1.y, x1.z, x1.w}, xc[4] = {x2.x, x2.y, x2.z, x2.w}, gg[4] = {gu.x, gu.y, gu.z, gu.w};
    unsigned ov[4];
#pragma unroll
    for (int e = 0; e < 4; ++e) {
      float ylo = a0 * BLO(xa[e]) + a1 * BLO(xb[e]) + a2 * BLO(xc[e]);
      float yhi = a0 * BHI(xa[e]) + a1 * BHI(xb[e]) + a2 * BHI(xc[e]);
      float glo = BLO(gg[e]), ghi = BHI(gg[e]);
      ov[e] = pack2(ylo * glo / (1.0f + __expf(-glo)), yhi * ghi / (1.0f + __expf(-ghi)));
    }
    uint4 w; w.x = ov[0]; w.y = ov[1]; w.z = ov[2]; w.w = ov[3];
    *(uint4*)gp = w;
  }
}

DI void merge_tile(const Params& p, int l, int tile, char* smem) {
  bf16_t* sA = (bf16_t*)smem; bf16_t* sB = sA + 128 * LLD;
  const int mt = tile & 255, nt = tile >> 8;
  f32x4 accM[4][2]; zero_acc<2>(accM);
  for (int n = 0; n < 4; ++n) {
    f32x4 accG[4][2]; zero_acc<2>(accG);
    gemm_mainloop<2>(accG, P_XN + (size_t)mt * 128 * 1024, 1024, P_WMT + ((size_t)l * 4096 + n * 1024 + nt * 64) * 1024, 1024, 1024, sA, sB);
    f32x4 accB[4][2]; zero_acc<2>(accB);
    gemm_mainloop<2>(accB, P_PROJ + (size_t)mt * 128 * PW + C_GATE + n * 256, PW, P_WBT + ((size_t)(l * 4 + n) * 1024 + nt * 64) * 256, 256, 256, sA, sB);
#pragma unroll
    for (int mi = 0; mi < 4; ++mi)
#pragma unroll
      for (int ni = 0; ni < 2; ++ni)
#pragma unroll
        for (int j = 0; j < 4; ++j) accM[mi][ni][j] += accB[mi][ni][j] / (1.0f + __expf(-accG[mi][ni][j]));
  }
  const int lane = otid() & 63, wid = otid() >> 6, wm = wid >> 1, wn = wid & 1, fr = lane & 15, fq = lane >> 4;
#pragma unroll
  for (int mi = 0; mi < 4; ++mi)
#pragma unroll
    for (int ni = 0; ni < 2; ++ni) {
      size_t row = (size_t)mt * 128 + wm * 64 + mi * 16 + fr; int col = nt * 64 + wn * 32 + ni * 16 + fq * 4;
      uint2 o; o.x = pack2(accM[mi][ni][0], accM[mi][ni][1]); o.y = pack2(accM[mi][ni][2], accM[mi][ni][3]);
      *(uint2*)(P_PROJ + row * PW + C_MERGED + col) = o;
    }
}

DI void outproj_tile(const Params& p, int l, int tile, char* smem) {
  bf16_t* sA = (bf16_t*)smem; bf16_t* sB = sA + 128 * LLD;
  const int mt = tile & 255, nt = tile >> 8;
  f32x4 acc[4][4]; zero_acc<4>(acc);
  gemm_mainloop<4>(acc, P_PROJ + (size_t)mt * 128 * PW + C_MERGED, PW, P_WOT + ((size_t)l * 1024 + nt * 128) * 1024, 1024, 1024, sA, sB);
  const float* xin = l == 0 ? p.x : p.out;
  const int lane = otid() & 63, wid = otid() >> 6, wm = wid >> 1, wn = wid & 1, fr = lane & 15, fq = lane >> 4;
#pragma unroll
  for (int mi = 0; mi < 4; ++mi)
#pragma unroll
    for (int ni = 0; ni < 4; ++ni) {
      size_t row = (size_t)mt * 128 + wm * 64 + mi * 16 + fr; int col = nt * 128 + wn * 64 + ni * 16 + fq * 4;
      float4 xi = *(const float4*)(xin + row * 1024 + col);
      float4 o; o.x = xi.x + acc[mi][ni][0]; o.y = xi.y + acc[mi][ni][1]; o.z = xi.z + acc[mi][ni][2]; o.w = xi.w + acc[mi][ni][3];
      *(float4*)(p.out + row * 1024 + col) = o;
    }
}

DI void run_phase(const Params& p, int ph, char* smem) {
  const int G = gridDim.x, B = blockIdx.x;
  if (ph == 0) {
    for (int i = B; i < 6097; i += G) prep_item(p, i, (float*)smem);
    for (int i = B; i < 1024; i += G) norm_rows_bf16(p.x, p.norm_g, P_XN, i);
  } else if (ph == 14) {
    for (int i = B; i < 1024; i += G) norm_rows_f32(p.out, p.final_g, i);
  } else if (ph == 7) {
    for (int i = B; i < 1024; i += G) norm_rows_bf16(p.out, p.norm_g + 1024, P_XN, i);
  } else {
    const int l = ph > 7 ? 1 : 0; const int s = ph > 7 ? ph - 8 : ph - 1;
#ifdef ONLY_S
    if (s != ONLY_S) return;
#endif
    if (s == 0) { for (int i = B; i < 256 * 38; i += G) inproj_tile(p, l, i, smem); }
    else if (s == 1) { for (int i = B; i < 2048; i += G) mla_item(p, l, i, smem); }
    else if (s == 2) {
      const int xcd = B & 7, lb = B >> 3, nl = G >> 3;
#ifndef NO_DENSE
      for (int w = lb; w < 256; w += nl) dense_item(p, xcd + 8 * (w >> 6), w & 63, smem);
#endif
#ifndef NO_BAND
      for (int i = B; i < 4096; i += G) band_item(p, l, i, smem);
#endif
    }
    else if (s == 3) { combine_c(p); }
    else if (s == 4) { for (int i = B; i < 256 * 16; i += G) merge_tile(p, l, i, smem); }
    else { for (int i = B; i < 256 * 8; i += G) outproj_tile(p, l, i, smem); }
  }
}

__global__ void __launch_bounds__(256, 2) mega(Params p, int ph_lo, int ph_hi) {
  __shared__ __attribute__((aligned(16))) char smem[47104];
  cg::grid_group grid = cg::this_grid();
  for (int ph = ph_lo; ph < ph_hi; ++ph) {
    run_phase(p, ph, smem);
    if (ph + 1 < ph_hi) grid.sync();
  }
}

extern "C" void kernel_launch(void* const* d_in, const int* in_sizes, int n_in, void* d_out, int out_size, void* d_ws,
                              size_t ws_size, hipStream_t stream) {
  Params p{};
  p.x = (const float*)d_in[0]; p.norm_g = (const float*)d_in[1]; p.w_in = (const float*)d_in[2];
  p.q_norm_g = (const float*)d_in[3]; p.kv_norm_g = (const float*)d_in[4]; p.w_q_up = (const float*)d_in[5];
  p.w_kv_up = (const float*)d_in[6]; p.gq_g = (const float*)d_in[7]; p.gk_g = (const float*)d_in[8];
  p.sink = (const float*)d_in[9]; p.t5 = (const float*)d_in[10]; p.w_branch = (const float*)d_in[11];
  p.w_out = (const float*)d_in[12]; p.final_g = (const float*)d_in[13];
  p.out = (float*)d_out;
  p.ws = (char*)d_ws;
  if (WS_NEED > ws_size) { fprintf(stderr, "workspace too small: need %zu have %zu\n", (size_t)WS_NEED, ws_size); return; }

  static int grid_blocks = 0;
  if (!grid_blocks) {
    int dev = 0, cus = 0, per_cu = 0;
    hipGetDevice(&dev);
    hipDeviceGetAttribute(&cus, hipDeviceAttributeMultiprocessorCount, dev);
    hipOccupancyMaxActiveBlocksPerMultiprocessor(&per_cu, mega, 256, 0);
    if (per_cu < 1) per_cu = 1;
    if (per_cu > 2) per_cu = 2;
    grid_blocks = cus * per_cu;
  }
  int lo = 0, hi = 15;
  void* args[] = {&p, &lo, &hi};
  hipError_t e = hipLaunchCooperativeKernel((void*)mega, dim3(grid_blocks), dim3(256), args, 0, stream);
  if (e != hipSuccess) fprintf(stderr, "cooperative launch failed: %s (grid %d)\n", hipGetErrorString(e), grid_blocks);
}
```

```cpp
#include <hip/hip_runtime.h>
#include <hip/hip_cooperative_groups.h>
#include <cstdio>
namespace cg = cooperative_groups;

typedef unsigned short bf16_t;
using bf16x8 = __attribute__((ext_vector_type(8))) short;
using f32x4 = __attribute__((ext_vector_type(4))) float;
using u32x4 = __attribute__((ext_vector_type(4))) unsigned;
using f32x16 = __attribute__((ext_vector_type(16))) float;
using bf16x4 = __attribute__((ext_vector_type(4))) short;
#define DI __device__ __forceinline__

constexpr int SEQ = 8192;
constexpr int PW = 4864;
constexpr int C_BQ = 0, C_BK = 256, C_BV = 384, C_CQ = 512, C_CK = 1280, C_CV = 2048, C_DQ = 2816, C_DK = 3072,
              C_DV = 3200, C_GATE = 3328, C_AQ = 4352, C_AKV = 4608, C_AKR = 4736;
constexpr int C_MERGED = 512;

struct Params {
  const float* x; const float* norm_g; const float* w_in; const float* q_norm_g; const float* kv_norm_g;
  const float* w_q_up; const float* w_kv_up; const float* gq_g; const float* gk_g; const float* sink;
  const float* t5; const float* w_branch; const float* w_out; const float* final_g;
  float* out; char* ws;
};
constexpr size_t al256(size_t x) { return (x + 255) & ~(size_t)255; }
constexpr size_t OFF_W1T = 0;
constexpr size_t OFF_WMT = OFF_W1T + al256((size_t)2 * 4864 * 1024 * 2);
constexpr size_t OFF_WOT = OFF_WMT + al256((size_t)2 * 4096 * 1024 * 2);
constexpr size_t OFF_WBT = OFF_WOT + al256((size_t)2 * 1024 * 1024 * 2);
constexpr size_t OFF_WQT = OFF_WBT + al256((size_t)2 * 4 * 1024 * 256 * 2);
constexpr size_t OFF_WKVT = OFF_WQT + al256((size_t)2 * 384 * 256 * 2);
constexpr size_t OFF_ROPE = OFF_WKVT + al256((size_t)2 * 512 * 128 * 2);
constexpr size_t OFF_LUTC = OFF_ROPE + al256((size_t)8192 * 32 * 4);
constexpr size_t OFF_LUTD = OFF_LUTC + 8192;
constexpr size_t OFF_XN = OFF_LUTD + 8192;
constexpr size_t OFF_PROJ = OFF_XN + al256((size_t)32768 * 1024 * 2);
constexpr size_t OFF_QA = OFF_PROJ + al256((size_t)32768 * 4864 * 2);
constexpr size_t OFF_KA = OFF_QA + al256((size_t)32768 * 384 * 2);
constexpr size_t OFF_VA = OFF_KA + al256((size_t)32768 * 384 * 2);
constexpr size_t OFF_LSE = OFF_VA + al256((size_t)32768 * 256 * 2);
constexpr size_t OFF_BAR = OFF_LSE + al256((size_t)32768 * 12 * 4);
constexpr size_t WS_NEED = OFF_BAR + 16384;
#define WSP(T, OFF) ((T*)(p.ws + (OFF)))
#define P_W1T WSP(bf16_t, OFF_W1T)
#define P_WMT WSP(bf16_t, OFF_WMT)
#define P_WOT WSP(bf16_t, OFF_WOT)
#define P_WBT WSP(bf16_t, OFF_WBT)
#define P_WQT WSP(bf16_t, OFF_WQT)
#define P_WKVT WSP(bf16_t, OFF_WKVT)
#define P_ROPE WSP(float, OFF_ROPE)
#define P_LUTC WSP(float, OFF_LUTC)
#define P_LUTD WSP(float, OFF_LUTD)
#define P_XN WSP(bf16_t, OFF_XN)
#define P_PROJ WSP(bf16_t, OFF_PROJ)
#define P_QA WSP(bf16_t, OFF_QA)
#define P_KA WSP(bf16_t, OFF_KA)
#define P_VA WSP(bf16_t, OFF_VA)
#define P_LSE WSP(float, OFF_LSE)


DI unsigned short f2bf(float x) { unsigned u = __float_as_uint(x); u += 0x7fffu + ((u >> 16) & 1u); return (unsigned short)(u >> 16); }
DI float bf2f(unsigned short b) { return __uint_as_float(((unsigned)b) << 16); }
typedef __bf16 bf2_t __attribute__((ext_vector_type(2)));
typedef float f2_t __attribute__((ext_vector_type(2)));
DI unsigned pack2(float a, float b) { f2_t v = {a, b}; bf2_t r = __builtin_convertvector(v, bf2_t); return __builtin_bit_cast(unsigned, r); }
constexpr float LOG2E = 1.4426950408889634f;
constexpr float QS64 = 0.125f * LOG2E;
constexpr float QS96 = 0.10206207261596575f * LOG2E;
#define BLO(u) __uint_as_float((u) << 16)
#define BHI(u) __uint_as_float((u) & 0xffff0000u)
DI int otid() { int t; asm volatile("v_mov_b32 %0, %1" : "=v"(t) : "v"((int)threadIdx.x)); __builtin_assume(t >= 0 && t < 256); return t; }
DI float wave_sum(float v) {
#pragma unroll
  for (int o = 32; o; o >>= 1) v += __shfl_xor(v, o);
  return v;
}

DI int srccol(int mode, int n) {
  if (mode == 0) return n < 4352 ? n + 416 : (n < 4768 ? n - 4352 : -1);
  if (mode == 1) return 4768 + n;
  if (mode == 2) return n;
  return n < 256 ? (n >> 6) * 96 + (n & 63) : ((n - 256) >> 5) * 96 + 64 + ((n - 256) & 31);
}
DI void conv_tile(const float* __restrict__ src, int ld, int K, bf16_t* __restrict__ dst, int n0, int k0, int mode,
                  const float* __restrict__ rs, float* tile) {
  const int tx = otid() & 63, ty = otid() >> 6;
  __syncthreads();
  const int sc = srccol(mode, n0 + tx);
  const int nq = n0 + tx;
  const float cscale = (mode == 0 && ((nq >= C_CQ && nq < C_CQ + 768) || (nq >= C_DQ && nq < C_DQ + 256))) ? QS64 : 1.0f;
#pragma unroll
  for (int i = 0; i < 16; ++i) {
    int kk = ty + 4 * i;
    float v = sc >= 0 ? src[(size_t)(k0 + kk) * ld + sc] : 0.f;
    if (rs) v *= rs[k0 + kk];
    tile[kk * 65 + tx] = v * cscale;
  }
  __syncthreads();
#pragma unroll
  for (int i = 0; i < 16; ++i) {
    int nn = ty + 4 * i;
    dst[(size_t)(n0 + nn) * K + k0 + tx] = f2bf(tile[tx * 65 + nn]);
  }
}

DI int t5_bucket(int rel) {
  int n = rel < 0 ? -rel : rel;
  float nf = (float)(n < 1 ? 1 : n);
  int large = 8 + (int)(logf(nf / 8.0f) / 4.852030263919617f * 8.0f);
  if (large > 15) large = 15;
  return (rel > 0 ? 16 : 0) + (n < 8 ? n : large);
}

DI void prep_item(const Params& p, int item, float* tile) {
  if (item < 5584) {
    int l = item / 2792, r = item % 2792;
    const float* src; int ld, K, mode, t; bf16_t* dst; const float* rs = nullptr;
    if (r < 1216) { t = r; src = p.w_in + (size_t)l * 1024 * 8864; ld = 8864; K = 1024; mode = 0; dst = P_W1T + (size_t)l * 4864 * 1024; }
    else if (r < 2240) { t = r - 1216; src = p.w_in + (size_t)l * 1024 * 8864; ld = 8864; K = 1024; mode = 1; dst = P_WMT + (size_t)l * 4096 * 1024; }
    else if (r < 2496) { t = r - 2240; src = p.w_out + (size_t)l * 1024 * 1024; ld = 1024; K = 1024; mode = 2; dst = P_WOT + (size_t)l * 1024 * 1024; }
    else if (r < 2752) { t = r - 2496; int n = t >> 6; t &= 63; src = p.w_branch + (size_t)(l * 4 + n) * 256 * 1024; ld = 1024; K = 256; mode = 2; dst = P_WBT + (size_t)(l * 4 + n) * 1024 * 256; }
    else if (r < 2776) { t = r - 2752; src = p.w_q_up + (size_t)l * 256 * 384; ld = 384; K = 256; mode = 3; dst = P_WQT + (size_t)l * 384 * 256; rs = p.q_norm_g + l * 256; }
    else { t = r - 2776; src = p.w_kv_up + (size_t)l * 128 * 512; ld = 512; K = 128; mode = 2; dst = P_WKVT + (size_t)l * 512 * 128; rs = p.kv_norm_g + l * 128; }
    int kt = K / 64;
    conv_tile(src, ld, K, dst, (t / kt) * 64, (t % kt) * 64, mode, rs, tile);
  } else if (item < 5584 + 512) {
    int idx = (item - 5584) * 256 + otid();
    int pos = idx >> 4, i = idx & 15;
    double invd = 1.0;
    for (int k = 0; k < i; ++k) invd *= 0.5623413251903491;
    float inv = (float)invd;
    float ang = (float)pos * inv;
    double a = (double)ang;
    double kq = rint(a * 0.15915494309189535);
    double r = a - kq * 6.283185307179586;
    double r2 = r * r, ts = r, tc = 1.0, sn = r, cs = 1.0;
    for (int k = 1; k <= 14; ++k) {
      tc = -tc * r2 / (double)((2 * k - 1) * (2 * k));
      ts = -ts * r2 / (double)((2 * k) * (2 * k + 1));
      cs += tc; sn += ts;
    }
    P_ROPE[pos * 32 + i] = (float)cs;
    P_ROPE[pos * 32 + 16 + i] = (float)sn;
  } else {
    for (int e = otid(); e < 12 * 129; e += 256) {
      int gh = e / 129, off = e % 129 - 64; int g = gh >> 2;
      int r = g == 0 ? 1 : (g == 1 ? 4 : 16);
      P_LUTC[e] = p.t5[t5_bucket(off * r) * 16 + gh] * LOG2E;
    }
    for (int e = otid(); e < 4 * 257; e += 256) {
      int hq = e / 257, off = e % 257 - 128;
      P_LUTD[e] = p.t5[t5_bucket(off) * 16 + 12 + hq] * LOG2E;
    }
  }
}

DI void norm_rows_bf16(const float* __restrict__ src, const float* __restrict__ g, bf16_t* __restrict__ dst, int item) {
  const int lane = otid() & 63, wid = otid() >> 6;
  for (int i = 0; i < 8; ++i) {
    size_t row = (size_t)item * 32 + wid * 8 + i;
    const float4* s = (const float4*)(src + row * 1024);
    float4 v[4]; float ss = 0.f;
#pragma unroll
    for (int j = 0; j < 4; ++j) { v[j] = s[lane + 64 * j]; ss += v[j].x * v[j].x + v[j].y * v[j].y + v[j].z * v[j].z + v[j].w * v[j].w; }
    ss = wave_sum(ss);
    float sc = rsqrtf(ss * (1.0f / 1024.0f) + 1e-6f);
#pragma unroll
    for (int j = 0; j < 4; ++j) {
      float4 gg = ((const float4*)g)[lane + 64 * j];
      uint2 o; o.x = pack2(v[j].x * sc * gg.x, v[j].y * sc * gg.y); o.y = pack2(v[j].z * sc * gg.z, v[j].w * sc * gg.w);
      *(uint2*)(dst + row * 1024 + (lane + 64 * j) * 4) = o;
    }
  }
}
DI void norm_rows_f32(float* io, const float* __restrict__ g, int item) {
  const int lane = otid() & 63, wid = otid() >> 6;
  for (int i = 0; i < 8; ++i) {
    size_t row = (size_t)item * 32 + wid * 8 + i;
    float4* s = (float4*)(io + row * 1024);
    float4 v[4]; float ss = 0.f;
#pragma unroll
    for (int j = 0; j < 4; ++j) { v[j] = s[lane + 64 * j]; ss += v[j].x * v[j].x + v[j].y * v[j].y + v[j].z * v[j].z + v[j].w * v[j].w; }
    ss = wave_sum(ss);
    float sc = rsqrtf(ss * (1.0f / 1024.0f) + 1e-6f);
#pragma unroll
    for (int j = 0; j < 4; ++j) {
      float4 gg = ((const float4*)g)[lane + 64 * j];
      float4 o; o.x = v[j].x * sc * gg.x; o.y = v[j].y * sc * gg.y; o.z = v[j].z * sc * gg.z; o.w = v[j].w * sc * gg.w;
      s[lane + 64 * j] = o;
    }
  }
}

constexpr int LLD = 72;
constexpr int GST = 128 * LLD;
template <int NT>
DI void gemm_mainloop(f32x4 (&acc)[4][NT], const bf16_t* A, int lda, const bf16_t* Bt, int ldb, int K, bf16_t* sA, bf16_t* sB) {
  constexpr int NB = NT;
  const int tid = otid(), lane = tid & 63, wid = tid >> 6;
  const int wm = wid >> 1, wn = wid & 1, fr = lane & 15, fq = lane >> 4;
  u32x4 ra[4], rb[NB];
  const int nk = K >> 6;
  const bf16_t* ap = A + (size_t)(tid >> 3) * lda + (tid & 7) * 8;
  const bf16_t* bp = Bt + (size_t)(tid >> 3) * ldb + (tid & 7) * 8;
  const int so = (tid >> 3) * LLD + (tid & 7) * 8;
#define GLOAD(ko) do { \
    _Pragma("unroll") for (int i = 0; i < 4; ++i) ra[i] = *(const u32x4*)(ap + (size_t)(32 * i) * lda + (ko)); \
    _Pragma("unroll") for (int i = 0; i < NB; ++i) rb[i] = *(const u32x4*)(bp + (size_t)(32 * i) * ldb + (ko)); } while (0)
#define GSTORE(st) do { \
    _Pragma("unroll") for (int i = 0; i < 4; ++i) *(u32x4*)(sA + (st) * GST + so + 32 * i * LLD) = ra[i]; \
    _Pragma("unroll") for (int i = 0; i < NB; ++i) *(u32x4*)(sB + (st) * GST + so + 32 * i * LLD) = rb[i]; } while (0)
  __syncthreads();
  GLOAD(0); GSTORE(0);
  if (nk > 1) GLOAD(64);
  __syncthreads();
  for (int kt = 0; kt < nk; ++kt) {
    const int cur = kt & 1;
    if (kt + 1 < nk) { GSTORE(cur ^ 1); if (kt + 2 < nk) GLOAD((kt + 2) * 64); }
    const bf16_t* cA = sA + cur * GST; const bf16_t* cB = sB + cur * GST;
#pragma unroll
    for (int ks = 0; ks < 2; ++ks) {
      bf16x8 af[4], bfr[NT];
#pragma unroll
      for (int mi = 0; mi < 4; ++mi) af[mi] = *(const bf16x8*)(cA + (wm * 64 + mi * 16 + fr) * LLD + ks * 32 + fq * 8);
#pragma unroll
      for (int ni = 0; ni < NT; ++ni) bfr[ni] = *(const bf16x8*)(cB + (wn * NT * 16 + ni * 16 + fr) * LLD + ks * 32 + fq * 8);
#pragma unroll
      for (int mi = 0; mi < 4; ++mi)
#pragma unroll
        for (int ni = 0; ni < NT; ++ni) acc[mi][ni] = __builtin_amdgcn_mfma_f32_16x16x32_bf16(bfr[ni], af[mi], acc[mi][ni], 0, 0, 0);
    }
    __syncthreads();
  }
#undef GLOAD
#undef GSTORE
}
template <int NT>
DI void zero_acc(f32x4 (&acc)[4][NT]) {
#pragma unroll
  for (int mi = 0; mi < 4; ++mi)
#pragma unroll
    for (int ni = 0; ni < NT; ++ni) acc[mi][ni] = f32x4{0.f, 0.f, 0.f, 0.f};
}

DI void inproj_tile(const Params& p, int l, int tile, char* smem) {
  bf16_t* sA = (bf16_t*)smem; bf16_t* sB = sA + 2 * GST;
  const int mt = tile & 255, nt = tile >> 8;
  f32x4 acc[4][4]; zero_acc<4>(acc);
  gemm_mainloop<4>(acc, P_XN + (size_t)mt * 128 * 1024, 1024, P_W1T + ((size_t)l * 4864 + nt * 128) * 1024, 1024, 1024, sA, sB);
  const int lane = otid() & 63, wid = otid() >> 6, wm = wid >> 1, wn = wid & 1, fr = lane & 15, fq = lane >> 4;
#pragma unroll
  for (int mi = 0; mi < 4; ++mi)
#pragma unroll
    for (int ni = 0; ni < 4; ++ni) {
      size_t row = (size_t)mt * 128 + wm * 64 + mi * 16 + fr; int col = nt * 128 + wn * 64 + ni * 16 + fq * 4;
      uint2 o; o.x = pack2(acc[mi][ni][0], acc[mi][ni][1]); o.y = pack2(acc[mi][ni][2], acc[mi][ni][3]);
      *(uint2*)(P_PROJ + row * PW + col) = o;
    }
}

DI void row_scales(const bf16_t* A, int lda, int K, float* sRow) {
  const int row = otid() >> 1, half = otid() & 1;
  const int per = K >> 1;
  const bf16_t* a = A + (size_t)row * lda + half * per;
  float ss = 0.f;
  for (int c = 0; c < per; c += 8) {
    uint4 u = *(const uint4*)(a + c);
    float f;
    f = BLO(u.x); ss += f * f; f = BHI(u.x); ss += f * f; f = BLO(u.y); ss += f * f; f = BHI(u.y); ss += f * f;
    f = BLO(u.z); ss += f * f; f = BHI(u.z); ss += f * f; f = BLO(u.w); ss += f * f; f = BHI(u.w); ss += f * f;
  }
  ss += __shfl_xor(ss, 1);
  if (half == 0) sRow[row] = rsqrtf(ss / (float)K + 1e-6f);
}
DI void mla_item(const Params& p, int l, int item, char* smem) {
  bf16_t* sA = (bf16_t*)smem; bf16_t* sB = sA + 2 * GST; float* sRow = (float*)(sB + 2 * GST);
  const int lane = otid() & 63, wid = otid() >> 6, wm = wid >> 1, wn = wid & 1, fr = lane & 15, fq = lane >> 4;
  if (item < 768) {
    const int mt = item & 255, nt = item >> 8;
    const bf16_t* A = P_PROJ + (size_t)mt * 128 * PW + C_AQ;
    __syncthreads();
    row_scales(A, PW, 256, sRow);
    f32x4 acc[4][4]; zero_acc<4>(acc);
    gemm_mainloop<4>(acc, A, PW, P_WQT + ((size_t)l * 384 + nt * 128) * 256, 256, 256, sA, sB);
    if (nt < 2) {
#pragma unroll
      for (int mi = 0; mi < 4; ++mi)
#pragma unroll
        for (int ni = 0; ni < 4; ++ni) {
          int rl = wm * 64 + mi * 16 + fr; size_t t = (size_t)mt * 128 + rl; float s = sRow[rl] * QS96;
          int c = nt * 128 + wn * 64 + ni * 16 + fq * 4; int h = c >> 6, d = c & 63;
          uint2 o; o.x = pack2(acc[mi][ni][0] * s, acc[mi][ni][1] * s); o.y = pack2(acc[mi][ni][2] * s, acc[mi][ni][3] * s);
          *(uint2*)(P_QA + t * 384 + h * 96 + d) = o;
        }
    } else {
#pragma unroll
      for (int mi = 0; mi < 4; ++mi)
#pragma unroll
        for (int np = 0; np < 2; ++np) {
          int rl = wm * 64 + mi * 16 + fr; size_t t = (size_t)mt * 128 + rl; float s = sRow[rl] * QS96;
          int pos = (int)(t & (SEQ - 1)); int h = wn * 2 + np;
          const float* cs = P_ROPE + pos * 32 + fq * 4;
          float o1[4], o2[4];
#pragma unroll
          for (int j = 0; j < 4; ++j) {
            float x1 = acc[mi][np * 2][j] * s, x2 = acc[mi][np * 2 + 1][j] * s; float c = cs[j], sn = cs[16 + j];
            o1[j] = x1 * c - x2 * sn; o2[j] = x1 * sn + x2 * c;
          }
          uint2 a; a.x = pack2(o1[0], o1[1]); a.y = pack2(o1[2], o1[3]);
          uint2 b; b.x = pack2(o2[0], o2[1]); b.y = pack2(o2[2], o2[3]);
          *(uint2*)(P_QA + t * 384 + h * 96 + 64 + fq * 4) = a;
          *(uint2*)(P_QA + t * 384 + h * 96 + 80 + fq * 4) = b;
        }
    }
  } else if (item < 768 + 1024) {
    const int it = item - 768; const int mt = it & 255, h = it >> 8;
    const bf16_t* A = P_PROJ + (size_t)mt * 128 * PW + C_AKV;
    __syncthreads();
    row_scales(A, PW, 128, sRow);
    f32x4 acc[4][4]; zero_acc<4>(acc);
    gemm_mainloop<4>(acc, A, PW, P_WKVT + ((size_t)l * 512 + h * 128) * 128, 128, 128, sA, sB);
#pragma unroll
    for (int mi = 0; mi < 4; ++mi)
#pragma unroll
      for (int ni = 0; ni < 4; ++ni) {
        int rl = wm * 64 + mi * 16 + fr; size_t t = (size_t)mt * 128 + rl; float s = sRow[rl];
        int d = ni * 16 + fq * 4;
        uint2 o; o.x = pack2(acc[mi][ni][0] * s, acc[mi][ni][1] * s); o.y = pack2(acc[mi][ni][2] * s, acc[mi][ni][3] * s);
        if (wn == 0) *(uint2*)(P_KA + t * 384 + h * 96 + d) = o;
        else *(uint2*)(P_VA + t * 256 + h * 64 + d) = o;
      }
  } else {
    const int it = item - 1792;
    const int half = lane >> 5, pl = lane & 31;
    for (int i = 0; i < 32; ++i) {
      size_t t = (size_t)it * 128 + wid * 32 + i; int pos = (int)(t & (SEQ - 1));
      bf16_t* row = P_PROJ + t * PW;
#pragma unroll
      for (int s3 = 0; s3 < 3; ++s3) {
        int slot = s3 * 2 + half;
        bf16_t* hp = row + (slot < 4 ? C_BQ + slot * 64 : C_BK + (slot - 4) * 64);
        const float* g = (slot < 4 ? p.gq_g : p.gk_g) + l * 64;
        int d1, fi, ap;
        if (pl < 16) { d1 = pl; fi = pl; ap = pos >> 6; } else { d1 = 32 + (pl - 16); fi = pl - 16; ap = pos & 63; }
        float x1 = bf2f(hp[d1]), x2 = bf2f(hp[d1 + 16]);
        float ss = x1 * x1 + x2 * x2;
#pragma unroll
        for (int o = 16; o; o >>= 1) ss += __shfl_xor(ss, o);
        float sc = rsqrtf(ss * (1.0f / 64.0f) + 1e-6f);
        if (slot < 4) sc *= QS64;
        x1 = x1 * sc * g[d1]; x2 = x2 * sc * g[d1 + 16];
        float c = P_ROPE[ap * 32 + fi], sn = P_ROPE[ap * 32 + 16 + fi];
        hp[d1] = f2bf(x1 * c - x2 * sn); hp[d1 + 16] = f2bf(x1 * sn + x2 * c);
      }
      if (lane < 16) {
        float x1 = bf2f(row[C_AKR + lane]), x2 = bf2f(row[C_AKR + 16 + lane]);
        float c = P_ROPE[pos * 32 + lane], sn = P_ROPE[pos * 32 + 16 + lane];
        bf16_t o1 = f2bf(x1 * c - x2 * sn), o2 = f2bf(x1 * sn + x2 * c);
#pragma unroll
        for (int h = 0; h < 4; ++h) { P_KA[t * 384 + h * 96 + 64 + lane] = o1; P_KA[t * 384 + h * 96 + 80 + lane] = o2; }
      }
    }
  }
}

#define MFMA32(a, b, c) __builtin_amdgcn_mfma_f32_32x32x16_bf16((a), (b), (c), 0, 0, 0)
template <int OFF> DI bf16x4 tr_read(unsigned addr) {
  bf16x4 r; asm volatile("ds_read_b64_tr_b16 %0, %1 offset:%2" : "=&v"(r) : "v"(addr), "i"(OFF) : "memory"); return r;
}
DI float half_swap_max(float v) {
  auto rr = __builtin_amdgcn_permlane32_swap(__float_as_uint(v), __float_as_uint(v), false, false);
  return fmaxf(__uint_as_float(rr[0]), __uint_as_float(rr[1]));
}
DI float half_swap_sum(float v) {
  auto rr = __builtin_amdgcn_permlane32_swap(__float_as_uint(v), __float_as_uint(v), false, false);
  return __uint_as_float(rr[0]) + __uint_as_float(rr[1]);
}
DI bf16x8 pack8(const f32x16& p, int base) {
  u32x4 w = {pack2(p[base + 0], p[base + 1]), pack2(p[base + 2], p[base + 3]), pack2(p[base + 4], p[base + 5]), pack2(p[base + 6], p[base + 7])};
  return __builtin_bit_cast(bf16x8, w);
}
template <int DB, int VLD> DI void pv_block(f32x16& o, unsigned vb, bf16x8 pb0, bf16x8 pb1, bf16x8 pb2, bf16x8 pb3) {
  constexpr int RB = VLD * 2;
  bf16x4 l0 = tr_read<0 * RB + 64 * DB>(vb), h0 = tr_read<8 * RB + 64 * DB>(vb);
  bf16x4 l1 = tr_read<16 * RB + 64 * DB>(vb), h1 = tr_read<24 * RB + 64 * DB>(vb);
  bf16x4 l2 = tr_read<32 * RB + 64 * DB>(vb), h2 = tr_read<40 * RB + 64 * DB>(vb);
  bf16x4 l3 = tr_read<48 * RB + 64 * DB>(vb), h3 = tr_read<56 * RB + 64 * DB>(vb);
  asm volatile("s_waitcnt lgkmcnt(0)" ::: "memory"); __builtin_amdgcn_sched_barrier(0);
  o = MFMA32(__builtin_shufflevector(l0, h0, 0, 1, 2, 3, 4, 5, 6, 7), pb0, o);
  o = MFMA32(__builtin_shufflevector(l1, h1, 0, 1, 2, 3, 4, 5, 6, 7), pb1, o);
  o = MFMA32(__builtin_shufflevector(l2, h2, 0, 1, 2, 3, 4, 5, 6, 7), pb2, o);
  o = MFMA32(__builtin_shufflevector(l3, h3, 0, 1, 2, 3, 4, 5, 6, 7), pb3, o);
}
DI f32x16 splat16(float v) { f32x16 r;
#pragma unroll
  for (int i = 0; i < 16; ++i) r[i] = v;
  return r; }

template <int DQK>
DI void attn_dense_mfma(const bf16_t* Qb, int ldq, const bf16_t* Kb, int ldk, const bf16_t* Vb, int ldv, bf16_t* gate_io, char* smem, bool store) {
  constexpr int NS = DQK / 16, KLD = DQK + 8, VLD = 72, CPR = DQK / 8, NKC = (64 * CPR) / 256;
  constexpr int KBYTES = 64 * KLD * 2, VBYTES = 64 * VLD * 2;
  char* sKc = smem; char* sVc = smem + 2 * KBYTES;
  const int tid = otid(), lane = tid & 63, wid = tid >> 6, r = lane & 31, h = lane >> 5;
  bf16x8 qf[NS];
#pragma unroll
  for (int s = 0; s < NS; ++s) qf[s] = *(const bf16x8*)(Qb + (size_t)(wid * 32 + r) * ldq + 16 * s + 8 * h);
  int krow[NKC], kcc[NKC];
#pragma unroll
  for (int i = 0; i < NKC; ++i) { int c = tid + 256 * i; krow[i] = c / CPR; kcc[i] = c % CPR; }
  const int vrow0 = tid >> 3, vcc = tid & 7;
  u32x4 rk[NKC], rv[2];
#define DLOAD(k0) do { \
    _Pragma("unroll") for (int i = 0; i < NKC; ++i) rk[i] = *(const u32x4*)(Kb + (size_t)((k0) + krow[i]) * ldk + kcc[i] * 8); \
    rv[0] = *(const u32x4*)(Vb + (size_t)((k0) + vrow0) * ldv + vcc * 8); \
    rv[1] = *(const u32x4*)(Vb + (size_t)((k0) + vrow0 + 32) * ldv + vcc * 8); } while (0)
#define DSTORE(st) do { \
    _Pragma("unroll") for (int i = 0; i < NKC; ++i) *(u32x4*)(sKc + (st) * KBYTES + (krow[i] * KLD + kcc[i] * 8) * 2) = rk[i]; \
    *(u32x4*)(sVc + (st) * VBYTES + (vrow0 * VLD + vcc * 8) * 2) = rv[0]; \
    *(u32x4*)(sVc + (st) * VBYTES + ((vrow0 + 32) * VLD + vcc * 8) * 2) = rv[1]; } while (0)
  const unsigned vb0 = (unsigned)(size_t)sVc + (unsigned)(((4 * h + ((lane & 15) >> 2)) * VLD + 16 * ((lane >> 4) & 1) + 4 * (lane & 3)) * 2);
  f32x16 o0 = splat16(0.f), o1 = splat16(0.f);
  float m_run = 0.f, l_run = 0.f;
  __syncthreads();
  DLOAD(0); DSTORE(0);
  __syncthreads();
  constexpr int NT = SEQ / 64;
  for (int j = 0; j < NT; ++j) {
    const int cur = j & 1;
    if (j + 1 < NT) DLOAD((j + 1) * 64);
    const bf16_t* sK = (const bf16_t*)(sKc + cur * KBYTES);
    f32x16 p0 = splat16(0.f), p1 = splat16(0.f);
#pragma unroll
    for (int s = 0; s < NS; ++s) {
      bf16x8 k0 = *(const bf16x8*)(sK + r * KLD + 16 * s + 8 * h);
      bf16x8 k1 = *(const bf16x8*)(sK + (32 + r) * KLD + 16 * s + 8 * h);
      p0 = MFMA32(k0, qf[s], p0);
      p1 = MFMA32(k1, qf[s], p1);
    }
    float pm = fmaxf(p0[0], p1[0]);
#pragma unroll
    for (int i = 1; i < 16; ++i) pm = fmaxf(pm, fmaxf(p0[i], p1[i]));
    pm = half_swap_max(pm) - m_run;
    if (j == 0 || __any(pm > 8.0f)) {
      float delta;
      if (j == 0) delta = pm;
      else {
        delta = fmaxf(pm, 0.f);
        float alpha = __builtin_amdgcn_exp2f(-delta);
        l_run *= alpha;
#pragma unroll
        for (int i = 0; i < 16; ++i) { o0[i] *= alpha; o1[i] *= alpha; }
      }
      m_run += delta;
    }
    float ls = 0.f;
#pragma unroll
    for (int i = 0; i < 16; ++i) { p0[i] = __builtin_amdgcn_exp2f(p0[i] - m_run); p1[i] = __builtin_amdgcn_exp2f(p1[i] - m_run); ls += p0[i] + p1[i]; }
    l_run += ls;
    bf16x8 pb0 = pack8(p0, 0), pb1 = pack8(p0, 8), pb2 = pack8(p1, 0), pb3 = pack8(p1, 8);
    const unsigned vb = vb0 + cur * VBYTES;
    pv_block<0, VLD>(o0, vb, pb0, pb1, pb2, pb3);
    pv_block<1, VLD>(o1, vb, pb0, pb1, pb2, pb3);
    if (j + 1 < NT) DSTORE(cur ^ 1);
    __syncthreads();
  }
#undef DLOAD
#undef DSTORE
  if (!store) return;
  const float inv = 1.0f / half_swap_sum(l_run);
  bf16_t* grow = gate_io + (size_t)(wid * 32 + r) * PW;
#pragma unroll
  for (int db = 0; db < 2; ++db)
#pragma unroll
    for (int g4 = 0; g4 < 4; ++g4) {
      bf16_t* gp = grow + 32 * db + 8 * g4 + 4 * h;
      uint2 u = *(const uint2*)gp;
      float g[4] = {BLO(u.x), BHI(u.x), BLO(u.y), BHI(u.y)};
      float y[4];
#pragma unroll
      for (int e = 0; e < 4; ++e) { float ov = db == 0 ? o0[4 * g4 + e] : o1[4 * g4 + e]; y[e] = ov * inv * g[e] / (1.0f + __expf(-g[e])); }
      uint2 w; w.x = pack2(y[0], y[1]); w.y = pack2(y[2], y[3]);
      *(uint2*)gp = w;
    }
}
DI void dense_item(const Params& p, int combo, int qblk, char* smem, bool store) {
  const int br = combo >> 4, bh = combo & 15, b = bh >> 2, h = bh & 3;
  const size_t t0 = (size_t)b * SEQ + qblk * 128;
  bf16_t* gate_io = P_PROJ + t0 * PW + C_GATE + br * 256 + h * 64;
  if (br == 0)
    attn_dense_mfma<96>(P_QA + t0 * 384 + h * 96, 384, P_KA + (size_t)b * SEQ * 384 + h * 96, 384, P_VA + (size_t)b * SEQ * 256 + h * 64, 256, gate_io, smem, store);
  else
    attn_dense_mfma<64>(P_PROJ + t0 * PW + C_BQ + h * 64, PW, P_PROJ + (size_t)b * SEQ * PW + C_BK + (h >> 1) * 64, PW,
                        P_PROJ + (size_t)b * SEQ * PW + C_BV + (h >> 1) * 64, PW, gate_io, smem, store);
}

template <int W, bool SINK>
DI void attn_band_mfma(const bf16_t* Qb, size_t ldq, const bf16_t* Kb, const bf16_t* Vb, size_t ldk, int L, int i0,
                       const float* lut_g, float sink2, bf16_t* outp, size_t ldo, float* lse_out, size_t ldl, char* smem) {
  constexpr int NS = 4, KLD = 72, VLD = 72, NTW = (128 + 2 * W) / 64, LUTN = 2 * W + 1;
  constexpr int KBYTES = 64 * KLD * 2, VBYTES = 64 * VLD * 2;
  char* sKc = smem; char* sVc = smem + 2 * KBYTES; float* sLut = (float*)(smem + 2 * KBYTES + 2 * VBYTES);
  const int tid = otid(), lane = tid & 63, wid = tid >> 6, r = lane & 31, h = lane >> 5;
  __syncthreads();
  for (int e = tid; e < LUTN; e += 256) sLut[e] = lut_g[e];
  const int qi = i0 + wid * 32 + r;
  bf16x8 qf[NS];
#pragma unroll
  for (int s = 0; s < NS; ++s) qf[s] = *(const bf16x8*)(Qb + (size_t)qi * ldq + 16 * s + 8 * h);
  const int srow = tid >> 3, scc = tid & 7;
  u32x4 rk[2], rv[2];
#define BLOAD(k0) do { \
    rk[0] = *(const u32x4*)(Kb + (size_t)((k0) + srow) * ldk + scc * 8); rk[1] = *(const u32x4*)(Kb + (size_t)((k0) + srow + 32) * ldk + scc * 8); \
    rv[0] = *(const u32x4*)(Vb + (size_t)((k0) + srow) * ldk + scc * 8); rv[1] = *(const u32x4*)(Vb + (size_t)((k0) + srow + 32) * ldk + scc * 8); } while (0)
#define BSTORE(st) do { \
    *(u32x4*)(sKc + (st) * KBYTES + (srow * KLD + scc * 8) * 2) = rk[0]; *(u32x4*)(sKc + (st) * KBYTES + ((srow + 32) * KLD + scc * 8) * 2) = rk[1]; \
    *(u32x4*)(sVc + (st) * VBYTES + (srow * VLD + scc * 8) * 2) = rv[0]; *(u32x4*)(sVc + (st) * VBYTES + ((srow + 32) * VLD + scc * 8) * 2) = rv[1]; } while (0)
  const unsigned vb0 = (unsigned)(size_t)sVc + (unsigned)(((4 * h + ((lane & 15) >> 2)) * VLD + 16 * ((lane >> 4) & 1) + 4 * (lane & 3)) * 2);
  f32x16 o0 = splat16(0.f), o1 = splat16(0.f);
  float m_run = SINK ? sink2 : 0.f, l_run = (SINK && h == 0) ? 1.f : 0.f;
  bool seen = SINK;
  f32x16 negm = splat16(-m_run);
  const int lo = (i0 == 0) ? W / 64 : 0, hi = (i0 + 128 >= L) ? NTW - W / 64 : NTW;
  BLOAD(i0 - W + 64 * lo); BSTORE(0);
  __syncthreads();
  for (int j = lo; j < hi; ++j) {
    const int cur = (j - lo) & 1, k0 = i0 - W + 64 * j;
    if (j + 1 < hi) BLOAD(k0 + 64);
    const bf16_t* sK = (const bf16_t*)(sKc + cur * KBYTES);
    f32x16 p0 = negm, p1 = negm;
#pragma unroll
    for (int s = 0; s < NS; ++s) {
      bf16x8 k0f = *(const bf16x8*)(sK + r * KLD + 16 * s + 8 * h);
      bf16x8 k1f = *(const bf16x8*)(sK + (32 + r) * KLD + 16 * s + 8 * h);
      p0 = MFMA32(k0f, qf[s], p0);
      p1 = MFMA32(k1f, qf[s], p1);
    }
    const int offb = k0 + 4 * h - qi + W;
    float pm = -1e30f;
#pragma unroll
    for (int i = 0; i < 16; ++i) {
      int idx0 = offb + (i & 3) + 8 * (i >> 2), idx1 = idx0 + 32;
      int c0 = min(max(idx0, 0), 2 * W), c1 = min(max(idx1, 0), 2 * W);
      float b0 = sLut[c0], b1 = sLut[c1];
      p0[i] = ((unsigned)idx0 <= (unsigned)(2 * W)) ? p0[i] + b0 : -1e30f;
      p1[i] = ((unsigned)idx1 <= (unsigned)(2 * W)) ? p1[i] + b1 : -1e30f;
      pm = fmaxf(pm, fmaxf(p0[i], p1[i]));
    }
    pm = half_swap_max(pm);
    const bool has = pm > -1e29f;
    float delta = 0.f;
    if (has) { if (!seen) delta = pm; else if (pm > 8.0f) delta = pm; }
    if (__any(delta != 0.f)) {
      float alpha = seen ? __builtin_amdgcn_exp2f(-delta) : 1.0f;
      l_run *= alpha; m_run += delta;
#pragma unroll
      for (int i = 0; i < 16; ++i) { o0[i] *= alpha; o1[i] *= alpha; p0[i] -= delta; p1[i] -= delta; }
      negm = splat16(-m_run);
    }
    seen = seen || has;
    float ls = 0.f;
#pragma unroll
    for (int i = 0; i < 16; ++i) { p0[i] = __builtin_amdgcn_exp2f(p0[i]); p1[i] = __builtin_amdgcn_exp2f(p1[i]); ls += p0[i] + p1[i]; }
    l_run += ls;
    bf16x8 pb0 = pack8(p0, 0), pb1 = pack8(p0, 8), pb2 = pack8(p1, 0), pb3 = pack8(p1, 8);
    const unsigned vb = vb0 + cur * VBYTES;
    pv_block<0, VLD>(o0, vb, pb0, pb1, pb2, pb3);
    pv_block<1, VLD>(o1, vb, pb0, pb1, pb2, pb3);
    if (j + 1 < hi) BSTORE(cur ^ 1);
    __syncthreads();
  }
#undef BLOAD
#undef BSTORE
  const float ltot = half_swap_sum(l_run);
  const float inv = 1.0f / ltot;
  bf16_t* orow = outp + (size_t)qi * ldo;
  if (!SINK && h == 0) lse_out[(size_t)qi * ldl] = m_run + __log2f(ltot);
#pragma unroll
  for (int db = 0; db < 2; ++db)
#pragma unroll
    for (int g4 = 0; g4 < 4; ++g4) {
      bf16_t* gp = orow + 32 * db + 8 * g4 + 4 * h;
      float y[4];
      if (SINK) {
        uint2 u = *(const uint2*)gp;
        float g[4] = {BLO(u.x), BHI(u.x), BLO(u.y), BHI(u.y)};
#pragma unroll
        for (int e = 0; e < 4; ++e) { float ov = db == 0 ? o0[4 * g4 + e] : o1[4 * g4 + e]; y[e] = ov * inv * g[e] / (1.0f + __expf(-g[e])); }
      } else {
#pragma unroll
        for (int e = 0; e < 4; ++e) { float ov = db == 0 ? o0[4 * g4 + e] : o1[4 * g4 + e]; y[e] = ov * inv; }
      }
      uint2 w; w.x = pack2(y[0], y[1]); w.y = pack2(y[2], y[3]);
      *(uint2*)gp = w;
    }
}
DI void band_item(const Params& p, int l, int idx, char* smem) {
  if (idx < 3072) {
    const int g = idx >> 10, rem = idx & 1023, h = rem & 3, rem2 = rem >> 2, b = rem2 >> 6, u = rem2 & 63;
    const int sh = 2 * g, rr = 1 << sh;
    const int rho = u & (rr - 1), qblk = u >> sh;
    const size_t tok0 = (size_t)b * SEQ + rho;
    bf16_t* base = P_PROJ + tok0 * PW + g * 256 + h * 64;
    attn_band_mfma<64, false>(base + C_CQ, (size_t)rr * PW, base + C_CK, base + C_CV, (size_t)rr * PW, SEQ >> sh, qblk * 128,
                              P_LUTC + (g * 4 + h) * 129, 0.f, base + C_CQ, (size_t)rr * PW, P_LSE + tok0 * 12 + g * 4 + h, (size_t)rr * 12, smem);
  } else {
    const int it = idx - 3072, hq = it & 3, rem = it >> 2, b = rem >> 6, qblk = rem & 63;
    bf16_t* base = P_PROJ + (size_t)b * SEQ * PW;
    attn_band_mfma<128, true>(base + C_DQ + hq * 64, PW, base + C_DK + (hq >> 1) * 64, base + C_DV + (hq >> 1) * 64, PW, SEQ, qblk * 128,
                              P_LUTD + hq * 257, p.sink[l * 4 + hq] * LOG2E, base + C_GATE + 768 + hq * 64, PW, nullptr, 0, smem);
  }
}
DI void combine_c(const Params& p) {
  for (size_t u = (size_t)blockIdx.x * 256 + otid(); u < (size_t)32768 * 32; u += (size_t)gridDim.x * 256) {
    const size_t t = u >> 5; const int h = (int)(u >> 3) & 3, ch = (int)u & 7;
    const float* ls = P_LSE + t * 12 + h;
    float l0 = ls[0], l1 = ls[4], l2 = ls[8];
    float mx = fmaxf(l0, fmaxf(l1, l2));
    float a0 = __builtin_amdgcn_exp2f(l0 - mx), a1 = __builtin_amdgcn_exp2f(l1 - mx), a2 = __builtin_amdgcn_exp2f(l2 - mx);
    float inv = 1.0f / (a0 + a1 + a2); a0 *= inv; a1 *= inv; a2 *= inv;
    const bf16_t* row = P_PROJ + t * PW;
    uint4 x0 = *(const uint4*)(row + C_CQ + h * 64 + ch * 8), x1 = *(const uint4*)(row + C_CQ + 256 + h * 64 + ch * 8),
          x2 = *(const uint4*)(row + C_CQ + 512 + h * 64 + ch * 8);
    bf16_t* gp = P_PROJ + t * PW + C_GATE + 512 + h * 64 + ch * 8;
    uint4 gu = *(const uint4*)gp;
    unsigned xa[4] = {x0.x, x0.y, x0.z, x0.w}, xb[4] = {x1.x, x1.y, x1.z, x1.w}, xc[4] = {x2.x, x2.y, x2.z, x2.w}, gg[4] = {gu.x, gu.y, gu.z, gu.w};
    unsigned ov[4];
#pragma unroll
    for (int e = 0; e < 4; ++e) {
      float ylo = a0 * BLO(xa[e]) + a1 * BLO(xb[e]) + a2 * BLO(xc[e]);
      float yhi = a0 * BHI(xa[e]) + a1 * BHI(xb[e]) + a2 * BHI(xc[e]);
      float glo = BLO(gg[e]), ghi = BHI(gg[e]);
      ov[e] = pack2(ylo * glo / (1.0f + __expf(-glo)), yhi * ghi / (1.0f + __expf(-ghi)));
    }
    uint4 w; w.x = ov[0]; w.y = ov[1]; w.z = ov[2]; w.w = ov[3];
    *(uint4*)gp = w;
  }
}

DI void merge_tile(const Params& p, int l, int tile, char* smem) {
  bf16_t* sA = (bf16_t*)smem; bf16_t* sB = sA + 2 * GST;
  const int mt = tile & 255, nt = tile >> 8;
  f32x4 accM[4][2]; zero_acc<2>(accM);
  for (int n = 0; n < 4; ++n) {
    f32x4 accG[4][2]; zero_acc<2>(accG);
    gemm_mainloop<2>(accG, P_XN + (size_t)mt * 128 * 1024, 1024, P_WMT + ((size_t)l * 4096 + n * 1024 + nt * 64) * 1024, 1024, 1024, sA, sB);
    f32x4 accB[4][2]; zero_acc<2>(accB);
    gemm_mainloop<2>(accB, P_PROJ + (size_t)mt * 128 * PW + C_GATE + n * 256, PW, P_WBT + ((size_t)(l * 4 + n) * 1024 + nt * 64) * 256, 256, 256, sA, sB);
#pragma unroll
    for (int mi = 0; mi < 4; ++mi)
#pragma unroll
      for (int ni = 0; ni < 2; ++ni)
#pragma unroll
        for (int j = 0; j < 4; ++j) accM[mi][ni][j] += accB[mi][ni][j] / (1.0f + __expf(-accG[mi][ni][j]));
  }
  const int lane = otid() & 63, wid = otid() >> 6, wm = wid >> 1, wn = wid & 1, fr = lane & 15, fq = lane >> 4;
#pragma unroll
  for (int mi = 0; mi < 4; ++mi)
#pragma unroll
    for (int ni = 0; ni < 2; ++ni) {
      size_t row = (size_t)mt * 128 + wm * 64 + mi * 16 + fr; int col = nt * 64 + wn * 32 + ni * 16 + fq * 4;
      uint2 o; o.x = pack2(accM[mi][ni][0], accM[mi][ni][1]); o.y = pack2(accM[mi][ni][2], accM[mi][ni][3]);
      *(uint2*)(P_PROJ + row * PW + C_MERGED + col) = o;
    }
}

DI void outproj_tile(const Params& p, int l, int tile, char* smem) {
  bf16_t* sA = (bf16_t*)smem; bf16_t* sB = sA + 2 * GST;
  const int mt = tile & 255, nt = tile >> 8;
  f32x4 acc[4][4]; zero_acc<4>(acc);
  gemm_mainloop<4>(acc, P_PROJ + (size_t)mt * 128 * PW + C_MERGED, PW, P_WOT + ((size_t)l * 1024 + nt * 128) * 1024, 1024, 1024, sA, sB);
  const float* xin = l == 0 ? p.x : p.out;
  const int lane = otid() & 63, wid = otid() >> 6, wm = wid >> 1, wn = wid & 1, fr = lane & 15, fq = lane >> 4;
#pragma unroll
  for (int mi = 0; mi < 4; ++mi)
#pragma unroll
    for (int ni = 0; ni < 4; ++ni) {
      size_t row = (size_t)mt * 128 + wm * 64 + mi * 16 + fr; int col = nt * 128 + wn * 64 + ni * 16 + fq * 4;
      float4 xi = *(const float4*)(xin + row * 1024 + col);
      float4 o; o.x = xi.x + acc[mi][ni][0]; o.y = xi.y + acc[mi][ni][1]; o.z = xi.z + acc[mi][ni][2]; o.w = xi.w + acc[mi][ni][3];
      *(float4*)(p.out + row * 1024 + col) = o;
    }
}


#define XB_TMO      128
#define XB_XCNT(j)  (256  + 64 * (j))
#define XB_XSUB(j)  (1280 + 64 * (j))
#define XB_XGEN(j)  (2304 + 64 * (j))
#define XB_TOP      3328
#define XB_TOPGEN   3392
#define XCD_BAR_WORDS 3456
#define XB_SPIN_CAP (1u << 18)
#define LAS __attribute__((address_space(3)))
DI unsigned xb_ld(unsigned* p)              { return __hip_atomic_load(p, __ATOMIC_RELAXED, __HIP_MEMORY_SCOPE_AGENT); }
DI unsigned xb_add(unsigned* p, unsigned v) { return __hip_atomic_fetch_add(p, v, __ATOMIC_RELAXED, __HIP_MEMORY_SCOPE_AGENT); }
DI unsigned xb_xcc_id() { return (unsigned)__builtin_amdgcn_s_getreg((3 << 11) | 20) & 0xFu; }
#define XB_SPIN(cond, bar) do { unsigned _sp = 0; while (cond) { __builtin_amdgcn_s_sleep(1); \
    if ((++_sp & 255u) == 0u) { if (xb_ld(&(bar)[XB_TMO])) break; if (_sp > XB_SPIN_CAP) { atomicAdd(&(bar)[XB_TMO], 1u); break; } } } } while (0)
struct XcdBarrier { unsigned* bar; unsigned x; volatile LAS unsigned* st; };
DI XcdBarrier xcd_barrier_post(unsigned* bar, volatile LAS unsigned* st) {
  XcdBarrier b; b.bar = bar; b.x = xb_xcc_id(); b.st = st;
  if (threadIdx.x == 0) (void)xb_add(&bar[XB_XCNT(b.x)], 1u);
  return b;
}
DI void xcd_barrier_complete(unsigned* bar, unsigned x, unsigned& nloc, unsigned& nx) {
  const unsigned G = gridDim.x * gridDim.y * gridDim.z;
  unsigned sum, cnt, mine, sp = 0u;
  for (;;) {
    sum = 0u; cnt = 0u; mine = 0u;
#pragma unroll
    for (unsigned j = 0; j < 16; ++j) { const unsigned c = xb_ld(&bar[XB_XCNT(j)]); sum += c; cnt += (c > 0u) ? 1u : 0u; mine = (j == x) ? c : mine; }
    if (sum == G) break;
    __builtin_amdgcn_s_sleep(1);
    if ((++sp & 255u) == 0u) { if (xb_ld(&bar[XB_TMO])) break; if (sp > XB_SPIN_CAP) { atomicAdd(&bar[XB_TMO], 1u); break; } }
  }
  nloc = mine > 0u ? mine : 1u; nx = cnt > 0u ? cnt : 1u;
}
DI void xcd_barrier(const XcdBarrier& b) {
  asm volatile("s_waitcnt vmcnt(0)" ::: "memory");
  __syncthreads();
  if (threadIdx.x == 0) {
    unsigned* bar = b.bar;
    __builtin_amdgcn_s_waitcnt(0);
    unsigned nloc = b.st[0], nx = b.st[1];
    if (nloc == 0u) { xcd_barrier_complete(bar, b.x, nloc, nx); b.st[0] = nloc; b.st[1] = nx; }
    const unsigned old = xb_add(&bar[XB_XSUB(b.x)], 1u);
    const unsigned gen = old / nloc;
    if (old + 1u == (gen + 1u) * nloc) {
      __builtin_amdgcn_fence(__ATOMIC_RELEASE, "agent");
      asm volatile("s_waitcnt vmcnt(0)" ::: "memory");
      const unsigned og = xb_add(&bar[XB_TOP], 1u);
      const unsigned tg = og / nx;
      if (og + 1u == (tg + 1u) * nx) xb_add(&bar[XB_TOPGEN], 1u);
      else XB_SPIN(xb_ld(&bar[XB_TOPGEN]) == tg, bar);
      __builtin_amdgcn_fence(__ATOMIC_ACQUIRE, "agent");
      xb_add(&bar[XB_XGEN(b.x)], 1u);
      asm volatile("s_waitcnt vmcnt(0)" ::: "memory");
    } else {
      XB_SPIN(xb_ld(&bar[XB_XGEN(b.x)]) == gen, bar);
      __builtin_amdgcn_fence(__ATOMIC_ACQUIRE, "agent");
      asm volatile("s_waitcnt vmcnt(0)" ::: "memory");
    }
  }
  __syncthreads();
}

DI void run_phase(const Params& p, int ph, char* smem, bool never) {
  const int G = gridDim.x, B = blockIdx.x;
  if (ph == 0) {
    for (int i = B; i < 6097; i += G) prep_item(p, i, (float*)smem);
    for (int i = B; i < 1024; i += G) norm_rows_bf16(p.x, p.norm_g, P_XN, i);
  } else if (ph == 14) {
    for (int i = B; i < 1024; i += G) norm_rows_f32(p.out, p.final_g, i);
  } else if (ph == 7) {
    for (int i = B; i < 1024; i += G) norm_rows_bf16(p.out, p.norm_g + 1024, P_XN, i);
  } else {
    const int l = ph > 7 ? 1 : 0; const int s = ph > 7 ? ph - 8 : ph - 1;
    const int xcd = B & 7, lb = B >> 3, nl = G >> 3;
    if (s == 0) {
      for (int w = lb; w < 64 * 20; w += nl) {
        const int it = w >> 6, l64 = w & 63, a = it / 5, gn = it % 5;
        const int mt = 8 * (xcd + 8 * a) + (l64 & 7), nt = 8 * gn + (l64 >> 3);
        if (nt < 38) inproj_tile(p, l, nt * 256 + mt, smem);
      }
    }
    else if (s == 1) { for (int i = B; i < 2048; i += G) mla_item(p, l, i, smem); }
    else if (s == 2) {
#ifdef REP_DENSE
      for (int w = lb; w < 256; w += nl) dense_item(p, xcd + 8 * (w >> 6), w & 63, smem, never);
#endif
      for (int w = lb; w < 256; w += nl) dense_item(p, xcd + 8 * (w >> 6), w & 63, smem, true);
      for (int i = B; i < 4096; i += G) band_item(p, l, i, smem);
    }
    else if (s == 3) { combine_c(p); }
    else if (s == 4) {
      for (int w = lb; w < 64 * 8; w += nl) {
        const int it = w >> 6, l64 = w & 63, a = it >> 1, gn = it & 1;
        const int mt = 8 * (xcd + 8 * a) + (l64 & 7), nt = 8 * gn + (l64 >> 3);
        merge_tile(p, l, nt * 256 + mt, smem);
      }
    }
    else {
      for (int w = lb; w < 64 * 4; w += nl) {
        const int a = w >> 6, l64 = w & 63;
        const int mt = 8 * (xcd + 8 * a) + (l64 & 7), nt = l64 >> 3;
        outproj_tile(p, l, nt * 256 + mt, smem);
      }
    }
  }
}

__global__ void __launch_bounds__(256, 2) mega(Params p, int ph_lo, int ph_hi) {
  __shared__ __attribute__((aligned(16))) char smem[74240];
  __shared__ uint4 xb_words;
  cg::grid_group grid = cg::this_grid();
  if (threadIdx.x == 0) xb_words = make_uint4(0u, 0u, 0u, 0u);
  __syncthreads();
  XcdBarrier xb = xcd_barrier_post((unsigned*)(p.ws + OFF_BAR), (volatile LAS unsigned*)&xb_words);
  if (ph_hi == 12345) grid.sync();
  for (int ph = ph_lo; ph < ph_hi; ++ph) {
    run_phase(p, ph, smem, ph_hi == 12345);
    if (ph + 1 < ph_hi) xcd_barrier(xb);
  }
}

extern "C" void kernel_launch(void* const* d_in, const int* in_sizes, int n_in, void* d_out, int out_size, void* d_ws,
                              size_t ws_size, hipStream_t stream) {
  Params p{};
  p.x = (const float*)d_in[0]; p.norm_g = (const float*)d_in[1]; p.w_in = (const float*)d_in[2];
  p.q_norm_g = (const float*)d_in[3]; p.kv_norm_g = (const float*)d_in[4]; p.w_q_up = (const float*)d_in[5];
  p.w_kv_up = (const float*)d_in[6]; p.gq_g = (const float*)d_in[7]; p.gk_g = (const float*)d_in[8];
  p.sink = (const float*)d_in[9]; p.t5 = (const float*)d_in[10]; p.w_branch = (const float*)d_in[11];
  p.w_out = (const float*)d_in[12]; p.final_g = (const float*)d_in[13];
  p.out = (float*)d_out;
  p.ws = (char*)d_ws;
  if (WS_NEED > ws_size) { fprintf(stderr, "workspace too small: need %zu have %zu\n", (size_t)WS_NEED, ws_size); return; }

  static int grid_blocks = 0;
  if (!grid_blocks) {
    int dev = 0, cus = 0, per_cu = 0;
    hipGetDevice(&dev);
    hipDeviceGetAttribute(&cus, hipDeviceAttributeMultiprocessorCount, dev);
    hipOccupancyMaxActiveBlocksPerMultiprocessor(&per_cu, mega, 256, 0);
    if (per_cu < 1) per_cu = 1;
    if (per_cu > 2) per_cu = 2;
    grid_blocks = cus * per_cu;
  }
  hipMemsetAsync((char*)d_ws + OFF_BAR, 0, 16384, stream);
  int lo = 0, hi = 15;
  void* args[] = {&p, &lo, &hi};
  hipError_t e = hipLaunchCooperativeKernel((void*)mega, dim3(grid_blocks), dim3(256), args, 0, stream);
  if (e != hipSuccess) fprintf(stderr, "cooperative launch failed: %s (grid %d)\n", hipGetErrorString(e), grid_blocks);
}
```

```cpp
#include <hip/hip_runtime.h>
#include <hip/hip_cooperative_groups.h>
#include <cstdio>
namespace cg = cooperative_groups;

typedef unsigned short bf16_t;
using bf16x8 = __attribute__((ext_vector_type(8))) short;
using f32x4 = __attribute__((ext_vector_type(4))) float;
using u32x4 = __attribute__((ext_vector_type(4))) unsigned;
using f32x16 = __attribute__((ext_vector_type(16))) float;
using bf16x4 = __attribute__((ext_vector_type(4))) short;
#define DI __device__ __forceinline__

constexpr int SEQ = 8192;
constexpr int PW = 4864;
constexpr int C_BQ = 0, C_BK = 256, C_BV = 384, C_CQ = 512, C_CK = 1280, C_CV = 2048, C_DQ = 2816, C_DK = 3072,
              C_DV = 3200, C_GATE = 3328, C_AQ = 4352, C_AKV = 4608, C_AKR = 4736;
constexpr int C_MERGED = 512;

struct Params {
  const float* x; const float* norm_g; const float* w_in; const float* q_norm_g; const float* kv_norm_g;
  const float* w_q_up; const float* w_kv_up; const float* gq_g; const float* gk_g; const float* sink;
  const float* t5; const float* w_branch; const float* w_out; const float* final_g;
  float* out; char* ws;
};
constexpr size_t al256(size_t x) { return (x + 255) & ~(size_t)255; }
constexpr size_t OFF_W1T = 0;
constexpr size_t OFF_WMT = OFF_W1T + al256((size_t)2 * 4864 * 1024 * 2);
constexpr size_t OFF_WOT = OFF_WMT + al256((size_t)2 * 4096 * 1024 * 2);
constexpr size_t OFF_WBT = OFF_WOT + al256((size_t)2 * 1024 * 1024 * 2);
constexpr size_t OFF_WQT = OFF_WBT + al256((size_t)2 * 4 * 1024 * 256 * 2);
constexpr size_t OFF_WKVT = OFF_WQT + al256((size_t)2 * 384 * 256 * 2);
constexpr size_t OFF_ROPE = OFF_WKVT + al256((size_t)2 * 512 * 128 * 2);
constexpr size_t OFF_LUTC = OFF_ROPE + al256((size_t)8192 * 32 * 4);
constexpr size_t OFF_LUTD = OFF_LUTC + 8192;
constexpr size_t OFF_XN = OFF_LUTD + 8192;
constexpr size_t OFF_PROJ = OFF_XN + al256((size_t)32768 * 1024 * 2);
constexpr size_t OFF_QA = OFF_PROJ + al256((size_t)32768 * 4864 * 2);
constexpr size_t OFF_KA = OFF_QA + al256((size_t)32768 * 384 * 2);
constexpr size_t OFF_VA = OFF_KA + al256((size_t)32768 * 384 * 2);
constexpr size_t OFF_LSE = OFF_VA + al256((size_t)32768 * 256 * 2);
constexpr size_t OFF_BAR = OFF_LSE + al256((size_t)32768 * 12 * 4);
constexpr size_t WS_NEED = OFF_BAR + 16384;
#define WSP(T, OFF) ((T*)(p.ws + (OFF)))
#define P_W1T WSP(bf16_t, OFF_W1T)
#define P_WMT WSP(bf16_t, OFF_WMT)
#define P_WOT WSP(bf16_t, OFF_WOT)
#define P_WBT WSP(bf16_t, OFF_WBT)
#define P_WQT WSP(bf16_t, OFF_WQT)
#define P_WKVT WSP(bf16_t, OFF_WKVT)
#define P_ROPE WSP(float, OFF_ROPE)
#define P_LUTC WSP(float, OFF_LUTC)
#define P_LUTD WSP(float, OFF_LUTD)
#define P_XN WSP(bf16_t, OFF_XN)
#define P_PROJ WSP(bf16_t, OFF_PROJ)
#define P_QA WSP(bf16_t, OFF_QA)
#define P_KA WSP(bf16_t, OFF_KA)
#define P_VA WSP(bf16_t, OFF_VA)
#define P_LSE WSP(float, OFF_LSE)


DI unsigned short f2bf(float x) { unsigned u = __float_as_uint(x); u += 0x7fffu + ((u >> 16) & 1u); return (unsigned short)(u >> 16); }
DI float bf2f(unsigned short b) { return __uint_as_float(((unsigned)b) << 16); }
typedef __bf16 bf2_t __attribute__((ext_vector_type(2)));
typedef float f2_t __attribute__((ext_vector_type(2)));
DI unsigned pack2(float a, float b) { f2_t v = {a, b}; bf2_t r = __builtin_convertvector(v, bf2_t); return __builtin_bit_cast(unsigned, r); }
constexpr float LOG2E = 1.4426950408889634f;
constexpr float QS64 = 0.125f * LOG2E;
constexpr float QS96 = 0.10206207261596575f * LOG2E;
#define BLO(u) __uint_as_float((u) << 16)
#define BHI(u) __uint_as_float((u) & 0xffff0000u)
DI int otid() { int t; asm volatile("v_mov_b32 %0, %1" : "=v"(t) : "v"((int)threadIdx.x)); __builtin_assume(t >= 0 && t < 256); return t; }
DI float wave_sum(float v) {
#pragma unroll
  for (int o = 32; o; o >>= 1) v += __shfl_xor(v, o);
  return v;
}

DI int srccol(int mode, int n) {
  if (mode == 0) return n < 4352 ? n + 416 : (n < 4768 ? n - 4352 : -1);
  if (mode == 1) return 4768 + n;
  if (mode == 2) return n;
  return n < 256 ? (n >> 6) * 96 + (n & 63) : ((n - 256) >> 5) * 96 + 64 + ((n - 256) & 31);
}
DI void conv_tile(const float* __restrict__ src, int ld, int K, bf16_t* __restrict__ dst, int n0, int k0, int mode,
                  const float* __restrict__ rs, float* tile) {
  const int tx = otid() & 63, ty = otid() >> 6;
  __syncthreads();
  const int sc = srccol(mode, n0 + tx);
  const int nq = n0 + tx;
  const float cscale = (mode == 0 && ((nq >= C_CQ && nq < C_CQ + 768) || (nq >= C_DQ && nq < C_DQ + 256))) ? QS64 : 1.0f;
#pragma unroll
  for (int i = 0; i < 16; ++i) {
    int kk = ty + 4 * i;
    float v = sc >= 0 ? src[(size_t)(k0 + kk) * ld + sc] : 0.f;
    if (rs) v *= rs[k0 + kk];
    tile[kk * 65 + tx] = v * cscale;
  }
  __syncthreads();
#pragma unroll
  for (int i = 0; i < 16; ++i) {
    int nn = ty + 4 * i;
    dst[(size_t)(n0 + nn) * K + k0 + tx] = f2bf(tile[tx * 65 + nn]);
  }
}

DI int t5_bucket(int rel) {
  int n = rel < 0 ? -rel : rel;
  float nf = (float)(n < 1 ? 1 : n);
  int large = 8 + (int)(logf(nf / 8.0f) / 4.852030263919617f * 8.0f);
  if (large > 15) large = 15;
  return (rel > 0 ? 16 : 0) + (n < 8 ? n : large);
}

DI void prep_item(const Params& p, int item, float* tile) {
  if (item < 5584) {
    int l = item / 2792, r = item % 2792;
    const float* src; int ld, K, mode, t; bf16_t* dst; const float* rs = nullptr;
    if (r < 1216) { t = r; src = p.w_in + (size_t)l * 1024 * 8864; ld = 8864; K = 1024; mode = 0; dst = P_W1T + (size_t)l * 4864 * 1024; }
    else if (r < 2240) { t = r - 1216; src = p.w_in + (size_t)l * 1024 * 8864; ld = 8864; K = 1024; mode = 1; dst = P_WMT + (size_t)l * 4096 * 1024; }
    else if (r < 2496) { t = r - 2240; src = p.w_out + (size_t)l * 1024 * 1024; ld = 1024; K = 1024; mode = 2; dst = P_WOT + (size_t)l * 1024 * 1024; }
    else if (r < 2752) { t = r - 2496; int n = t >> 6; t &= 63; src = p.w_branch + (size_t)(l * 4 + n) * 256 * 1024; ld = 1024; K = 256; mode = 2; dst = P_WBT + (size_t)(l * 4 + n) * 1024 * 256; }
    else if (r < 2776) { t = r - 2752; src = p.w_q_up + (size_t)l * 256 * 384; ld = 384; K = 256; mode = 3; dst = P_WQT + (size_t)l * 384 * 256; rs = p.q_norm_g + l * 256; }
    else { t = r - 2776; src = p.w_kv_up + (size_t)l * 128 * 512; ld = 512; K = 128; mode = 2; dst = P_WKVT + (size_t)l * 512 * 128; rs = p.kv_norm_g + l * 128; }
    int kt = K / 64;
    conv_tile(src, ld, K, dst, (t / kt) * 64, (t % kt) * 64, mode, rs, tile);
  } else if (item < 5584 + 512) {
    int idx = (item - 5584) * 256 + otid();
    int pos = idx >> 4, i = idx & 15;
    double invd = 1.0;
    for (int k = 0; k < i; ++k) invd *= 0.5623413251903491;
    float inv = (float)invd;
    float ang = (float)pos * inv;
    double a = (double)ang;
    double kq = rint(a * 0.15915494309189535);
    double r = a - kq * 6.283185307179586;
    double r2 = r * r, ts = r, tc = 1.0, sn = r, cs = 1.0;
    for (int k = 1; k <= 14; ++k) {
      tc = -tc * r2 / (double)((2 * k - 1) * (2 * k));
      ts = -ts * r2 / (double)((2 * k) * (2 * k + 1));
      cs += tc; sn += ts;
    }
    P_ROPE[pos * 32 + i] = (float)cs;
    P_ROPE[pos * 32 + 16 + i] = (float)sn;
  } else {
    for (int e = otid(); e < 12 * 129; e += 256) {
      int gh = e / 129, off = e % 129 - 64; int g = gh >> 2;
      int r = g == 0 ? 1 : (g == 1 ? 4 : 16);
      P_LUTC[e] = p.t5[t5_bucket(off * r) * 16 + gh] * LOG2E;
    }
    for (int e = otid(); e < 4 * 257; e += 256) {
      int hq = e / 257, off = e % 257 - 128;
      P_LUTD[e] = p.t5[t5_bucket(off) * 16 + 12 + hq] * LOG2E;
    }
  }
}

DI void norm_rows_bf16(const float* __restrict__ src, const float* __restrict__ g, bf16_t* __restrict__ dst, int item) {
  const int lane = otid() & 63, wid = otid() >> 6;
  for (int i = 0; i < 8; ++i) {
    size_t row = (size_t)item * 32 + wid * 8 + i;
    const float4* s = (const float4*)(src + row * 1024);
    float4 v[4]; float ss = 0.f;
#pragma unroll
    for (int j = 0; j < 4; ++j) { v[j] = s[lane + 64 * j]; ss += v[j].x * v[j].x + v[j].y * v[j].y + v[j].z * v[j].z + v[j].w * v[j].w; }
    ss = wave_sum(ss);
    float sc = rsqrtf(ss * (1.0f / 1024.0f) + 1e-6f);
#pragma unroll
    for (int j = 0; j < 4; ++j) {
      float4 gg = ((const float4*)g)[lane + 64 * j];
      uint2 o; o.x = pack2(v[j].x * sc * gg.x, v[j].y * sc * gg.y); o.y = pack2(v[j].z * sc * gg.z, v[j].w * sc * gg.w);
      *(uint2*)(dst + row * 1024 + (lane + 64 * j) * 4) = o;
    }
  }
}
DI void norm_rows_f32(float* io, const float* __restrict__ g, int item) {
  const int lane = otid() & 63, wid = otid() >> 6;
  for (int i = 0; i < 8; ++i) {
    size_t row = (size_t)item * 32 + wid * 8 + i;
    float4* s = (float4*)(io + row * 1024);
    float4 v[4]; float ss = 0.f;
#pragma unroll
    for (int j = 0; j < 4; ++j) { v[j] = s[lane + 64 * j]; ss += v[j].x * v[j].x + v[j].y * v[j].y + v[j].z * v[j].z + v[j].w * v[j].w; }
    ss = wave_sum(ss);
    float sc = rsqrtf(ss * (1.0f / 1024.0f) + 1e-6f);
#pragma unroll
    for (int j = 0; j < 4; ++j) {
      float4 gg = ((const float4*)g)[lane + 64 * j];
      float4 o; o.x = v[j].x * sc * gg.x; o.y = v[j].y * sc * gg.y; o.z = v[j].z * sc * gg.z; o.w = v[j].w * sc * gg.w;
      s[lane + 64 * j] = o;
    }
  }
}

constexpr int LLD = 72;
constexpr int GST = 128 * 64;
template <int NT>
DI void gemm_mainloop(f32x4 (&acc)[4][NT], const bf16_t* A, int lda, const bf16_t* Bt, int ldb, int K, bf16_t* sA, bf16_t* sB) {
  constexpr int NB = NT;
  const int tid = otid(), lane = tid & 63, wid = tid >> 6;
  const int wm = wid >> 1, wn = wid & 1, fr = lane & 15, fq = lane >> 4;
  u32x4 ra0[4], rb0[NB], ra1[4], rb1[NB];
  const int nk = K >> 6;
  const bf16_t* ap = A + (size_t)(tid >> 3) * lda + (tid & 7) * 8;
  const bf16_t* bp = Bt + (size_t)(tid >> 3) * ldb + (tid & 7) * 8;
  const int so = (tid >> 3) * 64 + (((tid & 7) ^ ((tid >> 4) & 7)) * 8);
  const int fsw = fr >> 1;
#define GLOAD(RA, RB, ko) do { \
    _Pragma("unroll") for (int i = 0; i < 4; ++i) RA[i] = *(const u32x4*)(ap + (size_t)(32 * i) * lda + (ko)); \
    _Pragma("unroll") for (int i = 0; i < NB; ++i) RB[i] = *(const u32x4*)(bp + (size_t)(32 * i) * ldb + (ko)); } while (0)
#define GSTORE(RA, RB, st) do { \
    _Pragma("unroll") for (int i = 0; i < 4; ++i) *(u32x4*)(sA + (st) * GST + so + 32 * i * 64) = RA[i]; \
    _Pragma("unroll") for (int i = 0; i < NB; ++i) *(u32x4*)(sB + (st) * GST + so + 32 * i * 64) = RB[i]; } while (0)
#define GCOMPUTE(st) do { \
    const bf16_t* cA = sA + (st) * GST; const bf16_t* cB = sB + (st) * GST; \
    _Pragma("unroll") for (int ks = 0; ks < 2; ++ks) { \
      bf16x8 af[4], bfr[NT]; \
      _Pragma("unroll") for (int mi = 0; mi < 4; ++mi) af[mi] = *(const bf16x8*)(cA + (wm * 64 + mi * 16 + fr) * 64 + (((ks * 4 + fq) ^ fsw) * 8)); \
      _Pragma("unroll") for (int ni = 0; ni < NT; ++ni) bfr[ni] = *(const bf16x8*)(cB + (wn * NT * 16 + ni * 16 + fr) * 64 + (((ks * 4 + fq) ^ fsw) * 8)); \
      _Pragma("unroll") for (int mi = 0; mi < 4; ++mi) \
        _Pragma("unroll") for (int ni = 0; ni < NT; ++ni) acc[mi][ni] = __builtin_amdgcn_mfma_f32_16x16x32_bf16(bfr[ni], af[mi], acc[mi][ni], 0, 0, 0); \
    } } while (0)
  __syncthreads();
  GLOAD(ra0, rb0, 0); GSTORE(ra0, rb0, 0);
  GLOAD(ra1, rb1, 64);
  if (nk > 2) GLOAD(ra0, rb0, 128);
  __syncthreads();
  for (int kt = 0; kt < nk; kt += 2) {
    GSTORE(ra1, rb1, 1);
    if (kt + 3 < nk) GLOAD(ra1, rb1, (kt + 3) * 64);
    GCOMPUTE(0);
    __syncthreads();
    if (kt + 2 < nk) { GSTORE(ra0, rb0, 0); if (kt + 4 < nk) GLOAD(ra0, rb0, (kt + 4) * 64); }
    GCOMPUTE(1);
    __syncthreads();
  }
#undef GLOAD
#undef GSTORE
#undef GCOMPUTE
}
template <int NT>
DI void zero_acc(f32x4 (&acc)[4][NT]) {
#pragma unroll
  for (int mi = 0; mi < 4; ++mi)
#pragma unroll
    for (int ni = 0; ni < NT; ++ni) acc[mi][ni] = f32x4{0.f, 0.f, 0.f, 0.f};
}

DI void inproj_tile(const Params& p, int l, int tile, char* smem) {
  bf16_t* sA = (bf16_t*)smem; bf16_t* sB = sA + 2 * GST;
  const int mt = tile & 255, nt = tile >> 8;
  f32x4 acc[4][4]; zero_acc<4>(acc);
  gemm_mainloop<4>(acc, P_XN + (size_t)mt * 128 * 1024, 1024, P_W1T + ((size_t)l * 4864 + nt * 128) * 1024, 1024, 1024, sA, sB);
  const int lane = otid() & 63, wid = otid() >> 6, wm = wid >> 1, wn = wid & 1, fr = lane & 15, fq = lane >> 4;
#pragma unroll
  for (int mi = 0; mi < 4; ++mi)
#pragma unroll
    for (int ni = 0; ni < 4; ++ni) {
      size_t row = (size_t)mt * 128 + wm * 64 + mi * 16 + fr; int col = nt * 128 + wn * 64 + ni * 16 + fq * 4;
      uint2 o; o.x = pack2(acc[mi][ni][0], acc[mi][ni][1]); o.y = pack2(acc[mi][ni][2], acc[mi][ni][3]);
      *(uint2*)(P_PROJ + row * PW + col) = o;
    }
}

DI void row_scales(const bf16_t* A, int lda, int K, float* sRow) {
  const int row = otid() >> 1, half = otid() & 1;
  const int per = K >> 1;
  const bf16_t* a = A + (size_t)row * lda + half * per;
  float ss = 0.f;
  for (int c = 0; c < per; c += 8) {
    uint4 u = *(const uint4*)(a + c);
    float f;
    f = BLO(u.x); ss += f * f; f = BHI(u.x); ss += f * f; f = BLO(u.y); ss += f * f; f = BHI(u.y); ss += f * f;
    f = BLO(u.z); ss += f * f; f = BHI(u.z); ss += f * f; f = BLO(u.w); ss += f * f; f = BHI(u.w); ss += f * f;
  }
  ss += __shfl_xor(ss, 1);
  if (half == 0) sRow[row] = rsqrtf(ss / (float)K + 1e-6f);
}
DI void mla_item(const Params& p, int l, int item, char* smem) {
  bf16_t* sA = (bf16_t*)smem; bf16_t* sB = sA + 2 * GST; float* sRow = (float*)(sB + 2 * GST);
  const int lane = otid() & 63, wid = otid() >> 6, wm = wid >> 1, wn = wid & 1, fr = lane & 15, fq = lane >> 4;
  if (item < 768) {
    const int mt = item & 255, nt = item >> 8;
    const bf16_t* A = P_PROJ + (size_t)mt * 128 * PW + C_AQ;
    __syncthreads();
    row_scales(A, PW, 256, sRow);
    f32x4 acc[4][4]; zero_acc<4>(acc);
    gemm_mainloop<4>(acc, A, PW, P_WQT + ((size_t)l * 384 + nt * 128) * 256, 256, 256, sA, sB);
    if (nt < 2) {
#pragma unroll
      for (int mi = 0; mi < 4; ++mi)
#pragma unroll
        for (int ni = 0; ni < 4; ++ni) {
          int rl = wm * 64 + mi * 16 + fr; size_t t = (size_t)mt * 128 + rl; float s = sRow[rl] * QS96;
          int c = nt * 128 + wn * 64 + ni * 16 + fq * 4; int h = c >> 6, d = c & 63;
          uint2 o; o.x = pack2(acc[mi][ni][0] * s, acc[mi][ni][1] * s); o.y = pack2(acc[mi][ni][2] * s, acc[mi][ni][3] * s);
          *(uint2*)(P_QA + t * 384 + h * 96 + d) = o;
        }
    } else {
#pragma unroll
      for (int mi = 0; mi < 4; ++mi)
#pragma unroll
        for (int np = 0; np < 2; ++np) {
          int rl = wm * 64 + mi * 16 + fr; size_t t = (size_t)mt * 128 + rl; float s = sRow[rl] * QS96;
          int pos = (int)(t & (SEQ - 1)); int h = wn * 2 + np;
          const float* cs = P_ROPE + pos * 32 + fq * 4;
          float o1[4], o2[4];
#pragma unroll
          for (int j = 0; j < 4; ++j) {
            float x1 = acc[mi][np * 2][j] * s, x2 = acc[mi][np * 2 + 1][j] * s; float c = cs[j], sn = cs[16 + j];
            o1[j] = x1 * c - x2 * sn; o2[j] = x1 * sn + x2 * c;
          }
          uint2 a; a.x = pack2(o1[0], o1[1]); a.y = pack2(o1[2], o1[3]);
          uint2 b; b.x = pack2(o2[0], o2[1]); b.y = pack2(o2[2], o2[3]);
          *(uint2*)(P_QA + t * 384 + h * 96 + 64 + fq * 4) = a;
          *(uint2*)(P_QA + t * 384 + h * 96 + 80 + fq * 4) = b;
        }
    }
  } else if (item < 768 + 1024) {
    const int it = item - 768; const int mt = it & 255, h = it >> 8;
    const bf16_t* A = P_PROJ + (size_t)mt * 128 * PW + C_AKV;
    __syncthreads();
    row_scales(A, PW, 128, sRow);
    f32x4 acc[4][4]; zero_acc<4>(acc);
    gemm_mainloop<4>(acc, A, PW, P_WKVT + ((size_t)l * 512 + h * 128) * 128, 128, 128, sA, sB);
#pragma unroll
    for (int mi = 0; mi < 4; ++mi)
#pragma unroll
      for (int ni = 0; ni < 4; ++ni) {
        int rl = wm * 64 + mi * 16 + fr; size_t t = (size_t)mt * 128 + rl; float s = sRow[rl];
        int d = ni * 16 + fq * 4;
        uint2 o; o.x = pack2(acc[mi][ni][0] * s, acc[mi][ni][1] * s); o.y = pack2(acc[mi][ni][2] * s, acc[mi][ni][3] * s);
        if (wn == 0) *(uint2*)(P_KA + t * 384 + h * 96 + d) = o;
        else *(uint2*)(P_VA + t * 256 + h * 64 + d) = o;
      }
  } else {
    const int it = item - 1792;
    const int half = lane >> 5, pl = lane & 31;
    for (int i = 0; i < 32; ++i) {
      size_t t = (size_t)it * 128 + wid * 32 + i; int pos = (int)(t & (SEQ - 1));
      bf16_t* row = P_PROJ + t * PW;
#pragma unroll
      for (int s3 = 0; s3 < 3; ++s3) {
        int slot = s3 * 2 + half;
        bf16_t* hp = row + (slot < 4 ? C_BQ + slot * 64 : C_BK + (slot - 4) * 64);
        const float* g = (slot < 4 ? p.gq_g : p.gk_g) + l * 64;
        int d1, fi, ap;
        if (pl < 16) { d1 = pl; fi = pl; ap = pos >> 6; } else { d1 = 32 + (pl - 16); fi = pl - 16; ap = pos & 63; }
        float x1 = bf2f(hp[d1]), x2 = bf2f(hp[d1 + 16]);
        float ss = x1 * x1 + x2 * x2;
#pragma unroll
        for (int o = 16; o; o >>= 1) ss += __shfl_xor(ss, o);
        float sc = rsqrtf(ss * (1.0f / 64.0f) + 1e-6f);
        if (slot < 4) sc *= QS64;
        x1 = x1 * sc * g[d1]; x2 = x2 * sc * g[d1 + 16];
        float c = P_ROPE[ap * 32 + fi], sn = P_ROPE[ap * 32 + 16 + fi];
        hp[d1] = f2bf(x1 * c - x2 * sn); hp[d1 + 16] = f2bf(x1 * sn + x2 * c);
      }
      if (lane < 16) {
        float x1 = bf2f(row[C_AKR + lane]), x2 = bf2f(row[C_AKR + 16 + lane]);
        float c = P_ROPE[pos * 32 + lane], sn = P_ROPE[pos * 32 + 16 + lane];
        bf16_t o1 = f2bf(x1 * c - x2 * sn), o2 = f2bf(x1 * sn + x2 * c);
#pragma unroll
        for (int h = 0; h < 4; ++h) { P_KA[t * 384 + h * 96 + 64 + lane] = o1; P_KA[t * 384 + h * 96 + 80 + lane] = o2; }
      }
    }
  }
}

#define MFMA32(a, b, c) __builtin_amdgcn_mfma_f32_32x32x16_bf16((a), (b), (c), 0, 0, 0)
template <int OFF> DI bf16x4 tr_read(unsigned addr) {
  bf16x4 r; asm volatile("ds_read_b64_tr_b16 %0, %1 offset:%2" : "=&v"(r) : "v"(addr), "i"(OFF) : "memory"); return r;
}
DI float half_swap_max(float v) {
  auto rr = __builtin_amdgcn_permlane32_swap(__float_as_uint(v), __float_as_uint(v), false, false);
  return fmaxf(__uint_as_float(rr[0]), __uint_as_float(rr[1]));
}
DI float half_swap_sum(float v) {
  auto rr = __builtin_amdgcn_permlane32_swap(__float_as_uint(v), __float_as_uint(v), false, false);
  return __uint_as_float(rr[0]) + __uint_as_float(rr[1]);
}
DI bf16x8 pack8(const f32x16& p, int base) {
  u32x4 w = {pack2(p[base + 0], p[base + 1]), pack2(p[base + 2], p[base + 3]), pack2(p[base + 4], p[base + 5]), pack2(p[base + 6], p[base + 7])};
  return __builtin_bit_cast(bf16x8, w);
}
template <int DB, int VLD> DI void pv_block(f32x16& o, unsigned vb, bf16x8 pb0, bf16x8 pb1, bf16x8 pb2, bf16x8 pb3) {
  constexpr int RB = VLD * 2;
  bf16x4 l0 = tr_read<0 * RB + 64 * DB>(vb), h0 = tr_read<8 * RB + 64 * DB>(vb);
  bf16x4 l1 = tr_read<16 * RB + 64 * DB>(vb), h1 = tr_read<24 * RB + 64 * DB>(vb);
  bf16x4 l2 = tr_read<32 * RB + 64 * DB>(vb), h2 = tr_read<40 * RB + 64 * DB>(vb);
  bf16x4 l3 = tr_read<48 * RB + 64 * DB>(vb), h3 = tr_read<56 * RB + 64 * DB>(vb);
  asm volatile("s_waitcnt lgkmcnt(0)" ::: "memory"); __builtin_amdgcn_sched_barrier(0);
  o = MFMA32(__builtin_shufflevector(l0, h0, 0, 1, 2, 3, 4, 5, 6, 7), pb0, o);
  o = MFMA32(__builtin_shufflevector(l1, h1, 0, 1, 2, 3, 4, 5, 6, 7), pb1, o);
  o = MFMA32(__builtin_shufflevector(l2, h2, 0, 1, 2, 3, 4, 5, 6, 7), pb2, o);
  o = MFMA32(__builtin_shufflevector(l3, h3, 0, 1, 2, 3, 4, 5, 6, 7), pb3, o);
}
DI f32x16 splat16(float v) { f32x16 r;
#pragma unroll
  for (int i = 0; i < 16; ++i) r[i] = v;
  return r; }

template <int DQK>
DI void attn_dense_mfma(const bf16_t* Qb, int ldq, const bf16_t* Kb, int ldk, const bf16_t* Vb, int ldv, bf16_t* gate_io, char* smem, bool store) {
  constexpr int NS = DQK / 16, KLD = DQK + 8, VLD = 96, CPR = DQK / 8, NKC = (64 * CPR) / 256;
  constexpr int KBYTES = 64 * KLD * 2, VBYTES = 64 * VLD * 2;
  char* sKc = smem; char* sVc = smem + 2 * KBYTES;
  const int tid = otid(), lane = tid & 63, wid = tid >> 6, r = lane & 31, h = lane >> 5;
  bf16x8 qf[NS];
#pragma unroll
  for (int s = 0; s < NS; ++s) qf[s] = *(const bf16x8*)(Qb + (size_t)(wid * 32 + r) * ldq + 16 * s + 8 * h);
  int krow[NKC], kcc[NKC];
#pragma unroll
  for (int i = 0; i < NKC; ++i) { int c = tid + 256 * i; krow[i] = c / CPR; kcc[i] = c % CPR; }
  const int vrow0 = tid >> 3, vcc = tid & 7;
  u32x4 rk[NKC], rv[2];
#define DLOAD(k0) do { \
    _Pragma("unroll") for (int i = 0; i < NKC; ++i) rk[i] = *(const u32x4*)(Kb + (size_t)((k0) + krow[i]) * ldk + kcc[i] * 8); \
    rv[0] = *(const u32x4*)(Vb + (size_t)((k0) + vrow0) * ldv + vcc * 8); \
    rv[1] = *(const u32x4*)(Vb + (size_t)((k0) + vrow0 + 32) * ldv + vcc * 8); } while (0)
#define DSTORE(st) do { \
    _Pragma("unroll") for (int i = 0; i < NKC; ++i) *(u32x4*)(sKc + (st) * KBYTES + (krow[i] * KLD + kcc[i] * 8) * 2) = rk[i]; \
    *(u32x4*)(sVc + (st) * VBYTES + (vrow0 * VLD + vcc * 8) * 2) = rv[0]; \
    *(u32x4*)(sVc + (st) * VBYTES + ((vrow0 + 32) * VLD + vcc * 8) * 2) = rv[1]; } while (0)
  const unsigned vb0 = (unsigned)(size_t)sVc + (unsigned)(((4 * h + ((lane & 15) >> 2)) * VLD + 16 * ((lane >> 4) & 1) + 4 * (lane & 3)) * 2);
  f32x16 o0 = splat16(0.f), o1 = splat16(0.f);
  float m_run = 0.f, l_run = 0.f;
  __syncthreads();
  DLOAD(0); DSTORE(0);
  __syncthreads();
  constexpr int NT = SEQ / 64;
  for (int j = 0; j < NT; ++j) {
    const int cur = j & 1;
    if (j + 1 < NT) DLOAD((j + 1) * 64);
    const bf16_t* sK = (const bf16_t*)(sKc + cur * KBYTES);
    f32x16 p0 = splat16(0.f), p1 = splat16(0.f);
#pragma unroll
    for (int s = 0; s < NS; ++s) {
      bf16x8 k0 = *(const bf16x8*)(sK + r * KLD + 16 * s + 8 * h);
      bf16x8 k1 = *(const bf16x8*)(sK + (32 + r) * KLD + 16 * s + 8 * h);
      p0 = MFMA32(k0, qf[s], p0);
      p1 = MFMA32(k1, qf[s], p1);
    }
    float pm = fmaxf(p0[0], p1[0]);
#pragma unroll
    for (int i = 1; i < 16; ++i) pm = fmaxf(pm, fmaxf(p0[i], p1[i]));
    pm = half_swap_max(pm) - m_run;
    if (j == 0 || __any(pm > 8.0f)) {
      float delta;
      if (j == 0) delta = pm;
      else {
        delta = fmaxf(pm, 0.f);
        float alpha = __builtin_amdgcn_exp2f(-delta);
        l_run *= alpha;
#pragma unroll
        for (int i = 0; i < 16; ++i) { o0[i] *= alpha; o1[i] *= alpha; }
      }
      m_run += delta;
    }
    float ls = 0.f;
#pragma unroll
    for (int i = 0; i < 16; ++i) { p0[i] = __builtin_amdgcn_exp2f(p0[i] - m_run); p1[i] = __builtin_amdgcn_exp2f(p1[i] - m_run); ls += p0[i] + p1[i]; }
    l_run += ls;
    bf16x8 pb0 = pack8(p0, 0), pb1 = pack8(p0, 8), pb2 = pack8(p1, 0), pb3 = pack8(p1, 8);
    const unsigned vb = vb0 + cur * VBYTES;
    pv_block<0, VLD>(o0, vb, pb0, pb1, pb2, pb3);
    pv_block<1, VLD>(o1, vb, pb0, pb1, pb2, pb3);
    if (j + 1 < NT) DSTORE(cur ^ 1);
    __syncthreads();
  }
#undef DLOAD
#undef DSTORE
  if (!store) return;
  const float inv = 1.0f / half_swap_sum(l_run);
  bf16_t* grow = gate_io + (size_t)(wid * 32 + r) * PW;
#pragma unroll
  for (int db = 0; db < 2; ++db)
#pragma unroll
    for (int g4 = 0; g4 < 4; ++g4) {
      bf16_t* gp = grow + 32 * db + 8 * g4 + 4 * h;
      uint2 u = *(const uint2*)gp;
      float g[4] = {BLO(u.x), BHI(u.x), BLO(u.y), BHI(u.y)};
      float y[4];
#pragma unroll
      for (int e = 0; e < 4; ++e) { float ov = db == 0 ? o0[4 * g4 + e] : o1[4 * g4 + e]; y[e] = ov * inv * g[e] / (1.0f + __expf(-g[e])); }
      uint2 w; w.x = pack2(y[0], y[1]); w.y = pack2(y[2], y[3]);
      *(uint2*)gp = w;
    }
}
DI void dense_item(const Params& p, int combo, int qblk, char* smem, bool store) {
  const int br = combo >> 4, bh = combo & 15, b = bh >> 2, h = bh & 3;
  const size_t t0 = (size_t)b * SEQ + qblk * 128;
  bf16_t* gate_io = P_PROJ + t0 * PW + C_GATE + br * 256 + h * 64;
  if (br == 0)
    attn_dense_mfma<96>(P_QA + t0 * 384 + h * 96, 384, P_KA + (size_t)b * SEQ * 384 + h * 96, 384, P_VA + (size_t)b * SEQ * 256 + h * 64, 256, gate_io, smem, store);
  else
    attn_dense_mfma<64>(P_PROJ + t0 * PW + C_BQ + h * 64, PW, P_PROJ + (size_t)b * SEQ * PW + C_BK + (h >> 1) * 64, PW,
                        P_PROJ + (size_t)b * SEQ * PW + C_BV + (h >> 1) * 64, PW, gate_io, smem, store);
}

template <int W, bool SINK>
DI void attn_band_mfma(const bf16_t* Qb, size_t ldq, const bf16_t* Kb, const bf16_t* Vb, size_t ldk, int L, int i0,
                       const float* lut_g, float sink2, bf16_t* outp, size_t ldo, float* lse_out, size_t ldl, char* smem) {
  constexpr int NS = 4, KLD = 72, VLD = 96, NTW = (128 + 2 * W) / 64, LUTN = 2 * W + 1;
  constexpr int KBYTES = 64 * KLD * 2, VBYTES = 64 * VLD * 2;
  char* sKc = smem; char* sVc = smem + 2 * KBYTES; float* sLut = (float*)(smem + 2 * KBYTES + 2 * VBYTES);
  const int tid = otid(), lane = tid & 63, wid = tid >> 6, r = lane & 31, h = lane >> 5;
  __syncthreads();
  for (int e = tid; e < LUTN; e += 256) sLut[e] = lut_g[e];
  const int qi = i0 + wid * 32 + r;
  bf16x8 qf[NS];
#pragma unroll
  for (int s = 0; s < NS; ++s) qf[s] = *(const bf16x8*)(Qb + (size_t)qi * ldq + 16 * s + 8 * h);
  const int srow = tid >> 3, scc = tid & 7;
  u32x4 rk[2], rv[2];
#define BLOAD(k0) do { \
    rk[0] = *(const u32x4*)(Kb + (size_t)((k0) + srow) * ldk + scc * 8); rk[1] = *(const u32x4*)(Kb + (size_t)((k0) + srow + 32) * ldk + scc * 8); \
    rv[0] = *(const u32x4*)(Vb + (size_t)((k0) + srow) * ldk + scc * 8); rv[1] = *(const u32x4*)(Vb + (size_t)((k0) + srow + 32) * ldk + scc * 8); } while (0)
#define BSTORE(st) do { \
    *(u32x4*)(sKc + (st) * KBYTES + (srow * KLD + scc * 8) * 2) = rk[0]; *(u32x4*)(sKc + (st) * KBYTES + ((srow + 32) * KLD + scc * 8) * 2) = rk[1]; \
    *(u32x4*)(sVc + (st) * VBYTES + (srow * VLD + scc * 8) * 2) = rv[0]; *(u32x4*)(sVc + (st) * VBYTES + ((srow + 32) * VLD + scc * 8) * 2) = rv[1]; } while (0)
  const unsigned vb0 = (unsigned)(size_t)sVc + (unsigned)(((4 * h + ((lane & 15) >> 2)) * VLD + 16 * ((lane >> 4) & 1) + 4 * (lane & 3)) * 2);
  f32x16 o0 = splat16(0.f), o1 = splat16(0.f);
  float m_run = SINK ? sink2 : 0.f, l_run = (SINK && h == 0) ? 1.f : 0.f;
  bool seen = SINK;
  f32x16 negm = splat16(-m_run);
  const int lo = (i0 == 0) ? W / 64 : 0, hi = (i0 + 128 >= L) ? NTW - W / 64 : NTW;
  BLOAD(i0 - W + 64 * lo); BSTORE(0);
  __syncthreads();
  for (int j = lo; j < hi; ++j) {
    const int cur = (j - lo) & 1, k0 = i0 - W + 64 * j;
    if (j + 1 < hi) BLOAD(k0 + 64);
    const bf16_t* sK = (const bf16_t*)(sKc + cur * KBYTES);
    f32x16 p0 = negm, p1 = negm;
#pragma unroll
    for (int s = 0; s < NS; ++s) {
      bf16x8 k0f = *(const bf16x8*)(sK + r * KLD + 16 * s + 8 * h);
      bf16x8 k1f = *(const bf16x8*)(sK + (32 + r) * KLD + 16 * s + 8 * h);
      p0 = MFMA32(k0f, qf[s], p0);
      p1 = MFMA32(k1f, qf[s], p1);
    }
    const int offb = k0 + 4 * h - qi + W;
    float pm = -1e30f;
#pragma unroll
    for (int i = 0; i < 16; ++i) {
      int idx0 = offb + (i & 3) + 8 * (i >> 2), idx1 = idx0 + 32;
      int c0 = min(max(idx0, 0), 2 * W), c1 = min(max(idx1, 0), 2 * W);
      float b0 = sLut[c0], b1 = sLut[c1];
      p0[i] = ((unsigned)idx0 <= (unsigned)(2 * W)) ? p0[i] + b0 : -1e30f;
      p1[i] = ((unsigned)idx1 <= (unsigned)(2 * W)) ? p1[i] + b1 : -1e30f;
      pm = fmaxf(pm, fmaxf(p0[i], p1[i]));
    }
    pm = half_swap_max(pm);
    const bool has = pm > -1e29f;
    float delta = 0.f;
    if (has) { if (!seen) delta = pm; else if (pm > 8.0f) delta = pm; }
    if (__any(delta != 0.f)) {
      float alpha = seen ? __builtin_amdgcn_exp2f(-delta) : 1.0f;
      l_run *= alpha; m_run += delta;
#pragma unroll
      for (int i = 0; i < 16; ++i) { o0[i] *= alpha; o1[i] *= alpha; p0[i] -= delta; p1[i] -= delta; }
      negm = splat16(-m_run);
    }
    seen = seen || has;
    float ls = 0.f;
#pragma unroll
    for (int i = 0; i < 16; ++i) { p0[i] = __builtin_amdgcn_exp2f(p0[i]); p1[i] = __builtin_amdgcn_exp2f(p1[i]); ls += p0[i] + p1[i]; }
    l_run += ls;
    bf16x8 pb0 = pack8(p0, 0), pb1 = pack8(p0, 8), pb2 = pack8(p1, 0), pb3 = pack8(p1, 8);
    const unsigned vb = vb0 + cur * VBYTES;
    pv_block<0, VLD>(o0, vb, pb0, pb1, pb2, pb3);
    pv_block<1, VLD>(o1, vb, pb0, pb1, pb2, pb3);
    if (j + 1 < hi) BSTORE(cur ^ 1);
    __syncthreads();
  }
#undef BLOAD
#undef BSTORE
  const float ltot = half_swap_sum(l_run);
  const float inv = 1.0f / ltot;
  bf16_t* orow = outp + (size_t)qi * ldo;
  if (!SINK && h == 0) lse_out[(size_t)qi * ldl] = m_run + __log2f(ltot);
#pragma unroll
  for (int db = 0; db < 2; ++db)
#pragma unroll
    for (int g4 = 0; g4 < 4; ++g4) {
      bf16_t* gp = orow + 32 * db + 8 * g4 + 4 * h;
      float y[4];
      if (SINK) {
        uint2 u = *(const uint2*)gp;
        float g[4] = {BLO(u.x), BHI(u.x), BLO(u.y), BHI(u.y)};
#pragma unroll
        for (int e = 0; e < 4; ++e) { float ov = db == 0 ? o0[4 * g4 + e] : o1[4 * g4 + e]; y[e] = ov * inv * g[e] / (1.0f + __expf(-g[e])); }
      } else {
#pragma unroll
        for (int e = 0; e < 4; ++e) { float ov = db == 0 ? o0[4 * g4 + e] : o1[4 * g4 + e]; y[e] = ov * inv; }
      }
      uint2 w; w.x = pack2(y[0], y[1]); w.y = pack2(y[2], y[3]);
      *(uint2*)gp = w;
    }
}
DI void band_item(const Params& p, int l, int idx, char* smem) {
  if (idx < 3072) {
    const int g = idx >> 10, rem = idx & 1023, h = rem & 3, rem2 = rem >> 2, b = rem2 >> 6, u = rem2 & 63;
    const int sh = 2 * g, rr = 1 << sh;
    const int rho = u & (rr - 1), qblk = u >> sh;
    const size_t tok0 = (size_t)b * SEQ + rho;
    bf16_t* base = P_PROJ + tok0 * PW + g * 256 + h * 64;
    attn_band_mfma<64, false>(base + C_CQ, (size_t)rr * PW, base + C_CK, base + C_CV, (size_t)rr * PW, SEQ >> sh, qblk * 128,
                              P_LUTC + (g * 4 + h) * 129, 0.f, base + C_CQ, (size_t)rr * PW, P_LSE + tok0 * 12 + g * 4 + h, (size_t)rr * 12, smem);
  } else {
    const int it = idx - 3072, hq = it & 3, rem = it >> 2, b = rem >> 6, qblk = rem & 63;
    bf16_t* base = P_PROJ + (size_t)b * SEQ * PW;
    attn_band_mfma<128, true>(base + C_DQ + hq * 64, PW, base + C_DK + (hq >> 1) * 64, base + C_DV + (hq >> 1) * 64, PW, SEQ, qblk * 128,
                              P_LUTD + hq * 257, p.sink[l * 4 + hq] * LOG2E, base + C_GATE + 768 + hq * 64, PW, nullptr, 0, smem);
  }
}
DI void combine_c(const Params& p) {
  for (size_t u = (size_t)blockIdx.x * 256 + otid(); u < (size_t)32768 * 32; u += (size_t)gridDim.x * 256) {
    const size_t t = u >> 5; const int h = (int)(u >> 3) & 3, ch = (int)u & 7;
    const float* ls = P_LSE + t * 12 + h;
    float l0 = ls[0], l1 = ls[4], l2 = ls[8];
    float mx = fmaxf(l0, fmaxf(l1, l2));
    float a0 = __builtin_amdgcn_exp2f(l0 - mx), a1 = __builtin_amdgcn_exp2f(l1 - mx), a2 = __builtin_amdgcn_exp2f(l2 - mx);
    float inv = 1.0f / (a0 + a1 + a2); a0 *= inv; a1 *= inv; a2 *= inv;
    const bf16_t* row = P_PROJ + t * PW;
    uint4 x0 = *(const uint4*)(row + C_CQ + h * 64 + ch * 8), x1 = *(const uint4*)(row + C_CQ + 256 + h * 64 + ch * 8),
          x2 = *(const uint4*)(row + C_CQ + 512 + h * 64 + ch * 8);
    bf16_t* gp = P_PROJ + t * PW + C_GATE + 512 + h * 64 + ch * 8;
    uint4 gu = *(const uint4*)gp;
    unsigned xa[4] = {x0.x, x0.y, x0.z, x0.w}, xb[4] = {x1.x, x1.y, x1.z, x1.w}, xc[4] = {x2.x, x2.y, x2.z, x2.w}, gg[4] = {gu.x, gu.y, gu.z, gu.w};
    unsigned ov[4];
#pragma unroll
    for (int e = 0; e < 4; ++e) {
      float ylo = a0 * BLO(xa[e]) + a1 * BLO(xb[e]) + a2 * BLO(xc[e]);
      float yhi = a0 * BHI(xa[e]) + a1 * BHI(xb[e]) + a2 * BHI(xc[e]);
      float glo = BLO(gg[e]), ghi = BHI(gg[e]);
      ov[e] = pack2(ylo * glo / (1.0f + __expf(-glo)), yhi * ghi / (1.0f + __expf(-ghi)));
    }
    uint4 w; w.x = ov[0]; w.y = ov[1]; w.z = ov[2]; w.w = ov[3];
    *(uint4*)gp = w;
  }
}

DI void merge_tile(const Params& p, int l, int tile, char* smem) {
  bf16_t* sA = (bf16_t*)smem; bf16_t* sB = sA + 2 * GST;
  const int mt = tile & 255, nt = tile >> 8;
  f32x4 accM[4][2]; zero_acc<2>(accM);
  for (int n = 0; n < 4; ++n) {
    f32x4 accG[4][2]; zero_acc<2>(accG);
    gemm_mainloop<2>(accG, P_XN + (size_t)mt * 128 * 1024, 1024, P_WMT + ((size_t)l * 4096 + n * 1024 + nt * 64) * 1024, 1024, 1024, sA, sB);
    f32x4 accB[4][2]; zero_acc<2>(accB);
    gemm_mainloop<2>(accB, P_PROJ + (size_t)mt * 128 * PW + C_GATE + n * 256, PW, P_WBT + ((size_t)(l * 4 + n) * 1024 + nt * 64) * 256, 256, 256, sA, sB);
#pragma unroll
    for (int mi = 0; mi < 4; ++mi)
#pragma unroll
      for (int ni = 0; ni < 2; ++ni)
#pragma unroll
        for (int j = 0; j < 4; ++j) accM[mi][ni][j] += accB[mi][ni][j] / (1.0f + __expf(-accG[mi][ni][j]));
  }
  const int lane = otid() & 63, wid = otid() >> 6, wm = wid >> 1, wn = wid & 1, fr = lane & 15, fq = lane >> 4;
#pragma unroll
  for (int mi = 0; mi < 4; ++mi)
#pragma unroll
    for (int ni = 0; ni < 2; ++ni) {
      size_t row = (size_t)mt * 128 + wm * 64 + mi * 16 + fr; int col = nt * 64 + wn * 32 + ni * 16 + fq * 4;
      uint2 o; o.x = pack2(accM[mi][ni][0], accM[mi][ni][1]); o.y = pack2(accM[mi][ni][2], accM[mi][ni][3]);
      *(uint2*)(P_PROJ + row * PW + C_MERGED + col) = o;
    }
}

DI void outproj_tile(const Params& p, int l, int tile, char* smem) {
  bf16_t* sA = (bf16_t*)smem; bf16_t* sB = sA + 2 * GST;
  const int mt = tile & 255, nt = tile >> 8;
  f32x4 acc[4][4]; zero_acc<4>(acc);
  gemm_mainloop<4>(acc, P_PROJ + (size_t)mt * 128 * PW + C_MERGED, PW, P_WOT + ((size_t)l * 1024 + nt * 128) * 1024, 1024, 1024, sA, sB);
  const float* xin = l == 0 ? p.x : p.out;
  const int lane = otid() & 63, wid = otid() >> 6, wm = wid >> 1, wn = wid & 1, fr = lane & 15, fq = lane >> 4;
#pragma unroll
  for (int mi = 0; mi < 4; ++mi)
#pragma unroll
    for (int ni = 0; ni < 4; ++ni) {
      size_t row = (size_t)mt * 128 + wm * 64 + mi * 16 + fr; int col = nt * 128 + wn * 64 + ni * 16 + fq * 4;
      float4 xi = *(const float4*)(xin + row * 1024 + col);
      float4 o; o.x = xi.x + acc[mi][ni][0]; o.y = xi.y + acc[mi][ni][1]; o.z = xi.z + acc[mi][ni][2]; o.w = xi.w + acc[mi][ni][3];
      *(float4*)(p.out + row * 1024 + col) = o;
    }
}


#define XB_TMO      128
#define XB_XCNT(j)  (256  + 64 * (j))
#define XB_XSUB(j)  (1280 + 64 * (j))
#define XB_XGEN(j)  (2304 + 64 * (j))
#define XB_TOP      3328
#define XB_TOPGEN   3392
#define XCD_BAR_WORDS 3456
#define XB_SPIN_CAP (1u << 18)
#define LAS __attribute__((address_space(3)))
DI unsigned xb_ld(unsigned* p)              { return __hip_atomic_load(p, __ATOMIC_RELAXED, __HIP_MEMORY_SCOPE_AGENT); }
DI unsigned xb_add(unsigned* p, unsigned v) { return __hip_atomic_fetch_add(p, v, __ATOMIC_RELAXED, __HIP_MEMORY_SCOPE_AGENT); }
DI unsigned xb_xcc_id() { return (unsigned)__builtin_amdgcn_s_getreg((3 << 11) | 20) & 0xFu; }
#define XB_SPIN(cond, bar) do { unsigned _sp = 0; while (cond) { __builtin_amdgcn_s_sleep(1); \
    if ((++_sp & 255u) == 0u) { if (xb_ld(&(bar)[XB_TMO])) break; if (_sp > XB_SPIN_CAP) { atomicAdd(&(bar)[XB_TMO], 1u); break; } } } } while (0)
struct XcdBarrier { unsigned* bar; unsigned x; volatile LAS unsigned* st; };
DI XcdBarrier xcd_barrier_post(unsigned* bar, volatile LAS unsigned* st) {
  XcdBarrier b; b.bar = bar; b.x = xb_xcc_id(); b.st = st;
  if (threadIdx.x == 0) (void)xb_add(&bar[XB_XCNT(b.x)], 1u);
  return b;
}
DI void xcd_barrier_complete(unsigned* bar, unsigned x, unsigned& nloc, unsigned& nx) {
  const unsigned G = gridDim.x * gridDim.y * gridDim.z;
  unsigned sum, cnt, mine, sp = 0u;
  for (;;) {
    sum = 0u; cnt = 0u; mine = 0u;
#pragma unroll
    for (unsigned j = 0; j < 16; ++j) { const unsigned c = xb_ld(&bar[XB_XCNT(j)]); sum += c; cnt += (c > 0u) ? 1u : 0u; mine = (j == x) ? c : mine; }
    if (sum == G) break;
    __builtin_amdgcn_s_sleep(1);
    if ((++sp & 255u) == 0u) { if (xb_ld(&bar[XB_TMO])) break; if (sp > XB_SPIN_CAP) { atomicAdd(&bar[XB_TMO], 1u); break; } }
  }
  nloc = mine > 0u ? mine : 1u; nx = cnt > 0u ? cnt : 1u;
}
DI void xcd_barrier(const XcdBarrier& b) {
  asm volatile("s_waitcnt vmcnt(0)" ::: "memory");
  __syncthreads();
  if (threadIdx.x == 0) {
    unsigned* bar = b.bar;
    __builtin_amdgcn_s_waitcnt(0);
    unsigned nloc = b.st[0], nx = b.st[1];
    if (nloc == 0u) { xcd_barrier_complete(bar, b.x, nloc, nx); b.st[0] = nloc; b.st[1] = nx; }
    const unsigned old = xb_add(&bar[XB_XSUB(b.x)], 1u);
    const unsigned gen = old / nloc;
    if (old + 1u == (gen + 1u) * nloc) {
      __builtin_amdgcn_fence(__ATOMIC_RELEASE, "agent");
      asm volatile("s_waitcnt vmcnt(0)" ::: "memory");
      const unsigned og = xb_add(&bar[XB_TOP], 1u);
      const unsigned tg = og / nx;
      if (og + 1u == (tg + 1u) * nx) xb_add(&bar[XB_TOPGEN], 1u);
      else XB_SPIN(xb_ld(&bar[XB_TOPGEN]) == tg, bar);
      __builtin_amdgcn_fence(__ATOMIC_ACQUIRE, "agent");
      xb_add(&bar[XB_XGEN(b.x)], 1u);
      asm volatile("s_waitcnt vmcnt(0)" ::: "memory");
    } else {
      XB_SPIN(xb_ld(&bar[XB_XGEN(b.x)]) == gen, bar);
      __builtin_amdgcn_fence(__ATOMIC_ACQUIRE, "agent");
      asm volatile("s_waitcnt vmcnt(0)" ::: "memory");
    }
  }
  __syncthreads();
}

DI void run_phase(const Params& p, int ph, char* smem, bool never) {
  const int G = gridDim.x, B = blockIdx.x;
  if (ph == 0) {
    for (int i = B; i < 6097; i += G) prep_item(p, i, (float*)smem);
    for (int i = B; i < 1024; i += G) norm_rows_bf16(p.x, p.norm_g, P_XN, i);
  } else if (ph == 14) {
    for (int i = B; i < 1024; i += G) norm_rows_f32(p.out, p.final_g, i);
  } else if (ph == 7) {
    for (int i = B; i < 1024; i += G) norm_rows_bf16(p.out, p.norm_g + 1024, P_XN, i);
  } else {
    const int l = ph > 7 ? 1 : 0; const int s = ph > 7 ? ph - 8 : ph - 1;
    const int xcd = B & 7, lb = B >> 3, nl = G >> 3;
    if (s == 0) {
      for (int w = lb; w < 64 * 20; w += nl) {
        const int it = w >> 6, l64 = w & 63, a = it / 5, gn = it % 5;
        const int mt = 8 * (xcd + 8 * a) + (l64 & 7), nt = 8 * gn + (l64 >> 3);
        if (nt < 38) inproj_tile(p, l, nt * 256 + mt, smem);
      }
    }
    else if (s == 1) { for (int i = B; i < 2048; i += G) mla_item(p, l, i, smem); }
    else if (s == 2) {
#ifdef REP_DENSE
      for (int w = lb; w < 256; w += nl) dense_item(p, xcd + 8 * (w >> 6), w & 63, smem, never);
#endif
      for (int w = lb; w < 256; w += nl) dense_item(p, xcd + 8 * (w >> 6), w & 63, smem, true);
      for (int i = B; i < 4096; i += G) band_item(p, l, i, smem);
    }
    else if (s == 3) { combine_c(p); }
    else if (s == 4) {
      for (int w = lb; w < 64 * 8; w += nl) {
        const int it = w >> 6, l64 = w & 63, a = it >> 1, gn = it & 1;
        const int mt = 8 * (xcd + 8 * a) + (l64 & 7), nt = 8 * gn + (l64 >> 3);
        merge_tile(p, l, nt * 256 + mt, smem);
      }
    }
    else {
      for (int w = lb; w < 64 * 4; w += nl) {
        const int a = w >> 6, l64 = w & 63;
        const int mt = 8 * (xcd + 8 * a) + (l64 & 7), nt = l64 >> 3;
        outproj_tile(p, l, nt * 256 + mt, smem);
      }
    }
  }
}

__global__ void __launch_bounds__(256, 2) mega(Params p, int ph_lo, int ph_hi) {
  __shared__ __attribute__((aligned(16))) char smem[66048];
  __shared__ uint4 xb_words;
  cg::grid_group grid = cg::this_grid();
  if (threadIdx.x == 0) xb_words = make_uint4(0u, 0u, 0u, 0u);
  __syncthreads();
  XcdBarrier xb = xcd_barrier_post((unsigned*)(p.ws + OFF_BAR), (volatile LAS unsigned*)&xb_words);
  if (ph_hi == 12345) grid.sync();
  for (int ph = ph_lo; ph < ph_hi; ++ph) {
    run_phase(p, ph, smem, ph_hi == 12345);
    if (ph + 1 < ph_hi) xcd_barrier(xb);
  }
}

extern "C" void kernel_launch(void* const* d_in, const int* in_sizes, int n_in, void* d_out, int out_size, void* d_ws,
                              size_t ws_size, hipStream_t stream) {
  Params p{};
  p.x = (const float*)d_in[0]; p.norm_g = (const float*)d_in[1]; p.w_in = (const float*)d_in[2];
  p.q_norm_g = (const float*)d_in[3]; p.kv_norm_g = (const float*)d_in[4]; p.w_q_up = (const float*)d_in[5];
  p.w_kv_up = (const float*)d_in[6]; p.gq_g = (const float*)d_in[7]; p.gk_g = (const float*)d_in[8];
  p.sink = (const float*)d_in[9]; p.t5 = (const float*)d_in[10]; p.w_branch = (const float*)d_in[11];
  p.w_out = (const float*)d_in[12]; p.final_g = (const float*)d_in[13];
  p.out = (float*)d_out;
  p.ws = (char*)d_ws;
  if (WS_NEED > ws_size) { fprintf(stderr, "workspace too small: need %zu have %zu\n", (size_t)WS_NEED, ws_size); return; }

  static int grid_blocks = 0;
  if (!grid_blocks) {
    int dev = 0, cus = 0, per_cu = 0;
    hipGetDevice(&dev);
    hipDeviceGetAttribute(&cus, hipDeviceAttributeMultiprocessorCount, dev);
    hipOccupancyMaxActiveBlocksPerMultiprocessor(&per_cu, mega, 256, 0);
    if (per_cu < 1) per_cu = 1;
    if (per_cu > 2) per_cu = 2;
    grid_blocks = cus * per_cu;
  }
  hipMemsetAsync((char*)d_ws + OFF_BAR, 0, 16384, stream);
  int lo = 0, hi = 15;
  void* args[] = {&p, &lo, &hi};
  hipError_t e = hipLaunchCooperativeKernel((void*)mega, dim3(grid_blocks), dim3(256), args, 0, stream);
  if (e != hipSuccess) fprintf(stderr, "cooperative launch failed: %s (grid %d)\n", hipGetErrorString(e), grid_blocks);
}
```

```cpp
#include <hip/hip_runtime.h>
#include <hip/hip_cooperative_groups.h>
#include <cstdio>
namespace cg = cooperative_groups;

typedef unsigned short bf16_t;
using bf16x8 = __attribute__((ext_vector_type(8))) short;
using f32x4 = __attribute__((ext_vector_type(4))) float;
using u32x4 = __attribute__((ext_vector_type(4))) unsigned;
using f32x16 = __attribute__((ext_vector_type(16))) float;
using bf16x4 = __attribute__((ext_vector_type(4))) short;
#define DI __device__ __forceinline__

constexpr int SEQ = 8192;
constexpr int PW = 4864;
constexpr int C_BQ = 0, C_BK = 256, C_BV = 384, C_CQ = 512, C_CK = 1280, C_CV = 2048, C_DQ = 2816, C_DK = 3072,
              C_DV = 3200, C_GATE = 3328, C_AQ = 4352, C_AKV = 4608, C_AKR = 4736;
constexpr int C_MERGED = 512;

struct Params {
  const float* x; const float* norm_g; const float* w_in; const float* q_norm_g; const float* kv_norm_g;
  const float* w_q_up; const float* w_kv_up; const float* gq_g; const float* gk_g; const float* sink;
  const float* t5; const float* w_branch; const float* w_out; const float* final_g;
  float* out; char* ws;
};
constexpr size_t al256(size_t x) { return (x + 255) & ~(size_t)255; }
constexpr size_t OFF_W1T = 0;
constexpr size_t OFF_WMT = OFF_W1T + al256((size_t)2 * 4864 * 1024 * 2);
constexpr size_t OFF_WOT = OFF_WMT + al256((size_t)2 * 4096 * 1024 * 2);
constexpr size_t OFF_WBT = OFF_WOT + al256((size_t)2 * 1024 * 1024 * 2);
constexpr size_t OFF_WQT = OFF_WBT + al256((size_t)2 * 4 * 1024 * 256 * 2);
constexpr size_t OFF_WKVT = OFF_WQT + al256((size_t)2 * 384 * 256 * 2);
constexpr size_t OFF_ROPE = OFF_WKVT + al256((size_t)2 * 512 * 128 * 2);
constexpr size_t OFF_LUTC = OFF_ROPE + al256((size_t)8192 * 32 * 4);
constexpr size_t OFF_LUTD = OFF_LUTC + 8192;
constexpr size_t OFF_XN = OFF_LUTD + 8192;
constexpr size_t OFF_PROJ = OFF_XN + al256((size_t)32768 * 1024 * 2);
constexpr size_t OFF_QA = OFF_PROJ + al256((size_t)32768 * 4864 * 2);
constexpr size_t OFF_KA = OFF_QA + al256((size_t)32768 * 384 * 2);
constexpr size_t OFF_VA = OFF_KA + al256((size_t)32768 * 384 * 2);
constexpr size_t OFF_LSE = OFF_VA + al256((size_t)32768 * 256 * 2);
constexpr size_t OFF_BAR = OFF_LSE + al256((size_t)32768 * 12 * 4);
constexpr size_t WS_NEED = OFF_BAR + 16384;
#define WSP(T, OFF) ((T*)(p.ws + (OFF)))
#define P_W1T WSP(bf16_t, OFF_W1T)
#define P_WMT WSP(bf16_t, OFF_WMT)
#define P_WOT WSP(bf16_t, OFF_WOT)
#define P_WBT WSP(bf16_t, OFF_WBT)
#define P_WQT WSP(bf16_t, OFF_WQT)
#define P_WKVT WSP(bf16_t, OFF_WKVT)
#define P_ROPE WSP(float, OFF_ROPE)
#define P_LUTC WSP(float, OFF_LUTC)
#define P_LUTD WSP(float, OFF_LUTD)
#define P_XN WSP(bf16_t, OFF_XN)
#define P_PROJ WSP(bf16_t, OFF_PROJ)
#define P_QA WSP(bf16_t, OFF_QA)
#define P_KA WSP(bf16_t, OFF_KA)
#define P_VA WSP(bf16_t, OFF_VA)
#define P_LSE WSP(float, OFF_LSE)


DI unsigned short f2bf(float x) { unsigned u = __float_as_uint(x); u += 0x7fffu + ((u >> 16) & 1u); return (unsigned short)(u >> 16); }
DI float bf2f(unsigned short b) { return __uint_as_float(((unsigned)b) << 16); }
typedef __bf16 bf2_t __attribute__((ext_vector_type(2)));
typedef float f2_t __attribute__((ext_vector_type(2)));
DI unsigned pack2(float a, float b) { f2_t v = {a, b}; bf2_t r = __builtin_convertvector(v, bf2_t); return __builtin_bit_cast(unsigned, r); }
constexpr float LOG2E = 1.4426950408889634f;
constexpr float QS64 = 0.125f * LOG2E;
constexpr float QS96 = 0.10206207261596575f * LOG2E;
#define BLO(u) __uint_as_float((u) << 16)
#define BHI(u) __uint_as_float((u) & 0xffff0000u)
DI int otid() { int t; asm volatile("v_mov_b32 %0, %1" : "=v"(t) : "v"((int)threadIdx.x)); __builtin_assume(t >= 0 && t < 256); return t; }
DI float wave_sum(float v) {
#pragma unroll
  for (int o = 32; o; o >>= 1) v += __shfl_xor(v, o);
  return v;
}

DI int srccol(int mode, int n) {
  if (mode == 0) return n < 4352 ? n + 416 : (n < 4768 ? n - 4352 : -1);
  if (mode == 1) return 4768 + n;
  if (mode == 2) return n;
  return n < 256 ? (n >> 6) * 96 + (n & 63) : ((n - 256) >> 5) * 96 + 64 + ((n - 256) & 31);
}
DI void conv_tile(const float* __restrict__ src, int ld, int K, bf16_t* __restrict__ dst, int n0, int k0, int mode,
                  const float* __restrict__ rs, float* tile) {
  const int tx = otid() & 63, ty = otid() >> 6;
  __syncthreads();
  const int sc = srccol(mode, n0 + tx);
  const int nq = n0 + tx;
  const float cscale = (mode == 0 && ((nq >= C_CQ && nq < C_CQ + 768) || (nq >= C_DQ && nq < C_DQ + 256))) ? QS64 : 1.0f;
#pragma unroll
  for (int i = 0; i < 16; ++i) {
    int kk = ty + 4 * i;
    float v = sc >= 0 ? src[(size_t)(k0 + kk) * ld + sc] : 0.f;
    if (rs) v *= rs[k0 + kk];
    tile[kk * 65 + tx] = v * cscale;
  }
  __syncthreads();
#pragma unroll
  for (int i = 0; i < 16; ++i) {
    int nn = ty + 4 * i;
    dst[(size_t)(n0 + nn) * K + k0 + tx] = f2bf(tile[tx * 65 + nn]);
  }
}

DI int t5_bucket(int rel) {
  int n = rel < 0 ? -rel : rel;
  float nf = (float)(n < 1 ? 1 : n);
  int large = 8 + (int)(logf(nf / 8.0f) / 4.852030263919617f * 8.0f);
  if (large > 15) large = 15;
  return (rel > 0 ? 16 : 0) + (n < 8 ? n : large);
}

DI void prep_item(const Params& p, int item, float* tile) {
  if (item < 5584) {
    int l = item / 2792, r = item % 2792;
    const float* src; int ld, K, mode, t; bf16_t* dst; const float* rs = nullptr;
    if (r < 1216) { t = r; src = p.w_in + (size_t)l * 1024 * 8864; ld = 8864; K = 1024; mode = 0; dst = P_W1T + (size_t)l * 4864 * 1024; }
    else if (r < 2240) { t = r - 1216; src = p.w_in + (size_t)l * 1024 * 8864; ld = 8864; K = 1024; mode = 1; dst = P_WMT + (size_t)l * 4096 * 1024; }
    else if (r < 2496) { t = r - 2240; src = p.w_out + (size_t)l * 1024 * 1024; ld = 1024; K = 1024; mode = 2; dst = P_WOT + (size_t)l * 1024 * 1024; }
    else if (r < 2752) { t = r - 2496; int n = t >> 6; t &= 63; src = p.w_branch + (size_t)(l * 4 + n) * 256 * 1024; ld = 1024; K = 256; mode = 2; dst = P_WBT + (size_t)(l * 4 + n) * 1024 * 256; }
    else if (r < 2776) { t = r - 2752; src = p.w_q_up + (size_t)l * 256 * 384; ld = 384; K = 256; mode = 3; dst = P_WQT + (size_t)l * 384 * 256; rs = p.q_norm_g + l * 256; }
    else { t = r - 2776; src = p.w_kv_up + (size_t)l * 128 * 512; ld = 512; K = 128; mode = 2; dst = P_WKVT + (size_t)l * 512 * 128; rs = p.kv_norm_g + l * 128; }
    int kt = K / 64;
    conv_tile(src, ld, K, dst, (t / kt) * 64, (t % kt) * 64, mode, rs, tile);
  } else if (item < 5584 + 512) {
    int idx = (item - 5584) * 256 + otid();
    int pos = idx >> 4, i = idx & 15;
    double invd = 1.0;
    for (int k = 0; k < i; ++k) invd *= 0.5623413251903491;
    float inv = (float)invd;
    float ang = (float)pos * inv;
    double a = (double)ang;
    double kq = rint(a * 0.15915494309189535);
    double r = a - kq * 6.283185307179586;
    double r2 = r * r, ts = r, tc = 1.0, sn = r, cs = 1.0;
    for (int k = 1; k <= 14; ++k) {
      tc = -tc * r2 / (double)((2 * k - 1) * (2 * k));
      ts = -ts * r2 / (double)((2 * k) * (2 * k + 1));
      cs += tc; sn += ts;
    }
    P_ROPE[pos * 32 + i] = (float)cs;
    P_ROPE[pos * 32 + 16 + i] = (float)sn;
  } else {
    for (int e = otid(); e < 12 * 129; e += 256) {
      int gh = e / 129, off = e % 129 - 64; int g = gh >> 2;
      int r = g == 0 ? 1 : (g == 1 ? 4 : 16);
      P_LUTC[e] = p.t5[t5_bucket(off * r) * 16 + gh] * LOG2E;
    }
    for (int e = otid(); e < 4 * 257; e += 256) {
      int hq = e / 257, off = e % 257 - 128;
      P_LUTD[e] = p.t5[t5_bucket(off) * 16 + 12 + hq] * LOG2E;
    }
  }
}

DI void norm_rows_bf16(const float* __restrict__ src, const float* __restrict__ g, bf16_t* __restrict__ dst, int item) {
  const int lane = otid() & 63, wid = otid() >> 6;
  for (int i = 0; i < 8; ++i) {
    size_t row = (size_t)item * 32 + wid * 8 + i;
    const float4* s = (const float4*)(src + row * 1024);
    float4 v[4]; float ss = 0.f;
#pragma unroll
    for (int j = 0; j < 4; ++j) { v[j] = s[lane + 64 * j]; ss += v[j].x * v[j].x + v[j].y * v[j].y + v[j].z * v[j].z + v[j].w * v[j].w; }
    ss = wave_sum(ss);
    float sc = rsqrtf(ss * (1.0f / 1024.0f) + 1e-6f);
#pragma unroll
    for (int j = 0; j < 4; ++j) {
      float4 gg = ((const float4*)g)[lane + 64 * j];
      uint2 o; o.x = pack2(v[j].x * sc * gg.x, v[j].y * sc * gg.y); o.y = pack2(v[j].z * sc * gg.z, v[j].w * sc * gg.w);
      *(uint2*)(dst + row * 1024 + (lane + 64 * j) * 4) = o;
    }
  }
}
DI void norm_rows_f32(float* io, const float* __restrict__ g, int item) {
  const int lane = otid() & 63, wid = otid() >> 6;
  for (int i = 0; i < 8; ++i) {
    size_t row = (size_t)item * 32 + wid * 8 + i;
    float4* s = (float4*)(io + row * 1024);
    float4 v[4]; float ss = 0.f;
#pragma unroll
    for (int j = 0; j < 4; ++j) { v[j] = s[lane + 64 * j]; ss += v[j].x * v[j].x + v[j].y * v[j].y + v[j].z * v[j].z + v[j].w * v[j].w; }
    ss = wave_sum(ss);
    float sc = rsqrtf(ss * (1.0f / 1024.0f) + 1e-6f);
#pragma unroll
    for (int j = 0; j < 4; ++j) {
      float4 gg = ((const float4*)g)[lane + 64 * j];
      float4 o; o.x = v[j].x * sc * gg.x; o.y = v[j].y * sc * gg.y; o.z = v[j].z * sc * gg.z; o.w = v[j].w * sc * gg.w;
      s[lane + 64 * j] = o;
    }
  }
}

constexpr int LLD = 72;
constexpr int GST = 128 * 64;
template <int NT, bool LOWREG = false>
DI void gemm_mainloop(f32x4 (&acc)[4][NT], const bf16_t* A, int lda, const bf16_t* Bt, int ldb, int K, bf16_t* sA, bf16_t* sB, int bstride = 32) {
  constexpr int NB = NT;
  const int tid = otid(), lane = tid & 63, wid = tid >> 6;
  const int wm = wid >> 1, wn = wid & 1, fr = lane & 15, fq = lane >> 4;
  u32x4 ra[4], rb[NB];
  const int nk = K >> 6;
  const bf16_t* ap = A + (size_t)(tid >> 3) * lda + (tid & 7) * 8;
  const bf16_t* bp = Bt + (size_t)(tid >> 3) * ldb + (tid & 7) * 8;
  const int so = (tid >> 3) * 64 + (((tid & 7) ^ ((tid >> 4) & 7)) * 8);
  const int fsw = fr >> 1;
#define GLOAD(ko) do { \
    _Pragma("unroll") for (int i = 0; i < 4; ++i) ra[i] = *(const u32x4*)(ap + (size_t)(32 * i) * lda + (ko)); \
    _Pragma("unroll") for (int i = 0; i < NB; ++i) rb[i] = *(const u32x4*)(bp + (size_t)(bstride * i) * ldb + (ko)); } while (0)
#define GSTORE(st) do { \
    _Pragma("unroll") for (int i = 0; i < 4; ++i) *(u32x4*)(sA + (st) * GST + so + 32 * i * 64) = ra[i]; \
    _Pragma("unroll") for (int i = 0; i < NB; ++i) *(u32x4*)(sB + (st) * GST + so + 32 * i * 64) = rb[i]; } while (0)
#define GCOMPUTE(st) do { \
    const bf16_t* cA = sA + (st) * GST; const bf16_t* cB = sB + (st) * GST; \
    _Pragma("unroll") for (int ks = 0; ks < 2; ++ks) { \
      bf16x8 af[4], bfr[NT]; \
      _Pragma("unroll") for (int mi = 0; mi < 4; ++mi) af[mi] = *(const bf16x8*)(cA + (wm * 64 + mi * 16 + fr) * 64 + (((ks * 4 + fq) ^ fsw) * 8)); \
      _Pragma("unroll") for (int ni = 0; ni < NT; ++ni) bfr[ni] = *(const bf16x8*)(cB + (wn * NT * 16 + ni * 16 + fr) * 64 + (((ks * 4 + fq) ^ fsw) * 8)); \
      _Pragma("unroll") for (int mi = 0; mi < 4; ++mi) \
        _Pragma("unroll") for (int ni = 0; ni < NT; ++ni) acc[mi][ni] = __builtin_amdgcn_mfma_f32_16x16x32_bf16(bfr[ni], af[mi], acc[mi][ni], 0, 0, 0); \
    } } while (0)
  __syncthreads();
  GLOAD(0); GSTORE(0);
  if (nk > 1) GLOAD(64);
  __syncthreads();
  for (int kt = 0; kt < nk; ++kt) {
    const int cur = kt & 1;
    if (kt + 1 < nk) { GSTORE(cur ^ 1); if (kt + 2 < nk) GLOAD((kt + 2) * 64); }
    if (LOWREG) {
      const bf16_t* cA = sA + cur * GST; const bf16_t* cB = sB + cur * GST;
#pragma nounroll
      for (int ks = 0; ks < 2; ++ks) {
        bf16x8 af[4], bfr[NT];
#pragma unroll
        for (int mi = 0; mi < 4; ++mi) af[mi] = *(const bf16x8*)(cA + (wm * 64 + mi * 16 + fr) * 64 + (((ks * 4 + fq) ^ fsw) * 8));
#pragma unroll
        for (int ni = 0; ni < NT; ++ni) bfr[ni] = *(const bf16x8*)(cB + (wn * NT * 16 + ni * 16 + fr) * 64 + (((ks * 4 + fq) ^ fsw) * 8));
#pragma unroll
        for (int mi = 0; mi < 4; ++mi)
#pragma unroll
          for (int ni = 0; ni < NT; ++ni) acc[mi][ni] = __builtin_amdgcn_mfma_f32_16x16x32_bf16(bfr[ni], af[mi], acc[mi][ni], 0, 0, 0);
      }
    } else GCOMPUTE(cur);
    __syncthreads();
  }
#undef GLOAD
#undef GSTORE
#undef GCOMPUTE
}
template <int NT>
DI void zero_acc(f32x4 (&acc)[4][NT]) {
#pragma unroll
  for (int mi = 0; mi < 4; ++mi)
#pragma unroll
    for (int ni = 0; ni < NT; ++ni) acc[mi][ni] = f32x4{0.f, 0.f, 0.f, 0.f};
}

DI void inproj_tile(const Params& p, int l, int tile, char* smem) {
  bf16_t* sA = (bf16_t*)smem; bf16_t* sB = sA + 2 * GST;
  const int mt = tile & 255, nt = tile >> 8;
  f32x4 acc[4][4]; zero_acc<4>(acc);
  gemm_mainloop<4>(acc, P_XN + (size_t)mt * 128 * 1024, 1024, P_W1T + ((size_t)l * 4864 + nt * 128) * 1024, 1024, 1024, sA, sB);
  const int lane = otid() & 63, wid = otid() >> 6, wm = wid >> 1, wn = wid & 1, fr = lane & 15, fq = lane >> 4;
#pragma unroll
  for (int mi = 0; mi < 4; ++mi)
#pragma unroll
    for (int ni = 0; ni < 4; ++ni) {
      size_t row = (size_t)mt * 128 + wm * 64 + mi * 16 + fr; int col = nt * 128 + wn * 64 + ni * 16 + fq * 4;
      uint2 o; o.x = pack2(acc[mi][ni][0], acc[mi][ni][1]); o.y = pack2(acc[mi][ni][2], acc[mi][ni][3]);
      *(uint2*)(P_PROJ + row * PW + col) = o;
    }
}

DI void row_scales(const bf16_t* A, int lda, int K, float* sRow) {
  const int row = otid() >> 1, half = otid() & 1;
  const int per = K >> 1;
  const bf16_t* a = A + (size_t)row * lda + half * per;
  float ss = 0.f;
  for (int c = 0; c < per; c += 8) {
    uint4 u = *(const uint4*)(a + c);
    float f;
    f = BLO(u.x); ss += f * f; f = BHI(u.x); ss += f * f; f = BLO(u.y); ss += f * f; f = BHI(u.y); ss += f * f;
    f = BLO(u.z); ss += f * f; f = BHI(u.z); ss += f * f; f = BLO(u.w); ss += f * f; f = BHI(u.w); ss += f * f;
  }
  ss += __shfl_xor(ss, 1);
  if (half == 0) sRow[row] = rsqrtf(ss / (float)K + 1e-6f);
}
DI void mla_item(const Params& p, int l, int item, char* smem) {
  bf16_t* sA = (bf16_t*)smem; bf16_t* sB = sA + 2 * GST; float* sRow = (float*)(sB + 2 * GST);
  const int lane = otid() & 63, wid = otid() >> 6, wm = wid >> 1, wn = wid & 1, fr = lane & 15, fq = lane >> 4;
  if (item < 768) {
    const int mt = item & 255, nt = item >> 8;
    const bf16_t* A = P_PROJ + (size_t)mt * 128 * PW + C_AQ;
    __syncthreads();
    row_scales(A, PW, 256, sRow);
    f32x4 acc[4][4]; zero_acc<4>(acc);
    gemm_mainloop<4>(acc, A, PW, P_WQT + ((size_t)l * 384 + nt * 128) * 256, 256, 256, sA, sB);
    if (nt < 2) {
#pragma unroll
      for (int mi = 0; mi < 4; ++mi)
#pragma unroll
        for (int ni = 0; ni < 4; ++ni) {
          int rl = wm * 64 + mi * 16 + fr; size_t t = (size_t)mt * 128 + rl; float s = sRow[rl] * QS96;
          int c = nt * 128 + wn * 64 + ni * 16 + fq * 4; int h = c >> 6, d = c & 63;
          uint2 o; o.x = pack2(acc[mi][ni][0] * s, acc[mi][ni][1] * s); o.y = pack2(acc[mi][ni][2] * s, acc[mi][ni][3] * s);
          *(uint2*)(P_QA + t * 384 + h * 96 + d) = o;
        }
    } else {
#pragma unroll
      for (int mi = 0; mi < 4; ++mi)
#pragma unroll
        for (int np = 0; np < 2; ++np) {
          int rl = wm * 64 + mi * 16 + fr; size_t t = (size_t)mt * 128 + rl; float s = sRow[rl] * QS96;
          int pos = (int)(t & (SEQ - 1)); int h = wn * 2 + np;
          const float* cs = P_ROPE + pos * 32 + fq * 4;
          float o1[4], o2[4];
#pragma unroll
          for (int j = 0; j < 4; ++j) {
            float x1 = acc[mi][np * 2][j] * s, x2 = acc[mi][np * 2 + 1][j] * s; float c = cs[j], sn = cs[16 + j];
            o1[j] = x1 * c - x2 * sn; o2[j] = x1 * sn + x2 * c;
          }
          uint2 a; a.x = pack2(o1[0], o1[1]); a.y = pack2(o1[2], o1[3]);
          uint2 b; b.x = pack2(o2[0], o2[1]); b.y = pack2(o2[2], o2[3]);
          *(uint2*)(P_QA + t * 384 + h * 96 + 64 + fq * 4) = a;
          *(uint2*)(P_QA + t * 384 + h * 96 + 80 + fq * 4) = b;
        }
    }
  } else if (item < 768 + 1024) {
    const int it = item - 768; const int mt = it & 255, h = it >> 8;
    const bf16_t* A = P_PROJ + (size_t)mt * 128 * PW + C_AKV;
    __syncthreads();
    row_scales(A, PW, 128, sRow);
    f32x4 acc[4][4]; zero_acc<4>(acc);
    gemm_mainloop<4>(acc, A, PW, P_WKVT + ((size_t)l * 512 + h * 128) * 128, 128, 128, sA, sB);
#pragma unroll
    for (int mi = 0; mi < 4; ++mi)
#pragma unroll
      for (int ni = 0; ni < 4; ++ni) {
        int rl = wm * 64 + mi * 16 + fr; size_t t = (size_t)mt * 128 + rl; float s = sRow[rl];
        int d = ni * 16 + fq * 4;
        uint2 o; o.x = pack2(acc[mi][ni][0] * s, acc[mi][ni][1] * s); o.y = pack2(acc[mi][ni][2] * s, acc[mi][ni][3] * s);
        if (wn == 0) *(uint2*)(P_KA + t * 384 + h * 96 + d) = o;
        else *(uint2*)(P_VA + t * 256 + h * 64 + d) = o;
      }
  } else {
    const int it = item - 1792;
    const int half = lane >> 5, pl = lane & 31;
    for (int i = 0; i < 32; ++i) {
      size_t t = (size_t)it * 128 + wid * 32 + i; int pos = (int)(t & (SEQ - 1));
      bf16_t* row = P_PROJ + t * PW;
#pragma unroll
      for (int s3 = 0; s3 < 3; ++s3) {
        int slot = s3 * 2 + half;
        bf16_t* hp = row + (slot < 4 ? C_BQ + slot * 64 : C_BK + (slot - 4) * 64);
        const float* g = (slot < 4 ? p.gq_g : p.gk_g) + l * 64;
        int d1, fi, ap;
        if (pl < 16) { d1 = pl; fi = pl; ap = pos >> 6; } else { d1 = 32 + (pl - 16); fi = pl - 16; ap = pos & 63; }
        float x1 = bf2f(hp[d1]), x2 = bf2f(hp[d1 + 16]);
        float ss = x1 * x1 + x2 * x2;
#pragma unroll
        for (int o = 16; o; o >>= 1) ss += __shfl_xor(ss, o);
        float sc = rsqrtf(ss * (1.0f / 64.0f) + 1e-6f);
        if (slot < 4) sc *= QS64;
        x1 = x1 * sc * g[d1]; x2 = x2 * sc * g[d1 + 16];
        float c = P_ROPE[ap * 32 + fi], sn = P_ROPE[ap * 32 + 16 + fi];
        hp[d1] = f2bf(x1 * c - x2 * sn); hp[d1 + 16] = f2bf(x1 * sn + x2 * c);
      }
      if (lane < 16) {
        float x1 = bf2f(row[C_AKR + lane]), x2 = bf2f(row[C_AKR + 16 + lane]);
        float c = P_ROPE[pos * 32 + lane], sn = P_ROPE[pos * 32 + 16 + lane];
        bf16_t o1 = f2bf(x1 * c - x2 * sn), o2 = f2bf(x1 * sn + x2 * c);
#pragma unroll
        for (int h = 0; h < 4; ++h) { P_KA[t * 384 + h * 96 + 64 + lane] = o1; P_KA[t * 384 + h * 96 + 80 + lane] = o2; }
      }
    }
  }
}

#define MFMA32(a, b, c) __builtin_amdgcn_mfma_f32_32x32x16_bf16((a), (b), (c), 0, 0, 0)
template <int OFF> DI bf16x4 tr_read(unsigned addr) {
  bf16x4 r; asm volatile("ds_read_b64_tr_b16 %0, %1 offset:%2" : "=&v"(r) : "v"(addr), "i"(OFF) : "memory"); return r;
}
DI float half_swap_max(float v) {
  auto rr = __builtin_amdgcn_permlane32_swap(__float_as_uint(v), __float_as_uint(v), false, false);
  return fmaxf(__uint_as_float(rr[0]), __uint_as_float(rr[1]));
}
DI float half_swap_sum(float v) {
  auto rr = __builtin_amdgcn_permlane32_swap(__float_as_uint(v), __float_as_uint(v), false, false);
  return __uint_as_float(rr[0]) + __uint_as_float(rr[1]);
}
DI bf16x8 pack8(const f32x16& p, int base) {
  u32x4 w = {pack2(p[base + 0], p[base + 1]), pack2(p[base + 2], p[base + 3]), pack2(p[base + 4], p[base + 5]), pack2(p[base + 6], p[base + 7])};
  return __builtin_bit_cast(bf16x8, w);
}
template <int DB, int VLD> DI void pv_block(f32x16& o, unsigned vb, bf16x8 pb0, bf16x8 pb1, bf16x8 pb2, bf16x8 pb3) {
  constexpr int RB = VLD * 2;
  bf16x4 l0 = tr_read<0 * RB + 64 * DB>(vb), h0 = tr_read<8 * RB + 64 * DB>(vb);
  bf16x4 l1 = tr_read<16 * RB + 64 * DB>(vb), h1 = tr_read<24 * RB + 64 * DB>(vb);
  bf16x4 l2 = tr_read<32 * RB + 64 * DB>(vb), h2 = tr_read<40 * RB + 64 * DB>(vb);
  bf16x4 l3 = tr_read<48 * RB + 64 * DB>(vb), h3 = tr_read<56 * RB + 64 * DB>(vb);
  asm volatile("s_waitcnt lgkmcnt(0)" ::: "memory"); __builtin_amdgcn_sched_barrier(0);
  o = MFMA32(__builtin_shufflevector(l0, h0, 0, 1, 2, 3, 4, 5, 6, 7), pb0, o);
  o = MFMA32(__builtin_shufflevector(l1, h1, 0, 1, 2, 3, 4, 5, 6, 7), pb1, o);
  o = MFMA32(__builtin_shufflevector(l2, h2, 0, 1, 2, 3, 4, 5, 6, 7), pb2, o);
  o = MFMA32(__builtin_shufflevector(l3, h3, 0, 1, 2, 3, 4, 5, 6, 7), pb3, o);
}
DI f32x16 splat16(float v) { f32x16 r;
#pragma unroll
  for (int i = 0; i < 16; ++i) r[i] = v;
  return r; }

template <int DQK>
DI void attn_dense_mfma(const bf16_t* Qb, int ldq, const bf16_t* Kb, int ldk, const bf16_t* Vb, int ldv, bf16_t* gate_io, char* smem, bool store) {
  constexpr int NS = DQK / 16, KLD = DQK + 8, VLD = 96, CPR = DQK / 8, NKC = (64 * CPR) / 256;
  constexpr int KBYTES = 64 * KLD * 2, VBYTES = 64 * VLD * 2;
  char* sKc = smem; char* sVc = smem + 2 * KBYTES;
  const int tid = otid(), lane = tid & 63, wid = tid >> 6, r = lane & 31, h = lane >> 5;
  bf16x8 qf[NS];
#pragma unroll
  for (int s = 0; s < NS; ++s) qf[s] = *(const bf16x8*)(Qb + (size_t)(wid * 32 + r) * ldq + 16 * s + 8 * h);
  const bf16_t* kp = Kb + (size_t)(tid >> 2) * ldk + (tid & 3) * (NKC * 8);
  const int kso = ((tid >> 2) * KLD + (tid & 3) * (NKC * 8)) * 2;
  const bf16_t* vp0 = Vb + (size_t)(tid >> 3) * ldv + (tid & 7) * 8;
  const bf16_t* vp1 = vp0 + (size_t)32 * ldv;
  const int vso = ((tid >> 3) * VLD + (tid & 7) * 8) * 2;
  const size_t kstep = (size_t)64 * ldk, vstep = (size_t)64 * ldv;
  u32x4 rk[NKC], rv[2];
#define KLOAD() do { _Pragma("unroll") for (int i = 0; i < NKC; ++i) rk[i] = *(const u32x4*)(kp + i * 8); kp += kstep; } while (0)
#define VLOAD() do { rv[0] = *(const u32x4*)vp0; rv[1] = *(const u32x4*)vp1; vp0 += vstep; vp1 += vstep; } while (0)
#define KSTORE(st) do { _Pragma("unroll") for (int i = 0; i < NKC; ++i) *(u32x4*)(sKc + (st) * KBYTES + kso + i * 16) = rk[i]; } while (0)
#define VSTORE(st) do { *(u32x4*)(sVc + (st) * VBYTES + vso) = rv[0]; *(u32x4*)(sVc + (st) * VBYTES + vso + 32 * VLD * 2) = rv[1]; } while (0)
#define QKT(P0, P1, st) do { \
    const bf16_t* sK = (const bf16_t*)(sKc + (st) * KBYTES) + r * KLD + 8 * h; \
    P0 = negm; P1 = negm; \
    _Pragma("unroll") for (int s = 0; s < NS; ++s) { \
      bf16x8 k0 = *(const bf16x8*)(sK + 16 * s); bf16x8 k1 = *(const bf16x8*)(sK + 32 * KLD + 16 * s); \
      P0 = MFMA32(k0, qf[s], P0); P1 = MFMA32(k1, qf[s], P1); } } while (0)
  const unsigned vb0 = (unsigned)(size_t)sVc + (unsigned)(((4 * h + ((lane & 15) >> 2)) * VLD + 16 * ((lane >> 4) & 1) + 4 * (lane & 3)) * 2);
  f32x16 o0 = splat16(0.f), o1 = splat16(0.f), negm = splat16(0.f);
  f32x16 pa0, pa1, pc0, pc1;
  float m_run = 0.f, l_run = 0.f;
  constexpr int NT = SEQ / 64;
  __syncthreads();
  KLOAD(); VLOAD(); KSTORE(0); VSTORE(0);
  KLOAD(); KSTORE(1);
  __syncthreads();
  QKT(pa0, pa1, 0);
  __syncthreads();
#define STEP(SC0, SC1, SN0, SN1, PAR, FIRST, LK, LV) do { \
    if (LK) KLOAD(); \
    if (LV) VLOAD(); \
    float pm = fmaxf(SC0[0], SC1[0]); \
    _Pragma("unroll") for (int i = 1; i < 16; i += 1) pm = fmaxf(fmaxf(pm, SC0[i]), SC1[i]); \
    pm = half_swap_max(pm); \
    if ((FIRST) || __any(pm > 8.0f)) { \
      float delta; \
      if (FIRST) delta = pm; \
      else { delta = fmaxf(pm, 0.f); float alpha = __builtin_amdgcn_exp2f(-delta); l_run *= alpha; \
        _Pragma("unroll") for (int i = 0; i < 16; ++i) { o0[i] *= alpha; o1[i] *= alpha; } } \
      m_run += delta; \
      _Pragma("unroll") for (int i = 0; i < 16; ++i) { SC0[i] -= delta; SC1[i] -= delta; } \
      negm = splat16(-m_run); \
    } \
    if (LV) QKT(SN0, SN1, (PAR) ^ 1); \
    float ls = 0.f; \
    _Pragma("unroll") for (int i = 0; i < 16; ++i) { SC0[i] = __builtin_amdgcn_exp2f(SC0[i]); SC1[i] = __builtin_amdgcn_exp2f(SC1[i]); ls += SC0[i] + SC1[i]; } \
    l_run += ls; \
    bf16x8 pb0 = pack8(SC0, 0), pb1 = pack8(SC0, 8), pb2 = pack8(SC1, 0), pb3 = pack8(SC1, 8); \
    const unsigned vb = vb0 + (PAR) * VBYTES; \
    pv_block<0, VLD>(o0, vb, pb0, pb1, pb2, pb3); \
    pv_block<1, VLD>(o1, vb, pb0, pb1, pb2, pb3); \
    if (LK) KSTORE(PAR); \
    if (LV) VSTORE((PAR) ^ 1); \
    __syncthreads(); } while (0)
  pc0 = negm; pc1 = negm;
  STEP(pa0, pa1, pc0, pc1, 0, true, 1, 1);
  STEP(pc0, pc1, pa0, pa1, 1, false, 1, 1);
  for (int j = 2; j < NT - 2; j += 2) {
    STEP(pa0, pa1, pc0, pc1, 0, false, 1, 1);
    STEP(pc0, pc1, pa0, pa1, 1, false, 1, 1);
  }
  STEP(pa0, pa1, pc0, pc1, 0, false, 0, 1);
  STEP(pc0, pc1, pa0, pa1, 1, false, 0, 0);
#undef STEP
#undef QKT
#undef KLOAD
#undef VLOAD
#undef KSTORE
#undef VSTORE
  if (!store) return;
  const float inv = 1.0f / half_swap_sum(l_run);
  bf16_t* grow = gate_io + (size_t)(wid * 32 + r) * PW;
#pragma unroll
  for (int db = 0; db < 2; ++db)
#pragma unroll
    for (int g4 = 0; g4 < 4; ++g4) {
      bf16_t* gp = grow + 32 * db + 8 * g4 + 4 * h;
      uint2 u = *(const uint2*)gp;
      float g[4] = {BLO(u.x), BHI(u.x), BLO(u.y), BHI(u.y)};
      float y[4];
#pragma unroll
      for (int e = 0; e < 4; ++e) { float ov = db == 0 ? o0[4 * g4 + e] : o1[4 * g4 + e]; y[e] = ov * inv * g[e] / (1.0f + __expf(-g[e])); }
      uint2 w; w.x = pack2(y[0], y[1]); w.y = pack2(y[2], y[3]);
      *(uint2*)gp = w;
    }
}
DI void dense_item(const Params& p, int combo, int qblk, char* smem, bool store) {
  const int br = combo >> 4, bh = combo & 15, b = bh >> 2, h = bh & 3;
  const size_t t0 = (size_t)b * SEQ + qblk * 128;
  bf16_t* gate_io = P_PROJ + t0 * PW + C_GATE + br * 256 + h * 64;
  if (br == 0)
    attn_dense_mfma<96>(P_QA + t0 * 384 + h * 96, 384, P_KA + (size_t)b * SEQ * 384 + h * 96, 384, P_VA + (size_t)b * SEQ * 256 + h * 64, 256, gate_io, smem, store);
  else
    attn_dense_mfma<64>(P_PROJ + t0 * PW + C_BQ + h * 64, PW, P_PROJ + (size_t)b * SEQ * PW + C_BK + (h >> 1) * 64, PW,
                        P_PROJ + (size_t)b * SEQ * PW + C_BV + (h >> 1) * 64, PW, gate_io, smem, store);
}

template <int W, bool SINK>
DI void attn_band_mfma(const bf16_t* Qb, size_t ldq, const bf16_t* Kb, const bf16_t* Vb, size_t ldk, int L, int i0,
                       const float* lut_g, float sink2, bf16_t* outp, size_t ldo, float* lse_out, size_t ldl, char* smem) {
  constexpr int NS = 4, KLD = 72, VLD = 96, NTW = (128 + 2 * W) / 64, LUTN = 2 * W + 1;
  constexpr int KBYTES = 64 * KLD * 2, VBYTES = 64 * VLD * 2;
  char* sKc = smem; char* sVc = smem + 2 * KBYTES; float* sLut = (float*)(smem + 2 * KBYTES + 2 * VBYTES);
  const int tid = otid(), lane = tid & 63, wid = tid >> 6, r = lane & 31, h = lane >> 5;
  __syncthreads();
  for (int e = tid; e < LUTN; e += 256) sLut[e] = lut_g[e];
  const int qi = i0 + wid * 32 + r;
  bf16x8 qf[NS];
#pragma unroll
  for (int s = 0; s < NS; ++s) qf[s] = *(const bf16x8*)(Qb + (size_t)qi * ldq + 16 * s + 8 * h);
  const int srow = tid >> 3, scc = tid & 7;
  u32x4 rk[2], rv[2];
#define BLOAD(k0) do { \
    rk[0] = *(const u32x4*)(Kb + (size_t)((k0) + srow) * ldk + scc * 8); rk[1] = *(const u32x4*)(Kb + (size_t)((k0) + srow + 32) * ldk + scc * 8); \
    rv[0] = *(const u32x4*)(Vb + (size_t)((k0) + srow) * ldk + scc * 8); rv[1] = *(const u32x4*)(Vb + (size_t)((k0) + srow + 32) * ldk + scc * 8); } while (0)
#define BSTORE(st) do { \
    *(u32x4*)(sKc + (st) * KBYTES + (srow * KLD + scc * 8) * 2) = rk[0]; *(u32x4*)(sKc + (st) * KBYTES + ((srow + 32) * KLD + scc * 8) * 2) = rk[1]; \
    *(u32x4*)(sVc + (st) * VBYTES + (srow * VLD + scc * 8) * 2) = rv[0]; *(u32x4*)(sVc + (st) * VBYTES + ((srow + 32) * VLD + scc * 8) * 2) = rv[1]; } while (0)
  const unsigned vb0 = (unsigned)(size_t)sVc + (unsigned)(((4 * h + ((lane & 15) >> 2)) * VLD + 16 * ((lane >> 4) & 1) + 4 * (lane & 3)) * 2);
  f32x16 o0 = splat16(0.f), o1 = splat16(0.f);
  float m_run = SINK ? sink2 : 0.f, l_run = (SINK && h == 0) ? 1.f : 0.f;
  bool seen = SINK;
  f32x16 negm = splat16(-m_run);
  const int lo = (i0 == 0) ? W / 64 : 0, hi = (i0 + 128 >= L) ? NTW - W / 64 : NTW;
  BLOAD(i0 - W + 64 * lo); BSTORE(0);
  __syncthreads();
  for (int j = lo; j < hi; ++j) {
    const int cur = (j - lo) & 1, k0 = i0 - W + 64 * j;
    if (j + 1 < hi) BLOAD(k0 + 64);
    const bf16_t* sK = (const bf16_t*)(sKc + cur * KBYTES);
    f32x16 p0 = negm, p1 = negm;
#pragma unroll
    for (int s = 0; s < NS; ++s) {
      bf16x8 k0f = *(const bf16x8*)(sK + r * KLD + 16 * s + 8 * h);
      bf16x8 k1f = *(const bf16x8*)(sK + (32 + r) * KLD + 16 * s + 8 * h);
      p0 = MFMA32(k0f, qf[s], p0);
      p1 = MFMA32(k1f, qf[s], p1);
    }
    const int offb = k0 + 4 * h - qi + W;
    float pm = -1e30f;
#pragma unroll
    for (int i = 0; i < 16; ++i) {
      int idx0 = offb + (i & 3) + 8 * (i >> 2), idx1 = idx0 + 32;
      int c0 = min(max(idx0, 0), 2 * W), c1 = min(max(idx1, 0), 2 * W);
      float b0 = sLut[c0], b1 = sLut[c1];
      p0[i] = ((unsigned)idx0 <= (unsigned)(2 * W)) ? p0[i] + b0 : -1e30f;
      p1[i] = ((unsigned)idx1 <= (unsigned)(2 * W)) ? p1[i] + b1 : -1e30f;
      pm = fmaxf(pm, fmaxf(p0[i], p1[i]));
    }
    pm = half_swap_max(pm);
    const bool has = pm > -1e29f;
    float delta = 0.f;
    if (has) { if (!seen) delta = pm; else if (pm > 8.0f) delta = pm; }
    if (__any(delta != 0.f)) {
      float alpha = seen ? __builtin_amdgcn_exp2f(-delta) : 1.0f;
      l_run *= alpha; m_run += delta;
#pragma unroll
      for (int i = 0; i < 16; ++i) { o0[i] *= alpha; o1[i] *= alpha; p0[i] -= delta; p1[i] -= delta; }
      negm = splat16(-m_run);
    }
    seen = seen || has;
    float ls = 0.f;
#pragma unroll
    for (int i = 0; i < 16; ++i) { p0[i] = __builtin_amdgcn_exp2f(p0[i]); p1[i] = __builtin_amdgcn_exp2f(p1[i]); ls += p0[i] + p1[i]; }
    l_run += ls;
    bf16x8 pb0 = pack8(p0, 0), pb1 = pack8(p0, 8), pb2 = pack8(p1, 0), pb3 = pack8(p1, 8);
    const unsigned vb = vb0 + cur * VBYTES;
    pv_block<0, VLD>(o0, vb, pb0, pb1, pb2, pb3);
    pv_block<1, VLD>(o1, vb, pb0, pb1, pb2, pb3);
    if (j + 1 < hi) BSTORE(cur ^ 1);
    __syncthreads();
  }
#undef BLOAD
#undef BSTORE
  const float ltot = half_swap_sum(l_run);
  const float inv = 1.0f / ltot;
  bf16_t* orow = outp + (size_t)qi * ldo;
  if (!SINK && h == 0) lse_out[(size_t)qi * ldl] = m_run + __log2f(ltot);
#pragma unroll
  for (int db = 0; db < 2; ++db)
#pragma unroll
    for (int g4 = 0; g4 < 4; ++g4) {
      bf16_t* gp = orow + 32 * db + 8 * g4 + 4 * h;
      float y[4];
      if (SINK) {
        uint2 u = *(const uint2*)gp;
        float g[4] = {BLO(u.x), BHI(u.x), BLO(u.y), BHI(u.y)};
#pragma unroll
        for (int e = 0; e < 4; ++e) { float ov = db == 0 ? o0[4 * g4 + e] : o1[4 * g4 + e]; y[e] = ov * inv * g[e] / (1.0f + __expf(-g[e])); }
      } else {
#pragma unroll
        for (int e = 0; e < 4; ++e) { float ov = db == 0 ? o0[4 * g4 + e] : o1[4 * g4 + e]; y[e] = ov * inv; }
      }
      uint2 w; w.x = pack2(y[0], y[1]); w.y = pack2(y[2], y[3]);
      *(uint2*)gp = w;
    }
}
DI void band_item(const Params& p, int l, int idx, char* smem) {
  if (idx < 3072) {
    const int g = idx >> 10, rem = idx & 1023, h = rem & 3, rem2 = rem >> 2, b = rem2 >> 6, u = rem2 & 63;
    const int sh = 2 * g, rr = 1 << sh;
    const int rho = u & (rr - 1), qblk = u >> sh;
    const size_t tok0 = (size_t)b * SEQ + rho;
    bf16_t* base = P_PROJ + tok0 * PW + g * 256 + h * 64;
    attn_band_mfma<64, false>(base + C_CQ, (size_t)rr * PW, base + C_CK, base + C_CV, (size_t)rr * PW, SEQ >> sh, qblk * 128,
                              P_LUTC + (g * 4 + h) * 129, 0.f, base + C_CQ, (size_t)rr * PW, P_LSE + tok0 * 12 + g * 4 + h, (size_t)rr * 12, smem);
  } else {
    const int it = idx - 3072, hq = it & 3, rem = it >> 2, b = rem >> 6, qblk = rem & 63;
    bf16_t* base = P_PROJ + (size_t)b * SEQ * PW;
    attn_band_mfma<128, true>(base + C_DQ + hq * 64, PW, base + C_DK + (hq >> 1) * 64, base + C_DV + (hq >> 1) * 64, PW, SEQ, qblk * 128,
                              P_LUTD + hq * 257, p.sink[l * 4 + hq] * LOG2E, base + C_GATE + 768 + hq * 64, PW, nullptr, 0, smem);
  }
}
DI void combine_c(const Params& p) {
  for (size_t u = (size_t)blockIdx.x * 256 + otid(); u < (size_t)32768 * 32; u += (size_t)gridDim.x * 256) {
    const size_t t = u >> 5; const int h = (int)(u >> 3) & 3, ch = (int)u & 7;
    const float* ls = P_LSE + t * 12 + h;
    float l0 = ls[0], l1 = ls[4], l2 = ls[8];
    float mx = fmaxf(l0, fmaxf(l1, l2));
    float a0 = __builtin_amdgcn_exp2f(l0 - mx), a1 = __builtin_amdgcn_exp2f(l1 - mx), a2 = __builtin_amdgcn_exp2f(l2 - mx);
    float inv = 1.0f / (a0 + a1 + a2); a0 *= inv; a1 *= inv; a2 *= inv;
    const bf16_t* row = P_PROJ + t * PW;
    uint4 x0 = *(const uint4*)(row + C_CQ + h * 64 + ch * 8), x1 = *(const uint4*)(row + C_CQ + 256 + h * 64 + ch * 8),
          x2 = *(const uint4*)(row + C_CQ + 512 + h * 64 + ch * 8);
    bf16_t* gp = P_PROJ + t * PW + C_GATE + 512 + h * 64 + ch * 8;
    uint4 gu = *(const uint4*)gp;
    unsigned xa[4] = {x0.x, x0.y, x0.z, x0.w}, xb[4] = {x1.x, x1.y, x1.z, x1.w}, xc[4] = {x2.x, x2.y, x2.z, x2.w}, gg[4] = {gu.x, gu.y, gu.z, gu.w};
    unsigned ov[4];
#pragma unroll
    for (int e = 0; e < 4; ++e) {
      float ylo = a0 * BLO(xa[e]) + a1 * BLO(xb[e]) + a2 * BLO(xc[e]);
      float yhi = a0 * BHI(xa[e]) + a1 * BHI(xb[e]) + a2 * BHI(xc[e]);
      float glo = BLO(gg[e]), ghi = BHI(gg[e]);
      ov[e] = pack2(ylo * glo / (1.0f + __expf(-glo)), yhi * ghi / (1.0f + __expf(-ghi)));
    }
    uint4 w; w.x = ov[0]; w.y = ov[1]; w.z = ov[2]; w.w = ov[3];
    *(uint4*)gp = w;
  }
}

DI void merge_tile(const Params& p, int l, int tile, char* smem) {
  bf16_t* sA = (bf16_t*)smem; bf16_t* sB = sA + 2 * GST;
  const int mt = tile & 255, nt = tile >> 8;
  f32x4 accM[4][4]; zero_acc<4>(accM);
#pragma unroll 1
  for (int n = 0; n < 4; ++n) {
    unsigned sg[4][4][2];
    {
      f32x4 accG[4][4]; zero_acc<4>(accG);
      gemm_mainloop<4>(accG, P_XN + (size_t)mt * 128 * 1024, 1024, P_WMT + ((size_t)l * 4096 + n * 1024 + nt * 128) * 1024, 1024, 1024, sA, sB);
#pragma unroll
      for (int mi = 0; mi < 4; ++mi)
#pragma unroll
        for (int ni = 0; ni < 4; ++ni) {
          float s0 = 1.0f / (1.0f + __expf(-accG[mi][ni][0])), s1 = 1.0f / (1.0f + __expf(-accG[mi][ni][1]));
          float s2 = 1.0f / (1.0f + __expf(-accG[mi][ni][2])), s3 = 1.0f / (1.0f + __expf(-accG[mi][ni][3]));
          sg[mi][ni][0] = pack2(s0, s1); sg[mi][ni][1] = pack2(s2, s3);
        }
    }
#pragma unroll
    for (int half = 0; half < 2; ++half) {
      f32x4 accB[4][2]; zero_acc<2>(accB);
      gemm_mainloop<2>(accB, P_PROJ + (size_t)mt * 128 * PW + C_GATE + n * 256, PW,
                       P_WBT + ((size_t)(l * 4 + n) * 1024 + nt * 128 + half * 32) * 256, 256, 256, sA, sB, 64);
#pragma unroll
      for (int mi = 0; mi < 4; ++mi)
#pragma unroll
        for (int ni = 0; ni < 2; ++ni) {
          const int nn = half * 2 + ni;
          accM[mi][nn][0] += accB[mi][ni][0] * BLO(sg[mi][nn][0]); accM[mi][nn][1] += accB[mi][ni][1] * BHI(sg[mi][nn][0]);
          accM[mi][nn][2] += accB[mi][ni][2] * BLO(sg[mi][nn][1]); accM[mi][nn][3] += accB[mi][ni][3] * BHI(sg[mi][nn][1]);
        }
    }
  }
  const int lane = otid() & 63, wid = otid() >> 6, wm = wid >> 1, wn = wid & 1, fr = lane & 15, fq = lane >> 4;
#pragma unroll
  for (int mi = 0; mi < 4; ++mi)
#pragma unroll
    for (int ni = 0; ni < 4; ++ni) {
      size_t row = (size_t)mt * 128 + wm * 64 + mi * 16 + fr; int col = nt * 128 + wn * 64 + ni * 16 + fq * 4;
      uint2 o; o.x = pack2(accM[mi][ni][0], accM[mi][ni][1]); o.y = pack2(accM[mi][ni][2], accM[mi][ni][3]);
      *(uint2*)(P_PROJ + row * PW + C_MERGED + col) = o;
    }
}

DI void outproj_tile(const Params& p, int l, int tile, char* smem) {
  bf16_t* sA = (bf16_t*)smem; bf16_t* sB = sA + 2 * GST;
  const int mt = tile & 255, nt = tile >> 8;
  f32x4 acc[4][4]; zero_acc<4>(acc);
  gemm_mainloop<4>(acc, P_PROJ + (size_t)mt * 128 * PW + C_MERGED, PW, P_WOT + ((size_t)l * 1024 + nt * 128) * 1024, 1024, 1024, sA, sB);
  const float* xin = l == 0 ? p.x : p.out;
  const int lane = otid() & 63, wid = otid() >> 6, wm = wid >> 1, wn = wid & 1, fr = lane & 15, fq = lane >> 4;
#pragma unroll
  for (int mi = 0; mi < 4; ++mi)
#pragma unroll
    for (int ni = 0; ni < 4; ++ni) {
      size_t row = (size_t)mt * 128 + wm * 64 + mi * 16 + fr; int col = nt * 128 + wn * 64 + ni * 16 + fq * 4;
      float4 xi = *(const float4*)(xin + row * 1024 + col);
      float4 o; o.x = xi.x + acc[mi][ni][0]; o.y = xi.y + acc[mi][ni][1]; o.z = xi.z + acc[mi][ni][2]; o.w = xi.w + acc[mi][ni][3];
      *(float4*)(p.out + row * 1024 + col) = o;
    }
}


#define XB_TMO      128
#define XB_XCNT(j)  (256  + 64 * (j))
#define XB_XSUB(j)  (1280 + 64 * (j))
#define XB_XGEN(j)  (2304 + 64 * (j))
#define XB_TOP      3328
#define XB_TOPGEN   3392
#define XCD_BAR_WORDS 3456
#define XB_SPIN_CAP (1u << 18)
#define LAS __attribute__((address_space(3)))
DI unsigned xb_ld(unsigned* p)              { return __hip_atomic_load(p, __ATOMIC_RELAXED, __HIP_MEMORY_SCOPE_AGENT); }
DI unsigned xb_add(unsigned* p, unsigned v) { return __hip_atomic_fetch_add(p, v, __ATOMIC_RELAXED, __HIP_MEMORY_SCOPE_AGENT); }
DI unsigned xb_xcc_id() { return (unsigned)__builtin_amdgcn_s_getreg((3 << 11) | 20) & 0xFu; }
#define XB_SPIN(cond, bar) do { unsigned _sp = 0; while (cond) { __builtin_amdgcn_s_sleep(1); \
    if ((++_sp & 255u) == 0u) { if (xb_ld(&(bar)[XB_TMO])) break; if (_sp > XB_SPIN_CAP) { atomicAdd(&(bar)[XB_TMO], 1u); break; } } } } while (0)
struct XcdBarrier { unsigned* bar; unsigned x; volatile LAS unsigned* st; };
DI XcdBarrier xcd_barrier_post(unsigned* bar, volatile LAS unsigned* st) {
  XcdBarrier b; b.bar = bar; b.x = xb_xcc_id(); b.st = st;
  if (threadIdx.x == 0) (void)xb_add(&bar[XB_XCNT(b.x)], 1u);
  return b;
}
DI void xcd_barrier_complete(unsigned* bar, unsigned x, unsigned& nloc, unsigned& nx) {
  const unsigned G = gridDim.x * gridDim.y * gridDim.z;
  unsigned sum, cnt, mine, sp = 0u;
  for (;;) {
    sum = 0u; cnt = 0u; mine = 0u;
#pragma unroll
    for (unsigned j = 0; j < 16; ++j) { const unsigned c = xb_ld(&bar[XB_XCNT(j)]); sum += c; cnt += (c > 0u) ? 1u : 0u; mine = (j == x) ? c : mine; }
    if (sum == G) break;
    __builtin_amdgcn_s_sleep(1);
    if ((++sp & 255u) == 0u) { if (xb_ld(&bar[XB_TMO])) break; if (sp > XB_SPIN_CAP) { atomicAdd(&bar[XB_TMO], 1u); break; } }
  }
  nloc = mine > 0u ? mine : 1u; nx = cnt > 0u ? cnt : 1u;
}
DI void xcd_barrier(const XcdBarrier& b) {
  asm volatile("s_waitcnt vmcnt(0)" ::: "memory");
  __syncthreads();
  if (threadIdx.x == 0) {
    unsigned* bar = b.bar;
    __builtin_amdgcn_s_waitcnt(0);
    unsigned nloc = b.st[0], nx = b.st[1];
    if (nloc == 0u) { xcd_barrier_complete(bar, b.x, nloc, nx); b.st[0] = nloc; b.st[1] = nx; }
    const unsigned old = xb_add(&bar[XB_XSUB(b.x)], 1u);
    const unsigned gen = old / nloc;
    if (old + 1u == (gen + 1u) * nloc) {
      __builtin_amdgcn_fence(__ATOMIC_RELEASE, "agent");
      asm volatile("s_waitcnt vmcnt(0)" ::: "memory");
      const unsigned og = xb_add(&bar[XB_TOP], 1u);
      const unsigned tg = og / nx;
      if (og + 1u == (tg + 1u) * nx) xb_add(&bar[XB_TOPGEN], 1u);
      else XB_SPIN(xb_ld(&bar[XB_TOPGEN]) == tg, bar);
      __builtin_amdgcn_fence(__ATOMIC_ACQUIRE, "agent");
      xb_add(&bar[XB_XGEN(b.x)], 1u);
      asm volatile("s_waitcnt vmcnt(0)" ::: "memory");
    } else {
      XB_SPIN(xb_ld(&bar[XB_XGEN(b.x)]) == gen, bar);
      __builtin_amdgcn_fence(__ATOMIC_ACQUIRE, "agent");
      asm volatile("s_waitcnt vmcnt(0)" ::: "memory");
    }
  }
  __syncthreads();
}

DI void run_phase(const Params& p, int ph, char* smem, bool never) {
  const int G = gridDim.x, B = blockIdx.x;
  if (ph == 0) {
    for (int i = B; i < 6097; i += G) prep_item(p, i, (float*)smem);
    for (int i = B; i < 1024; i += G) norm_rows_bf16(p.x, p.norm_g, P_XN, i);
  } else if (ph == 14) {
    for (int i = B; i < 1024; i += G) norm_rows_f32(p.out, p.final_g, i);
  } else if (ph == 7) {
    for (int i = B; i < 1024; i += G) norm_rows_bf16(p.out, p.norm_g + 1024, P_XN, i);
  } else {
    const int l = ph > 7 ? 1 : 0; const int s = ph > 7 ? ph - 8 : ph - 1;
    const int xcd = B & 7, lb = B >> 3, nl = G >> 3;
    if (s == 0) {
      for (int w = lb; w < 64 * 20; w += nl) {
        const int it = w >> 6, l64 = w & 63, a = it / 5, gn = it % 5;
        const int mt = 8 * (xcd + 8 * a) + (l64 & 7), nt = 8 * gn + (l64 >> 3);
        if (nt < 38) inproj_tile(p, l, nt * 256 + mt, smem);
      }
    }
    else if (s == 1) { for (int i = B; i < 2048; i += G) mla_item(p, l, i, smem); }
    else if (s == 2) {
#ifdef REP_DENSE
      for (int w = lb; w < 256; w += nl) dense_item(p, xcd + 8 * (w >> 6), w & 63, smem, never);
#endif
      for (int w = lb; w < 256; w += nl) dense_item(p, xcd + 8 * (w >> 6), w & 63, smem, true);
      for (int i = B; i < 4096; i += G) band_item(p, l, i, smem);
    }
    else if (s == 3) { combine_c(p); }
    else if (s == 4) {
      for (int w = lb; w < 64 * 4; w += nl) {
        const int a = w >> 6, l64 = w & 63;
        const int mt = 8 * (xcd + 8 * a) + (l64 & 7), nt = l64 >> 3;
        merge_tile(p, l, nt * 256 + mt, smem);
      }
    }
    else {
      for (int w = lb; w < 64 * 4; w += nl) {
        const int a = w >> 6, l64 = w & 63;
        const int mt = 8 * (xcd + 8 * a) + (l64 & 7), nt = l64 >> 3;
        outproj_tile(p, l, nt * 256 + mt, smem);
      }
    }
  }
}

__global__ void __launch_bounds__(256, 2) mega(Params p, int ph_lo, int ph_hi) {
  __shared__ __attribute__((aligned(16))) char smem[66048];
  __shared__ uint4 xb_words;
  cg::grid_group grid = cg::this_grid();
  if (threadIdx.x == 0) xb_words = make_uint4(0u, 0u, 0u, 0u);
  __syncthreads();
  XcdBarrier xb = xcd_barrier_post((unsigned*)(p.ws + OFF_BAR), (volatile LAS unsigned*)&xb_words);
  if (ph_hi == 12345) grid.sync();
  for (int ph = ph_lo; ph < ph_hi; ++ph) {
    run_phase(p, ph, smem, ph_hi == 12345);
    if (ph + 1 < ph_hi) xcd_barrier(xb);
  }
}

extern "C" void kernel_launch(void* const* d_in, const int* in_sizes, int n_in, void* d_out, int out_size, void* d_ws,
                              size_t ws_size, hipStream_t stream) {
  Params p{};
  p.x = (const float*)d_in[0]; p.norm_g = (const float*)d_in[1]; p.w_in = (const float*)d_in[2];
  p.q_norm_g = (const float*)d_in[3]; p.kv_norm_g = (const float*)d_in[4]; p.w_q_up = (const float*)d_in[5];
  p.w_kv_up = (const float*)d_in[6]; p.gq_g = (const float*)d_in[7]; p.gk_g = (const float*)d_in[8];
  p.sink = (const float*)d_in[9]; p.t5 = (const float*)d_in[10]; p.w_branch = (const float*)d_in[11];
  p.w_out = (const float*)d_in[12]; p.final_g = (const float*)d_in[13];
  p.out = (float*)d_out;
  p.ws = (char*)d_ws;
  if (WS_NEED > ws_size) { fprintf(stderr, "workspace too small: need %zu have %zu\n", (size_t)WS_NEED, ws_size); return; }

  static int grid_blocks = 0;
  if (!grid_blocks) {
    int dev = 0, cus = 0, per_cu = 0;
    hipGetDevice(&dev);
    hipDeviceGetAttribute(&cus, hipDeviceAttributeMultiprocessorCount, dev);
    hipOccupancyMaxActiveBlocksPerMultiprocessor(&per_cu, mega, 256, 0);
    if (per_cu < 1) per_cu = 1;
    if (per_cu > 2) per_cu = 2;
    grid_blocks = cus * per_cu;
  }
  hipMemsetAsync((char*)d_ws + OFF_BAR, 0, 16384, stream);
  int lo = 0, hi = 15;
  void* args[] = {&p, &lo, &hi};
  hipError_t e = hipLaunchCooperativeKernel((void*)mega, dim3(grid_blocks), dim3(256), args, 0, stream);
  if (e != hipSuccess) fprintf(stderr, "cooperative launch failed: %s (grid %d)\n", hipGetErrorString(e), grid_blocks);
}
```

```cpp
#include <hip/hip_runtime.h>
#include <hip/hip_cooperative_groups.h>
#include <cstdio>
namespace cg = cooperative_groups;

typedef unsigned short bf16_t;
using bf16x8 = __attribute__((ext_vector_type(8))) short;
using f32x4 = __attribute__((ext_vector_type(4))) float;
using u32x4 = __attribute__((ext_vector_type(4))) unsigned;
using f32x16 = __attribute__((ext_vector_type(16))) float;
using bf16x4 = __attribute__((ext_vector_type(4))) short;
#define DI __device__ __forceinline__

constexpr int SEQ = 8192;
constexpr int PW = 4864;
constexpr int C_BQ = 0, C_BK = 256, C_BV = 384, C_CQ = 512, C_CK = 1280, C_CV = 2048, C_DQ = 2816, C_DK = 3072,
              C_DV = 3200, C_GATE = 3328, C_AQ = 4352, C_AKV = 4608, C_AKR = 4736;
constexpr int C_MERGED = 512;

struct Params {
  const float* x; const float* norm_g; const float* w_in; const float* q_norm_g; const float* kv_norm_g;
  const float* w_q_up; const float* w_kv_up; const float* gq_g; const float* gk_g; const float* sink;
  const float* t5; const float* w_branch; const float* w_out; const float* final_g;
  float* out; char* ws;
};
constexpr size_t al256(size_t x) { return (x + 255) & ~(size_t)255; }
constexpr size_t OFF_W1T = 0;
constexpr size_t OFF_WMT = OFF_W1T + al256((size_t)2 * 4864 * 1024 * 2);
constexpr size_t OFF_WOT = OFF_WMT + al256((size_t)2 * 4096 * 1024 * 2);
constexpr size_t OFF_WBT = OFF_WOT + al256((size_t)2 * 1024 * 1024 * 2);
constexpr size_t OFF_WQT = OFF_WBT + al256((size_t)2 * 4 * 1024 * 256 * 2);
constexpr size_t OFF_WKVT = OFF_WQT + al256((size_t)2 * 384 * 256 * 2);
constexpr size_t OFF_ROPE = OFF_WKVT + al256((size_t)2 * 512 * 128 * 2);
constexpr size_t OFF_LUTC = OFF_ROPE + al256((size_t)8192 * 32 * 4);
constexpr size_t OFF_LUTD = OFF_LUTC + 8192;
constexpr size_t OFF_XN = OFF_LUTD + 8192;
constexpr size_t OFF_PROJ = OFF_XN + al256((size_t)32768 * 1024 * 2);
constexpr size_t OFF_QA = OFF_PROJ + al256((size_t)32768 * 4864 * 2);
constexpr size_t OFF_KA = OFF_QA + al256((size_t)32768 * 384 * 2);
constexpr size_t OFF_VA = OFF_KA + al256((size_t)32768 * 384 * 2);
constexpr size_t OFF_LSE = OFF_VA + al256((size_t)32768 * 256 * 2);
constexpr size_t OFF_BAR = OFF_LSE + al256((size_t)32768 * 12 * 4);
constexpr size_t WS_NEED = OFF_BAR + 16384;
#define WSP(T, OFF) ((T*)(p.ws + (OFF)))
#define P_W1T WSP(bf16_t, OFF_W1T)
#define P_WMT WSP(bf16_t, OFF_WMT)
#define P_WOT WSP(bf16_t, OFF_WOT)
#define P_WBT WSP(bf16_t, OFF_WBT)
#define P_WQT WSP(bf16_t, OFF_WQT)
#define P_WKVT WSP(bf16_t, OFF_WKVT)
#define P_ROPE WSP(float, OFF_ROPE)
#define P_LUTC WSP(float, OFF_LUTC)
#define P_LUTD WSP(float, OFF_LUTD)
#define P_XN WSP(bf16_t, OFF_XN)
#define P_PROJ WSP(bf16_t, OFF_PROJ)
#define P_QA WSP(bf16_t, OFF_QA)
#define P_KA WSP(bf16_t, OFF_KA)
#define P_VA WSP(bf16_t, OFF_VA)
#define P_LSE WSP(float, OFF_LSE)


DI unsigned short f2bf(float x) { unsigned u = __float_as_uint(x); u += 0x7fffu + ((u >> 16) & 1u); return (unsigned short)(u >> 16); }
DI float bf2f(unsigned short b) { return __uint_as_float(((unsigned)b) << 16); }
typedef __bf16 bf2_t __attribute__((ext_vector_type(2)));
typedef float f2_t __attribute__((ext_vector_type(2)));
DI unsigned pack2(float a, float b) { f2_t v = {a, b}; bf2_t r = __builtin_convertvector(v, bf2_t); return __builtin_bit_cast(unsigned, r); }
constexpr float LOG2E = 1.4426950408889634f;
constexpr float QS64 = 0.125f * LOG2E;
constexpr float QS96 = 0.10206207261596575f * LOG2E;
#define BLO(u) __uint_as_float((u) << 16)
#define BHI(u) __uint_as_float((u) & 0xffff0000u)
DI int otid() { int t; asm volatile("v_mov_b32 %0, %1" : "=v"(t) : "v"((int)threadIdx.x)); __builtin_assume(t >= 0 && t < 256); return t; }
DI float wave_sum(float v) {
#pragma unroll
  for (int o = 32; o; o >>= 1) v += __shfl_xor(v, o);
  return v;
}

DI int srccol(int mode, int n) {
  if (mode == 0) return n < 4352 ? n + 416 : (n < 4768 ? n - 4352 : -1);
  if (mode == 1) return 4768 + n;
  if (mode == 2) return n;
  return n < 256 ? (n >> 6) * 96 + (n & 63) : ((n - 256) >> 5) * 96 + 64 + ((n - 256) & 31);
}
DI void conv_tile(const float* __restrict__ src, int ld, int K, bf16_t* __restrict__ dst, int n0, int k0, int mode,
                  const float* __restrict__ rs, float* tile) {
  const int tx = otid() & 63, ty = otid() >> 6;
  __syncthreads();
  const int sc = srccol(mode, n0 + tx);
  const int nq = n0 + tx;
  const float cscale = (mode == 0 && ((nq >= C_CQ && nq < C_CQ + 768) || (nq >= C_DQ && nq < C_DQ + 256))) ? QS64 : 1.0f;
#pragma unroll
  for (int i = 0; i < 16; ++i) {
    int kk = ty + 4 * i;
    float v = sc >= 0 ? src[(size_t)(k0 + kk) * ld + sc] : 0.f;
    if (rs) v *= rs[k0 + kk];
    tile[kk * 65 + tx] = v * cscale;
  }
  __syncthreads();
#pragma unroll
  for (int i = 0; i < 16; ++i) {
    int nn = ty + 4 * i;
    dst[(size_t)(n0 + nn) * K + k0 + tx] = f2bf(tile[tx * 65 + nn]);
  }
}

DI int t5_bucket(int rel) {
  int n = rel < 0 ? -rel : rel;
  float nf = (float)(n < 1 ? 1 : n);
  int large = 8 + (int)(logf(nf / 8.0f) / 4.852030263919617f * 8.0f);
  if (large > 15) large = 15;
  return (rel > 0 ? 16 : 0) + (n < 8 ? n : large);
}

DI void prep_item(const Params& p, int item, float* tile) {
  if (item < 5584) {
    int l = item / 2792, r = item % 2792;
    const float* src; int ld, K, mode, t; bf16_t* dst; const float* rs = nullptr;
    if (r < 1216) { t = r; src = p.w_in + (size_t)l * 1024 * 8864; ld = 8864; K = 1024; mode = 0; dst = P_W1T + (size_t)l * 4864 * 1024; }
    else if (r < 2240) { t = r - 1216; src = p.w_in + (size_t)l * 1024 * 8864; ld = 8864; K = 1024; mode = 1; dst = P_WMT + (size_t)l * 4096 * 1024; }
    else if (r < 2496) { t = r - 2240; src = p.w_out + (size_t)l * 1024 * 1024; ld = 1024; K = 1024; mode = 2; dst = P_WOT + (size_t)l * 1024 * 1024; }
    else if (r < 2752) { t = r - 2496; int n = t >> 6; t &= 63; src = p.w_branch + (size_t)(l * 4 + n) * 256 * 1024; ld = 1024; K = 256; mode = 2; dst = P_WBT + (size_t)(l * 4 + n) * 1024 * 256; }
    else if (r < 2776) { t = r - 2752; src = p.w_q_up + (size_t)l * 256 * 384; ld = 384; K = 256; mode = 3; dst = P_WQT + (size_t)l * 384 * 256; rs = p.q_norm_g + l * 256; }
    else { t = r - 2776; src = p.w_kv_up + (size_t)l * 128 * 512; ld = 512; K = 128; mode = 2; dst = P_WKVT + (size_t)l * 512 * 128; rs = p.kv_norm_g + l * 128; }
    int kt = K / 64;
    conv_tile(src, ld, K, dst, (t / kt) * 64, (t % kt) * 64, mode, rs, tile);
  } else if (item < 5584 + 512) {
    int idx = (item - 5584) * 256 + otid();
    int pos = idx >> 4, i = idx & 15;
    double invd = 1.0;
    for (int k = 0; k < i; ++k) invd *= 0.5623413251903491;
    float inv = (float)invd;
    float ang = (float)pos * inv;
    double a = (double)ang;
    double kq = rint(a * 0.15915494309189535);
    double r = a - kq * 6.283185307179586;
    double r2 = r * r, ts = r, tc = 1.0, sn = r, cs = 1.0;
    for (int k = 1; k <= 14; ++k) {
      tc = -tc * r2 / (double)((2 * k - 1) * (2 * k));
      ts = -ts * r2 / (double)((2 * k) * (2 * k + 1));
      cs += tc; sn += ts;
    }
    P_ROPE[pos * 32 + i] = (float)cs;
    P_ROPE[pos * 32 + 16 + i] = (float)sn;
  } else {
    for (int e = otid(); e < 12 * 129; e += 256) {
      int gh = e / 129, off = e % 129 - 64; int g = gh >> 2;
      int r = g == 0 ? 1 : (g == 1 ? 4 : 16);
      P_LUTC[e] = p.t5[t5_bucket(off * r) * 16 + gh] * LOG2E;
    }
    for (int e = otid(); e < 4 * 257; e += 256) {
      int hq = e / 257, off = e % 257 - 128;
      P_LUTD[e] = p.t5[t5_bucket(off) * 16 + 12 + hq] * LOG2E;
    }
  }
}

DI void norm_rows_bf16(const float* __restrict__ src, const float* __restrict__ g, bf16_t* __restrict__ dst, int item) {
  const int lane = otid() & 63, wid = otid() >> 6;
  for (int i = 0; i < 8; ++i) {
    size_t row = (size_t)item * 32 + wid * 8 + i;
    const float4* s = (const float4*)(src + row * 1024);
    float4 v[4]; float ss = 0.f;
#pragma unroll
    for (int j = 0; j < 4; ++j) { v[j] = s[lane + 64 * j]; ss += v[j].x * v[j].x + v[j].y * v[j].y + v[j].z * v[j].z + v[j].w * v[j].w; }
    ss = wave_sum(ss);
    float sc = rsqrtf(ss * (1.0f / 1024.0f) + 1e-6f);
#pragma unroll
    for (int j = 0; j < 4; ++j) {
      float4 gg = ((const float4*)g)[lane + 64 * j];
      uint2 o; o.x = pack2(v[j].x * sc * gg.x, v[j].y * sc * gg.y); o.y = pack2(v[j].z * sc * gg.z, v[j].w * sc * gg.w);
      *(uint2*)(dst + row * 1024 + (lane + 64 * j) * 4) = o;
    }
  }
}
DI void norm_rows_f32(float* io, const float* __restrict__ g, int item) {
  const int lane = otid() & 63, wid = otid() >> 6;
  for (int i = 0; i < 8; ++i) {
    size_t row = (size_t)item * 32 + wid * 8 + i;
    float4* s = (float4*)(io + row * 1024);
    float4 v[4]; float ss = 0.f;
#pragma unroll
    for (int j = 0; j < 4; ++j) { v[j] = s[lane + 64 * j]; ss += v[j].x * v[j].x + v[j].y * v[j].y + v[j].z * v[j].z + v[j].w * v[j].w; }
    ss = wave_sum(ss);
    float sc = rsqrtf(ss * (1.0f / 1024.0f) + 1e-6f);
#pragma unroll
    for (int j = 0; j < 4; ++j) {
      float4 gg = ((const float4*)g)[lane + 64 * j];
      float4 o; o.x = v[j].x * sc * gg.x; o.y = v[j].y * sc * gg.y; o.z = v[j].z * sc * gg.z; o.w = v[j].w * sc * gg.w;
      s[lane + 64 * j] = o;
    }
  }
}

constexpr int LLD = 72;
constexpr int GST = 128 * 64;
template <int NT, bool LOWREG = false>
DI void gemm_mainloop(f32x4 (&acc)[4][NT], const bf16_t* A, int lda, const bf16_t* Bt, int ldb, int K, bf16_t* sA, bf16_t* sB, int bstride = 32) {
  constexpr int NB = NT;
  const int tid = otid(), lane = tid & 63, wid = tid >> 6;
  const int wm = wid >> 1, wn = wid & 1, fr = lane & 15, fq = lane >> 4;
  u32x4 ra[4], rb[NB];
  const int nk = K >> 6;
  const bf16_t* ap = A + (size_t)(tid >> 3) * lda + (tid & 7) * 8;
  const bf16_t* bp = Bt + (size_t)(tid >> 3) * ldb + (tid & 7) * 8;
  const int so = (tid >> 3) * 64 + (((tid & 7) ^ ((tid >> 4) & 7)) * 8);
  const int fsw = fr >> 1;
#define GLOAD(ko) do { \
    _Pragma("unroll") for (int i = 0; i < 4; ++i) ra[i] = *(const u32x4*)(ap + (size_t)(32 * i) * lda + (ko)); \
    _Pragma("unroll") for (int i = 0; i < NB; ++i) rb[i] = *(const u32x4*)(bp + (size_t)(bstride * i) * ldb + (ko)); } while (0)
#define GSTORE(st) do { \
    _Pragma("unroll") for (int i = 0; i < 4; ++i) *(u32x4*)(sA + (st) * GST + so + 32 * i * 64) = ra[i]; \
    _Pragma("unroll") for (int i = 0; i < NB; ++i) *(u32x4*)(sB + (st) * GST + so + 32 * i * 64) = rb[i]; } while (0)
#define GCOMPUTE(st) do { \
    const bf16_t* cA = sA + (st) * GST; const bf16_t* cB = sB + (st) * GST; \
    _Pragma("unroll") for (int ks = 0; ks < 2; ++ks) { \
      bf16x8 af[4], bfr[NT]; \
      _Pragma("unroll") for (int mi = 0; mi < 4; ++mi) af[mi] = *(const bf16x8*)(cA + (wm * 64 + mi * 16 + fr) * 64 + (((ks * 4 + fq) ^ fsw) * 8)); \
      _Pragma("unroll") for (int ni = 0; ni < NT; ++ni) bfr[ni] = *(const bf16x8*)(cB + (wn * NT * 16 + ni * 16 + fr) * 64 + (((ks * 4 + fq) ^ fsw) * 8)); \
      _Pragma("unroll") for (int mi = 0; mi < 4; ++mi) \
        _Pragma("unroll") for (int ni = 0; ni < NT; ++ni) acc[mi][ni] = __builtin_amdgcn_mfma_f32_16x16x32_bf16(bfr[ni], af[mi], acc[mi][ni], 0, 0, 0); \
    } } while (0)
  __syncthreads();
  GLOAD(0); GSTORE(0);
  if (nk > 1) GLOAD(64);
  __syncthreads();
  for (int kt = 0; kt < nk; ++kt) {
    const int cur = kt & 1;
    if (kt + 1 < nk) { GSTORE(cur ^ 1); if (kt + 2 < nk) GLOAD((kt + 2) * 64); }
    if (LOWREG) {
      const bf16_t* cA = sA + cur * GST; const bf16_t* cB = sB + cur * GST;
#pragma nounroll
      for (int ks = 0; ks < 2; ++ks) {
        bf16x8 af[4], bfr[NT];
#pragma unroll
        for (int mi = 0; mi < 4; ++mi) af[mi] = *(const bf16x8*)(cA + (wm * 64 + mi * 16 + fr) * 64 + (((ks * 4 + fq) ^ fsw) * 8));
#pragma unroll
        for (int ni = 0; ni < NT; ++ni) bfr[ni] = *(const bf16x8*)(cB + (wn * NT * 16 + ni * 16 + fr) * 64 + (((ks * 4 + fq) ^ fsw) * 8));
#pragma unroll
        for (int mi = 0; mi < 4; ++mi)
#pragma unroll
          for (int ni = 0; ni < NT; ++ni) acc[mi][ni] = __builtin_amdgcn_mfma_f32_16x16x32_bf16(bfr[ni], af[mi], acc[mi][ni], 0, 0, 0);
      }
    } else GCOMPUTE(cur);
    __syncthreads();
  }
#undef GLOAD
#undef GSTORE
#undef GCOMPUTE
}
template <int NT>
DI void zero_acc(f32x4 (&acc)[4][NT]) {
#pragma unroll
  for (int mi = 0; mi < 4; ++mi)
#pragma unroll
    for (int ni = 0; ni < NT; ++ni) acc[mi][ni] = f32x4{0.f, 0.f, 0.f, 0.f};
}

DI void inproj_tile(const Params& p, int l, int tile, char* smem) {
  bf16_t* sA = (bf16_t*)smem; bf16_t* sB = sA + 2 * GST;
  const int mt = tile & 255, nt = tile >> 8;
  f32x4 acc[4][4]; zero_acc<4>(acc);
  gemm_mainloop<4>(acc, P_XN + (size_t)mt * 128 * 1024, 1024, P_W1T + ((size_t)l * 4864 + nt * 128) * 1024, 1024, 1024, sA, sB);
  const int lane = otid() & 63, wid = otid() >> 6, wm = wid >> 1, wn = wid & 1, fr = lane & 15, fq = lane >> 4;
#pragma unroll
  for (int mi = 0; mi < 4; ++mi)
#pragma unroll
    for (int ni = 0; ni < 4; ++ni) {
      size_t row = (size_t)mt * 128 + wm * 64 + mi * 16 + fr; int col = nt * 128 + wn * 64 + ni * 16 + fq * 4;
      uint2 o; o.x = pack2(acc[mi][ni][0], acc[mi][ni][1]); o.y = pack2(acc[mi][ni][2], acc[mi][ni][3]);
      *(uint2*)(P_PROJ + row * PW + col) = o;
    }
}

DI void row_scales(const bf16_t* A, int lda, int K, float* sRow) {
  const int row = otid() >> 1, half = otid() & 1;
  const int per = K >> 1;
  const bf16_t* a = A + (size_t)row * lda + half * per;
  float ss = 0.f;
  for (int c = 0; c < per; c += 8) {
    uint4 u = *(const uint4*)(a + c);
    float f;
    f = BLO(u.x); ss += f * f; f = BHI(u.x); ss += f * f; f = BLO(u.y); ss += f * f; f = BHI(u.y); ss += f * f;
    f = BLO(u.z); ss += f * f; f = BHI(u.z); ss += f * f; f = BLO(u.w); ss += f * f; f = BHI(u.w); ss += f * f;
  }
  ss += __shfl_xor(ss, 1);
  if (half == 0) sRow[row] = rsqrtf(ss / (float)K + 1e-6f);
}
DI void mla_item(const Params& p, int l, int item, char* smem) {
  bf16_t* sA = (bf16_t*)smem; bf16_t* sB = sA + 2 * GST; float* sRow = (float*)(sB + 2 * GST);
  const int lane = otid() & 63, wid = otid() >> 6, wm = wid >> 1, wn = wid & 1, fr = lane & 15, fq = lane >> 4;
  if (item < 768) {
    const int mt = item & 255, nt = item >> 8;
    const bf16_t* A = P_PROJ + (size_t)mt * 128 * PW + C_AQ;
    __syncthreads();
    row_scales(A, PW, 256, sRow);
    f32x4 acc[4][4]; zero_acc<4>(acc);
    gemm_mainloop<4>(acc, A, PW, P_WQT + ((size_t)l * 384 + nt * 128) * 256, 256, 256, sA, sB);
    if (nt < 2) {
#pragma unroll
      for (int mi = 0; mi < 4; ++mi)
#pragma unroll
        for (int ni = 0; ni < 4; ++ni) {
          int rl = wm * 64 + mi * 16 + fr; size_t t = (size_t)mt * 128 + rl; float s = sRow[rl] * QS96;
          int c = nt * 128 + wn * 64 + ni * 16 + fq * 4; int h = c >> 6, d = c & 63;
          uint2 o; o.x = pack2(acc[mi][ni][0] * s, acc[mi][ni][1] * s); o.y = pack2(acc[mi][ni][2] * s, acc[mi][ni][3] * s);
          *(uint2*)(P_QA + t * 384 + h * 96 + d) = o;
        }
    } else {
#pragma unroll
      for (int mi = 0; mi < 4; ++mi)
#pragma unroll
        for (int np = 0; np < 2; ++np) {
          int rl = wm * 64 + mi * 16 + fr; size_t t = (size_t)mt * 128 + rl; float s = sRow[rl] * QS96;
          int pos = (int)(t & (SEQ - 1)); int h = wn * 2 + np;
          const float* cs = P_ROPE + pos * 32 + fq * 4;
          float o1[4], o2[4];
#pragma unroll
          for (int j = 0; j < 4; ++j) {
            float x1 = acc[mi][np * 2][j] * s, x2 = acc[mi][np * 2 + 1][j] * s; float c = cs[j], sn = cs[16 + j];
            o1[j] = x1 * c - x2 * sn; o2[j] = x1 * sn + x2 * c;
          }
          uint2 a; a.x = pack2(o1[0], o1[1]); a.y = pack2(o1[2], o1[3]);
          uint2 b; b.x = pack2(o2[0], o2[1]); b.y = pack2(o2[2], o2[3]);
          *(uint2*)(P_QA + t * 384 + h * 96 + 64 + fq * 4) = a;
          *(uint2*)(P_QA + t * 384 + h * 96 + 80 + fq * 4) = b;
        }
    }
  } else if (item < 768 + 1024) {
    const int it = item - 768; const int mt = it & 255, h = it >> 8;
    const bf16_t* A = P_PROJ + (size_t)mt * 128 * PW + C_AKV;
    __syncthreads();
    row_scales(A, PW, 128, sRow);
    f32x4 acc[4][4]; zero_acc<4>(acc);
    gemm_mainloop<4>(acc, A, PW, P_WKVT + ((size_t)l * 512 + h * 128) * 128, 128, 128, sA, sB);
#pragma unroll
    for (int mi = 0; mi < 4; ++mi)
#pragma unroll
      for (int ni = 0; ni < 4; ++ni) {
        int rl = wm * 64 + mi * 16 + fr; size_t t = (size_t)mt * 128 + rl; float s = sRow[rl];
        int d = ni * 16 + fq * 4;
        uint2 o; o.x = pack2(acc[mi][ni][0] * s, acc[mi][ni][1] * s); o.y = pack2(acc[mi][ni][2] * s, acc[mi][ni][3] * s);
        if (wn == 0) *(uint2*)(P_KA + t * 384 + h * 96 + d) = o;
        else *(uint2*)(P_VA + t * 256 + h * 64 + d) = o;
      }
  } else {
    const int it = item - 1792;
    const int half = lane >> 5, pl = lane & 31;
    for (int i = 0; i < 32; ++i) {
      size_t t = (size_t)it * 128 + wid * 32 + i; int pos = (int)(t & (SEQ - 1));
      bf16_t* row = P_PROJ + t * PW;
#pragma unroll
      for (int s3 = 0; s3 < 3; ++s3) {
        int slot = s3 * 2 + half;
        bf16_t* hp = row + (slot < 4 ? C_BQ + slot * 64 : C_BK + (slot - 4) * 64);
        const float* g = (slot < 4 ? p.gq_g : p.gk_g) + l * 64;
        int d1, fi, ap;
        if (pl < 16) { d1 = pl; fi = pl; ap = pos >> 6; } else { d1 = 32 + (pl - 16); fi = pl - 16; ap = pos & 63; }
        float x1 = bf2f(hp[d1]), x2 = bf2f(hp[d1 + 16]);
        float ss = x1 * x1 + x2 * x2;
#pragma unroll
        for (int o = 16; o; o >>= 1) ss += __shfl_xor(ss, o);
        float sc = rsqrtf(ss * (1.0f / 64.0f) + 1e-6f);
        if (slot < 4) sc *= QS64;
        x1 = x1 * sc * g[d1]; x2 = x2 * sc * g[d1 + 16];
        float c = P_ROPE[ap * 32 + fi], sn = P_ROPE[ap * 32 + 16 + fi];
        hp[d1] = f2bf(x1 * c - x2 * sn); hp[d1 + 16] = f2bf(x1 * sn + x2 * c);
      }
      if (lane < 16) {
        float x1 = bf2f(row[C_AKR + lane]), x2 = bf2f(row[C_AKR + 16 + lane]);
        float c = P_ROPE[pos * 32 + lane], sn = P_ROPE[pos * 32 + 16 + lane];
        bf16_t o1 = f2bf(x1 * c - x2 * sn), o2 = f2bf(x1 * sn + x2 * c);
#pragma unroll
        for (int h = 0; h < 4; ++h) { P_KA[t * 384 + h * 96 + 64 + lane] = o1; P_KA[t * 384 + h * 96 + 80 + lane] = o2; }
      }
    }
  }
}

#define MFMA32(a, b, c) __builtin_amdgcn_mfma_f32_32x32x16_bf16((a), (b), (c), 0, 0, 0)
template <int OFF> DI bf16x4 tr_read(unsigned addr) {
  bf16x4 r; asm volatile("ds_read_b64_tr_b16 %0, %1 offset:%2" : "=&v"(r) : "v"(addr), "i"(OFF) : "memory"); return r;
}
DI float half_swap_max(float v) {
  auto rr = __builtin_amdgcn_permlane32_swap(__float_as_uint(v), __float_as_uint(v), false, false);
  return fmaxf(__uint_as_float(rr[0]), __uint_as_float(rr[1]));
}
DI float half_swap_sum(float v) {
  auto rr = __builtin_amdgcn_permlane32_swap(__float_as_uint(v), __float_as_uint(v), false, false);
  return __uint_as_float(rr[0]) + __uint_as_float(rr[1]);
}
DI bf16x8 pack8(const f32x16& p, int base) {
  u32x4 w = {pack2(p[base + 0], p[base + 1]), pack2(p[base + 2], p[base + 3]), pack2(p[base + 4], p[base + 5]), pack2(p[base + 6], p[base + 7])};
  return __builtin_bit_cast(bf16x8, w);
}
template <int DB, int VLD> DI void pv_block(f32x16& o, unsigned vb, bf16x8 pb0, bf16x8 pb1, bf16x8 pb2, bf16x8 pb3) {
  constexpr int RB = VLD * 2;
  bf16x4 l0 = tr_read<0 * RB + 64 * DB>(vb), h0 = tr_read<8 * RB + 64 * DB>(vb);
  bf16x4 l1 = tr_read<16 * RB + 64 * DB>(vb), h1 = tr_read<24 * RB + 64 * DB>(vb);
  bf16x4 l2 = tr_read<32 * RB + 64 * DB>(vb), h2 = tr_read<40 * RB + 64 * DB>(vb);
  bf16x4 l3 = tr_read<48 * RB + 64 * DB>(vb), h3 = tr_read<56 * RB + 64 * DB>(vb);
  asm volatile("s_waitcnt lgkmcnt(0)" ::: "memory"); __builtin_amdgcn_sched_barrier(0);
  o = MFMA32(__builtin_shufflevector(l0, h0, 0, 1, 2, 3, 4, 5, 6, 7), pb0, o);
  o = MFMA32(__builtin_shufflevector(l1, h1, 0, 1, 2, 3, 4, 5, 6, 7), pb1, o);
  o = MFMA32(__builtin_shufflevector(l2, h2, 0, 1, 2, 3, 4, 5, 6, 7), pb2, o);
  o = MFMA32(__builtin_shufflevector(l3, h3, 0, 1, 2, 3, 4, 5, 6, 7), pb3, o);
}
DI f32x16 splat16(float v) { f32x16 r;
#pragma unroll
  for (int i = 0; i < 16; ++i) r[i] = v;
  return r; }

template <int DQK, bool FIXEDM>
DI void attn_dense_mfma(const bf16_t* Qb, int ldq, const bf16_t* Kb, int ldk, const bf16_t* Vb, int ldv, bf16_t* gate_io, char* smem, bool store, float mbound) {
  constexpr int NS = DQK / 16, KLD = DQK + 8, VLD = 96, CPR = DQK / 8, NKC = (64 * CPR) / 256;
  constexpr int KBYTES = 64 * KLD * 2, VBYTES = 64 * VLD * 2;
  char* sKc = smem; char* sVc = smem + 2 * KBYTES;
  const int tid = otid(), lane = tid & 63, wid = tid >> 6, r = lane & 31, h = lane >> 5;
  bf16x8 qf[NS];
#pragma unroll
  for (int s = 0; s < NS; ++s) qf[s] = *(const bf16x8*)(Qb + (size_t)(wid * 32 + r) * ldq + 16 * s + 8 * h);
  const bf16_t* kp = Kb + (size_t)(tid >> 2) * ldk + (tid & 3) * (NKC * 8);
  const int kso = ((tid >> 2) * KLD + (tid & 3) * (NKC * 8)) * 2;
  const bf16_t* vp0 = Vb + (size_t)(tid >> 3) * ldv + (tid & 7) * 8;
  const bf16_t* vp1 = vp0 + (size_t)32 * ldv;
  const int vso = ((tid >> 3) * VLD + (tid & 7) * 8) * 2;
  const size_t kstep = (size_t)64 * ldk, vstep = (size_t)64 * ldv;
  u32x4 rk[NKC], rv[2];
#define KLOAD() do { _Pragma("unroll") for (int i = 0; i < NKC; ++i) rk[i] = *(const u32x4*)(kp + i * 8); kp += kstep; } while (0)
#define VLOAD() do { rv[0] = *(const u32x4*)vp0; rv[1] = *(const u32x4*)vp1; vp0 += vstep; vp1 += vstep; } while (0)
#define KSTORE(st) do { _Pragma("unroll") for (int i = 0; i < NKC; ++i) *(u32x4*)(sKc + (st) * KBYTES + kso + i * 16) = rk[i]; } while (0)
#define VSTORE(st) do { *(u32x4*)(sVc + (st) * VBYTES + vso) = rv[0]; *(u32x4*)(sVc + (st) * VBYTES + vso + 32 * VLD * 2) = rv[1]; } while (0)
#define QKT(P0, P1, st) do { \
    const bf16_t* sK = (const bf16_t*)(sKc + (st) * KBYTES) + r * KLD + 8 * h; \
    P0 = negm; P1 = negm; \
    _Pragma("unroll") for (int s = 0; s < NS; ++s) { \
      bf16x8 k0 = *(const bf16x8*)(sK + 16 * s); bf16x8 k1 = *(const bf16x8*)(sK + 32 * KLD + 16 * s); \
      P0 = MFMA32(k0, qf[s], P0); P1 = MFMA32(k1, qf[s], P1); } } while (0)
  const unsigned vb0 = (unsigned)(size_t)sVc + (unsigned)(((4 * h + ((lane & 15) >> 2)) * VLD + 16 * ((lane >> 4) & 1) + 4 * (lane & 3)) * 2);
  f32x16 o0 = splat16(0.f), o1 = splat16(0.f), negm = splat16(FIXEDM ? -mbound : 0.f);
  f32x16 pa0, pa1, pc0, pc1;
  float m_run = 0.f, l_run = 0.f;
  constexpr int NT = SEQ / 64;
  __syncthreads();
  KLOAD(); VLOAD(); KSTORE(0); VSTORE(0);
  KLOAD(); KSTORE(1);
  __syncthreads();
  QKT(pa0, pa1, 0);
  __syncthreads();
#define STEP(SC0, SC1, SN0, SN1, PAR, FIRST, LK, LV) do { \
    if (LK) KLOAD(); \
    if (LV) VLOAD(); \
    float pm = 0.f; \
    if (!FIXEDM) { pm = fmaxf(SC0[0], SC1[0]); \
    _Pragma("unroll") for (int i = 1; i < 16; i += 1) pm = fmaxf(fmaxf(pm, SC0[i]), SC1[i]); \
    pm = half_swap_max(pm); } \
    if (!FIXEDM && ((FIRST) || __any(pm > 8.0f))) { \
      float delta; \
      if (FIRST) delta = pm; \
      else { delta = fmaxf(pm, 0.f); float alpha = __builtin_amdgcn_exp2f(-delta); l_run *= alpha; \
        _Pragma("unroll") for (int i = 0; i < 16; ++i) { o0[i] *= alpha; o1[i] *= alpha; } } \
      m_run += delta; \
      _Pragma("unroll") for (int i = 0; i < 16; ++i) { SC0[i] -= delta; SC1[i] -= delta; } \
      negm = splat16(-m_run); \
    } \
    if (LV) QKT(SN0, SN1, (PAR) ^ 1); \
    float ls = 0.f; \
    _Pragma("unroll") for (int i = 0; i < 16; ++i) { SC0[i] = __builtin_amdgcn_exp2f(SC0[i]); SC1[i] = __builtin_amdgcn_exp2f(SC1[i]); ls += SC0[i] + SC1[i]; } \
    l_run += ls; \
    bf16x8 pb0 = pack8(SC0, 0), pb1 = pack8(SC0, 8), pb2 = pack8(SC1, 0), pb3 = pack8(SC1, 8); \
    const unsigned vb = vb0 + (PAR) * VBYTES; \
    pv_block<0, VLD>(o0, vb, pb0, pb1, pb2, pb3); \
    pv_block<1, VLD>(o1, vb, pb0, pb1, pb2, pb3); \
    if (LK) KSTORE(PAR); \
    if (LV) VSTORE((PAR) ^ 1); \
    __syncthreads(); } while (0)
  pc0 = negm; pc1 = negm;
  STEP(pa0, pa1, pc0, pc1, 0, true, 1, 1);
  STEP(pc0, pc1, pa0, pa1, 1, false, 1, 1);
  for (int j = 2; j < NT - 2; j += 2) {
    STEP(pa0, pa1, pc0, pc1, 0, false, 1, 1);
    STEP(pc0, pc1, pa0, pa1, 1, false, 1, 1);
  }
  STEP(pa0, pa1, pc0, pc1, 0, false, 0, 1);
  STEP(pc0, pc1, pa0, pa1, 1, false, 0, 0);
#undef STEP
#undef QKT
#undef KLOAD
#undef VLOAD
#undef KSTORE
#undef VSTORE
  if (!store) return;
  const float inv = 1.0f / half_swap_sum(l_run);
  bf16_t* grow = gate_io + (size_t)(wid * 32 + r) * PW;
#pragma unroll
  for (int db = 0; db < 2; ++db)
#pragma unroll
    for (int g4 = 0; g4 < 4; ++g4) {
      bf16_t* gp = grow + 32 * db + 8 * g4 + 4 * h;
      uint2 u = *(const uint2*)gp;
      float g[4] = {BLO(u.x), BHI(u.x), BLO(u.y), BHI(u.y)};
      float y[4];
#pragma unroll
      for (int e = 0; e < 4; ++e) { float ov = db == 0 ? o0[4 * g4 + e] : o1[4 * g4 + e]; y[e] = ov * inv * g[e] / (1.0f + __expf(-g[e])); }
      uint2 w; w.x = pack2(y[0], y[1]); w.y = pack2(y[2], y[3]);
      *(uint2*)gp = w;
    }
}
DI void dense_item(const Params& p, int l, int combo, int qblk, char* smem, bool store) {
  const int br = combo >> 4, bh = combo & 15, b = bh >> 2, h = bh & 3;
  const size_t t0 = (size_t)b * SEQ + qblk * 128;
  bf16_t* gate_io = P_PROJ + t0 * PW + C_GATE + br * 256 + h * 64;
  float bbound = 0.f;
  if (br != 0) {
    const int ln = otid() & 63;
    float gq = fabsf(p.gq_g[l * 64 + ln]), gk = fabsf(p.gk_g[l * 64 + ln]);
#pragma unroll
    for (int o = 32; o; o >>= 1) { gq = fmaxf(gq, __shfl_xor(gq, o)); gk = fmaxf(gk, __shfl_xor(gk, o)); }
    bbound = 64.0f * QS64 * 1.02f * gq * gk + 0.05f;
  }
  if (br == 0)
    attn_dense_mfma<96, false>(P_QA + t0 * 384 + h * 96, 384, P_KA + (size_t)b * SEQ * 384 + h * 96, 384, P_VA + (size_t)b * SEQ * 256 + h * 64, 256, gate_io, smem, store, 0.f);
  else {
    if (bbound <= 60.0f) attn_dense_mfma<64, true>(P_PROJ + t0 * PW + C_BQ + h * 64, PW, P_PROJ + (size_t)b * SEQ * PW + C_BK + (h >> 1) * 64, PW,
                        P_PROJ + (size_t)b * SEQ * PW + C_BV + (h >> 1) * 64, PW, gate_io, smem, store, bbound);
    else attn_dense_mfma<64, false>(P_PROJ + t0 * PW + C_BQ + h * 64, PW, P_PROJ + (size_t)b * SEQ * PW + C_BK + (h >> 1) * 64, PW,
                        P_PROJ + (size_t)b * SEQ * PW + C_BV + (h >> 1) * 64, PW, gate_io, smem, store, bbound);
  }
}

template <int W, bool SINK>
DI void attn_band_mfma(const bf16_t* Qb, size_t ldq, const bf16_t* Kb, const bf16_t* Vb, size_t ldk, int L, int i0,
                       const float* lut_g, float sink2, bf16_t* outp, size_t ldo, float* lse_out, size_t ldl, char* smem) {
  constexpr int NS = 4, KLD = 72, VLD = 96, NTW = (128 + 2 * W) / 64, LUTN = 2 * W + 1;
  constexpr int KBYTES = 64 * KLD * 2, VBYTES = 64 * VLD * 2;
  char* sKc = smem; char* sVc = smem + 2 * KBYTES; float* sLut = (float*)(smem + 2 * KBYTES + 2 * VBYTES);
  const int tid = otid(), lane = tid & 63, wid = tid >> 6, r = lane & 31, h = lane >> 5;
  __syncthreads();
  for (int e = tid; e < LUTN; e += 256) sLut[e] = lut_g[e];
  const int qi = i0 + wid * 32 + r;
  bf16x8 qf[NS];
#pragma unroll
  for (int s = 0; s < NS; ++s) qf[s] = *(const bf16x8*)(Qb + (size_t)qi * ldq + 16 * s + 8 * h);
  const int srow = tid >> 3, scc = tid & 7;
  u32x4 rk[2], rv[2];
#define BLOAD(k0) do { \
    rk[0] = *(const u32x4*)(Kb + (size_t)((k0) + srow) * ldk + scc * 8); rk[1] = *(const u32x4*)(Kb + (size_t)((k0) + srow + 32) * ldk + scc * 8); \
    rv[0] = *(const u32x4*)(Vb + (size_t)((k0) + srow) * ldk + scc * 8); rv[1] = *(const u32x4*)(Vb + (size_t)((k0) + srow + 32) * ldk + scc * 8); } while (0)
#define BSTORE(st) do { \
    *(u32x4*)(sKc + (st) * KBYTES + (srow * KLD + scc * 8) * 2) = rk[0]; *(u32x4*)(sKc + (st) * KBYTES + ((srow + 32) * KLD + scc * 8) * 2) = rk[1]; \
    *(u32x4*)(sVc + (st) * VBYTES + (srow * VLD + scc * 8) * 2) = rv[0]; *(u32x4*)(sVc + (st) * VBYTES + ((srow + 32) * VLD + scc * 8) * 2) = rv[1]; } while (0)
  const unsigned vb0 = (unsigned)(size_t)sVc + (unsigned)(((4 * h + ((lane & 15) >> 2)) * VLD + 16 * ((lane >> 4) & 1) + 4 * (lane & 3)) * 2);
  f32x16 o0 = splat16(0.f), o1 = splat16(0.f);
  float m_run = SINK ? sink2 : 0.f, l_run = (SINK && h == 0) ? 1.f : 0.f;
  bool seen = SINK;
  f32x16 negm = splat16(-m_run);
  const int lo = (i0 == 0) ? W / 64 : 0, hi = (i0 + 128 >= L) ? NTW - W / 64 : NTW;
  BLOAD(i0 - W + 64 * lo); BSTORE(0);
  __syncthreads();
  for (int j = lo; j < hi; ++j) {
    const int cur = (j - lo) & 1, k0 = i0 - W + 64 * j;
    if (j + 1 < hi) BLOAD(k0 + 64);
    const bf16_t* sK = (const bf16_t*)(sKc + cur * KBYTES);
    f32x16 p0 = negm, p1 = negm;
#pragma unroll
    for (int s = 0; s < NS; ++s) {
      bf16x8 k0f = *(const bf16x8*)(sK + r * KLD + 16 * s + 8 * h);
      bf16x8 k1f = *(const bf16x8*)(sK + (32 + r) * KLD + 16 * s + 8 * h);
      p0 = MFMA32(k0f, qf[s], p0);
      p1 = MFMA32(k1f, qf[s], p1);
    }
    const int offb = k0 + 4 * h - qi + W;
    float pm = -1e30f;
#pragma unroll
    for (int i = 0; i < 16; ++i) {
      int idx0 = offb + (i & 3) + 8 * (i >> 2), idx1 = idx0 + 32;
      int c0 = min(max(idx0, 0), 2 * W), c1 = min(max(idx1, 0), 2 * W);
      float b0 = sLut[c0], b1 = sLut[c1];
      p0[i] = ((unsigned)idx0 <= (unsigned)(2 * W)) ? p0[i] + b0 : -1e30f;
      p1[i] = ((unsigned)idx1 <= (unsigned)(2 * W)) ? p1[i] + b1 : -1e30f;
      pm = fmaxf(pm, fmaxf(p0[i], p1[i]));
    }
    pm = half_swap_max(pm);
    const bool has = pm > -1e29f;
    float delta = 0.f;
    if (has) { if (!seen) delta = pm; else if (pm > 8.0f) delta = pm; }
    if (__any(delta != 0.f)) {
      float alpha = seen ? __builtin_amdgcn_exp2f(-delta) : 1.0f;
      l_run *= alpha; m_run += delta;
#pragma unroll
      for (int i = 0; i < 16; ++i) { o0[i] *= alpha; o1[i] *= alpha; p0[i] -= delta; p1[i] -= delta; }
      negm = splat16(-m_run);
    }
    seen = seen || has;
    float ls = 0.f;
#pragma unroll
    for (int i = 0; i < 16; ++i) { p0[i] = __builtin_amdgcn_exp2f(p0[i]); p1[i] = __builtin_amdgcn_exp2f(p1[i]); ls += p0[i] + p1[i]; }
    l_run += ls;
    bf16x8 pb0 = pack8(p0, 0), pb1 = pack8(p0, 8), pb2 = pack8(p1, 0), pb3 = pack8(p1, 8);
    const unsigned vb = vb0 + cur * VBYTES;
    pv_block<0, VLD>(o0, vb, pb0, pb1, pb2, pb3);
    pv_block<1, VLD>(o1, vb, pb0, pb1, pb2, pb3);
    if (j + 1 < hi) BSTORE(cur ^ 1);
    __syncthreads();
  }
#undef BLOAD
#undef BSTORE
  const float ltot = half_swap_sum(l_run);
  const float inv = 1.0f / ltot;
  bf16_t* orow = outp + (size_t)qi * ldo;
  if (!SINK && h == 0) lse_out[(size_t)qi * ldl] = m_run + __log2f(ltot);
#pragma unroll
  for (int db = 0; db < 2; ++db)
#pragma unroll
    for (int g4 = 0; g4 < 4; ++g4) {
      bf16_t* gp = orow + 32 * db + 8 * g4 + 4 * h;
      float y[4];
      if (SINK) {
        uint2 u = *(const uint2*)gp;
        float g[4] = {BLO(u.x), BHI(u.x), BLO(u.y), BHI(u.y)};
#pragma unroll
        for (int e = 0; e < 4; ++e) { float ov = db == 0 ? o0[4 * g4 + e] : o1[4 * g4 + e]; y[e] = ov * inv * g[e] / (1.0f + __expf(-g[e])); }
      } else {
#pragma unroll
        for (int e = 0; e < 4; ++e) { float ov = db == 0 ? o0[4 * g4 + e] : o1[4 * g4 + e]; y[e] = ov * inv; }
      }
      uint2 w; w.x = pack2(y[0], y[1]); w.y = pack2(y[2], y[3]);
      *(uint2*)gp = w;
    }
}
DI void band_item(const Params& p, int l, int idx, char* smem) {
  if (idx < 3072) {
    const int g = idx >> 10, rem = idx & 1023, h = rem & 3, rem2 = rem >> 2, b = rem2 >> 6, u = rem2 & 63;
    const int sh = 2 * g, rr = 1 << sh;
    const int rho = u & (rr - 1), qblk = u >> sh;
    const size_t tok0 = (size_t)b * SEQ + rho;
    bf16_t* base = P_PROJ + tok0 * PW + g * 256 + h * 64;
    attn_band_mfma<64, false>(base + C_CQ, (size_t)rr * PW, base + C_CK, base + C_CV, (size_t)rr * PW, SEQ >> sh, qblk * 128,
                              P_LUTC + (g * 4 + h) * 129, 0.f, base + C_CQ, (size_t)rr * PW, P_LSE + tok0 * 12 + g * 4 + h, (size_t)rr * 12, smem);
  } else {
    const int it = idx - 3072, hq = it & 3, rem = it >> 2, b = rem >> 6, qblk = rem & 63;
    bf16_t* base = P_PROJ + (size_t)b * SEQ * PW;
    attn_band_mfma<128, true>(base + C_DQ + hq * 64, PW, base + C_DK + (hq >> 1) * 64, base + C_DV + (hq >> 1) * 64, PW, SEQ, qblk * 128,
                              P_LUTD + hq * 257, p.sink[l * 4 + hq] * LOG2E, base + C_GATE + 768 + hq * 64, PW, nullptr, 0, smem);
  }
}
DI void combine_c(const Params& p) {
  for (size_t u = (size_t)blockIdx.x * 256 + otid(); u < (size_t)32768 * 32; u += (size_t)gridDim.x * 256) {
    const size_t t = u >> 5; const int h = (int)(u >> 3) & 3, ch = (int)u & 7;
    const float* ls = P_LSE + t * 12 + h;
    float l0 = ls[0], l1 = ls[4], l2 = ls[8];
    float mx = fmaxf(l0, fmaxf(l1, l2));
    float a0 = __builtin_amdgcn_exp2f(l0 - mx), a1 = __builtin_amdgcn_exp2f(l1 - mx), a2 = __builtin_amdgcn_exp2f(l2 - mx);
    float inv = 1.0f / (a0 + a1 + a2); a0 *= inv; a1 *= inv; a2 *= inv;
    const bf16_t* row = P_PROJ + t * PW;
    uint4 x0 = *(const uint4*)(row + C_CQ + h * 64 + ch * 8), x1 = *(const uint4*)(row + C_CQ + 256 + h * 64 + ch * 8),
          x2 = *(const uint4*)(row + C_CQ + 512 + h * 64 + ch * 8);
    bf16_t* gp = P_PROJ + t * PW + C_GATE + 512 + h * 64 + ch * 8;
    uint4 gu = *(const uint4*)gp;
    unsigned xa[4] = {x0.x, x0.y, x0.z, x0.w}, xb[4] = {x1.x, x1.y, x1.z, x1.w}, xc[4] = {x2.x, x2.y, x2.z, x2.w}, gg[4] = {gu.x, gu.y, gu.z, gu.w};
    unsigned ov[4];
#pragma unroll
    for (int e = 0; e < 4; ++e) {
      float ylo = a0 * BLO(xa[e]) + a1 * BLO(xb[e]) + a2 * BLO(xc[e]);
      float yhi = a0 * BHI(xa[e]) + a1 * BHI(xb[e]) + a2 * BHI(xc[e]);
      float glo = BLO(gg[e]), ghi = BHI(gg[e]);
      ov[e] = pack2(ylo * glo / (1.0f + __expf(-glo)), yhi * ghi / (1.0f + __expf(-ghi)));
    }
    uint4 w; w.x = ov[0]; w.y = ov[1]; w.z = ov[2]; w.w = ov[3];
    *(uint4*)gp = w;
  }
}

DI void merge_tile(const Params& p, int l, int tile, char* smem) {
  bf16_t* sA = (bf16_t*)smem; bf16_t* sB = sA + 2 * GST;
  const int mt = tile & 255, nt = tile >> 8;
  f32x4 accM[4][4]; zero_acc<4>(accM);
#pragma unroll 1
  for (int n = 0; n < 4; ++n) {
    unsigned sg[4][4][2];
    {
      f32x4 accG[4][4]; zero_acc<4>(accG);
      gemm_mainloop<4>(accG, P_XN + (size_t)mt * 128 * 1024, 1024, P_WMT + ((size_t)l * 4096 + n * 1024 + nt * 128) * 1024, 1024, 1024, sA, sB);
#pragma unroll
      for (int mi = 0; mi < 4; ++mi)
#pragma unroll
        for (int ni = 0; ni < 4; ++ni) {
          float s0 = 1.0f / (1.0f + __expf(-accG[mi][ni][0])), s1 = 1.0f / (1.0f + __expf(-accG[mi][ni][1]));
          float s2 = 1.0f / (1.0f + __expf(-accG[mi][ni][2])), s3 = 1.0f / (1.0f + __expf(-accG[mi][ni][3]));
          sg[mi][ni][0] = pack2(s0, s1); sg[mi][ni][1] = pack2(s2, s3);
        }
    }
#pragma unroll
    for (int half = 0; half < 2; ++half) {
      f32x4 accB[4][2]; zero_acc<2>(accB);
      gemm_mainloop<2>(accB, P_PROJ + (size_t)mt * 128 * PW + C_GATE + n * 256, PW,
                       P_WBT + ((size_t)(l * 4 + n) * 1024 + nt * 128 + half * 32) * 256, 256, 256, sA, sB, 64);
#pragma unroll
      for (int mi = 0; mi < 4; ++mi)
#pragma unroll
        for (int ni = 0; ni < 2; ++ni) {
          const int nn = half * 2 + ni;
          accM[mi][nn][0] += accB[mi][ni][0] * BLO(sg[mi][nn][0]); accM[mi][nn][1] += accB[mi][ni][1] * BHI(sg[mi][nn][0]);
          accM[mi][nn][2] += accB[mi][ni][2] * BLO(sg[mi][nn][1]); accM[mi][nn][3] += accB[mi][ni][3] * BHI(sg[mi][nn][1]);
        }
    }
  }
  const int lane = otid() & 63, wid = otid() >> 6, wm = wid >> 1, wn = wid & 1, fr = lane & 15, fq = lane >> 4;
#pragma unroll
  for (int mi = 0; mi < 4; ++mi)
#pragma unroll
    for (int ni = 0; ni < 4; ++ni) {
      size_t row = (size_t)mt * 128 + wm * 64 + mi * 16 + fr; int col = nt * 128 + wn * 64 + ni * 16 + fq * 4;
      uint2 o; o.x = pack2(accM[mi][ni][0], accM[mi][ni][1]); o.y = pack2(accM[mi][ni][2], accM[mi][ni][3]);
      *(uint2*)(P_PROJ + row * PW + C_MERGED + col) = o;
    }
}

DI void outproj_tile(const Params& p, int l, int tile, char* smem) {
  bf16_t* sA = (bf16_t*)smem; bf16_t* sB = sA + 2 * GST;
  const int mt = tile & 255, nt = tile >> 8;
  f32x4 acc[4][4]; zero_acc<4>(acc);
  gemm_mainloop<4>(acc, P_PROJ + (size_t)mt * 128 * PW + C_MERGED, PW, P_WOT + ((size_t)l * 1024 + nt * 128) * 1024, 1024, 1024, sA, sB);
  const float* xin = l == 0 ? p.x : p.out;
  const int lane = otid() & 63, wid = otid() >> 6, wm = wid >> 1, wn = wid & 1, fr = lane & 15, fq = lane >> 4;
#pragma unroll
  for (int mi = 0; mi < 4; ++mi)
#pragma unroll
    for (int ni = 0; ni < 4; ++ni) {
      size_t row = (size_t)mt * 128 + wm * 64 + mi * 16 + fr; int col = nt * 128 + wn * 64 + ni * 16 + fq * 4;
      float4 xi = *(const float4*)(xin + row * 1024 + col);
      float4 o; o.x = xi.x + acc[mi][ni][0]; o.y = xi.y + acc[mi][ni][1]; o.z = xi.z + acc[mi][ni][2]; o.w = xi.w + acc[mi][ni][3];
      *(float4*)(p.out + row * 1024 + col) = o;
    }
}


#define XB_TMO      128
#define XB_XCNT(j)  (256  + 64 * (j))
#define XB_XSUB(j)  (1280 + 64 * (j))
#define XB_XGEN(j)  (2304 + 64 * (j))
#define XB_TOP      3328
#define XB_TOPGEN   3392
#define XCD_BAR_WORDS 3456
#define XB_SPIN_CAP (1u << 18)
#define LAS __attribute__((address_space(3)))
DI unsigned xb_ld(unsigned* p)              { return __hip_atomic_load(p, __ATOMIC_RELAXED, __HIP_MEMORY_SCOPE_AGENT); }
DI unsigned xb_add(unsigned* p, unsigned v) { return __hip_atomic_fetch_add(p, v, __ATOMIC_RELAXED, __HIP_MEMORY_SCOPE_AGENT); }
DI unsigned xb_xcc_id() { return (unsigned)__builtin_amdgcn_s_getreg((3 << 11) | 20) & 0xFu; }
#define XB_SPIN(cond, bar) do { unsigned _sp = 0; while (cond) { __builtin_amdgcn_s_sleep(1); \
    if ((++_sp & 255u) == 0u) { if (xb_ld(&(bar)[XB_TMO])) break; if (_sp > XB_SPIN_CAP) { atomicAdd(&(bar)[XB_TMO], 1u); break; } } } } while (0)
struct XcdBarrier { unsigned* bar; unsigned x; volatile LAS unsigned* st; };
DI XcdBarrier xcd_barrier_post(unsigned* bar, volatile LAS unsigned* st) {
  XcdBarrier b; b.bar = bar; b.x = xb_xcc_id(); b.st = st;
  if (threadIdx.x == 0) (void)xb_add(&bar[XB_XCNT(b.x)], 1u);
  return b;
}
DI void xcd_barrier_complete(unsigned* bar, unsigned x, unsigned& nloc, unsigned& nx) {
  const unsigned G = gridDim.x * gridDim.y * gridDim.z;
  unsigned sum, cnt, mine, sp = 0u;
  for (;;) {
    sum = 0u; cnt = 0u; mine = 0u;
#pragma unroll
    for (unsigned j = 0; j < 16; ++j) { const unsigned c = xb_ld(&bar[XB_XCNT(j)]); sum += c; cnt += (c > 0u) ? 1u : 0u; mine = (j == x) ? c : mine; }
    if (sum == G) break;
    __builtin_amdgcn_s_sleep(1);
    if ((++sp & 255u) == 0u) { if (xb_ld(&bar[XB_TMO])) break; if (sp > XB_SPIN_CAP) { atomicAdd(&bar[XB_TMO], 1u); break; } }
  }
  nloc = mine > 0u ? mine : 1u; nx = cnt > 0u ? cnt : 1u;
}
DI void xcd_barrier(const XcdBarrier& b) {
  asm volatile("s_waitcnt vmcnt(0)" ::: "memory");
  __syncthreads();
  if (threadIdx.x == 0) {
    unsigned* bar = b.bar;
    __builtin_amdgcn_s_waitcnt(0);
    unsigned nloc = b.st[0], nx = b.st[1];
    if (nloc == 0u) { xcd_barrier_complete(bar, b.x, nloc, nx); b.st[0] = nloc; b.st[1] = nx; }
    const unsigned old = xb_add(&bar[XB_XSUB(b.x)], 1u);
    const unsigned gen = old / nloc;
    if (old + 1u == (gen + 1u) * nloc) {
      __builtin_amdgcn_fence(__ATOMIC_RELEASE, "agent");
      asm volatile("s_waitcnt vmcnt(0)" ::: "memory");
      const unsigned og = xb_add(&bar[XB_TOP], 1u);
      const unsigned tg = og / nx;
      if (og + 1u == (tg + 1u) * nx) xb_add(&bar[XB_TOPGEN], 1u);
      else XB_SPIN(xb_ld(&bar[XB_TOPGEN]) == tg, bar);
      __builtin_amdgcn_fence(__ATOMIC_ACQUIRE, "agent");
      xb_add(&bar[XB_XGEN(b.x)], 1u);
      asm volatile("s_waitcnt vmcnt(0)" ::: "memory");
    } else {
      XB_SPIN(xb_ld(&bar[XB_XGEN(b.x)]) == gen, bar);
      __builtin_amdgcn_fence(__ATOMIC_ACQUIRE, "agent");
      asm volatile("s_waitcnt vmcnt(0)" ::: "memory");
    }
  }
  __syncthreads();
}

DI void run_phase(const Params& p, int ph, char* smem, bool never) {
  const int G = gridDim.x, B = blockIdx.x;
  if (ph == 0) {
    for (int i = B; i < 6097; i += G) prep_item(p, i, (float*)smem);
    for (int i = B; i < 1024; i += G) norm_rows_bf16(p.x, p.norm_g, P_XN, i);
  } else if (ph == 14) {
    for (int i = B; i < 1024; i += G) norm_rows_f32(p.out, p.final_g, i);
  } else if (ph == 7) {
    for (int i = B; i < 1024; i += G) norm_rows_bf16(p.out, p.norm_g + 1024, P_XN, i);
  } else {
    const int l = ph > 7 ? 1 : 0; const int s = ph > 7 ? ph - 8 : ph - 1;
    const int xcd = B & 7, lb = B >> 3, nl = G >> 3;
    if (s == 0) {
      for (int w = lb; w < 64 * 19; w += nl) {
        const int it = w >> 6, l64 = w & 63;
        int mt, nt;
        if (it < 16) { const int a = it >> 2, gn = it & 3; mt = 8 * (xcd + 8 * a) + (l64 & 7); nt = 8 * gn + (l64 >> 3); }
        else { const int q = (it - 16) * 64 + l64; const int ml = q / 6; mt = 8 * (xcd + 8 * (ml >> 3)) + (ml & 7); nt = 32 + q % 6; }
        inproj_tile(p, l, nt * 256 + mt, smem);
      }
    }
    else if (s == 1) { for (int i = B; i < 2048; i += G) mla_item(p, l, i, smem); }
    else if (s == 2) {
#ifdef REP_DENSE
      for (int w = lb; w < 256; w += nl) dense_item(p, l, xcd + 8 * (w >> 6), w & 63, smem, never);
#endif
      for (int w = lb; w < 256; w += nl) dense_item(p, l, xcd + 8 * (w >> 6), w & 63, smem, true);
      for (int i = B; i < 4096; i += G) band_item(p, l, i, smem);
    }
    else if (s == 3) { combine_c(p); }
    else if (s == 4) {
      for (int w = lb; w < 64 * 4; w += nl) {
        const int a = w >> 6, l64 = w & 63;
        const int mt = 8 * (xcd + 8 * a) + (l64 & 7), nt = l64 >> 3;
        merge_tile(p, l, nt * 256 + mt, smem);
      }
    }
    else {
      for (int w = lb; w < 64 * 4; w += nl) {
        const int a = w >> 6, l64 = w & 63;
        const int mt = 8 * (xcd + 8 * a) + (l64 & 7), nt = l64 >> 3;
        outproj_tile(p, l, nt * 256 + mt, smem);
      }
    }
  }
}

__global__ void __launch_bounds__(256, 2) mega(Params p, int ph_lo, int ph_hi) {
  __shared__ __attribute__((aligned(16))) char smem[66048];
  __shared__ uint4 xb_words;
  cg::grid_group grid = cg::this_grid();
  if (threadIdx.x == 0) xb_words = make_uint4(0u, 0u, 0u, 0u);
  __syncthreads();
  XcdBarrier xb = xcd_barrier_post((unsigned*)(p.ws + OFF_BAR), (volatile LAS unsigned*)&xb_words);
  if (ph_hi == 12345) grid.sync();
  for (int ph = ph_lo; ph < ph_hi; ++ph) {
    run_phase(p, ph, smem, ph_hi == 12345);
    if (ph + 1 < ph_hi) xcd_barrier(xb);
  }
}

extern "C" void kernel_launch(void* const* d_in, const int* in_sizes, int n_in, void* d_out, int out_size, void* d_ws,
                              size_t ws_size, hipStream_t stream) {
  Params p{};
  p.x = (const float*)d_in[0]; p.norm_g = (const float*)d_in[1]; p.w_in = (const float*)d_in[2];
  p.q_norm_g = (const float*)d_in[3]; p.kv_norm_g = (const float*)d_in[4]; p.w_q_up = (const float*)d_in[5];
  p.w_kv_up = (const float*)d_in[6]; p.gq_g = (const float*)d_in[7]; p.gk_g = (const float*)d_in[8];
  p.sink = (const float*)d_in[9]; p.t5 = (const float*)d_in[10]; p.w_branch = (const float*)d_in[11];
  p.w_out = (const float*)d_in[12]; p.final_g = (const float*)d_in[13];
  p.out = (float*)d_out;
  p.ws = (char*)d_ws;
  if (WS_NEED > ws_size) { fprintf(stderr, "workspace too small: need %zu have %zu\n", (size_t)WS_NEED, ws_size); return; }

  static int grid_blocks = 0;
  if (!grid_blocks) {
    int dev = 0, cus = 0, per_cu = 0;
    hipGetDevice(&dev);
    hipDeviceGetAttribute(&cus, hipDeviceAttributeMultiprocessorCount, dev);
    hipOccupancyMaxActiveBlocksPerMultiprocessor(&per_cu, mega, 256, 0);
    if (per_cu < 1) per_cu = 1;
    if (per_cu > 2) per_cu = 2;
    grid_blocks = cus * per_cu;
  }
  hipMemsetAsync((char*)d_ws + OFF_BAR, 0, 16384, stream);
  int lo = 0, hi = 15;
  void* args[] = {&p, &lo, &hi};
  hipError_t e = hipLaunchCooperativeKernel((void*)mega, dim3(grid_blocks), dim3(256), args, 0, stream);
  if (e != hipSuccess) fprintf(stderr, "cooperative launch failed: %s (grid %d)\n", hipGetErrorString(e), grid_blocks);
}
```

```cpp
#include <hip/hip_runtime.h>
#include <hip/hip_cooperative_groups.h>
#include <cstdio>
namespace cg = cooperative_groups;

typedef unsigned short bf16_t;
using bf16x8 = __attribute__((ext_vector_type(8))) short;
using f32x4 = __attribute__((ext_vector_type(4))) float;
using u32x4 = __attribute__((ext_vector_type(4))) unsigned;
using f32x16 = __attribute__((ext_vector_type(16))) float;
using bf16x4 = __attribute__((ext_vector_type(4))) short;
#define DI __device__ __forceinline__

constexpr int SEQ = 8192;
constexpr int PW = 4864;
constexpr int C_BQ = 0, C_BK = 256, C_BV = 384, C_CQ = 512, C_CK = 1280, C_CV = 2048, C_DQ = 2816, C_DK = 3072,
              C_DV = 3200, C_GATE = 3328, C_AQ = 4352, C_AKV = 4608, C_AKR = 4736;
constexpr int C_MERGED = 512;

struct Params {
  const float* x; const float* norm_g; const float* w_in; const float* q_norm_g; const float* kv_norm_g;
  const float* w_q_up; const float* w_kv_up; const float* gq_g; const float* gk_g; const float* sink;
  const float* t5; const float* w_branch; const float* w_out; const float* final_g;
  float* out; char* ws;
};
constexpr size_t al256(size_t x) { return (x + 255) & ~(size_t)255; }
constexpr size_t OFF_W1T = 0;
constexpr size_t OFF_WMT = OFF_W1T + al256((size_t)2 * 4864 * 1024 * 2);
constexpr size_t OFF_WOT = OFF_WMT + al256((size_t)2 * 4096 * 1024 * 2);
constexpr size_t OFF_WBT = OFF_WOT + al256((size_t)2 * 1024 * 1024 * 2);
constexpr size_t OFF_WQT = OFF_WBT + al256((size_t)2 * 4 * 1024 * 256 * 2);
constexpr size_t OFF_WKVT = OFF_WQT + al256((size_t)2 * 384 * 256 * 2);
constexpr size_t OFF_ROPE = OFF_WKVT + al256((size_t)2 * 512 * 128 * 2);
constexpr size_t OFF_LUTC = OFF_ROPE + al256((size_t)8192 * 32 * 4);
constexpr size_t OFF_LUTD = OFF_LUTC + 8192;
constexpr size_t OFF_XN = OFF_LUTD + 8192;
constexpr size_t OFF_PROJ = OFF_XN + al256((size_t)32768 * 1024 * 2);
constexpr size_t OFF_QA = OFF_PROJ + al256((size_t)32768 * 4864 * 2);
constexpr size_t OFF_KA = OFF_QA + al256((size_t)32768 * 384 * 2);
constexpr size_t OFF_VA = OFF_KA + al256((size_t)32768 * 384 * 2);
constexpr size_t OFF_LSE = OFF_VA + al256((size_t)32768 * 256 * 2);
constexpr size_t OFF_BAR = OFF_LSE + al256((size_t)32768 * 12 * 4);
constexpr size_t WS_NEED = OFF_BAR + 16384;
#define WSP(T, OFF) ((T*)(p.ws + (OFF)))
#define P_W1T WSP(bf16_t, OFF_W1T)
#define P_WMT WSP(bf16_t, OFF_WMT)
#define P_WOT WSP(bf16_t, OFF_WOT)
#define P_WBT WSP(bf16_t, OFF_WBT)
#define P_WQT WSP(bf16_t, OFF_WQT)
#define P_WKVT WSP(bf16_t, OFF_WKVT)
#define P_ROPE WSP(float, OFF_ROPE)
#define P_LUTC WSP(float, OFF_LUTC)
#define P_LUTD WSP(float, OFF_LUTD)
#define P_XN WSP(bf16_t, OFF_XN)
#define P_PROJ WSP(bf16_t, OFF_PROJ)
#define P_QA WSP(bf16_t, OFF_QA)
#define P_KA WSP(bf16_t, OFF_KA)
#define P_VA WSP(bf16_t, OFF_VA)
#define P_LSE WSP(float, OFF_LSE)


DI unsigned short f2bf(float x) { unsigned u = __float_as_uint(x); u += 0x7fffu + ((u >> 16) & 1u); return (unsigned short)(u >> 16); }
DI float bf2f(unsigned short b) { return __uint_as_float(((unsigned)b) << 16); }
typedef __bf16 bf2_t __attribute__((ext_vector_type(2)));
typedef float f2_t __attribute__((ext_vector_type(2)));
DI unsigned pack2(float a, float b) { f2_t v = {a, b}; bf2_t r = __builtin_convertvector(v, bf2_t); return __builtin_bit_cast(unsigned, r); }
constexpr float LOG2E = 1.4426950408889634f;
constexpr float QS64 = 0.125f * LOG2E;
constexpr float QS96 = 0.10206207261596575f * LOG2E;
#define BLO(u) __uint_as_float((u) << 16)
#define BHI(u) __uint_as_float((u) & 0xffff0000u)
DI int otid() { int t; asm volatile("v_mov_b32 %0, %1" : "=v"(t) : "v"((int)threadIdx.x)); __builtin_assume(t >= 0 && t < 256); return t; }
DI float wave_sum(float v) {
#pragma unroll
  for (int o = 32; o; o >>= 1) v += __shfl_xor(v, o);
  return v;
}

DI int srccol(int mode, int n) {
  if (mode == 0) return n < 4352 ? n + 416 : (n < 4768 ? n - 4352 : -1);
  if (mode == 1) return 4768 + n;
  if (mode == 2) return n;
  return n < 256 ? (n >> 6) * 96 + (n & 63) : ((n - 256) >> 5) * 96 + 64 + ((n - 256) & 31);
}
DI void conv_tile(const float* __restrict__ src, int ld, int K, bf16_t* __restrict__ dst, int n0, int k0, int mode,
                  const float* __restrict__ rs, float* tile) {
  const int tx = otid() & 63, ty = otid() >> 6;
  __syncthreads();
  const int sc = srccol(mode, n0 + tx);
  const int nq = n0 + tx;
  const float cscale = (mode == 0 && ((nq >= C_CQ && nq < C_CQ + 768) || (nq >= C_DQ && nq < C_DQ + 256))) ? QS64 : 1.0f;
#pragma unroll
  for (int i = 0; i < 16; ++i) {
    int kk = ty + 4 * i;
    float v = sc >= 0 ? src[(size_t)(k0 + kk) * ld + sc] : 0.f;
    if (rs) v *= rs[k0 + kk];
    tile[kk * 65 + tx] = v * cscale;
  }
  __syncthreads();
#pragma unroll
  for (int i = 0; i < 16; ++i) {
    int nn = ty + 4 * i;
    dst[(size_t)(n0 + nn) * K + k0 + tx] = f2bf(tile[tx * 65 + nn]);
  }
}

DI int t5_bucket(int rel) {
  int n = rel < 0 ? -rel : rel;
  float nf = (float)(n < 1 ? 1 : n);
  int large = 8 + (int)(logf(nf / 8.0f) / 4.852030263919617f * 8.0f);
  if (large > 15) large = 15;
  return (rel > 0 ? 16 : 0) + (n < 8 ? n : large);
}

DI void prep_item(const Params& p, int item, float* tile) {
  if (item < 5584) {
    int l = item / 2792, r = item % 2792;
    const float* src; int ld, K, mode, t; bf16_t* dst; const float* rs = nullptr;
    if (r < 1216) { t = r; src = p.w_in + (size_t)l * 1024 * 8864; ld = 8864; K = 1024; mode = 0; dst = P_W1T + (size_t)l * 4864 * 1024; }
    else if (r < 2240) { t = r - 1216; src = p.w_in + (size_t)l * 1024 * 8864; ld = 8864; K = 1024; mode = 1; dst = P_WMT + (size_t)l * 4096 * 1024; }
    else if (r < 2496) { t = r - 2240; src = p.w_out + (size_t)l * 1024 * 1024; ld = 1024; K = 1024; mode = 2; dst = P_WOT + (size_t)l * 1024 * 1024; }
    else if (r < 2752) { t = r - 2496; int n = t >> 6; t &= 63; src = p.w_branch + (size_t)(l * 4 + n) * 256 * 1024; ld = 1024; K = 256; mode = 2; dst = P_WBT + (size_t)(l * 4 + n) * 1024 * 256; }
    else if (r < 2776) { t = r - 2752; src = p.w_q_up + (size_t)l * 256 * 384; ld = 384; K = 256; mode = 3; dst = P_WQT + (size_t)l * 384 * 256; rs = p.q_norm_g + l * 256; }
    else { t = r - 2776; src = p.w_kv_up + (size_t)l * 128 * 512; ld = 512; K = 128; mode = 2; dst = P_WKVT + (size_t)l * 512 * 128; rs = p.kv_norm_g + l * 128; }
    int kt = K / 64;
    conv_tile(src, ld, K, dst, (t / kt) * 64, (t % kt) * 64, mode, rs, tile);
  } else if (item < 5584 + 512) {
    int idx = (item - 5584) * 256 + otid();
    int pos = idx >> 4, i = idx & 15;
    double invd = 1.0;
    for (int k = 0; k < i; ++k) invd *= 0.5623413251903491;
    float inv = (float)invd;
    float ang = (float)pos * inv;
    double a = (double)ang;
    double kq = rint(a * 0.15915494309189535);
    double r = a - kq * 6.283185307179586;
    double r2 = r * r, ts = r, tc = 1.0, sn = r, cs = 1.0;
    for (int k = 1; k <= 14; ++k) {
      tc = -tc * r2 / (double)((2 * k - 1) * (2 * k));
      ts = -ts * r2 / (double)((2 * k) * (2 * k + 1));
      cs += tc; sn += ts;
    }
    P_ROPE[pos * 32 + i] = (float)cs;
    P_ROPE[pos * 32 + 16 + i] = (float)sn;
  } else {
    for (int e = otid(); e < 12 * 129; e += 256) {
      int gh = e / 129, off = e % 129 - 64; int g = gh >> 2;
      int r = g == 0 ? 1 : (g == 1 ? 4 : 16);
      P_LUTC[e] = p.t5[t5_bucket(off * r) * 16 + gh] * LOG2E;
    }
    for (int e = otid(); e < 4 * 257; e += 256) {
      int hq = e / 257, off = e % 257 - 128;
      P_LUTD[e] = p.t5[t5_bucket(off) * 16 + 12 + hq] * LOG2E;
    }
  }
}

DI void norm_rows_bf16(const float* __restrict__ src, const float* __restrict__ g, bf16_t* __restrict__ dst, int item) {
  const int lane = otid() & 63, wid = otid() >> 6;
  for (int i = 0; i < 8; ++i) {
    size_t row = (size_t)item * 32 + wid * 8 + i;
    const float4* s = (const float4*)(src + row * 1024);
    float4 v[4]; float ss = 0.f;
#pragma unroll
    for (int j = 0; j < 4; ++j) { v[j] = s[lane + 64 * j]; ss += v[j].x * v[j].x + v[j].y * v[j].y + v[j].z * v[j].z + v[j].w * v[j].w; }
    ss = wave_sum(ss);
    float sc = rsqrtf(ss * (1.0f / 1024.0f) + 1e-6f);
#pragma unroll
    for (int j = 0; j < 4; ++j) {
      float4 gg = ((const float4*)g)[lane + 64 * j];
      uint2 o; o.x = pack2(v[j].x * sc * gg.x, v[j].y * sc * gg.y); o.y = pack2(v[j].z * sc * gg.z, v[j].w * sc * gg.w);
      *(uint2*)(dst + row * 1024 + (lane + 64 * j) * 4) = o;
    }
  }
}
DI void norm_rows_f32(float* io, const float* __restrict__ g, int item) {
  const int lane = otid() & 63, wid = otid() >> 6;
  for (int i = 0; i < 8; ++i) {
    size_t row = (size_t)item * 32 + wid * 8 + i;
    float4* s = (float4*)(io + row * 1024);
    float4 v[4]; float ss = 0.f;
#pragma unroll
    for (int j = 0; j < 4; ++j) { v[j] = s[lane + 64 * j]; ss += v[j].x * v[j].x + v[j].y * v[j].y + v[j].z * v[j].z + v[j].w * v[j].w; }
    ss = wave_sum(ss);
    float sc = rsqrtf(ss * (1.0f / 1024.0f) + 1e-6f);
#pragma unroll
    for (int j = 0; j < 4; ++j) {
      float4 gg = ((const float4*)g)[lane + 64 * j];
      float4 o; o.x = v[j].x * sc * gg.x; o.y = v[j].y * sc * gg.y; o.z = v[j].z * sc * gg.z; o.w = v[j].w * sc * gg.w;
      s[lane + 64 * j] = o;
    }
  }
}

constexpr int LLD = 72;
constexpr int GST = 128 * 64;
template <int NT, bool LOWREG = false>
DI void gemm_mainloop(f32x4 (&acc)[4][NT], const bf16_t* A, int lda, const bf16_t* Bt, int ldb, int K, bf16_t* sA, bf16_t* sB, int bstride = 32) {
  constexpr int NB = NT;
  const int tid = otid(), lane = tid & 63, wid = tid >> 6;
  const int wm = wid >> 1, wn = wid & 1, fr = lane & 15, fq = lane >> 4;
  u32x4 ra[4], rb[NB];
  const int nk = K >> 6;
  const bf16_t* ap = A + (size_t)(tid >> 3) * lda + (tid & 7) * 8;
  const bf16_t* bp = Bt + (size_t)(tid >> 3) * ldb + (tid & 7) * 8;
  const int so = (tid >> 3) * 64 + (((tid & 7) ^ ((tid >> 4) & 7)) * 8);
  const int fsw = fr >> 1;
#define GLOAD(ko) do { \
    _Pragma("unroll") for (int i = 0; i < 4; ++i) ra[i] = *(const u32x4*)(ap + (size_t)(32 * i) * lda + (ko)); \
    _Pragma("unroll") for (int i = 0; i < NB; ++i) rb[i] = *(const u32x4*)(bp + (size_t)(bstride * i) * ldb + (ko)); } while (0)
#define GSTORE(st) do { \
    _Pragma("unroll") for (int i = 0; i < 4; ++i) *(u32x4*)(sA + (st) * GST + so + 32 * i * 64) = ra[i]; \
    _Pragma("unroll") for (int i = 0; i < NB; ++i) *(u32x4*)(sB + (st) * GST + so + 32 * i * 64) = rb[i]; } while (0)
#define GCOMPUTE(st) do { \
    const bf16_t* cA = sA + (st) * GST; const bf16_t* cB = sB + (st) * GST; \
    _Pragma("unroll") for (int ks = 0; ks < 2; ++ks) { \
      bf16x8 af[4], bfr[NT]; \
      _Pragma("unroll") for (int mi = 0; mi < 4; ++mi) af[mi] = *(const bf16x8*)(cA + (wm * 64 + mi * 16 + fr) * 64 + (((ks * 4 + fq) ^ fsw) * 8)); \
      _Pragma("unroll") for (int ni = 0; ni < NT; ++ni) bfr[ni] = *(const bf16x8*)(cB + (wn * NT * 16 + ni * 16 + fr) * 64 + (((ks * 4 + fq) ^ fsw) * 8)); \
      _Pragma("unroll") for (int mi = 0; mi < 4; ++mi) \
        _Pragma("unroll") for (int ni = 0; ni < NT; ++ni) acc[mi][ni] = __builtin_amdgcn_mfma_f32_16x16x32_bf16(bfr[ni], af[mi], acc[mi][ni], 0, 0, 0); \
    } } while (0)
  __syncthreads();
  GLOAD(0); GSTORE(0);
  if (nk > 1) GLOAD(64);
  __syncthreads();
  for (int kt = 0; kt < nk; ++kt) {
    const int cur = kt & 1;
    if (kt + 1 < nk) { GSTORE(cur ^ 1); if (kt + 2 < nk) GLOAD((kt + 2) * 64); }
    if (LOWREG) {
      const bf16_t* cA = sA + cur * GST; const bf16_t* cB = sB + cur * GST;
#pragma nounroll
      for (int ks = 0; ks < 2; ++ks) {
        bf16x8 af[4], bfr[NT];
#pragma unroll
        for (int mi = 0; mi < 4; ++mi) af[mi] = *(const bf16x8*)(cA + (wm * 64 + mi * 16 + fr) * 64 + (((ks * 4 + fq) ^ fsw) * 8));
#pragma unroll
        for (int ni = 0; ni < NT; ++ni) bfr[ni] = *(const bf16x8*)(cB + (wn * NT * 16 + ni * 16 + fr) * 64 + (((ks * 4 + fq) ^ fsw) * 8));
#pragma unroll
        for (int mi = 0; mi < 4; ++mi)
#pragma unroll
          for (int ni = 0; ni < NT; ++ni) acc[mi][ni] = __builtin_amdgcn_mfma_f32_16x16x32_bf16(bfr[ni], af[mi], acc[mi][ni], 0, 0, 0);
      }
    } else GCOMPUTE(cur);
    __syncthreads();
  }
#undef GLOAD
#undef GSTORE
#undef GCOMPUTE
}
template <int NT>
DI void zero_acc(f32x4 (&acc)[4][NT]) {
#pragma unroll
  for (int mi = 0; mi < 4; ++mi)
#pragma unroll
    for (int ni = 0; ni < NT; ++ni) acc[mi][ni] = f32x4{0.f, 0.f, 0.f, 0.f};
}


constexpr int BGA = 128 * 32, BGB = 256 * 32;
DI void gemm_big(f32x4 (&acc)[4][8], const bf16_t* A, int lda, const bf16_t* Bt, int ldb, int K, char* smem, int s1 = 64, int s2 = 128, int brow = -1) {
  bf16_t* sA = (bf16_t*)smem; bf16_t* sB = sA + 2 * BGA;
  const int tid = otid(), lane = tid & 63, wid = tid >> 6;
  const int wm = wid >> 1, wn = wid & 1, fr = lane & 15, fq = lane >> 4;
  const int nk = K >> 5;
  const bf16_t* ap = A + (size_t)(tid >> 2) * lda + (tid & 3) * 8;
  const bf16_t* bp = Bt + (size_t)(brow >= 0 ? brow : (tid >> 2)) * ldb + (tid & 3) * 8;
  const int so = (tid >> 2) * 32 + (((tid & 3) ^ (((tid >> 5) & 1) << 1)) * 8);
  const int fo = fr * 32 + ((fq ^ (((fr >> 3) & 1) << 1)) * 8);
  u32x4 ra[2], rb[4];
#define BLOADG(kt) do { \
    _Pragma("unroll") for (int i = 0; i < 2; ++i) ra[i] = *(const u32x4*)(ap + (size_t)(64 * i) * lda + (kt) * 32); \
    _Pragma("unroll") for (int i = 0; i < 4; ++i) rb[i] = *(const u32x4*)(bp + (size_t)((i & 1) * s1 + (i >> 1) * s2) * ldb + (kt) * 32); } while (0)
#define BSTOREG(st) do { \
    _Pragma("unroll") for (int i = 0; i < 2; ++i) *(u32x4*)(sA + (st) * BGA + so + 64 * i * 32) = ra[i]; \
    _Pragma("unroll") for (int i = 0; i < 4; ++i) *(u32x4*)(sB + (st) * BGB + so + 64 * i * 32) = rb[i]; } while (0)
  __syncthreads();
  BLOADG(0); BSTOREG(0);
  if (nk > 1) BLOADG(1);
  __syncthreads();
  for (int kt = 0; kt < nk; ++kt) {
    const int cur = kt & 1;
    if (kt + 1 < nk) { BSTOREG(cur ^ 1); if (kt + 2 < nk) BLOADG(kt + 2); }
    const bf16_t* cA = sA + cur * BGA + (wm * 64) * 32 + fo; const bf16_t* cB = sB + cur * BGB + (wn * 128) * 32 + fo;
    bf16x8 af[4];
#pragma unroll
    for (int mi = 0; mi < 4; ++mi) af[mi] = *(const bf16x8*)(cA + mi * 16 * 32);
#pragma unroll
    for (int nh = 0; nh < 2; ++nh) {
      bf16x8 bfr[4];
#pragma unroll
      for (int ni = 0; ni < 4; ++ni) bfr[ni] = *(const bf16x8*)(cB + (nh * 4 + ni) * 16 * 32);
#pragma unroll
      for (int mi = 0; mi < 4; ++mi)
#pragma unroll
        for (int ni = 0; ni < 4; ++ni) acc[mi][nh * 4 + ni] = __builtin_amdgcn_mfma_f32_16x16x32_bf16(bfr[ni], af[mi], acc[mi][nh * 4 + ni], 0, 0, 0);
    }
    __syncthreads();
  }
#undef BLOADG
#undef BSTOREG
}
DI void zero_acc8(f32x4 (&acc)[4][8]) {
#pragma unroll
  for (int mi = 0; mi < 4; ++mi)
#pragma unroll
    for (int ni = 0; ni < 8; ++ni) acc[mi][ni] = f32x4{0.f, 0.f, 0.f, 0.f};
}

DI void inproj_tile(const Params& p, int l, int tile, char* smem) {
  const int mt = tile & 255, nt = tile >> 8;
  f32x4 acc[4][8]; zero_acc8(acc);
  gemm_big(acc, P_XN + (size_t)mt * 128 * 1024, 1024, P_W1T + ((size_t)l * 4864 + nt * 256) * 1024, 1024, 1024, smem);
  const int lane = otid() & 63, wid = otid() >> 6, wm = wid >> 1, wn = wid & 1, fr = lane & 15, fq = lane >> 4;
#pragma unroll
  for (int mi = 0; mi < 4; ++mi)
#pragma unroll
    for (int ni = 0; ni < 8; ++ni) {
      size_t row = (size_t)mt * 128 + wm * 64 + mi * 16 + fr; int col = nt * 256 + wn * 128 + ni * 16 + fq * 4;
      uint2 o; o.x = pack2(acc[mi][ni][0], acc[mi][ni][1]); o.y = pack2(acc[mi][ni][2], acc[mi][ni][3]);
      *(uint2*)(P_PROJ + row * PW + col) = o;
    }
}

DI void row_scales(const bf16_t* A, int lda, int K, float* sRow) {
  const int row = otid() >> 1, half = otid() & 1;
  const int per = K >> 1;
  const bf16_t* a = A + (size_t)row * lda + half * per;
  float ss = 0.f;
  for (int c = 0; c < per; c += 8) {
    uint4 u = *(const uint4*)(a + c);
    float f;
    f = BLO(u.x); ss += f * f; f = BHI(u.x); ss += f * f; f = BLO(u.y); ss += f * f; f = BHI(u.y); ss += f * f;
    f = BLO(u.z); ss += f * f; f = BHI(u.z); ss += f * f; f = BLO(u.w); ss += f * f; f = BHI(u.w); ss += f * f;
  }
  ss += __shfl_xor(ss, 1);
  if (half == 0) sRow[row] = rsqrtf(ss / (float)K + 1e-6f);
}
DI void mla_item(const Params& p, int l, int item, char* smem) {
  bf16_t* sA = (bf16_t*)smem; bf16_t* sB = sA + 2 * GST; float* sRow = (float*)(sB + 2 * GST);
  const int lane = otid() & 63, wid = otid() >> 6, wm = wid >> 1, wn = wid & 1, fr = lane & 15, fq = lane >> 4;
  if (item < 768) {
    const int mt = item & 255, nt = item >> 8;
    const bf16_t* A = P_PROJ + (size_t)mt * 128 * PW + C_AQ;
    __syncthreads();
    row_scales(A, PW, 256, sRow);
    f32x4 acc[4][4]; zero_acc<4>(acc);
    gemm_mainloop<4>(acc, A, PW, P_WQT + ((size_t)l * 384 + nt * 128) * 256, 256, 256, sA, sB);
    if (nt < 2) {
#pragma unroll
      for (int mi = 0; mi < 4; ++mi)
#pragma unroll
        for (int ni = 0; ni < 4; ++ni) {
          int rl = wm * 64 + mi * 16 + fr; size_t t = (size_t)mt * 128 + rl; float s = sRow[rl] * QS96;
          int c = nt * 128 + wn * 64 + ni * 16 + fq * 4; int h = c >> 6, d = c & 63;
          uint2 o; o.x = pack2(acc[mi][ni][0] * s, acc[mi][ni][1] * s); o.y = pack2(acc[mi][ni][2] * s, acc[mi][ni][3] * s);
          *(uint2*)(P_QA + t * 384 + h * 96 + d) = o;
        }
    } else {
#pragma unroll
      for (int mi = 0; mi < 4; ++mi)
#pragma unroll
        for (int np = 0; np < 2; ++np) {
          int rl = wm * 64 + mi * 16 + fr; size_t t = (size_t)mt * 128 + rl; float s = sRow[rl] * QS96;
          int pos = (int)(t & (SEQ - 1)); int h = wn * 2 + np;
          const float* cs = P_ROPE + pos * 32 + fq * 4;
          float o1[4], o2[4];
#pragma unroll
          for (int j = 0; j < 4; ++j) {
            float x1 = acc[mi][np * 2][j] * s, x2 = acc[mi][np * 2 + 1][j] * s; float c = cs[j], sn = cs[16 + j];
            o1[j] = x1 * c - x2 * sn; o2[j] = x1 * sn + x2 * c;
          }
          uint2 a; a.x = pack2(o1[0], o1[1]); a.y = pack2(o1[2], o1[3]);
          uint2 b; b.x = pack2(o2[0], o2[1]); b.y = pack2(o2[2], o2[3]);
          *(uint2*)(P_QA + t * 384 + h * 96 + 64 + fq * 4) = a;
          *(uint2*)(P_QA + t * 384 + h * 96 + 80 + fq * 4) = b;
        }
    }
  } else if (item < 768 + 1024) {
    const int it = item - 768; const int mt = it & 255, h = it >> 8;
    const bf16_t* A = P_PROJ + (size_t)mt * 128 * PW + C_AKV;
    __syncthreads();
    row_scales(A, PW, 128, sRow);
    f32x4 acc[4][4]; zero_acc<4>(acc);
    gemm_mainloop<4>(acc, A, PW, P_WKVT + ((size_t)l * 512 + h * 128) * 128, 128, 128, sA, sB);
#pragma unroll
    for (int mi = 0; mi < 4; ++mi)
#pragma unroll
      for (int ni = 0; ni < 4; ++ni) {
        int rl = wm * 64 + mi * 16 + fr; size_t t = (size_t)mt * 128 + rl; float s = sRow[rl];
        int d = ni * 16 + fq * 4;
        uint2 o; o.x = pack2(acc[mi][ni][0] * s, acc[mi][ni][1] * s); o.y = pack2(acc[mi][ni][2] * s, acc[mi][ni][3] * s);
        if (wn == 0) *(uint2*)(P_KA + t * 384 + h * 96 + d) = o;
        else *(uint2*)(P_VA + t * 256 + h * 64 + d) = o;
      }
  } else {
    const int it = item - 1792;
    const int half = lane >> 5, pl = lane & 31;
    for (int i = 0; i < 32; ++i) {
      size_t t = (size_t)it * 128 + wid * 32 + i; int pos = (int)(t & (SEQ - 1));
      bf16_t* row = P_PROJ + t * PW;
#pragma unroll
      for (int s3 = 0; s3 < 3; ++s3) {
        int slot = s3 * 2 + half;
        bf16_t* hp = row + (slot < 4 ? C_BQ + slot * 64 : C_BK + (slot - 4) * 64);
        const float* g = (slot < 4 ? p.gq_g : p.gk_g) + l * 64;
        int d1, fi, ap;
        if (pl < 16) { d1 = pl; fi = pl; ap = pos >> 6; } else { d1 = 32 + (pl - 16); fi = pl - 16; ap = pos & 63; }
        float x1 = bf2f(hp[d1]), x2 = bf2f(hp[d1 + 16]);
        float ss = x1 * x1 + x2 * x2;
#pragma unroll
        for (int o = 16; o; o >>= 1) ss += __shfl_xor(ss, o);
        float sc = rsqrtf(ss * (1.0f / 64.0f) + 1e-6f);
        if (slot < 4) sc *= QS64;
        x1 = x1 * sc * g[d1]; x2 = x2 * sc * g[d1 + 16];
        float c = P_ROPE[ap * 32 + fi], sn = P_ROPE[ap * 32 + 16 + fi];
        hp[d1] = f2bf(x1 * c - x2 * sn); hp[d1 + 16] = f2bf(x1 * sn + x2 * c);
      }
      if (lane < 16) {
        float x1 = bf2f(row[C_AKR + lane]), x2 = bf2f(row[C_AKR + 16 + lane]);
        float c = P_ROPE[pos * 32 + lane], sn = P_ROPE[pos * 32 + 16 + lane];
        bf16_t o1 = f2bf(x1 * c - x2 * sn), o2 = f2bf(x1 * sn + x2 * c);
#pragma unroll
        for (int h = 0; h < 4; ++h) { P_KA[t * 384 + h * 96 + 64 + lane] = o1; P_KA[t * 384 + h * 96 + 80 + lane] = o2; }
      }
    }
  }
}

#define MFMA32(a, b, c) __builtin_amdgcn_mfma_f32_32x32x16_bf16((a), (b), (c), 0, 0, 0)
template <int OFF> DI bf16x4 tr_read(unsigned addr) {
  bf16x4 r; asm volatile("ds_read_b64_tr_b16 %0, %1 offset:%2" : "=&v"(r) : "v"(addr), "i"(OFF) : "memory"); return r;
}
DI float half_swap_max(float v) {
  auto rr = __builtin_amdgcn_permlane32_swap(__float_as_uint(v), __float_as_uint(v), false, false);
  return fmaxf(__uint_as_float(rr[0]), __uint_as_float(rr[1]));
}
DI float half_swap_sum(float v) {
  auto rr = __builtin_amdgcn_permlane32_swap(__float_as_uint(v), __float_as_uint(v), false, false);
  return __uint_as_float(rr[0]) + __uint_as_float(rr[1]);
}
DI bf16x8 pack8(const f32x16& p, int base) {
  u32x4 w = {pack2(p[base + 0], p[base + 1]), pack2(p[base + 2], p[base + 3]), pack2(p[base + 4], p[base + 5]), pack2(p[base + 6], p[base + 7])};
  return __builtin_bit_cast(bf16x8, w);
}
template <int DB, int VLD> DI void pv_block(f32x16& o, unsigned vb, bf16x8 pb0, bf16x8 pb1, bf16x8 pb2, bf16x8 pb3) {
  constexpr int RB = VLD * 2;
  bf16x4 l0 = tr_read<0 * RB + 64 * DB>(vb), h0 = tr_read<8 * RB + 64 * DB>(vb);
  bf16x4 l1 = tr_read<16 * RB + 64 * DB>(vb), h1 = tr_read<24 * RB + 64 * DB>(vb);
  bf16x4 l2 = tr_read<32 * RB + 64 * DB>(vb), h2 = tr_read<40 * RB + 64 * DB>(vb);
  bf16x4 l3 = tr_read<48 * RB + 64 * DB>(vb), h3 = tr_read<56 * RB + 64 * DB>(vb);
  asm volatile("s_waitcnt lgkmcnt(0)" ::: "memory"); __builtin_amdgcn_sched_barrier(0);
  o = MFMA32(__builtin_shufflevector(l0, h0, 0, 1, 2, 3, 4, 5, 6, 7), pb0, o);
  o = MFMA32(__builtin_shufflevector(l1, h1, 0, 1, 2, 3, 4, 5, 6, 7), pb1, o);
  o = MFMA32(__builtin_shufflevector(l2, h2, 0, 1, 2, 3, 4, 5, 6, 7), pb2, o);
  o = MFMA32(__builtin_shufflevector(l3, h3, 0, 1, 2, 3, 4, 5, 6, 7), pb3, o);
}
DI f32x16 splat16(float v) { f32x16 r;
#pragma unroll
  for (int i = 0; i < 16; ++i) r[i] = v;
  return r; }

template <int DQK, bool FIXEDM>
DI void attn_dense_mfma(const bf16_t* Qb, int ldq, const bf16_t* Kb, int ldk, const bf16_t* Vb, int ldv, bf16_t* gate_io, char* smem, bool store, float mbound) {
  constexpr int NS = DQK / 16, KLD = DQK + 8, VLD = 96, CPR = DQK / 8, NKC = (64 * CPR) / 256;
  constexpr int KBYTES = 64 * KLD * 2, VBYTES = 64 * VLD * 2;
  char* sKc = smem; char* sVc = smem + 2 * KBYTES;
  const int tid = otid(), lane = tid & 63, wid = tid >> 6, r = lane & 31, h = lane >> 5;
  bf16x8 qf[NS];
#pragma unroll
  for (int s = 0; s < NS; ++s) qf[s] = *(const bf16x8*)(Qb + (size_t)(wid * 32 + r) * ldq + 16 * s + 8 * h);
  const bf16_t* kp = Kb + (size_t)(tid >> 2) * ldk + (tid & 3) * (NKC * 8);
  const int kso = ((tid >> 2) * KLD + (tid & 3) * (NKC * 8)) * 2;
  const bf16_t* vp0 = Vb + (size_t)(tid >> 3) * ldv + (tid & 7) * 8;
  const bf16_t* vp1 = vp0 + (size_t)32 * ldv;
  const int vso = ((tid >> 3) * VLD + (tid & 7) * 8) * 2;
  const size_t kstep = (size_t)64 * ldk, vstep = (size_t)64 * ldv;
  u32x4 rk[NKC], rv[2];
#define KLOAD() do { _Pragma("unroll") for (int i = 0; i < NKC; ++i) rk[i] = *(const u32x4*)(kp + i * 8); kp += kstep; } while (0)
#define VLOAD() do { rv[0] = *(const u32x4*)vp0; rv[1] = *(const u32x4*)vp1; vp0 += vstep; vp1 += vstep; } while (0)
#define KSTORE(st) do { _Pragma("unroll") for (int i = 0; i < NKC; ++i) *(u32x4*)(sKc + (st) * KBYTES + kso + i * 16) = rk[i]; } while (0)
#define VSTORE(st) do { *(u32x4*)(sVc + (st) * VBYTES + vso) = rv[0]; *(u32x4*)(sVc + (st) * VBYTES + vso + 32 * VLD * 2) = rv[1]; } while (0)
#define QKT(P0, P1, st) do { \
    const bf16_t* sK = (const bf16_t*)(sKc + (st) * KBYTES) + r * KLD + 8 * h; \
    P0 = negm; P1 = negm; \
    _Pragma("unroll") for (int s = 0; s < NS; ++s) { \
      bf16x8 k0 = *(const bf16x8*)(sK + 16 * s); bf16x8 k1 = *(const bf16x8*)(sK + 32 * KLD + 16 * s); \
      P0 = MFMA32(k0, qf[s], P0); P1 = MFMA32(k1, qf[s], P1); } } while (0)
  const unsigned vb0 = (unsigned)(size_t)sVc + (unsigned)(((4 * h + ((lane & 15) >> 2)) * VLD + 16 * ((lane >> 4) & 1) + 4 * (lane & 3)) * 2);
  f32x16 o0 = splat16(0.f), o1 = splat16(0.f), negm = splat16(FIXEDM ? -mbound : 0.f);
  f32x16 pa0, pa1, pc0, pc1;
  float m_run = 0.f, l_run = 0.f;
  constexpr int NT = SEQ / 64;
  __syncthreads();
  KLOAD(); VLOAD(); KSTORE(0); VSTORE(0);
  KLOAD(); KSTORE(1);
  __syncthreads();
  QKT(pa0, pa1, 0);
  __syncthreads();
#define STEP(SC0, SC1, SN0, SN1, PAR, FIRST, LK, LV) do { \
    if (LK) KLOAD(); \
    if (LV) VLOAD(); \
    float pm = 0.f; \
    if (!FIXEDM) { pm = fmaxf(SC0[0], SC1[0]); \
    _Pragma("unroll") for (int i = 1; i < 16; i += 1) pm = fmaxf(fmaxf(pm, SC0[i]), SC1[i]); \
    pm = half_swap_max(pm); } \
    if (!FIXEDM && ((FIRST) || __any(pm > 8.0f))) { \
      float delta; \
      if (FIRST) delta = pm; \
      else { delta = fmaxf(pm, 0.f); float alpha = __builtin_amdgcn_exp2f(-delta); l_run *= alpha; \
        _Pragma("unroll") for (int i = 0; i < 16; ++i) { o0[i] *= alpha; o1[i] *= alpha; } } \
      m_run += delta; \
      _Pragma("unroll") for (int i = 0; i < 16; ++i) { SC0[i] -= delta; SC1[i] -= delta; } \
      negm = splat16(-m_run); \
    } \
    if (LV) QKT(SN0, SN1, (PAR) ^ 1); \
    float ls = 0.f; \
    _Pragma("unroll") for (int i = 0; i < 16; ++i) { SC0[i] = __builtin_amdgcn_exp2f(SC0[i]); SC1[i] = __builtin_amdgcn_exp2f(SC1[i]); ls += SC0[i] + SC1[i]; } \
    l_run += ls; \
    bf16x8 pb0 = pack8(SC0, 0), pb1 = pack8(SC0, 8), pb2 = pack8(SC1, 0), pb3 = pack8(SC1, 8); \
    const unsigned vb = vb0 + (PAR) * VBYTES; \
    pv_block<0, VLD>(o0, vb, pb0, pb1, pb2, pb3); \
    pv_block<1, VLD>(o1, vb, pb0, pb1, pb2, pb3); \
    if (LK) KSTORE(PAR); \
    if (LV) VSTORE((PAR) ^ 1); \
    __syncthreads(); } while (0)
  pc0 = negm; pc1 = negm;
  STEP(pa0, pa1, pc0, pc1, 0, true, 1, 1);
  STEP(pc0, pc1, pa0, pa1, 1, false, 1, 1);
  for (int j = 2; j < NT - 2; j += 2) {
    STEP(pa0, pa1, pc0, pc1, 0, false, 1, 1);
    STEP(pc0, pc1, pa0, pa1, 1, false, 1, 1);
  }
  STEP(pa0, pa1, pc0, pc1, 0, false, 0, 1);
  STEP(pc0, pc1, pa0, pa1, 1, false, 0, 0);
#undef STEP
#undef QKT
#undef KLOAD
#undef VLOAD
#undef KSTORE
#undef VSTORE
  if (!store) return;
  const float inv = 1.0f / half_swap_sum(l_run);
  bf16_t* grow = gate_io + (size_t)(wid * 32 + r) * PW;
#pragma unroll
  for (int db = 0; db < 2; ++db)
#pragma unroll
    for (int g4 = 0; g4 < 4; ++g4) {
      bf16_t* gp = grow + 32 * db + 8 * g4 + 4 * h;
      uint2 u = *(const uint2*)gp;
      float g[4] = {BLO(u.x), BHI(u.x), BLO(u.y), BHI(u.y)};
      float y[4];
#pragma unroll
      for (int e = 0; e < 4; ++e) { float ov = db == 0 ? o0[4 * g4 + e] : o1[4 * g4 + e]; y[e] = ov * inv * g[e] / (1.0f + __expf(-g[e])); }
      uint2 w; w.x = pack2(y[0], y[1]); w.y = pack2(y[2], y[3]);
      *(uint2*)gp = w;
    }
}
DI void dense_item(const Params& p, int l, int combo, int qblk, char* smem, bool store) {
  const int br = combo >> 4, bh = combo & 15, b = bh >> 2, h = bh & 3;
  const size_t t0 = (size_t)b * SEQ + qblk * 128;
  bf16_t* gate_io = P_PROJ + t0 * PW + C_GATE + br * 256 + h * 64;
  float bbound = 0.f;
  if (br != 0) {
    const int ln = otid() & 63;
    float gq = fabsf(p.gq_g[l * 64 + ln]), gk = fabsf(p.gk_g[l * 64 + ln]);
#pragma unroll
    for (int o = 32; o; o >>= 1) { gq = fmaxf(gq, __shfl_xor(gq, o)); gk = fmaxf(gk, __shfl_xor(gk, o)); }
    bbound = 64.0f * QS64 * 1.02f * gq * gk + 0.05f;
  }
  if (br == 0)
    attn_dense_mfma<96, false>(P_QA + t0 * 384 + h * 96, 384, P_KA + (size_t)b * SEQ * 384 + h * 96, 384, P_VA + (size_t)b * SEQ * 256 + h * 64, 256, gate_io, smem, store, 0.f);
  else {
    if (bbound <= 60.0f) attn_dense_mfma<64, true>(P_PROJ + t0 * PW + C_BQ + h * 64, PW, P_PROJ + (size_t)b * SEQ * PW + C_BK + (h >> 1) * 64, PW,
                        P_PROJ + (size_t)b * SEQ * PW + C_BV + (h >> 1) * 64, PW, gate_io, smem, store, bbound);
    else attn_dense_mfma<64, false>(P_PROJ + t0 * PW + C_BQ + h * 64, PW, P_PROJ + (size_t)b * SEQ * PW + C_BK + (h >> 1) * 64, PW,
                        P_PROJ + (size_t)b * SEQ * PW + C_BV + (h >> 1) * 64, PW, gate_io, smem, store, bbound);
  }
}

template <int W, bool SINK>
DI void attn_band_mfma(const bf16_t* Qb, size_t ldq, const bf16_t* Kb, const bf16_t* Vb, size_t ldk, int L, int i0,
                       const float* lut_g, float sink2, bf16_t* outp, size_t ldo, float* lse_out, size_t ldl, char* smem) {
  constexpr int NS = 4, KLD = 72, VLD = 96, NTW = (128 + 2 * W) / 64, LUTN = 2 * W + 1;
  constexpr int KBYTES = 64 * KLD * 2, VBYTES = 64 * VLD * 2;
  char* sKc = smem; char* sVc = smem + 2 * KBYTES; float* sLut = (float*)(smem + 2 * KBYTES + 2 * VBYTES);
  const int tid = otid(), lane = tid & 63, wid = tid >> 6, r = lane & 31, h = lane >> 5;
  __syncthreads();
  for (int e = tid; e < LUTN; e += 256) sLut[e] = lut_g[e];
  const int qi = i0 + wid * 32 + r;
  bf16x8 qf[NS];
#pragma unroll
  for (int s = 0; s < NS; ++s) qf[s] = *(const bf16x8*)(Qb + (size_t)qi * ldq + 16 * s + 8 * h);
  const int srow = tid >> 3, scc = tid & 7;
  u32x4 rk[2], rv[2];
#define BLOAD(k0) do { \
    rk[0] = *(const u32x4*)(Kb + (size_t)((k0) + srow) * ldk + scc * 8); rk[1] = *(const u32x4*)(Kb + (size_t)((k0) + srow + 32) * ldk + scc * 8); \
    rv[0] = *(const u32x4*)(Vb + (size_t)((k0) + srow) * ldk + scc * 8); rv[1] = *(const u32x4*)(Vb + (size_t)((k0) + srow + 32) * ldk + scc * 8); } while (0)
#define BSTORE(st) do { \
    *(u32x4*)(sKc + (st) * KBYTES + (srow * KLD + scc * 8) * 2) = rk[0]; *(u32x4*)(sKc + (st) * KBYTES + ((srow + 32) * KLD + scc * 8) * 2) = rk[1]; \
    *(u32x4*)(sVc + (st) * VBYTES + (srow * VLD + scc * 8) * 2) = rv[0]; *(u32x4*)(sVc + (st) * VBYTES + ((srow + 32) * VLD + scc * 8) * 2) = rv[1]; } while (0)
  const unsigned vb0 = (unsigned)(size_t)sVc + (unsigned)(((4 * h + ((lane & 15) >> 2)) * VLD + 16 * ((lane >> 4) & 1) + 4 * (lane & 3)) * 2);
  f32x16 o0 = splat16(0.f), o1 = splat16(0.f);
  float m_run = SINK ? sink2 : 0.f, l_run = (SINK && h == 0) ? 1.f : 0.f;
  bool seen = SINK;
  f32x16 negm = splat16(-m_run);
  const int lo = (i0 == 0) ? W / 64 : 0, hi = (i0 + 128 >= L) ? NTW - W / 64 : NTW;
  BLOAD(i0 - W + 64 * lo); BSTORE(0);
  __syncthreads();
  for (int j = lo; j < hi; ++j) {
    const int cur = (j - lo) & 1, k0 = i0 - W + 64 * j;
    if (j + 1 < hi) BLOAD(k0 + 64);
    const bf16_t* sK = (const bf16_t*)(sKc + cur * KBYTES);
    f32x16 p0 = negm, p1 = negm;
#pragma unroll
    for (int s = 0; s < NS; ++s) {
      bf16x8 k0f = *(const bf16x8*)(sK + r * KLD + 16 * s + 8 * h);
      bf16x8 k1f = *(const bf16x8*)(sK + (32 + r) * KLD + 16 * s + 8 * h);
      p0 = MFMA32(k0f, qf[s], p0);
      p1 = MFMA32(k1f, qf[s], p1);
    }
    const int offb = k0 + 4 * h - qi + W;
    float pm = -1e30f;
#pragma unroll
    for (int i = 0; i < 16; ++i) {
      int idx0 = offb + (i & 3) + 8 * (i >> 2), idx1 = idx0 + 32;
      int c0 = min(max(idx0, 0), 2 * W), c1 = min(max(idx1, 0), 2 * W);
      float b0 = sLut[c0], b1 = sLut[c1];
      p0[i] = ((unsigned)idx0 <= (unsigned)(2 * W)) ? p0[i] + b0 : -1e30f;
      p1[i] = ((unsigned)idx1 <= (unsigned)(2 * W)) ? p1[i] + b1 : -1e30f;
      pm = fmaxf(pm, fmaxf(p0[i], p1[i]));
    }
    pm = half_swap_max(pm);
    const bool has = pm > -1e29f;
    float delta = 0.f;
    if (has) { if (!seen) delta = pm; else if (pm > 8.0f) delta = pm; }
    if (__any(delta != 0.f)) {
      float alpha = seen ? __builtin_amdgcn_exp2f(-delta) : 1.0f;
      l_run *= alpha; m_run += delta;
#pragma unroll
      for (int i = 0; i < 16; ++i) { o0[i] *= alpha; o1[i] *= alpha; p0[i] -= delta; p1[i] -= delta; }
      negm = splat16(-m_run);
    }
    seen = seen || has;
    float ls = 0.f;
#pragma unroll
    for (int i = 0; i < 16; ++i) { p0[i] = __builtin_amdgcn_exp2f(p0[i]); p1[i] = __builtin_amdgcn_exp2f(p1[i]); ls += p0[i] + p1[i]; }
    l_run += ls;
    bf16x8 pb0 = pack8(p0, 0), pb1 = pack8(p0, 8), pb2 = pack8(p1, 0), pb3 = pack8(p1, 8);
    const unsigned vb = vb0 + cur * VBYTES;
    pv_block<0, VLD>(o0, vb, pb0, pb1, pb2, pb3);
    pv_block<1, VLD>(o1, vb, pb0, pb1, pb2, pb3);
    if (j + 1 < hi) BSTORE(cur ^ 1);
    __syncthreads();
  }
#undef BLOAD
#undef BSTORE
  const float ltot = half_swap_sum(l_run);
  const float inv = 1.0f / ltot;
  bf16_t* orow = outp + (size_t)qi * ldo;
  if (!SINK && h == 0) lse_out[(size_t)qi * ldl] = m_run + __log2f(ltot);
#pragma unroll
  for (int db = 0; db < 2; ++db)
#pragma unroll
    for (int g4 = 0; g4 < 4; ++g4) {
      bf16_t* gp = orow + 32 * db + 8 * g4 + 4 * h;
      float y[4];
      if (SINK) {
        uint2 u = *(const uint2*)gp;
        float g[4] = {BLO(u.x), BHI(u.x), BLO(u.y), BHI(u.y)};
#pragma unroll
        for (int e = 0; e < 4; ++e) { float ov = db == 0 ? o0[4 * g4 + e] : o1[4 * g4 + e]; y[e] = ov * inv * g[e] / (1.0f + __expf(-g[e])); }
      } else {
#pragma unroll
        for (int e = 0; e < 4; ++e) { float ov = db == 0 ? o0[4 * g4 + e] : o1[4 * g4 + e]; y[e] = ov * inv; }
      }
      uint2 w; w.x = pack2(y[0], y[1]); w.y = pack2(y[2], y[3]);
      *(uint2*)gp = w;
    }
}
DI void band_item(const Params& p, int l, int idx, char* smem) {
  if (idx < 3072) {
    const int g = idx >> 10, rem = idx & 1023, h = rem & 3, rem2 = rem >> 2, b = rem2 >> 6, u = rem2 & 63;
    const int sh = 2 * g, rr = 1 << sh;
    const int rho = u & (rr - 1), qblk = u >> sh;
    const size_t tok0 = (size_t)b * SEQ + rho;
    bf16_t* base = P_PROJ + tok0 * PW + g * 256 + h * 64;
    attn_band_mfma<64, false>(base + C_CQ, (size_t)rr * PW, base + C_CK, base + C_CV, (size_t)rr * PW, SEQ >> sh, qblk * 128,
                              P_LUTC + (g * 4 + h) * 129, 0.f, base + C_CQ, (size_t)rr * PW, P_LSE + tok0 * 12 + g * 4 + h, (size_t)rr * 12, smem);
  } else {
    const int it = idx - 3072, hq = it & 3, rem = it >> 2, b = rem >> 6, qblk = rem & 63;
    bf16_t* base = P_PROJ + (size_t)b * SEQ * PW;
    attn_band_mfma<128, true>(base + C_DQ + hq * 64, PW, base + C_DK + (hq >> 1) * 64, base + C_DV + (hq >> 1) * 64, PW, SEQ, qblk * 128,
                              P_LUTD + hq * 257, p.sink[l * 4 + hq] * LOG2E, base + C_GATE + 768 + hq * 64, PW, nullptr, 0, smem);
  }
}
DI void combine_c(const Params& p) {
  for (size_t u = (size_t)blockIdx.x * 256 + otid(); u < (size_t)32768 * 32; u += (size_t)gridDim.x * 256) {
    const size_t t = u >> 5; const int h = (int)(u >> 3) & 3, ch = (int)u & 7;
    const float* ls = P_LSE + t * 12 + h;
    float l0 = ls[0], l1 = ls[4], l2 = ls[8];
    float mx = fmaxf(l0, fmaxf(l1, l2));
    float a0 = __builtin_amdgcn_exp2f(l0 - mx), a1 = __builtin_amdgcn_exp2f(l1 - mx), a2 = __builtin_amdgcn_exp2f(l2 - mx);
    float inv = 1.0f / (a0 + a1 + a2); a0 *= inv; a1 *= inv; a2 *= inv;
    const bf16_t* row = P_PROJ + t * PW;
    uint4 x0 = *(const uint4*)(row + C_CQ + h * 64 + ch * 8), x1 = *(const uint4*)(row + C_CQ + 256 + h * 64 + ch * 8),
          x2 = *(const uint4*)(row + C_CQ + 512 + h * 64 + ch * 8);
    bf16_t* gp = P_PROJ + t * PW + C_GATE + 512 + h * 64 + ch * 8;
    uint4 gu = *(const uint4*)gp;
    unsigned xa[4] = {x0.x, x0.y, x0.z, x0.w}, xb[4] = {x1.x, x1.y, x1.z, x1.w}, xc[4] = {x2.x, x2.y, x2.z, x2.w}, gg[4] = {gu.x, gu.y, gu.z, gu.w};
    unsigned ov[4];
#pragma unroll
    for (int e = 0; e < 4; ++e) {
      float ylo = a0 * BLO(xa[e]) + a1 * BLO(xb[e]) + a2 * BLO(xc[e]);
      float yhi = a0 * BHI(xa[e]) + a1 * BHI(xb[e]) + a2 * BHI(xc[e]);
      float glo = BLO(gg[e]), ghi = BHI(gg[e]);
      ov[e] = pack2(ylo * glo / (1.0f + __expf(-glo)), yhi * ghi / (1.0f + __expf(-ghi)));
    }
    uint4 w; w.x = ov[0]; w.y = ov[1]; w.z = ov[2]; w.w = ov[3];
    *(uint4*)gp = w;
  }
}

DI void merge_tile(const Params& p, int l, int tile, char* smem) {
  bf16_t* sA = (bf16_t*)smem; bf16_t* sB = sA + 2 * GST;
  const int mt = tile & 255, nt = tile >> 8;
  unsigned sg[4][8][2];
  {
    f32x4 accG[4][8]; zero_acc8(accG);
    gemm_big(accG, P_XN + (size_t)mt * 128 * 1024, 1024, P_WMT + ((size_t)l * 4096 + nt * 64) * 1024, 1024, 1024, smem, 2048, 32,
             (otid() >> 7) * 1024 + ((otid() >> 2) & 31));
#pragma unroll
    for (int mi = 0; mi < 4; ++mi)
#pragma unroll
      for (int ni = 0; ni < 8; ++ni) {
        float s0 = 1.0f / (1.0f + __expf(-accG[mi][ni][0])), s1 = 1.0f / (1.0f + __expf(-accG[mi][ni][1]));
        float s2 = 1.0f / (1.0f + __expf(-accG[mi][ni][2])), s3 = 1.0f / (1.0f + __expf(-accG[mi][ni][3]));
        sg[mi][ni][0] = pack2(s0, s1); sg[mi][ni][1] = pack2(s2, s3);
      }
  }
  f32x4 accM[4][2]; zero_acc<2>(accM);
#pragma unroll 1
  for (int n = 0; n < 4; ++n) {
    f32x4 accB[4][2]; zero_acc<2>(accB);
    gemm_mainloop<2>(accB, P_PROJ + (size_t)mt * 128 * PW + C_GATE + n * 256, PW, P_WBT + ((size_t)(l * 4 + n) * 1024 + nt * 64) * 256, 256, 256, sA, sB);
#pragma unroll
    for (int mi = 0; mi < 4; ++mi)
#pragma unroll
      for (int ni = 0; ni < 2; ++ni) {
        accM[mi][ni][0] += accB[mi][ni][0] * BLO(sg[mi][ni][0]); accM[mi][ni][1] += accB[mi][ni][1] * BHI(sg[mi][ni][0]);
        accM[mi][ni][2] += accB[mi][ni][2] * BLO(sg[mi][ni][1]); accM[mi][ni][3] += accB[mi][ni][3] * BHI(sg[mi][ni][1]);
      }
#pragma unroll
    for (int mi = 0; mi < 4; ++mi)
#pragma unroll
      for (int k = 0; k < 6; ++k) { sg[mi][k][0] = sg[mi][k + 2][0]; sg[mi][k][1] = sg[mi][k + 2][1]; }
  }
  const int lane = otid() & 63, wid = otid() >> 6, wm = wid >> 1, wn = wid & 1, fr = lane & 15, fq = lane >> 4;
#pragma unroll
  for (int mi = 0; mi < 4; ++mi)
#pragma unroll
    for (int ni = 0; ni < 2; ++ni) {
      size_t row = (size_t)mt * 128 + wm * 64 + mi * 16 + fr; int col = nt * 64 + wn * 32 + ni * 16 + fq * 4;
      uint2 o; o.x = pack2(accM[mi][ni][0], accM[mi][ni][1]); o.y = pack2(accM[mi][ni][2], accM[mi][ni][3]);
      *(uint2*)(P_PROJ + row * PW + C_MERGED + col) = o;
    }
}

DI void outproj_tile(const Params& p, int l, int tile, char* smem) {
  const int mt = tile & 255, nt = tile >> 8;
  f32x4 acc[4][8]; zero_acc8(acc);
  gemm_big(acc, P_PROJ + (size_t)mt * 128 * PW + C_MERGED, PW, P_WOT + ((size_t)l * 1024 + nt * 256) * 1024, 1024, 1024, smem);
  const float* xin = l == 0 ? p.x : p.out;
  const int lane = otid() & 63, wid = otid() >> 6, wm = wid >> 1, wn = wid & 1, fr = lane & 15, fq = lane >> 4;
#pragma unroll
  for (int mi = 0; mi < 4; ++mi)
#pragma unroll
    for (int ni = 0; ni < 8; ++ni) {
      size_t row = (size_t)mt * 128 + wm * 64 + mi * 16 + fr; int col = nt * 256 + wn * 128 + ni * 16 + fq * 4;
      float4 xi = *(const float4*)(xin + row * 1024 + col);
      float4 o; o.x = xi.x + acc[mi][ni][0]; o.y = xi.y + acc[mi][ni][1]; o.z = xi.z + acc[mi][ni][2]; o.w = xi.w + acc[mi][ni][3];
      *(float4*)(p.out + row * 1024 + col) = o;
    }
}


#define XB_TMO      128
#define XB_XCNT(j)  (256  + 64 * (j))
#define XB_XSUB(j)  (1280 + 64 * (j))
#define XB_XGEN(j)  (2304 + 64 * (j))
#define XB_TOP      3328
#define XB_TOPGEN   3392
#define XCD_BAR_WORDS 3456
#define XB_SPIN_CAP (1u << 18)
#define LAS __attribute__((address_space(3)))
DI unsigned xb_ld(unsigned* p)              { return __hip_atomic_load(p, __ATOMIC_RELAXED, __HIP_MEMORY_SCOPE_AGENT); }
DI unsigned xb_add(unsigned* p, unsigned v) { return __hip_atomic_fetch_add(p, v, __ATOMIC_RELAXED, __HIP_MEMORY_SCOPE_AGENT); }
DI unsigned xb_xcc_id() { return (unsigned)__builtin_amdgcn_s_getreg((3 << 11) | 20) & 0xFu; }
#define XB_SPIN(cond, bar) do { unsigned _sp = 0; while (cond) { __builtin_amdgcn_s_sleep(1); \
    if ((++_sp & 255u) == 0u) { if (xb_ld(&(bar)[XB_TMO])) break; if (_sp > XB_SPIN_CAP) { atomicAdd(&(bar)[XB_TMO], 1u); break; } } } } while (0)
struct XcdBarrier { unsigned* bar; unsigned x; volatile LAS unsigned* st; };
DI XcdBarrier xcd_barrier_post(unsigned* bar, volatile LAS unsigned* st) {
  XcdBarrier b; b.bar = bar; b.x = xb_xcc_id(); b.st = st;
  if (threadIdx.x == 0) (void)xb_add(&bar[XB_XCNT(b.x)], 1u);
  return b;
}
DI void xcd_barrier_complete(unsigned* bar, unsigned x, unsigned& nloc, unsigned& nx) {
  const unsigned G = gridDim.x * gridDim.y * gridDim.z;
  unsigned sum, cnt, mine, sp = 0u;
  for (;;) {
    sum = 0u; cnt = 0u; mine = 0u;
#pragma unroll
    for (unsigned j = 0; j < 16; ++j) { const unsigned c = xb_ld(&bar[XB_XCNT(j)]); sum += c; cnt += (c > 0u) ? 1u : 0u; mine = (j == x) ? c : mine; }
    if (sum == G) break;
    __builtin_amdgcn_s_sleep(1);
    if ((++sp & 255u) == 0u) { if (xb_ld(&bar[XB_TMO])) break; if (sp > XB_SPIN_CAP) { atomicAdd(&bar[XB_TMO], 1u); break; } }
  }
  nloc = mine > 0u ? mine : 1u; nx = cnt > 0u ? cnt : 1u;
}
DI void xcd_barrier(const XcdBarrier& b) {
  asm volatile("s_waitcnt vmcnt(0)" ::: "memory");
  __syncthreads();
  if (threadIdx.x == 0) {
    unsigned* bar = b.bar;
    __builtin_amdgcn_s_waitcnt(0);
    unsigned nloc = b.st[0], nx = b.st[1];
    if (nloc == 0u) { xcd_barrier_complete(bar, b.x, nloc, nx); b.st[0] = nloc; b.st[1] = nx; }
    const unsigned old = xb_add(&bar[XB_XSUB(b.x)], 1u);
    const unsigned gen = old / nloc;
    if (old + 1u == (gen + 1u) * nloc) {
      __builtin_amdgcn_fence(__ATOMIC_RELEASE, "agent");
      asm volatile("s_waitcnt vmcnt(0)" ::: "memory");
      const unsigned og = xb_add(&bar[XB_TOP], 1u);
      const unsigned tg = og / nx;
      if (og + 1u == (tg + 1u) * nx) xb_add(&bar[XB_TOPGEN], 1u);
      else XB_SPIN(xb_ld(&bar[XB_TOPGEN]) == tg, bar);
      __builtin_amdgcn_fence(__ATOMIC_ACQUIRE, "agent");
      xb_add(&bar[XB_XGEN(b.x)], 1u);
      asm volatile("s_waitcnt vmcnt(0)" ::: "memory");
    } else {
      XB_SPIN(xb_ld(&bar[XB_XGEN(b.x)]) == gen, bar);
      __builtin_amdgcn_fence(__ATOMIC_ACQUIRE, "agent");
      asm volatile("s_waitcnt vmcnt(0)" ::: "memory");
    }
  }
  __syncthreads();
}

DI void run_phase(const Params& p, int ph, char* smem, bool never) {
  const int G = gridDim.x, B = blockIdx.x;
  if (ph == 0) {
    for (int i = B; i < 6097; i += G) prep_item(p, i, (float*)smem);
    for (int i = B; i < 1024; i += G) norm_rows_bf16(p.x, p.norm_g, P_XN, i);
  } else if (ph == 14) {
    for (int i = B; i < 1024; i += G) norm_rows_f32(p.out, p.final_g, i);
  } else if (ph == 7) {
    for (int i = B; i < 1024; i += G) norm_rows_bf16(p.out, p.norm_g + 1024, P_XN, i);
  } else {
    const int l = ph > 7 ? 1 : 0; const int s = ph > 7 ? ph - 8 : ph - 1;
    const int xcd = B & 7, lb = B >> 3, nl = G >> 3;
    if (s == 0) {
      for (int w = lb; w < 64 * 8 + 96; w += nl) {
        const int it = w >> 6, l64 = w & 63;
        int mt, nt;
        if (it < 8) { const int a = it >> 1, gn = it & 1; mt = 8 * (xcd + 8 * a) + (l64 & 7); nt = 8 * gn + (l64 >> 3); }
        else { const int q = (it - 8) * 64 + l64; const int ml = q / 3; mt = 8 * (xcd + 8 * (ml >> 3)) + (ml & 7); nt = 16 + q % 3; }
        inproj_tile(p, l, nt * 256 + mt, smem);
      }
    }
    else if (s == 1) { for (int i = B; i < 2048; i += G) mla_item(p, l, i, smem); }
    else if (s == 2) {
#ifdef REP_DENSE
      for (int w = lb; w < 256; w += nl) dense_item(p, l, xcd + 8 * (w >> 6), w & 63, smem, never);
#endif
      for (int w = lb; w < 256; w += nl) dense_item(p, l, xcd + 8 * (w >> 6), w & 63, smem, true);
      for (int i = B; i < 4096; i += G) band_item(p, l, i, smem);
    }
    else if (s == 3) { combine_c(p); }
    else if (s == 4) {
      for (int w = lb; w < 64 * 8; w += nl) {
        const int it = w >> 6, l64 = w & 63, a = it >> 1, gn = it & 1;
        const int mt = 8 * (xcd + 8 * a) + (l64 & 7), nt = 8 * gn + (l64 >> 3);
        merge_tile(p, l, nt * 256 + mt, smem);
      }
    }
    else {
      for (int w = lb; w < 64 * 2; w += nl) {
        const int a = w >> 6, l64 = w & 63;
        const int mt = 8 * (xcd + 8 * (2 * a + (l64 >> 5))) + (l64 & 7), nt = (l64 >> 3) & 3;
        outproj_tile(p, l, nt * 256 + mt, smem);
      }
    }
  }
}

__global__ void __launch_bounds__(256, 2) mega(Params p, int ph_lo, int ph_hi) {
  __shared__ __attribute__((aligned(16))) char smem[66048];
  __shared__ uint4 xb_words;
  cg::grid_group grid = cg::this_grid();
  if (threadIdx.x == 0) xb_words = make_uint4(0u, 0u, 0u, 0u);
  __syncthreads();
  XcdBarrier xb = xcd_barrier_post((unsigned*)(p.ws + OFF_BAR), (volatile LAS unsigned*)&xb_words);
  if (ph_hi == 12345) grid.sync();
  for (int ph = ph_lo; ph < ph_hi; ++ph) {
    run_phase(p, ph, smem, ph_hi == 12345);
    if (ph + 1 < ph_hi) xcd_barrier(xb);
  }
}

extern "C" void kernel_launch(void* const* d_in, const int* in_sizes, int n_in, void* d_out, int out_size, void* d_ws,
                              size_t ws_size, hipStream_t stream) {
  Params p{};
  p.x = (const float*)d_in[0]; p.norm_g = (const float*)d_in[1]; p.w_in = (const float*)d_in[2];
  p.q_norm_g = (const float*)d_in[3]; p.kv_norm_g = (const float*)d_in[4]; p.w_q_up = (const float*)d_in[5];
  p.w_kv_up = (const float*)d_in[6]; p.gq_g = (const float*)d_in[7]; p.gk_g = (const float*)d_in[8];
  p.sink = (const float*)d_in[9]; p.t5 = (const float*)d_in[10]; p.w_branch = (const float*)d_in[11];
  p.w_out = (const float*)d_in[12]; p.final_g = (const float*)d_in[13];
  p.out = (float*)d_out;
  p.ws = (char*)d_ws;
  if (WS_NEED > ws_size) { fprintf(stderr, "workspace too small: need %zu have %zu\n", (size_t)WS_NEED, ws_size); return; }

  static int grid_blocks = 0;
  if (!grid_blocks) {
    int dev = 0, cus = 0, per_cu = 0;
    hipGetDevice(&dev);
    hipDeviceGetAttribute(&cus, hipDeviceAttributeMultiprocessorCount, dev);
    hipOccupancyMaxActiveBlocksPerMultiprocessor(&per_cu, mega, 256, 0);
    if (per_cu < 1) per_cu = 1;
    if (per_cu > 2) per_cu = 2;
    grid_blocks = cus * per_cu;
  }
  hipMemsetAsync((char*)d_ws + OFF_BAR, 0, 16384, stream);
  int lo = 0, hi = 15;
  void* args[] = {&p, &lo, &hi};
  hipError_t e = hipLaunchCooperativeKernel((void*)mega, dim3(grid_blocks), dim3(256), args, 0, stream);
  if (e != hipSuccess) fprintf(stderr, "cooperative launch failed: %s (grid %d)\n", hipGetErrorString(e), grid_blocks);
}
```

```cpp
#include <hip/hip_runtime.h>
#include <hip/hip_cooperative_groups.h>
#include <cstdio>
namespace cg = cooperative_groups;

typedef unsigned short bf16_t;
using bf16x8 = __attribute__((ext_vector_type(8))) short;
using f32x4 = __attribute__((ext_vector_type(4))) float;
using u32x4 = __attribute__((ext_vector_type(4))) unsigned;
using f32x16 = __attribute__((ext_vector_type(16))) float;
using bf16x4 = __attribute__((ext_vector_type(4))) short;
#define DI __device__ __forceinline__

constexpr int SEQ = 8192;
constexpr int PW = 4864;
constexpr int C_BQ = 0, C_BK = 256, C_BV = 384, C_CQ = 512, C_CK = 1280, C_CV = 2048, C_DQ = 2816, C_DK = 3072,
              C_DV = 3200, C_GATE = 3328, C_AQ = 4352, C_AKV = 4608, C_AKR = 4736;
constexpr int C_MERGED = 512;

struct Params {
  const float* x; const float* norm_g; const float* w_in; const float* q_norm_g; const float* kv_norm_g;
  const float* w_q_up; const float* w_kv_up; const float* gq_g; const float* gk_g; const float* sink;
  const float* t5; const float* w_branch; const float* w_out; const float* final_g;
  float* out; char* ws;
};
constexpr size_t al256(size_t x) { return (x + 255) & ~(size_t)255; }
constexpr size_t OFF_W1T = 0;
constexpr size_t OFF_WMT = OFF_W1T + al256((size_t)2 * 4864 * 1024 * 2);
constexpr size_t OFF_WOT = OFF_WMT + al256((size_t)2 * 4096 * 1024 * 2);
constexpr size_t OFF_WBT = OFF_WOT + al256((size_t)2 * 1024 * 1024 * 2);
constexpr size_t OFF_WQT = OFF_WBT + al256((size_t)2 * 4 * 1024 * 256 * 2);
constexpr size_t OFF_WKVT = OFF_WQT + al256((size_t)2 * 384 * 256 * 2);
constexpr size_t OFF_ROPE = OFF_WKVT + al256((size_t)2 * 512 * 128 * 2);
constexpr size_t OFF_LUTC = OFF_ROPE + al256((size_t)8192 * 32 * 4);
constexpr size_t OFF_LUTD = OFF_LUTC + 8192;
constexpr size_t OFF_XN = OFF_LUTD + 8192;
constexpr size_t OFF_PROJ = OFF_XN + al256((size_t)32768 * 1024 * 2);
constexpr size_t OFF_QA = OFF_PROJ + al256((size_t)32768 * 4864 * 2);
constexpr size_t OFF_KA = OFF_QA + al256((size_t)32768 * 384 * 2);
constexpr size_t OFF_VA = OFF_KA + al256((size_t)32768 * 384 * 2);
constexpr size_t OFF_LSE = OFF_VA + al256((size_t)32768 * 256 * 2);
constexpr size_t OFF_BAR = OFF_LSE + al256((size_t)32768 * 12 * 4);
constexpr size_t WS_NEED = OFF_BAR + 16384;
#define WSP(T, OFF) ((T*)(p.ws + (OFF)))
#define P_W1T WSP(bf16_t, OFF_W1T)
#define P_WMT WSP(bf16_t, OFF_WMT)
#define P_WOT WSP(bf16_t, OFF_WOT)
#define P_WBT WSP(bf16_t, OFF_WBT)
#define P_WQT WSP(bf16_t, OFF_WQT)
#define P_WKVT WSP(bf16_t, OFF_WKVT)
#define P_ROPE WSP(float, OFF_ROPE)
#define P_LUTC WSP(float, OFF_LUTC)
#define P_LUTD WSP(float, OFF_LUTD)
#define P_XN WSP(bf16_t, OFF_XN)
#define P_PROJ WSP(bf16_t, OFF_PROJ)
#define P_QA WSP(bf16_t, OFF_QA)
#define P_KA WSP(bf16_t, OFF_KA)
#define P_VA WSP(bf16_t, OFF_VA)
#define P_LSE WSP(float, OFF_LSE)


DI unsigned short f2bf(float x) { unsigned u = __float_as_uint(x); u += 0x7fffu + ((u >> 16) & 1u); return (unsigned short)(u >> 16); }
DI float bf2f(unsigned short b) { return __uint_as_float(((unsigned)b) << 16); }
typedef __bf16 bf2_t __attribute__((ext_vector_type(2)));
typedef float f2_t __attribute__((ext_vector_type(2)));
DI unsigned pack2(float a, float b) { f2_t v = {a, b}; bf2_t r = __builtin_convertvector(v, bf2_t); return __builtin_bit_cast(unsigned, r); }
constexpr float LOG2E = 1.4426950408889634f;
constexpr float QS64 = 0.125f * LOG2E;
constexpr float QS96 = 0.10206207261596575f * LOG2E;
#define BLO(u) __uint_as_float((u) << 16)
#define BHI(u) __uint_as_float((u) & 0xffff0000u)
DI int otid() { int t; asm volatile("v_mov_b32 %0, %1" : "=v"(t) : "v"((int)threadIdx.x)); __builtin_assume(t >= 0 && t < 256); return t; }
DI float wave_sum(float v) {
#pragma unroll
  for (int o = 32; o; o >>= 1) v += __shfl_xor(v, o);
  return v;
}

DI int srccol(int mode, int n) {
  if (mode == 0) return n < 4352 ? n + 416 : (n < 4768 ? n - 4352 : -1);
  if (mode == 1) return 4768 + n;
  if (mode == 2) return n;
  return n < 256 ? (n >> 6) * 96 + (n & 63) : ((n - 256) >> 5) * 96 + 64 + ((n - 256) & 31);
}
DI void conv_tile(const float* __restrict__ src, int ld, int K, bf16_t* __restrict__ dst, int n0, int k0, int mode,
                  const float* __restrict__ rs, float* tile) {
  const int tx = otid() & 63, ty = otid() >> 6;
  __syncthreads();
  const int sc = srccol(mode, n0 + tx);
  const int nq = n0 + tx;
  const float cscale = (mode == 0 && ((nq >= C_CQ && nq < C_CQ + 768) || (nq >= C_DQ && nq < C_DQ + 256))) ? QS64 : 1.0f;
#pragma unroll
  for (int i = 0; i < 16; ++i) {
    int kk = ty + 4 * i;
    float v = sc >= 0 ? src[(size_t)(k0 + kk) * ld + sc] : 0.f;
    if (rs) v *= rs[k0 + kk];
    tile[kk * 65 + tx] = v * cscale;
  }
  __syncthreads();
#pragma unroll
  for (int i = 0; i < 16; ++i) {
    int nn = ty + 4 * i;
    dst[(size_t)(n0 + nn) * K + k0 + tx] = f2bf(tile[tx * 65 + nn]);
  }
}

DI int t5_bucket(int rel) {
  int n = rel < 0 ? -rel : rel;
  float nf = (float)(n < 1 ? 1 : n);
  int large = 8 + (int)(logf(nf / 8.0f) / 4.852030263919617f * 8.0f);
  if (large > 15) large = 15;
  return (rel > 0 ? 16 : 0) + (n < 8 ? n : large);
}

DI void prep_item(const Params& p, int item, float* tile) {
  if (item < 5584) {
    int l = item / 2792, r = item % 2792;
    const float* src; int ld, K, mode, t; bf16_t* dst; const float* rs = nullptr;
    if (r < 1216) { t = r; src = p.w_in + (size_t)l * 1024 * 8864; ld = 8864; K = 1024; mode = 0; dst = P_W1T + (size_t)l * 4864 * 1024; }
    else if (r < 2240) { t = r - 1216; src = p.w_in + (size_t)l * 1024 * 8864; ld = 8864; K = 1024; mode = 1; dst = P_WMT + (size_t)l * 4096 * 1024; }
    else if (r < 2496) { t = r - 2240; src = p.w_out + (size_t)l * 1024 * 1024; ld = 1024; K = 1024; mode = 2; dst = P_WOT + (size_t)l * 1024 * 1024; }
    else if (r < 2752) { t = r - 2496; int n = t >> 6; t &= 63; src = p.w_branch + (size_t)(l * 4 + n) * 256 * 1024; ld = 1024; K = 256; mode = 2; dst = P_WBT + (size_t)(l * 4 + n) * 1024 * 256; }
    else if (r < 2776) { t = r - 2752; src = p.w_q_up + (size_t)l * 256 * 384; ld = 384; K = 256; mode = 3; dst = P_WQT + (size_t)l * 384 * 256; rs = p.q_norm_g + l * 256; }
    else { t = r - 2776; src = p.w_kv_up + (size_t)l * 128 * 512; ld = 512; K = 128; mode = 2; dst = P_WKVT + (size_t)l * 512 * 128; rs = p.kv_norm_g + l * 128; }
    int kt = K / 64;
    conv_tile(src, ld, K, dst, (t / kt) * 64, (t % kt) * 64, mode, rs, tile);
  } else if (item < 5584 + 512) {
    int idx = (item - 5584) * 256 + otid();
    int pos = idx >> 4, i = idx & 15;
    double invd = 1.0;
    for (int k = 0; k < i; ++k) invd *= 0.5623413251903491;
    float inv = (float)invd;
    float ang = (float)pos * inv;
    double a = (double)ang;
    double kq = rint(a * 0.15915494309189535);
    double r = a - kq * 6.283185307179586;
    double r2 = r * r, ts = r, tc = 1.0, sn = r, cs = 1.0;
    for (int k = 1; k <= 14; ++k) {
      tc = -tc * r2 / (double)((2 * k - 1) * (2 * k));
      ts = -ts * r2 / (double)((2 * k) * (2 * k + 1));
      cs += tc; sn += ts;
    }
    P_ROPE[pos * 32 + i] = (float)cs;
    P_ROPE[pos * 32 + 16 + i] = (float)sn;
  } else {
    for (int e = otid(); e < 12 * 129; e += 256) {
      int gh = e / 129, off = e % 129 - 64; int g = gh >> 2;
      int r = g == 0 ? 1 : (g == 1 ? 4 : 16);
      P_LUTC[e] = p.t5[t5_bucket(off * r) * 16 + gh] * LOG2E;
    }
    for (int e = otid(); e < 4 * 257; e += 256) {
      int hq = e / 257, off = e % 257 - 128;
      P_LUTD[e] = p.t5[t5_bucket(off) * 16 + 12 + hq] * LOG2E;
    }
  }
}

DI void norm_rows_bf16(const float* __restrict__ src, const float* __restrict__ g, bf16_t* __restrict__ dst, int item) {
  const int lane = otid() & 63, wid = otid() >> 6;
  for (int i = 0; i < 8; ++i) {
    size_t row = (size_t)item * 32 + wid * 8 + i;
    const float4* s = (const float4*)(src + row * 1024);
    float4 v[4]; float ss = 0.f;
#pragma unroll
    for (int j = 0; j < 4; ++j) { v[j] = s[lane + 64 * j]; ss += v[j].x * v[j].x + v[j].y * v[j].y + v[j].z * v[j].z + v[j].w * v[j].w; }
    ss = wave_sum(ss);
    float sc = rsqrtf(ss * (1.0f / 1024.0f) + 1e-6f);
#pragma unroll
    for (int j = 0; j < 4; ++j) {
      float4 gg = ((const float4*)g)[lane + 64 * j];
      uint2 o; o.x = pack2(v[j].x * sc * gg.x, v[j].y * sc * gg.y); o.y = pack2(v[j].z * sc * gg.z, v[j].w * sc * gg.w);
      *(uint2*)(dst + row * 1024 + (lane + 64 * j) * 4) = o;
    }
  }
}
DI void norm_rows_f32(float* io, const float* __restrict__ g, int item) {
  const int lane = otid() & 63, wid = otid() >> 6;
  for (int i = 0; i < 8; ++i) {
    size_t row = (size_t)item * 32 + wid * 8 + i;
    float4* s = (float4*)(io + row * 1024);
    float4 v[4]; float ss = 0.f;
#pragma unroll
    for (int j = 0; j < 4; ++j) { v[j] = s[lane + 64 * j]; ss += v[j].x * v[j].x + v[j].y * v[j].y + v[j].z * v[j].z + v[j].w * v[j].w; }
    ss = wave_sum(ss);
    float sc = rsqrtf(ss * (1.0f / 1024.0f) + 1e-6f);
#pragma unroll
    for (int j = 0; j < 4; ++j) {
      float4 gg = ((const float4*)g)[lane + 64 * j];
      float4 o; o.x = v[j].x * sc * gg.x; o.y = v[j].y * sc * gg.y; o.z = v[j].z * sc * gg.z; o.w = v[j].w * sc * gg.w;
      s[lane + 64 * j] = o;
    }
  }
}

constexpr int LLD = 72;
constexpr int GST = 128 * 64;
template <int NT, bool LOWREG = false>
DI void gemm_mainloop(f32x4 (&acc)[4][NT], const bf16_t* A, int lda, const bf16_t* Bt, int ldb, int K, bf16_t* sA, bf16_t* sB, int bstride = 32) {
  constexpr int NB = NT;
  const int tid = otid(), lane = tid & 63, wid = tid >> 6;
  const int wm = wid >> 1, wn = wid & 1, fr = lane & 15, fq = lane >> 4;
  u32x4 ra[4], rb[NB];
  const int nk = K >> 6;
  const bf16_t* ap = A + (size_t)(tid >> 3) * lda + (tid & 7) * 8;
  const bf16_t* bp = Bt + (size_t)(tid >> 3) * ldb + (tid & 7) * 8;
  const int so = (tid >> 3) * 64 + (((tid & 7) ^ ((tid >> 4) & 7)) * 8);
  const int fsw = fr >> 1;
#define GLOAD(ko) do { \
    _Pragma("unroll") for (int i = 0; i < 4; ++i) ra[i] = *(const u32x4*)(ap + (size_t)(32 * i) * lda + (ko)); \
    _Pragma("unroll") for (int i = 0; i < NB; ++i) rb[i] = *(const u32x4*)(bp + (size_t)(bstride * i) * ldb + (ko)); } while (0)
#define GSTORE(st) do { \
    _Pragma("unroll") for (int i = 0; i < 4; ++i) *(u32x4*)(sA + (st) * GST + so + 32 * i * 64) = ra[i]; \
    _Pragma("unroll") for (int i = 0; i < NB; ++i) *(u32x4*)(sB + (st) * GST + so + 32 * i * 64) = rb[i]; } while (0)
#define GCOMPUTE(st) do { \
    const bf16_t* cA = sA + (st) * GST; const bf16_t* cB = sB + (st) * GST; \
    _Pragma("unroll") for (int ks = 0; ks < 2; ++ks) { \
      bf16x8 af[4], bfr[NT]; \
      _Pragma("unroll") for (int mi = 0; mi < 4; ++mi) af[mi] = *(const bf16x8*)(cA + (wm * 64 + mi * 16 + fr) * 64 + (((ks * 4 + fq) ^ fsw) * 8)); \
      _Pragma("unroll") for (int ni = 0; ni < NT; ++ni) bfr[ni] = *(const bf16x8*)(cB + (wn * NT * 16 + ni * 16 + fr) * 64 + (((ks * 4 + fq) ^ fsw) * 8)); \
      _Pragma("unroll") for (int mi = 0; mi < 4; ++mi) \
        _Pragma("unroll") for (int ni = 0; ni < NT; ++ni) acc[mi][ni] = __builtin_amdgcn_mfma_f32_16x16x32_bf16(bfr[ni], af[mi], acc[mi][ni], 0, 0, 0); \
    } } while (0)
  __syncthreads();
  GLOAD(0); GSTORE(0);
  if (nk > 1) GLOAD(64);
  __syncthreads();
  for (int kt = 0; kt < nk; ++kt) {
    const int cur = kt & 1;
    if (kt + 1 < nk) { GSTORE(cur ^ 1); if (kt + 2 < nk) GLOAD((kt + 2) * 64); }
    if (LOWREG) {
      const bf16_t* cA = sA + cur * GST; const bf16_t* cB = sB + cur * GST;
#pragma nounroll
      for (int ks = 0; ks < 2; ++ks) {
        bf16x8 af[4], bfr[NT];
#pragma unroll
        for (int mi = 0; mi < 4; ++mi) af[mi] = *(const bf16x8*)(cA + (wm * 64 + mi * 16 + fr) * 64 + (((ks * 4 + fq) ^ fsw) * 8));
#pragma unroll
        for (int ni = 0; ni < NT; ++ni) bfr[ni] = *(const bf16x8*)(cB + (wn * NT * 16 + ni * 16 + fr) * 64 + (((ks * 4 + fq) ^ fsw) * 8));
#pragma unroll
        for (int mi = 0; mi < 4; ++mi)
#pragma unroll
          for (int ni = 0; ni < NT; ++ni) acc[mi][ni] = __builtin_amdgcn_mfma_f32_16x16x32_bf16(bfr[ni], af[mi], acc[mi][ni], 0, 0, 0);
      }
    } else GCOMPUTE(cur);
    __syncthreads();
  }
#undef GLOAD
#undef GSTORE
#undef GCOMPUTE
}
template <int NT>
DI void zero_acc(f32x4 (&acc)[4][NT]) {
#pragma unroll
  for (int mi = 0; mi < 4; ++mi)
#pragma unroll
    for (int ni = 0; ni < NT; ++ni) acc[mi][ni] = f32x4{0.f, 0.f, 0.f, 0.f};
}


constexpr int BGA = 128 * 32, BGB = 256 * 32;
DI void gemm_big(f32x4 (&acc)[4][8], const bf16_t* A, int lda, const bf16_t* Bt, int ldb, int K, char* smem, int s1 = 64, int s2 = 128, int brow = -1) {
  bf16_t* sA = (bf16_t*)smem; bf16_t* sB = sA + 2 * BGA;
  const int tid = otid(), lane = tid & 63, wid = tid >> 6;
  const int wm = wid >> 1, wn = wid & 1, fr = lane & 15, fq = lane >> 4;
  const int nk = K >> 5;
  const bf16_t* ap = A + (size_t)(tid >> 2) * lda + (tid & 3) * 8;
  const bf16_t* bp = Bt + (size_t)(brow >= 0 ? brow : (tid >> 2)) * ldb + (tid & 3) * 8;
  const int so = (tid >> 2) * 32 + (((tid & 3) ^ (((tid >> 5) & 1) << 1)) * 8);
  const int fo = fr * 32 + ((fq ^ (((fr >> 3) & 1) << 1)) * 8);
  u32x4 ra[2], rb[4];
#define BLOADG(kt) do { \
    _Pragma("unroll") for (int i = 0; i < 2; ++i) ra[i] = *(const u32x4*)(ap + (size_t)(64 * i) * lda + (kt) * 32); \
    _Pragma("unroll") for (int i = 0; i < 4; ++i) rb[i] = *(const u32x4*)(bp + (size_t)((i & 1) * s1 + (i >> 1) * s2) * ldb + (kt) * 32); } while (0)
#define BSTOREG(st) do { \
    _Pragma("unroll") for (int i = 0; i < 2; ++i) *(u32x4*)(sA + (st) * BGA + so + 64 * i * 32) = ra[i]; \
    _Pragma("unroll") for (int i = 0; i < 4; ++i) *(u32x4*)(sB + (st) * BGB + so + 64 * i * 32) = rb[i]; } while (0)
  __syncthreads();
  BLOADG(0); BSTOREG(0);
  if (nk > 1) BLOADG(1);
  __syncthreads();
  for (int kt = 0; kt < nk; ++kt) {
    const int cur = kt & 1;
    if (kt + 1 < nk) { BSTOREG(cur ^ 1); if (kt + 2 < nk) BLOADG(kt + 2); }
    const bf16_t* cA = sA + cur * BGA + (wm * 64) * 32 + fo; const bf16_t* cB = sB + cur * BGB + (wn * 128) * 32 + fo;
    bf16x8 af[4];
#pragma unroll
    for (int mi = 0; mi < 4; ++mi) af[mi] = *(const bf16x8*)(cA + mi * 16 * 32);
#pragma unroll
    for (int nh = 0; nh < 2; ++nh) {
      bf16x8 bfr[4];
#pragma unroll
      for (int ni = 0; ni < 4; ++ni) bfr[ni] = *(const bf16x8*)(cB + (nh * 4 + ni) * 16 * 32);
#pragma unroll
      for (int mi = 0; mi < 4; ++mi)
#pragma unroll
        for (int ni = 0; ni < 4; ++ni) acc[mi][nh * 4 + ni] = __builtin_amdgcn_mfma_f32_16x16x32_bf16(bfr[ni], af[mi], acc[mi][nh * 4 + ni], 0, 0, 0);
    }
    __syncthreads();
  }
#undef BLOADG
#undef BSTOREG
}
DI void zero_acc8(f32x4 (&acc)[4][8]) {
#pragma unroll
  for (int mi = 0; mi < 4; ++mi)
#pragma unroll
    for (int ni = 0; ni < 8; ++ni) acc[mi][ni] = f32x4{0.f, 0.f, 0.f, 0.f};
}

DI void inproj_tile(const Params& p, int l, int tile, char* smem) {
  const int mt = tile & 255, nt = tile >> 8;
  f32x4 acc[4][8]; zero_acc8(acc);
  gemm_big(acc, P_XN + (size_t)mt * 128 * 1024, 1024, P_W1T + ((size_t)l * 4864 + nt * 256) * 1024, 1024, 1024, smem);
  const int lane = otid() & 63, wid = otid() >> 6, wm = wid >> 1, wn = wid & 1, fr = lane & 15, fq = lane >> 4;
#pragma unroll
  for (int mi = 0; mi < 4; ++mi)
#pragma unroll
    for (int ni = 0; ni < 8; ++ni) {
      size_t row = (size_t)mt * 128 + wm * 64 + mi * 16 + fr; int col = nt * 256 + wn * 128 + ni * 16 + fq * 4;
      uint2 o; o.x = pack2(acc[mi][ni][0], acc[mi][ni][1]); o.y = pack2(acc[mi][ni][2], acc[mi][ni][3]);
      *(uint2*)(P_PROJ + row * PW + col) = o;
    }
}

DI void row_scales(const bf16_t* A, int lda, int K, float* sRow) {
  const int row = otid() >> 1, half = otid() & 1;
  const int per = K >> 1;
  const bf16_t* a = A + (size_t)row * lda + half * per;
  float ss = 0.f;
  for (int c = 0; c < per; c += 8) {
    uint4 u = *(const uint4*)(a + c);
    float f;
    f = BLO(u.x); ss += f * f; f = BHI(u.x); ss += f * f; f = BLO(u.y); ss += f * f; f = BHI(u.y); ss += f * f;
    f = BLO(u.z); ss += f * f; f = BHI(u.z); ss += f * f; f = BLO(u.w); ss += f * f; f = BHI(u.w); ss += f * f;
  }
  ss += __shfl_xor(ss, 1);
  if (half == 0) sRow[row] = rsqrtf(ss / (float)K + 1e-6f);
}
DI void mla_item(const Params& p, int l, int item, char* smem) {
  bf16_t* sA = (bf16_t*)smem; bf16_t* sB = sA + 2 * GST; float* sRow = (float*)(sB + 2 * GST);
  const int lane = otid() & 63, wid = otid() >> 6, wm = wid >> 1, wn = wid & 1, fr = lane & 15, fq = lane >> 4;
  if (item < 768) {
    const int mt = item & 255, nt = item >> 8;
    const bf16_t* A = P_PROJ + (size_t)mt * 128 * PW + C_AQ;
    __syncthreads();
    row_scales(A, PW, 256, sRow);
    f32x4 acc[4][4]; zero_acc<4>(acc);
    gemm_mainloop<4>(acc, A, PW, P_WQT + ((size_t)l * 384 + nt * 128) * 256, 256, 256, sA, sB);
    if (nt < 2) {
#pragma unroll
      for (int mi = 0; mi < 4; ++mi)
#pragma unroll
        for (int ni = 0; ni < 4; ++ni) {
          int rl = wm * 64 + mi * 16 + fr; size_t t = (size_t)mt * 128 + rl; float s = sRow[rl] * QS96;
          int c = nt * 128 + wn * 64 + ni * 16 + fq * 4; int h = c >> 6, d = c & 63;
          uint2 o; o.x = pack2(acc[mi][ni][0] * s, acc[mi][ni][1] * s); o.y = pack2(acc[mi][ni][2] * s, acc[mi][ni][3] * s);
          *(uint2*)(P_QA + t * 384 + h * 96 + d) = o;
        }
    } else {
#pragma unroll
      for (int mi = 0; mi < 4; ++mi)
#pragma unroll
        for (int np = 0; np < 2; ++np) {
          int rl = wm * 64 + mi * 16 + fr; size_t t = (size_t)mt * 128 + rl; float s = sRow[rl] * QS96;
          int pos = (int)(t & (SEQ - 1)); int h = wn * 2 + np;
          const float* cs = P_ROPE + pos * 32 + fq * 4;
          float o1[4], o2[4];
#pragma unroll
          for (int j = 0; j < 4; ++j) {
            float x1 = acc[mi][np * 2][j] * s, x2 = acc[mi][np * 2 + 1][j] * s; float c = cs[j], sn = cs[16 + j];
            o1[j] = x1 * c - x2 * sn; o2[j] = x1 * sn + x2 * c;
          }
          uint2 a; a.x = pack2(o1[0], o1[1]); a.y = pack2(o1[2], o1[3]);
          uint2 b; b.x = pack2(o2[0], o2[1]); b.y = pack2(o2[2], o2[3]);
          *(uint2*)(P_QA + t * 384 + h * 96 + 64 + fq * 4) = a;
          *(uint2*)(P_QA + t * 384 + h * 96 + 80 + fq * 4) = b;
        }
    }
  } else if (item < 768 + 1024) {
    const int it = item - 768; const int mt = it & 255, h = it >> 8;
    const bf16_t* A = P_PROJ + (size_t)mt * 128 * PW + C_AKV;
    __syncthreads();
    row_scales(A, PW, 128, sRow);
    f32x4 acc[4][4]; zero_acc<4>(acc);
    gemm_mainloop<4>(acc, A, PW, P_WKVT + ((size_t)l * 512 + h * 128) * 128, 128, 128, sA, sB);
#pragma unroll
    for (int mi = 0; mi < 4; ++mi)
#pragma unroll
      for (int ni = 0; ni < 4; ++ni) {
        int rl = wm * 64 + mi * 16 + fr; size_t t = (size_t)mt * 128 + rl; float s = sRow[rl];
        int d = ni * 16 + fq * 4;
        uint2 o; o.x = pack2(acc[mi][ni][0] * s, acc[mi][ni][1] * s); o.y = pack2(acc[mi][ni][2] * s, acc[mi][ni][3] * s);
        if (wn == 0) *(uint2*)(P_KA + t * 384 + h * 96 + d) = o;
        else *(uint2*)(P_VA + t * 256 + h * 64 + d) = o;
      }
  } else {
    const int it = item - 1792;
    const int half = lane >> 5, pl = lane & 31;
    for (int i = 0; i < 32; ++i) {
      size_t t = (size_t)it * 128 + wid * 32 + i; int pos = (int)(t & (SEQ - 1));
      bf16_t* row = P_PROJ + t * PW;
#pragma unroll
      for (int s3 = 0; s3 < 3; ++s3) {
        int slot = s3 * 2 + half;
        bf16_t* hp = row + (slot < 4 ? C_BQ + slot * 64 : C_BK + (slot - 4) * 64);
        const float* g = (slot < 4 ? p.gq_g : p.gk_g) + l * 64;
        int d1, fi, ap;
        if (pl < 16) { d1 = pl; fi = pl; ap = pos >> 6; } else { d1 = 32 + (pl - 16); fi = pl - 16; ap = pos & 63; }
        float x1 = bf2f(hp[d1]), x2 = bf2f(hp[d1 + 16]);
        float ss = x1 * x1 + x2 * x2;
#pragma unroll
        for (int o = 16; o; o >>= 1) ss += __shfl_xor(ss, o);
        float sc = rsqrtf(ss * (1.0f / 64.0f) + 1e-6f);
        if (slot < 4) sc *= QS64;
        x1 = x1 * sc * g[d1]; x2 = x2 * sc * g[d1 + 16];
        float c = P_ROPE[ap * 32 + fi], sn = P_ROPE[ap * 32 + 16 + fi];
        hp[d1] = f2bf(x1 * c - x2 * sn); hp[d1 + 16] = f2bf(x1 * sn + x2 * c);
      }
      if (lane < 16) {
        float x1 = bf2f(row[C_AKR + lane]), x2 = bf2f(row[C_AKR + 16 + lane]);
        float c = P_ROPE[pos * 32 + lane], sn = P_ROPE[pos * 32 + 16 + lane];
        bf16_t o1 = f2bf(x1 * c - x2 * sn), o2 = f2bf(x1 * sn + x2 * c);
#pragma unroll
        for (int h = 0; h < 4; ++h) { P_KA[t * 384 + h * 96 + 64 + lane] = o1; P_KA[t * 384 + h * 96 + 80 + lane] = o2; }
      }
    }
  }
}

#define MFMA32(a, b, c) __builtin_amdgcn_mfma_f32_32x32x16_bf16((a), (b), (c), 0, 0, 0)
template <int OFF> DI bf16x4 tr_read(unsigned addr) {
  bf16x4 r; asm volatile("ds_read_b64_tr_b16 %0, %1 offset:%2" : "=&v"(r) : "v"(addr), "i"(OFF) : "memory"); return r;
}
DI float half_swap_max(float v) {
  auto rr = __builtin_amdgcn_permlane32_swap(__float_as_uint(v), __float_as_uint(v), false, false);
  return fmaxf(__uint_as_float(rr[0]), __uint_as_float(rr[1]));
}
DI float half_swap_sum(float v) {
  auto rr = __builtin_amdgcn_permlane32_swap(__float_as_uint(v), __float_as_uint(v), false, false);
  return __uint_as_float(rr[0]) + __uint_as_float(rr[1]);
}
DI bf16x8 pack8(const f32x16& p, int base) {
  u32x4 w = {pack2(p[base + 0], p[base + 1]), pack2(p[base + 2], p[base + 3]), pack2(p[base + 4], p[base + 5]), pack2(p[base + 6], p[base + 7])};
  return __builtin_bit_cast(bf16x8, w);
}
template <int DB, int VLD> DI void pv_block(f32x16& o, unsigned vb, bf16x8 pb0, bf16x8 pb1, bf16x8 pb2, bf16x8 pb3) {
  constexpr int RB = VLD * 2;
  bf16x4 l0 = tr_read<0 * RB + 64 * DB>(vb), h0 = tr_read<8 * RB + 64 * DB>(vb);
  bf16x4 l1 = tr_read<16 * RB + 64 * DB>(vb), h1 = tr_read<24 * RB + 64 * DB>(vb);
  bf16x4 l2 = tr_read<32 * RB + 64 * DB>(vb), h2 = tr_read<40 * RB + 64 * DB>(vb);
  bf16x4 l3 = tr_read<48 * RB + 64 * DB>(vb), h3 = tr_read<56 * RB + 64 * DB>(vb);
  asm volatile("s_waitcnt lgkmcnt(0)" ::: "memory"); __builtin_amdgcn_sched_barrier(0);
  o = MFMA32(__builtin_shufflevector(l0, h0, 0, 1, 2, 3, 4, 5, 6, 7), pb0, o);
  o = MFMA32(__builtin_shufflevector(l1, h1, 0, 1, 2, 3, 4, 5, 6, 7), pb1, o);
  o = MFMA32(__builtin_shufflevector(l2, h2, 0, 1, 2, 3, 4, 5, 6, 7), pb2, o);
  o = MFMA32(__builtin_shufflevector(l3, h3, 0, 1, 2, 3, 4, 5, 6, 7), pb3, o);
}
DI f32x16 splat16(float v) { f32x16 r;
#pragma unroll
  for (int i = 0; i < 16; ++i) r[i] = v;
  return r; }

template <int DQK, bool FIXEDM>
DI void attn_dense_mfma(const bf16_t* Qb, int ldq, const bf16_t* Kb, int ldk, const bf16_t* Vb, int ldv, bf16_t* gate_io, char* smem, bool store, float mbound) {
  constexpr int NS = DQK / 16, KLD = DQK + 8, VLD = 96, CPR = DQK / 8, NKC = (64 * CPR) / 256;
  constexpr int KBYTES = 64 * KLD * 2, VBYTES = 64 * VLD * 2;
  char* sKc = smem; char* sVc = smem + 2 * KBYTES;
  const int tid = otid(), lane = tid & 63, wid = tid >> 6, r = lane & 31, h = lane >> 5;
  bf16x8 qf[NS];
#pragma unroll
  for (int s = 0; s < NS; ++s) qf[s] = *(const bf16x8*)(Qb + (size_t)(wid * 32 + r) * ldq + 16 * s + 8 * h);
  const bf16_t* kp = Kb + (size_t)(tid >> 2) * ldk + (tid & 3) * (NKC * 8);
  const int kso = ((tid >> 2) * KLD + (tid & 3) * (NKC * 8)) * 2;
  const bf16_t* vp0 = Vb + (size_t)(tid >> 3) * ldv + (tid & 7) * 8;
  const bf16_t* vp1 = vp0 + (size_t)32 * ldv;
  const int vso = ((tid >> 3) * VLD + (tid & 7) * 8) * 2;
  const size_t kstep = (size_t)64 * ldk, vstep = (size_t)64 * ldv;
  u32x4 rk[NKC], rv[2];
#define KLOAD() do { _Pragma("unroll") for (int i = 0; i < NKC; ++i) rk[i] = *(const u32x4*)(kp + i * 8); kp += kstep; } while (0)
#define VLOAD() do { rv[0] = *(const u32x4*)vp0; rv[1] = *(const u32x4*)vp1; vp0 += vstep; vp1 += vstep; } while (0)
#define KSTORE(st) do { _Pragma("unroll") for (int i = 0; i < NKC; ++i) *(u32x4*)(sKc + (st) * KBYTES + kso + i * 16) = rk[i]; } while (0)
#define VSTORE(st) do { *(u32x4*)(sVc + (st) * VBYTES + vso) = rv[0]; *(u32x4*)(sVc + (st) * VBYTES + vso + 32 * VLD * 2) = rv[1]; } while (0)
#define QKT(P0, P1, st) do { \
    const bf16_t* sK = (const bf16_t*)(sKc + (st) * KBYTES) + r * KLD + 8 * h; \
    P0 = negm; P1 = negm; \
    _Pragma("unroll") for (int s = 0; s < NS; ++s) { \
      bf16x8 k0 = *(const bf16x8*)(sK + 16 * s); bf16x8 k1 = *(const bf16x8*)(sK + 32 * KLD + 16 * s); \
      P0 = MFMA32(k0, qf[s], P0); P1 = MFMA32(k1, qf[s], P1); } } while (0)
  const unsigned vb0 = (unsigned)(size_t)sVc + (unsigned)(((4 * h + ((lane & 15) >> 2)) * VLD + 16 * ((lane >> 4) & 1) + 4 * (lane & 3)) * 2);
  f32x16 o0 = splat16(0.f), o1 = splat16(0.f), negm = splat16(FIXEDM ? -mbound : 0.f);
  f32x16 pa0, pa1, pc0, pc1;
  float m_run = 0.f, l_run = 0.f;
  constexpr int NT = SEQ / 64;
  __syncthreads();
  KLOAD(); VLOAD(); KSTORE(0); VSTORE(0);
  KLOAD(); KSTORE(1);
  __syncthreads();
  QKT(pa0, pa1, 0);
  __syncthreads();
#define STEP(SC0, SC1, SN0, SN1, PAR, FIRST, LK, LV) do { \
    if (LK) KLOAD(); \
    if (LV) VLOAD(); \
    float pm = 0.f; \
    if (!FIXEDM) { pm = fmaxf(SC0[0], SC1[0]); \
    _Pragma("unroll") for (int i = 1; i < 16; i += 1) pm = fmaxf(fmaxf(pm, SC0[i]), SC1[i]); \
    pm = half_swap_max(pm); } \
    if (!FIXEDM && ((FIRST) || __any(pm > 8.0f))) { \
      float delta; \
      if (FIRST) delta = pm; \
      else { delta = fmaxf(pm, 0.f); float alpha = __builtin_amdgcn_exp2f(-delta); l_run *= alpha; \
        _Pragma("unroll") for (int i = 0; i < 16; ++i) { o0[i] *= alpha; o1[i] *= alpha; } } \
      m_run += delta; \
      _Pragma("unroll") for (int i = 0; i < 16; ++i) { SC0[i] -= delta; SC1[i] -= delta; } \
      negm = splat16(-m_run); \
    } \
    if (LV) QKT(SN0, SN1, (PAR) ^ 1); \
    float ls = 0.f; \
    _Pragma("unroll") for (int i = 0; i < 16; ++i) { SC0[i] = __builtin_amdgcn_exp2f(SC0[i]); SC1[i] = __builtin_amdgcn_exp2f(SC1[i]); ls += SC0[i] + SC1[i]; } \
    l_run += ls; \
    bf16x8 pb0 = pack8(SC0, 0), pb1 = pack8(SC0, 8), pb2 = pack8(SC1, 0), pb3 = pack8(SC1, 8); \
    const unsigned vb = vb0 + (PAR) * VBYTES; \
    pv_block<0, VLD>(o0, vb, pb0, pb1, pb2, pb3); \
    pv_block<1, VLD>(o1, vb, pb0, pb1, pb2, pb3); \
    if (LK) KSTORE(PAR); \
    if (LV) VSTORE((PAR) ^ 1); \
    __syncthreads(); } while (0)
  pc0 = negm; pc1 = negm;
  STEP(pa0, pa1, pc0, pc1, 0, true, 1, 1);
  STEP(pc0, pc1, pa0, pa1, 1, false, 1, 1);
  for (int j = 2; j < NT - 2; j += 2) {
    STEP(pa0, pa1, pc0, pc1, 0, false, 1, 1);
    STEP(pc0, pc1, pa0, pa1, 1, false, 1, 1);
  }
  STEP(pa0, pa1, pc0, pc1, 0, false, 0, 1);
  STEP(pc0, pc1, pa0, pa1, 1, false, 0, 0);
#undef STEP
#undef QKT
#undef KLOAD
#undef VLOAD
#undef KSTORE
#undef VSTORE
  if (!store) return;
  const float inv = 1.0f / half_swap_sum(l_run);
  bf16_t* grow = gate_io + (size_t)(wid * 32 + r) * PW;
#pragma unroll
  for (int db = 0; db < 2; ++db)
#pragma unroll
    for (int g4 = 0; g4 < 4; ++g4) {
      bf16_t* gp = grow + 32 * db + 8 * g4 + 4 * h;
      uint2 u = *(const uint2*)gp;
      float g[4] = {BLO(u.x), BHI(u.x), BLO(u.y), BHI(u.y)};
      float y[4];
#pragma unroll
      for (int e = 0; e < 4; ++e) { float ov = db == 0 ? o0[4 * g4 + e] : o1[4 * g4 + e]; y[e] = ov * inv * g[e] / (1.0f + __expf(-g[e])); }
      uint2 w; w.x = pack2(y[0], y[1]); w.y = pack2(y[2], y[3]);
      *(uint2*)gp = w;
    }
}
DI void dense_item(const Params& p, int l, int combo, int qblk, char* smem, bool store) {
  const int br = combo >> 4, bh = combo & 15, b = bh >> 2, h = bh & 3;
  const size_t t0 = (size_t)b * SEQ + qblk * 128;
  bf16_t* gate_io = P_PROJ + t0 * PW + C_GATE + br * 256 + h * 64;
  float bbound = 0.f;
  if (br != 0) {
    const int ln = otid() & 63;
    float gq = fabsf(p.gq_g[l * 64 + ln]), gk = fabsf(p.gk_g[l * 64 + ln]);
#pragma unroll
    for (int o = 32; o; o >>= 1) { gq = fmaxf(gq, __shfl_xor(gq, o)); gk = fmaxf(gk, __shfl_xor(gk, o)); }
    bbound = 64.0f * QS64 * 1.02f * gq * gk + 0.05f;
  }
  if (br == 0)
    attn_dense_mfma<96, false>(P_QA + t0 * 384 + h * 96, 384, P_KA + (size_t)b * SEQ * 384 + h * 96, 384, P_VA + (size_t)b * SEQ * 256 + h * 64, 256, gate_io, smem, store, 0.f);
  else {
    if (bbound <= 60.0f) attn_dense_mfma<64, true>(P_PROJ + t0 * PW + C_BQ + h * 64, PW, P_PROJ + (size_t)b * SEQ * PW + C_BK + (h >> 1) * 64, PW,
                        P_PROJ + (size_t)b * SEQ * PW + C_BV + (h >> 1) * 64, PW, gate_io, smem, store, bbound);
    else attn_dense_mfma<64, false>(P_PROJ + t0 * PW + C_BQ + h * 64, PW, P_PROJ + (size_t)b * SEQ * PW + C_BK + (h >> 1) * 64, PW,
                        P_PROJ + (size_t)b * SEQ * PW + C_BV + (h >> 1) * 64, PW, gate_io, smem, store, bbound);
  }
}

template <int W, bool SINK>
DI void attn_band_mfma(const bf16_t* Qb, size_t ldq, const bf16_t* Kb, const bf16_t* Vb, size_t ldk, int L, int i0,
                       const float* lut_g, float sink2, bf16_t* outp, size_t ldo, float* lse_out, size_t ldl, char* smem) {
  constexpr int NS = 4, KLD = 72, VLD = 96, NTW = (128 + 2 * W) / 64, LUTN = 2 * W + 1;
  constexpr int KBYTES = 64 * KLD * 2, VBYTES = 64 * VLD * 2;
  char* sKc = smem; char* sVc = smem + 2 * KBYTES; float* sLut = (float*)(smem + 2 * KBYTES + 2 * VBYTES);
  const int tid = otid(), lane = tid & 63, wid = tid >> 6, r = lane & 31, h = lane >> 5;
  __syncthreads();
  for (int e = tid; e < LUTN; e += 256) sLut[e] = lut_g[e];
  const int qi = i0 + wid * 32 + r;
  bf16x8 qf[NS];
#pragma unroll
  for (int s = 0; s < NS; ++s) qf[s] = *(const bf16x8*)(Qb + (size_t)qi * ldq + 16 * s + 8 * h);
  const int srow = tid >> 3, scc = tid & 7;
  u32x4 rk[2], rv[2];
#define BLOAD(k0) do { \
    rk[0] = *(const u32x4*)(Kb + (size_t)((k0) + srow) * ldk + scc * 8); rk[1] = *(const u32x4*)(Kb + (size_t)((k0) + srow + 32) * ldk + scc * 8); \
    rv[0] = *(const u32x4*)(Vb + (size_t)((k0) + srow) * ldk + scc * 8); rv[1] = *(const u32x4*)(Vb + (size_t)((k0) + srow + 32) * ldk + scc * 8); } while (0)
#define BSTORE(st) do { \
    *(u32x4*)(sKc + (st) * KBYTES + (srow * KLD + scc * 8) * 2) = rk[0]; *(u32x4*)(sKc + (st) * KBYTES + ((srow + 32) * KLD + scc * 8) * 2) = rk[1]; \
    *(u32x4*)(sVc + (st) * VBYTES + (srow * VLD + scc * 8) * 2) = rv[0]; *(u32x4*)(sVc + (st) * VBYTES + ((srow + 32) * VLD + scc * 8) * 2) = rv[1]; } while (0)
  const unsigned vb0 = (unsigned)(size_t)sVc + (unsigned)(((4 * h + ((lane & 15) >> 2)) * VLD + 16 * ((lane >> 4) & 1) + 4 * (lane & 3)) * 2);
  f32x16 o0 = splat16(0.f), o1 = splat16(0.f);
  float m_run = SINK ? sink2 : 0.f, l_run = (SINK && h == 0) ? 1.f : 0.f;
  bool seen = SINK;
  f32x16 negm = splat16(-m_run);
  const int lo = (i0 == 0) ? W / 64 : 0, hi = (i0 + 128 >= L) ? NTW - W / 64 : NTW;
  BLOAD(i0 - W + 64 * lo); BSTORE(0);
  __syncthreads();
  for (int j = lo; j < hi; ++j) {
    const int cur = (j - lo) & 1, k0 = i0 - W + 64 * j;
    if (j + 1 < hi) BLOAD(k0 + 64);
    const bf16_t* sK = (const bf16_t*)(sKc + cur * KBYTES);
    f32x16 p0 = negm, p1 = negm;
#pragma unroll
    for (int s = 0; s < NS; ++s) {
      bf16x8 k0f = *(const bf16x8*)(sK + r * KLD + 16 * s + 8 * h);
      bf16x8 k1f = *(const bf16x8*)(sK + (32 + r) * KLD + 16 * s + 8 * h);
      p0 = MFMA32(k0f, qf[s], p0);
      p1 = MFMA32(k1f, qf[s], p1);
    }
    const int offb = k0 + 4 * h - qi + W;
    float pm = -1e30f;
#pragma unroll
    for (int i = 0; i < 16; ++i) {
      int idx0 = offb + (i & 3) + 8 * (i >> 2), idx1 = idx0 + 32;
      int c0 = min(max(idx0, 0), 2 * W), c1 = min(max(idx1, 0), 2 * W);
      float b0 = sLut[c0], b1 = sLut[c1];
      p0[i] = ((unsigned)idx0 <= (unsigned)(2 * W)) ? p0[i] + b0 : -1e30f;
      p1[i] = ((unsigned)idx1 <= (unsigned)(2 * W)) ? p1[i] + b1 : -1e30f;
      pm = fmaxf(pm, fmaxf(p0[i], p1[i]));
    }
    pm = half_swap_max(pm);
    const bool has = pm > -1e29f;
    float delta = 0.f;
    if (has) { if (!seen) delta = pm; else if (pm > 8.0f) delta = pm; }
    if (__any(delta != 0.f)) {
      float alpha = seen ? __builtin_amdgcn_exp2f(-delta) : 1.0f;
      l_run *= alpha; m_run += delta;
#pragma unroll
      for (int i = 0; i < 16; ++i) { o0[i] *= alpha; o1[i] *= alpha; p0[i] -= delta; p1[i] -= delta; }
      negm = splat16(-m_run);
    }
    seen = seen || has;
    float ls = 0.f;
#pragma unroll
    for (int i = 0; i < 16; ++i) { p0[i] = __builtin_amdgcn_exp2f(p0[i]); p1[i] = __builtin_amdgcn_exp2f(p1[i]); ls += p0[i] + p1[i]; }
    l_run += ls;
    bf16x8 pb0 = pack8(p0, 0), pb1 = pack8(p0, 8), pb2 = pack8(p1, 0), pb3 = pack8(p1, 8);
    const unsigned vb = vb0 + cur * VBYTES;
    pv_block<0, VLD>(o0, vb, pb0, pb1, pb2, pb3);
    pv_block<1, VLD>(o1, vb, pb0, pb1, pb2, pb3);
    if (j + 1 < hi) BSTORE(cur ^ 1);
    __syncthreads();
  }
#undef BLOAD
#undef BSTORE
  const float ltot = half_swap_sum(l_run);
  const float inv = 1.0f / ltot;
  bf16_t* orow = outp + (size_t)qi * ldo;
  if (!SINK && h == 0) lse_out[(size_t)qi * ldl] = m_run + __log2f(ltot);
#pragma unroll
  for (int db = 0; db < 2; ++db)
#pragma unroll
    for (int g4 = 0; g4 < 4; ++g4) {
      bf16_t* gp = orow + 32 * db + 8 * g4 + 4 * h;
      float y[4];
      if (SINK) {
        uint2 u = *(const uint2*)gp;
        float g[4] = {BLO(u.x), BHI(u.x), BLO(u.y), BHI(u.y)};
#pragma unroll
        for (int e = 0; e < 4; ++e) { float ov = db == 0 ? o0[4 * g4 + e] : o1[4 * g4 + e]; y[e] = ov * inv * g[e] / (1.0f + __expf(-g[e])); }
      } else {
#pragma unroll
        for (int e = 0; e < 4; ++e) { float ov = db == 0 ? o0[4 * g4 + e] : o1[4 * g4 + e]; y[e] = ov * inv; }
      }
      uint2 w; w.x = pack2(y[0], y[1]); w.y = pack2(y[2], y[3]);
      *(uint2*)gp = w;
    }
}
DI void band_item(const Params& p, int l, int idx, char* smem) {
  if (idx < 3072) {
    const int g = idx >> 10, rem = idx & 1023, h = rem & 3, rem2 = rem >> 2, b = rem2 >> 6, u = rem2 & 63;
    const int sh = 2 * g, rr = 1 << sh;
    const int rho = u & (rr - 1), qblk = u >> sh;
    const size_t tok0 = (size_t)b * SEQ + rho;
    bf16_t* base = P_PROJ + tok0 * PW + g * 256 + h * 64;
    attn_band_mfma<64, false>(base + C_CQ, (size_t)rr * PW, base + C_CK, base + C_CV, (size_t)rr * PW, SEQ >> sh, qblk * 128,
                              P_LUTC + (g * 4 + h) * 129, 0.f, base + C_CQ, (size_t)rr * PW, P_LSE + tok0 * 12 + g * 4 + h, (size_t)rr * 12, smem);
  } else {
    const int it = idx - 3072, hq = it & 3, rem = it >> 2, b = rem >> 6, qblk = rem & 63;
    bf16_t* base = P_PROJ + (size_t)b * SEQ * PW;
    attn_band_mfma<128, true>(base + C_DQ + hq * 64, PW, base + C_DK + (hq >> 1) * 64, base + C_DV + (hq >> 1) * 64, PW, SEQ, qblk * 128,
                              P_LUTD + hq * 257, p.sink[l * 4 + hq] * LOG2E, base + C_GATE + 768 + hq * 64, PW, nullptr, 0, smem);
  }
}
DI void combine_c(const Params& p) {
  for (size_t u = (size_t)blockIdx.x * 256 + otid(); u < (size_t)32768 * 32; u += (size_t)gridDim.x * 256) {
    const size_t t = u >> 5; const int h = (int)(u >> 3) & 3, ch = (int)u & 7;
    const float* ls = P_LSE + t * 12 + h;
    float l0 = ls[0], l1 = ls[4], l2 = ls[8];
    float mx = fmaxf(l0, fmaxf(l1, l2));
    float a0 = __builtin_amdgcn_exp2f(l0 - mx), a1 = __builtin_amdgcn_exp2f(l1 - mx), a2 = __builtin_amdgcn_exp2f(l2 - mx);
    float inv = 1.0f / (a0 + a1 + a2); a0 *= inv; a1 *= inv; a2 *= inv;
    const bf16_t* row = P_PROJ + t * PW;
    uint4 x0 = *(const uint4*)(row + C_CQ + h * 64 + ch * 8), x1 = *(const uint4*)(row + C_CQ + 256 + h * 64 + ch * 8),
          x2 = *(const uint4*)(row + C_CQ + 512 + h * 64 + ch * 8);
    bf16_t* gp = P_PROJ + t * PW + C_GATE + 512 + h * 64 + ch * 8;
    uint4 gu = *(const uint4*)gp;
    unsigned xa[4] = {x0.x, x0.y, x0.z, x0.w}, xb[4] = {x1.x, x1.y, x1.z, x1.w}, xc[4] = {x2.x, x2.y, x2.z, x2.w}, gg[4] = {gu.x, gu.y, gu.z, gu.w};
    unsigned ov[4];
#pragma unroll
    for (int e = 0; e < 4; ++e) {
      float ylo = a0 * BLO(xa[e]) + a1 * BLO(xb[e]) + a2 * BLO(xc[e]);
      float yhi = a0 * BHI(xa[e]) + a1 * BHI(xb[e]) + a2 * BHI(xc[e]);
      float glo = BLO(gg[e]), ghi = BHI(gg[e]);
      ov[e] = pack2(ylo * glo / (1.0f + __expf(-glo)), yhi * ghi / (1.0f + __expf(-ghi)));
    }
    uint4 w; w.x = ov[0]; w.y = ov[1]; w.z = ov[2]; w.w = ov[3];
    *(uint4*)gp = w;
  }
}

DI void merge_tile(const Params& p, int l, int tile, char* smem) {
  bf16_t* sA = (bf16_t*)smem; bf16_t* sB = sA + 2 * GST;
  const int mt = tile & 255, nt = tile >> 8;
  unsigned sg[4][8][2];
  {
    f32x4 accG[4][8]; zero_acc8(accG);
    gemm_big(accG, P_XN + (size_t)mt * 128 * 1024, 1024, P_WMT + ((size_t)l * 4096 + nt * 64) * 1024, 1024, 1024, smem, 2048, 32,
             (otid() >> 7) * 1024 + ((otid() >> 2) & 31));
#pragma unroll
    for (int mi = 0; mi < 4; ++mi)
#pragma unroll
      for (int ni = 0; ni < 8; ++ni) {
        float s0 = 1.0f / (1.0f + __expf(-accG[mi][ni][0])), s1 = 1.0f / (1.0f + __expf(-accG[mi][ni][1]));
        float s2 = 1.0f / (1.0f + __expf(-accG[mi][ni][2])), s3 = 1.0f / (1.0f + __expf(-accG[mi][ni][3]));
        sg[mi][ni][0] = pack2(s0, s1); sg[mi][ni][1] = pack2(s2, s3);
      }
  }
  f32x4 accM[4][2]; zero_acc<2>(accM);
#pragma unroll 1
  for (int n = 0; n < 4; ++n) {
    f32x4 accB[4][2]; zero_acc<2>(accB);
    gemm_mainloop<2>(accB, P_PROJ + (size_t)mt * 128 * PW + C_GATE + n * 256, PW, P_WBT + ((size_t)(l * 4 + n) * 1024 + nt * 64) * 256, 256, 256, sA, sB);
#pragma unroll
    for (int mi = 0; mi < 4; ++mi)
#pragma unroll
      for (int ni = 0; ni < 2; ++ni) {
        accM[mi][ni][0] += accB[mi][ni][0] * BLO(sg[mi][ni][0]); accM[mi][ni][1] += accB[mi][ni][1] * BHI(sg[mi][ni][0]);
        accM[mi][ni][2] += accB[mi][ni][2] * BLO(sg[mi][ni][1]); accM[mi][ni][3] += accB[mi][ni][3] * BHI(sg[mi][ni][1]);
      }
#pragma unroll
    for (int mi = 0; mi < 4; ++mi)
#pragma unroll
      for (int k = 0; k < 6; ++k) { sg[mi][k][0] = sg[mi][k + 2][0]; sg[mi][k][1] = sg[mi][k + 2][1]; }
  }
  const int lane = otid() & 63, wid = otid() >> 6, wm = wid >> 1, wn = wid & 1, fr = lane & 15, fq = lane >> 4;
#pragma unroll
  for (int mi = 0; mi < 4; ++mi)
#pragma unroll
    for (int ni = 0; ni < 2; ++ni) {
      size_t row = (size_t)mt * 128 + wm * 64 + mi * 16 + fr; int col = nt * 64 + wn * 32 + ni * 16 + fq * 4;
      uint2 o; o.x = pack2(accM[mi][ni][0], accM[mi][ni][1]); o.y = pack2(accM[mi][ni][2], accM[mi][ni][3]);
      *(uint2*)(P_PROJ + row * PW + C_MERGED + col) = o;
    }
}

DI void outproj_tile(const Params& p, int l, int tile, char* smem) {
  const int mt = tile & 255, nt = tile >> 8;
  f32x4 acc[4][8]; zero_acc8(acc);
  gemm_big(acc, P_PROJ + (size_t)mt * 128 * PW + C_MERGED, PW, P_WOT + ((size_t)l * 1024 + nt * 256) * 1024, 1024, 1024, smem);
  const float* xin = l == 0 ? p.x : p.out;
  const int lane = otid() & 63, wid = otid() >> 6, wm = wid >> 1, wn = wid & 1, fr = lane & 15, fq = lane >> 4;
#pragma unroll
  for (int mi = 0; mi < 4; ++mi)
#pragma unroll
    for (int ni = 0; ni < 8; ++ni) {
      size_t row = (size_t)mt * 128 + wm * 64 + mi * 16 + fr; int col = nt * 256 + wn * 128 + ni * 16 + fq * 4;
      float4 xi = *(const float4*)(xin + row * 1024 + col);
      float4 o; o.x = xi.x + acc[mi][ni][0]; o.y = xi.y + acc[mi][ni][1]; o.z = xi.z + acc[mi][ni][2]; o.w = xi.w + acc[mi][ni][3];
      *(float4*)(p.out + row * 1024 + col) = o;
    }
}


#define XB_TMO      128
#define XB_XCNT(j)  (256  + 64 * (j))
#define XB_XSUB(j)  (1280 + 64 * (j))
#define XB_XGEN(j)  (2304 + 64 * (j))
#define XB_TOP      3328
#define XB_TOPGEN   3392
#define XCD_BAR_WORDS 3456
#define XB_SPIN_CAP (1u << 22)
#define LAS __attribute__((address_space(3)))
DI unsigned xb_ld(unsigned* p)              { return __hip_atomic_load(p, __ATOMIC_RELAXED, __HIP_MEMORY_SCOPE_AGENT); }
DI unsigned xb_add(unsigned* p, unsigned v) { return __hip_atomic_fetch_add(p, v, __ATOMIC_RELAXED, __HIP_MEMORY_SCOPE_AGENT); }
DI unsigned xb_xcc_id() { return (unsigned)__builtin_amdgcn_s_getreg((3 << 11) | 20) & 0xFu; }
#define XB_SPIN(cond, bar) do { unsigned _sp = 0; while (cond) { __builtin_amdgcn_s_sleep(1); \
    if ((++_sp & 255u) == 0u) { if (xb_ld(&(bar)[XB_TMO])) break; if (_sp > XB_SPIN_CAP) { atomicAdd(&(bar)[XB_TMO], 1u); break; } } } } while (0)
struct XcdBarrier { unsigned* bar; unsigned x; volatile LAS unsigned* st; };
DI XcdBarrier xcd_barrier_post(unsigned* bar, volatile LAS unsigned* st) {
  XcdBarrier b; b.bar = bar; b.x = xb_xcc_id(); b.st = st;
  if (threadIdx.x == 0) (void)xb_add(&bar[XB_XCNT(b.x)], 1u);
  return b;
}
DI void xcd_barrier_complete(unsigned* bar, unsigned x, unsigned& nloc, unsigned& nx) {
  const unsigned G = gridDim.x * gridDim.y * gridDim.z;
  unsigned sum, cnt, mine, sp = 0u;
  for (;;) {
    sum = 0u; cnt = 0u; mine = 0u;
#pragma unroll
    for (unsigned j = 0; j < 16; ++j) { const unsigned c = xb_ld(&bar[XB_XCNT(j)]); sum += c; cnt += (c > 0u) ? 1u : 0u; mine = (j == x) ? c : mine; }
    if (sum == G) break;
    __builtin_amdgcn_s_sleep(1);
    if ((++sp & 255u) == 0u) { if (xb_ld(&bar[XB_TMO])) break; if (sp > XB_SPIN_CAP) { atomicAdd(&bar[XB_TMO], 1u); break; } }
  }
  nloc = mine > 0u ? mine : 1u; nx = cnt > 0u ? cnt : 1u;
}
DI void xcd_barrier(const XcdBarrier& b) {
  asm volatile("s_waitcnt vmcnt(0)" ::: "memory");
  __syncthreads();
  if (threadIdx.x == 0) {
    unsigned* bar = b.bar;
    __builtin_amdgcn_s_waitcnt(0);
    unsigned nloc = b.st[0], nx = b.st[1];
    if (nloc == 0u) { xcd_barrier_complete(bar, b.x, nloc, nx); b.st[0] = nloc; b.st[1] = nx; }
    const unsigned old = xb_add(&bar[XB_XSUB(b.x)], 1u);
    const unsigned gen = old / nloc;
    if (old + 1u == (gen + 1u) * nloc) {
      __builtin_amdgcn_fence(__ATOMIC_RELEASE, "agent");
      asm volatile("s_waitcnt vmcnt(0)" ::: "memory");
      const unsigned og = xb_add(&bar[XB_TOP], 1u);
      const unsigned tg = og / nx;
      if (og + 1u == (tg + 1u) * nx) xb_add(&bar[XB_TOPGEN], 1u);
      else XB_SPIN(xb_ld(&bar[XB_TOPGEN]) == tg, bar);
      __builtin_amdgcn_fence(__ATOMIC_ACQUIRE, "agent");
      xb_add(&bar[XB_XGEN(b.x)], 1u);
      asm volatile("s_waitcnt vmcnt(0)" ::: "memory");
    } else {
      XB_SPIN(xb_ld(&bar[XB_XGEN(b.x)]) == gen, bar);
      __builtin_amdgcn_fence(__ATOMIC_ACQUIRE, "agent");
      asm volatile("s_waitcnt vmcnt(0)" ::: "memory");
    }
  }
  __syncthreads();
}

DI void run_phase(const Params& p, int ph, char* smem, bool never) {
  const int G = gridDim.x, B = blockIdx.x;
  if (ph == 0) {
    for (int i = B; i < 6097; i += G) prep_item(p, i, (float*)smem);
    for (int i = B; i < 1024; i += G) norm_rows_bf16(p.x, p.norm_g, P_XN, i);
  } else if (ph == 14) {
    for (int i = B; i < 1024; i += G) norm_rows_f32(p.out, p.final_g, i);
  } else if (ph == 7) {
    for (int i = B; i < 1024; i += G) norm_rows_bf16(p.out, p.norm_g + 1024, P_XN, i);
  } else {
    const int l = ph > 7 ? 1 : 0; const int s = ph > 7 ? ph - 8 : ph - 1;
    const int xcd = B & 7, lb = B >> 3, nl = G >> 3;
    if (s == 0) {
      for (int w = lb; w < 64 * 8 + 96; w += nl) {
        const int it = w >> 6, l64 = w & 63;
        int mt, nt;
        if (it < 8) { const int a = it >> 1, gn = it & 1; mt = 8 * (xcd + 8 * a) + (l64 & 7); nt = 8 * gn + (l64 >> 3); }
        else { const int q = (it - 8) * 64 + l64; const int ml = q / 3; mt = 8 * (xcd + 8 * (ml >> 3)) + (ml & 7); nt = 16 + q % 3; }
        inproj_tile(p, l, nt * 256 + mt, smem);
      }
    }
    else if (s == 1) { for (int i = B; i < 2048; i += G) mla_item(p, l, i, smem); }
    else if (s == 2) {
#ifdef REP_DENSE
      for (int w = lb; w < 256; w += nl) dense_item(p, l, xcd + 8 * (w >> 6), w & 63, smem, never);
#endif
      for (int w = lb; w < 256; w += nl) dense_item(p, l, xcd + 8 * (w >> 6), w & 63, smem, true);
      for (int i = B; i < 4096; i += G) band_item(p, l, i, smem);
    }
    else if (s == 3) { combine_c(p); }
    else if (s == 4) {
      for (int w = lb; w < 64 * 8; w += nl) {
        const int it = w >> 6, l64 = w & 63, a = it >> 1, gn = it & 1;
        const int mt = 8 * (xcd + 8 * a) + (l64 & 7), nt = 8 * gn + (l64 >> 3);
        merge_tile(p, l, nt * 256 + mt, smem);
      }
    }
    else {
      for (int w = lb; w < 64 * 2; w += nl) {
        const int a = w >> 6, l64 = w & 63;
        const int mt = 8 * (xcd + 8 * (2 * a + (l64 >> 5))) + (l64 & 7), nt = (l64 >> 3) & 3;
        outproj_tile(p, l, nt * 256 + mt, smem);
      }
    }
  }
}

__global__ void __launch_bounds__(256, 2) mega(Params p, int ph_lo, int ph_hi) {
  __shared__ __attribute__((aligned(16))) char smem[66048];
  __shared__ uint4 xb_words;
  cg::grid_group grid = cg::this_grid();
  if (threadIdx.x == 0) xb_words = make_uint4(0u, 0u, 0u, 0u);
  __syncthreads();
  XcdBarrier xb = xcd_barrier_post((unsigned*)(p.ws + OFF_BAR), (volatile LAS unsigned*)&xb_words);
  if (ph_hi == 12345) grid.sync();
  for (int ph = ph_lo; ph < ph_hi; ++ph) {
    run_phase(p, ph, smem, ph_hi == 12345);
    if (ph + 1 < ph_hi) xcd_barrier(xb);
  }
}

extern "C" void kernel_launch(void* const* d_in, const int* in_sizes, int n_in, void* d_out, int out_size, void* d_ws,
                              size_t ws_size, hipStream_t stream) {
  Params p{};
  p.x = (const float*)d_in[0]; p.norm_g = (const float*)d_in[1]; p.w_in = (const float*)d_in[2];
  p.q_norm_g = (const float*)d_in[3]; p.kv_norm_g = (const float*)d_in[4]; p.w_q_up = (const float*)d_in[5];
  p.w_kv_up = (const float*)d_in[6]; p.gq_g = (const float*)d_in[7]; p.gk_g = (const float*)d_in[8];
  p.sink = (const float*)d_in[9]; p.t5 = (const float*)d_in[10]; p.w_branch = (const float*)d_in[11];
  p.w_out = (const float*)d_in[12]; p.final_g = (const float*)d_in[13];
  p.out = (float*)d_out;
  p.ws = (char*)d_ws;
  if (WS_NEED > ws_size) { fprintf(stderr, "workspace too small: need %zu have %zu\n", (size_t)WS_NEED, ws_size); return; }

  static int grid_blocks = 0;
  if (!grid_blocks) {
    int dev = 0, cus = 0, per_cu = 0;
    hipGetDevice(&dev);
    hipDeviceGetAttribute(&cus, hipDeviceAttributeMultiprocessorCount, dev);
    hipOccupancyMaxActiveBlocksPerMultiprocessor(&per_cu, mega, 256, 0);
    if (per_cu < 1) per_cu = 1;
    if (per_cu > 2) per_cu = 2;
    grid_blocks = cus * per_cu;
  }
  hipMemsetAsync((char*)d_ws + OFF_BAR, 0, 16384, stream);
  int lo = 0, hi = 15;
  void* args[] = {&p, &lo, &hi};
  hipError_t e = hipLaunchCooperativeKernel((void*)mega, dim3(grid_blocks), dim3(256), args, 0, stream);
  if (e != hipSuccess) fprintf(stderr, "cooperative launch failed: %s (grid %d)\n", hipGetErrorString(e), grid_blocks);
}
```

```cpp
#include <hip/hip_runtime.h>
#include <hip/hip_cooperative_groups.h>
#include <cstdio>
namespace cg = cooperative_groups;

typedef unsigned short bf16_t;
using bf16x8 = __attribute__((ext_vector_type(8))) short;
using f32x4 = __attribute__((ext_vector_type(4))) float;
using u32x4 = __attribute__((ext_vector_type(4))) unsigned;
using f32x16 = __attribute__((ext_vector_type(16))) float;
using bf16x4 = __attribute__((ext_vector_type(4))) short;
#define DI __device__ __forceinline__

constexpr int SEQ = 8192;
constexpr int PW = 4864;
constexpr int C_BQ = 0, C_BK = 256, C_BV = 384, C_CQ = 512, C_CK = 1280, C_CV = 2048, C_DQ = 2816, C_DK = 3072,
              C_DV = 3200, C_GATE = 3328, C_AQ = 4352, C_AKV = 4608, C_AKR = 4736;
constexpr int C_MERGED = 512;

struct Params {
  const float* x; const float* norm_g; const float* w_in; const float* q_norm_g; const float* kv_norm_g;
  const float* w_q_up; const float* w_kv_up; const float* gq_g; const float* gk_g; const float* sink;
  const float* t5; const float* w_branch; const float* w_out; const float* final_g;
  float* out; char* ws;
};
constexpr size_t al256(size_t x) { return (x + 255) & ~(size_t)255; }
constexpr size_t OFF_W1T = 0;
constexpr size_t OFF_WMT = OFF_W1T + al256((size_t)2 * 4864 * 1024 * 2);
constexpr size_t OFF_WOT = OFF_WMT + al256((size_t)2 * 4096 * 1024 * 2);
constexpr size_t OFF_WBT = OFF_WOT + al256((size_t)2 * 1024 * 1024 * 2);
constexpr size_t OFF_WQT = OFF_WBT + al256((size_t)2 * 4 * 1024 * 256 * 2);
constexpr size_t OFF_WKVT = OFF_WQT + al256((size_t)2 * 384 * 256 * 2);
constexpr size_t OFF_ROPE = OFF_WKVT + al256((size_t)2 * 512 * 128 * 2);
constexpr size_t OFF_LUTC = OFF_ROPE + al256((size_t)8192 * 32 * 4);
constexpr size_t OFF_LUTD = OFF_LUTC + 8192;
constexpr size_t OFF_XN = OFF_LUTD + 8192;
constexpr size_t OFF_PROJ = OFF_XN + al256((size_t)32768 * 1024 * 2);
constexpr size_t OFF_QA = OFF_PROJ + al256((size_t)32768 * 4864 * 2);
constexpr size_t OFF_KA = OFF_QA + al256((size_t)32768 * 384 * 2);
constexpr size_t OFF_VA = OFF_KA + al256((size_t)32768 * 384 * 2);
constexpr size_t OFF_LSE = OFF_VA + al256((size_t)32768 * 256 * 2);
constexpr size_t OFF_BAR = OFF_LSE + al256((size_t)32768 * 12 * 4);
constexpr size_t WS_NEED = OFF_BAR + 16384;
#define WSP(T, OFF) ((T*)(p.ws + (OFF)))
#define P_W1T WSP(bf16_t, OFF_W1T)
#define P_WMT WSP(bf16_t, OFF_WMT)
#define P_WOT WSP(bf16_t, OFF_WOT)
#define P_WBT WSP(bf16_t, OFF_WBT)
#define P_WQT WSP(bf16_t, OFF_WQT)
#define P_WKVT WSP(bf16_t, OFF_WKVT)
#define P_ROPE WSP(float, OFF_ROPE)
#define P_LUTC WSP(float, OFF_LUTC)
#define P_LUTD WSP(float, OFF_LUTD)
#define P_XN WSP(bf16_t, OFF_XN)
#define P_PROJ WSP(bf16_t, OFF_PROJ)
#define P_QA WSP(bf16_t, OFF_QA)
#define P_KA WSP(bf16_t, OFF_KA)
#define P_VA WSP(bf16_t, OFF_VA)
#define P_LSE WSP(float, OFF_LSE)


DI unsigned short f2bf(float x) { unsigned u = __float_as_uint(x); u += 0x7fffu + ((u >> 16) & 1u); return (unsigned short)(u >> 16); }
DI float bf2f(unsigned short b) { return __uint_as_float(((unsigned)b) << 16); }
typedef __bf16 bf2_t __attribute__((ext_vector_type(2)));
typedef float f2_t __attribute__((ext_vector_type(2)));
DI unsigned pack2(float a, float b) { f2_t v = {a, b}; bf2_t r = __builtin_convertvector(v, bf2_t); return __builtin_bit_cast(unsigned, r); }
constexpr float LOG2E = 1.4426950408889634f;
constexpr float QS64 = 0.125f * LOG2E;
constexpr float QS96 = 0.10206207261596575f * LOG2E;
#define BLO(u) __uint_as_float((u) << 16)
#define BHI(u) __uint_as_float((u) & 0xffff0000u)
DI int otid() { int t; asm volatile("v_mov_b32 %0, %1" : "=v"(t) : "v"((int)threadIdx.x)); __builtin_assume(t >= 0 && t < 256); return t; }
DI float wave_sum(float v) {
#pragma unroll
  for (int o = 32; o; o >>= 1) v += __shfl_xor(v, o);
  return v;
}

DI int srccol(int mode, int n) {
  if (mode == 0) return n < 4352 ? n + 416 : (n < 4768 ? n - 4352 : -1);
  if (mode == 1) return 4768 + n;
  if (mode == 2) return n;
  return n < 256 ? (n >> 6) * 96 + (n & 63) : ((n - 256) >> 5) * 96 + 64 + ((n - 256) & 31);
}
DI void conv_tile(const float* __restrict__ src, int ld, int K, bf16_t* __restrict__ dst, int n0, int k0, int mode,
                  const float* __restrict__ rs, float* tile) {
  const int tx = otid() & 63, ty = otid() >> 6;
  __syncthreads();
  const int sc = srccol(mode, n0 + tx);
  const int nq = n0 + tx;
  const float cscale = (mode == 0 && ((nq >= C_CQ && nq < C_CQ + 768) || (nq >= C_DQ && nq < C_DQ + 256))) ? QS64 : 1.0f;
#pragma unroll
  for (int i = 0; i < 16; ++i) {
    int kk = ty + 4 * i;
    float v = sc >= 0 ? src[(size_t)(k0 + kk) * ld + sc] : 0.f;
    if (rs) v *= rs[k0 + kk];
    tile[kk * 65 + tx] = v * cscale;
  }
  __syncthreads();
#pragma unroll
  for (int i = 0; i < 16; ++i) {
    int nn = ty + 4 * i;
    dst[(size_t)(n0 + nn) * K + k0 + tx] = f2bf(tile[tx * 65 + nn]);
  }
}

DI int t5_bucket(int rel) {
  int n = rel < 0 ? -rel : rel;
  float nf = (float)(n < 1 ? 1 : n);
  int large = 8 + (int)(logf(nf / 8.0f) / 4.852030263919617f * 8.0f);
  if (large > 15) large = 15;
  return (rel > 0 ? 16 : 0) + (n < 8 ? n : large);
}

DI void prep_item(const Params& p, int item, float* tile) {
  if (item < 5584) {
    int l = item / 2792, r = item % 2792;
    const float* src; int ld, K, mode, t; bf16_t* dst; const float* rs = nullptr;
    if (r < 1216) { t = r; src = p.w_in + (size_t)l * 1024 * 8864; ld = 8864; K = 1024; mode = 0; dst = P_W1T + (size_t)l * 4864 * 1024; }
    else if (r < 2240) { t = r - 1216; src = p.w_in + (size_t)l * 1024 * 8864; ld = 8864; K = 1024; mode = 1; dst = P_WMT + (size_t)l * 4096 * 1024; }
    else if (r < 2496) { t = r - 2240; src = p.w_out + (size_t)l * 1024 * 1024; ld = 1024; K = 1024; mode = 2; dst = P_WOT + (size_t)l * 1024 * 1024; }
    else if (r < 2752) { t = r - 2496; int n = t >> 6; t &= 63; src = p.w_branch + (size_t)(l * 4 + n) * 256 * 1024; ld = 1024; K = 256; mode = 2; dst = P_WBT + (size_t)(l * 4 + n) * 1024 * 256; }
    else if (r < 2776) { t = r - 2752; src = p.w_q_up + (size_t)l * 256 * 384; ld = 384; K = 256; mode = 3; dst = P_WQT + (size_t)l * 384 * 256; rs = p.q_norm_g + l * 256; }
    else { t = r - 2776; src = p.w_kv_up + (size_t)l * 128 * 512; ld = 512; K = 128; mode = 2; dst = P_WKVT + (size_t)l * 512 * 128; rs = p.kv_norm_g + l * 128; }
    int kt = K / 64;
    conv_tile(src, ld, K, dst, (t / kt) * 64, (t % kt) * 64, mode, rs, tile);
  } else if (item < 5584 + 512) {
    int idx = (item - 5584) * 256 + otid();
    int pos = idx >> 4, i = idx & 15;
    double invd = 1.0;
    for (int k = 0; k < i; ++k) invd *= 0.5623413251903491;
    float inv = (float)invd;
    float ang = (float)pos * inv;
    double a = (double)ang;
    double kq = rint(a * 0.15915494309189535);
    double r = a - kq * 6.283185307179586;
    double r2 = r * r, ts = r, tc = 1.0, sn = r, cs = 1.0;
    for (int k = 1; k <= 14; ++k) {
      tc = -tc * r2 / (double)((2 * k - 1) * (2 * k));
      ts = -ts * r2 / (double)((2 * k) * (2 * k + 1));
      cs += tc; sn += ts;
    }
    P_ROPE[pos * 32 + i] = (float)cs;
    P_ROPE[pos * 32 + 16 + i] = (float)sn;
  } else {
    for (int e = otid(); e < 12 * 129; e += 256) {
      int gh = e / 129, off = e % 129 - 64; int g = gh >> 2;
      int r = g == 0 ? 1 : (g == 1 ? 4 : 16);
      P_LUTC[e] = p.t5[t5_bucket(off * r) * 16 + gh] * LOG2E;
    }
    for (int e = otid(); e < 4 * 257; e += 256) {
      int hq = e / 257, off = e % 257 - 128;
      P_LUTD[e] = p.t5[t5_bucket(off) * 16 + 12 + hq] * LOG2E;
    }
  }
}

DI void norm_rows_bf16(const float* __restrict__ src, const float* __restrict__ g, bf16_t* __restrict__ dst, int item) {
  const int lane = otid() & 63, wid = otid() >> 6;
  for (int i = 0; i < 8; ++i) {
    size_t row = (size_t)item * 32 + wid * 8 + i;
    const float4* s = (const float4*)(src + row * 1024);
    float4 v[4]; float ss = 0.f;
#pragma unroll
    for (int j = 0; j < 4; ++j) { v[j] = s[lane + 64 * j]; ss += v[j].x * v[j].x + v[j].y * v[j].y + v[j].z * v[j].z + v[j].w * v[j].w; }
    ss = wave_sum(ss);
    float sc = rsqrtf(ss * (1.0f / 1024.0f) + 1e-6f);
#pragma unroll
    for (int j = 0; j < 4; ++j) {
      float4 gg = ((const float4*)g)[lane + 64 * j];
      uint2 o; o.x = pack2(v[j].x * sc * gg.x, v[j].y * sc * gg.y); o.y = pack2(v[j].z * sc * gg.z, v[j].w * sc * gg.w);
      *(uint2*)(dst + row * 1024 + (lane + 64 * j) * 4) = o;
    }
  }
}
DI void norm_rows_f32(float* io, const float* __restrict__ g, int item) {
  const int lane = otid() & 63, wid = otid() >> 6;
  for (int i = 0; i < 8; ++i) {
    size_t row = (size_t)item * 32 + wid * 8 + i;
    float4* s = (float4*)(io + row * 1024);
    float4 v[4]; float ss = 0.f;
#pragma unroll
    for (int j = 0; j < 4; ++j) { v[j] = s[lane + 64 * j]; ss += v[j].x * v[j].x + v[j].y * v[j].y + v[j].z * v[j].z + v[j].w * v[j].w; }
    ss = wave_sum(ss);
    float sc = rsqrtf(ss * (1.0f / 1024.0f) + 1e-6f);
#pragma unroll
    for (int j = 0; j < 4; ++j) {
      float4 gg = ((const float4*)g)[lane + 64 * j];
      float4 o; o.x = v[j].x * sc * gg.x; o.y = v[j].y * sc * gg.y; o.z = v[j].z * sc * gg.z; o.w = v[j].w * sc * gg.w;
      s[lane + 64 * j] = o;
    }
  }
}

constexpr int LLD = 72;
constexpr int GST = 128 * 64;
template <int NT, bool LOWREG = false>
DI void gemm_mainloop(f32x4 (&acc)[4][NT], const bf16_t* A, int lda, const bf16_t* Bt, int ldb, int K, bf16_t* sA, bf16_t* sB, int bstride = 32) {
  constexpr int NB = NT;
  const int tid = otid(), lane = tid & 63, wid = tid >> 6;
  const int wm = wid >> 1, wn = wid & 1, fr = lane & 15, fq = lane >> 4;
  u32x4 ra[4], rb[NB];
  const int nk = K >> 6;
  const bf16_t* ap = A + (size_t)(tid >> 3) * lda + (tid & 7) * 8;
  const bf16_t* bp = Bt + (size_t)(tid >> 3) * ldb + (tid & 7) * 8;
  const int so = (tid >> 3) * 64 + (((tid & 7) ^ ((tid >> 4) & 7)) * 8);
  const int fsw = fr >> 1;
#define GLOAD(ko) do { \
    _Pragma("unroll") for (int i = 0; i < 4; ++i) ra[i] = *(const u32x4*)(ap + (size_t)(32 * i) * lda + (ko)); \
    _Pragma("unroll") for (int i = 0; i < NB; ++i) rb[i] = *(const u32x4*)(bp + (size_t)(bstride * i) * ldb + (ko)); } while (0)
#define GSTORE(st) do { \
    _Pragma("unroll") for (int i = 0; i < 4; ++i) *(u32x4*)(sA + (st) * GST + so + 32 * i * 64) = ra[i]; \
    _Pragma("unroll") for (int i = 0; i < NB; ++i) *(u32x4*)(sB + (st) * GST + so + 32 * i * 64) = rb[i]; } while (0)
#define GCOMPUTE(st) do { \
    const bf16_t* cA = sA + (st) * GST; const bf16_t* cB = sB + (st) * GST; \
    _Pragma("unroll") for (int ks = 0; ks < 2; ++ks) { \
      bf16x8 af[4], bfr[NT]; \
      _Pragma("unroll") for (int mi = 0; mi < 4; ++mi) af[mi] = *(const bf16x8*)(cA + (wm * 64 + mi * 16 + fr) * 64 + (((ks * 4 + fq) ^ fsw) * 8)); \
      _Pragma("unroll") for (int ni = 0; ni < NT; ++ni) bfr[ni] = *(const bf16x8*)(cB + (wn * NT * 16 + ni * 16 + fr) * 64 + (((ks * 4 + fq) ^ fsw) * 8)); \
      _Pragma("unroll") for (int mi = 0; mi < 4; ++mi) \
        _Pragma("unroll") for (int ni = 0; ni < NT; ++ni) acc[mi][ni] = __builtin_amdgcn_mfma_f32_16x16x32_bf16(bfr[ni], af[mi], acc[mi][ni], 0, 0, 0); \
    } } while (0)
  __syncthreads();
  GLOAD(0); GSTORE(0);
  if (nk > 1) GLOAD(64);
  __syncthreads();
  for (int kt = 0; kt < nk; ++kt) {
    const int cur = kt & 1;
    if (kt + 1 < nk) { GSTORE(cur ^ 1); if (kt + 2 < nk) GLOAD((kt + 2) * 64); }
    if (LOWREG) {
      const bf16_t* cA = sA + cur * GST; const bf16_t* cB = sB + cur * GST;
#pragma nounroll
      for (int ks = 0; ks < 2; ++ks) {
        bf16x8 af[4], bfr[NT];
#pragma unroll
        for (int mi = 0; mi < 4; ++mi) af[mi] = *(const bf16x8*)(cA + (wm * 64 + mi * 16 + fr) * 64 + (((ks * 4 + fq) ^ fsw) * 8));
#pragma unroll
        for (int ni = 0; ni < NT; ++ni) bfr[ni] = *(const bf16x8*)(cB + (wn * NT * 16 + ni * 16 + fr) * 64 + (((ks * 4 + fq) ^ fsw) * 8));
#pragma unroll
        for (int mi = 0; mi < 4; ++mi)
#pragma unroll
          for (int ni = 0; ni < NT; ++ni) acc[mi][ni] = __builtin_amdgcn_mfma_f32_16x16x32_bf16(bfr[ni], af[mi], acc[mi][ni], 0, 0, 0);
      }
    } else GCOMPUTE(cur);
    __syncthreads();
  }
#undef GLOAD
#undef GSTORE
#undef GCOMPUTE
}
template <int NT>
DI void zero_acc(f32x4 (&acc)[4][NT]) {
#pragma unroll
  for (int mi = 0; mi < 4; ++mi)
#pragma unroll
    for (int ni = 0; ni < NT; ++ni) acc[mi][ni] = f32x4{0.f, 0.f, 0.f, 0.f};
}


constexpr int BGA = 128 * 32, BGB = 256 * 32;
DI void gemm_big(f32x4 (&acc)[4][8], const bf16_t* A, int lda, const bf16_t* Bt, int ldb, int K, char* smem, int s1 = 64, int s2 = 128, int brow = -1) {
  bf16_t* sA = (bf16_t*)smem; bf16_t* sB = sA + 2 * BGA;
  const int tid = otid(), lane = tid & 63, wid = tid >> 6;
  const int wm = wid >> 1, wn = wid & 1, fr = lane & 15, fq = lane >> 4;
  const int nk = K >> 5;
  const bf16_t* ap = A + (size_t)(tid >> 2) * lda + (tid & 3) * 8;
  const bf16_t* bp = Bt + (size_t)(brow >= 0 ? brow : (tid >> 2)) * ldb + (tid & 3) * 8;
  const int so = (tid >> 2) * 32 + (((tid & 3) ^ (((tid >> 5) & 1) << 1)) * 8);
  const int fo = fr * 32 + ((fq ^ (((fr >> 3) & 1) << 1)) * 8);
  u32x4 ra[2], rb[4];
#define BLOADG(kt) do { \
    _Pragma("unroll") for (int i = 0; i < 2; ++i) ra[i] = *(const u32x4*)(ap + (size_t)(64 * i) * lda + (kt) * 32); \
    _Pragma("unroll") for (int i = 0; i < 4; ++i) rb[i] = *(const u32x4*)(bp + (size_t)((i & 1) * s1 + (i >> 1) * s2) * ldb + (kt) * 32); } while (0)
#define BSTOREG(st) do { \
    _Pragma("unroll") for (int i = 0; i < 2; ++i) *(u32x4*)(sA + (st) * BGA + so + 64 * i * 32) = ra[i]; \
    _Pragma("unroll") for (int i = 0; i < 4; ++i) *(u32x4*)(sB + (st) * BGB + so + 64 * i * 32) = rb[i]; } while (0)
  __syncthreads();
  BLOADG(0); BSTOREG(0);
  if (nk > 1) BLOADG(1);
  __syncthreads();
  for (int kt = 0; kt < nk; ++kt) {
    const int cur = kt & 1;
    if (kt + 1 < nk) { BSTOREG(cur ^ 1); if (kt + 2 < nk) BLOADG(kt + 2); }
    const bf16_t* cA = sA + cur * BGA + (wm * 64) * 32 + fo; const bf16_t* cB = sB + cur * BGB + (wn * 128) * 32 + fo;
    bf16x8 af[4];
#pragma unroll
    for (int mi = 0; mi < 4; ++mi) af[mi] = *(const bf16x8*)(cA + mi * 16 * 32);
#pragma unroll
    for (int nh = 0; nh < 2; ++nh) {
      bf16x8 bfr[4];
#pragma unroll
      for (int ni = 0; ni < 4; ++ni) bfr[ni] = *(const bf16x8*)(cB + (nh * 4 + ni) * 16 * 32);
#pragma unroll
      for (int mi = 0; mi < 4; ++mi)
#pragma unroll
        for (int ni = 0; ni < 4; ++ni) acc[mi][nh * 4 + ni] = __builtin_amdgcn_mfma_f32_16x16x32_bf16(bfr[ni], af[mi], acc[mi][nh * 4 + ni], 0, 0, 0);
    }
    __syncthreads();
  }
#undef BLOADG
#undef BSTOREG
}
DI void zero_acc8(f32x4 (&acc)[4][8]) {
#pragma unroll
  for (int mi = 0; mi < 4; ++mi)
#pragma unroll
    for (int ni = 0; ni < 8; ++ni) acc[mi][ni] = f32x4{0.f, 0.f, 0.f, 0.f};
}

DI void inproj_tile(const Params& p, int l, int tile, char* smem) {
  const int mt = tile & 255, nt = tile >> 8;
  f32x4 acc[4][8]; zero_acc8(acc);
  gemm_big(acc, P_XN + (size_t)mt * 128 * 1024, 1024, P_W1T + ((size_t)l * 4864 + nt * 256) * 1024, 1024, 1024, smem);
  const int lane = otid() & 63, wid = otid() >> 6, wm = wid >> 1, wn = wid & 1, fr = lane & 15, fq = lane >> 4;
#pragma unroll
  for (int mi = 0; mi < 4; ++mi)
#pragma unroll
    for (int ni = 0; ni < 8; ++ni) {
      size_t row = (size_t)mt * 128 + wm * 64 + mi * 16 + fr; int col = nt * 256 + wn * 128 + ni * 16 + fq * 4;
      uint2 o; o.x = pack2(acc[mi][ni][0], acc[mi][ni][1]); o.y = pack2(acc[mi][ni][2], acc[mi][ni][3]);
      *(uint2*)(P_PROJ + row * PW + col) = o;
    }
}

DI void row_scales(const bf16_t* A, int lda, int K, float* sRow) {
  const int row = otid() >> 1, half = otid() & 1;
  const int per = K >> 1;
  const bf16_t* a = A + (size_t)row * lda + half * per;
  float ss = 0.f;
  for (int c = 0; c < per; c += 8) {
    uint4 u = *(const uint4*)(a + c);
    float f;
    f = BLO(u.x); ss += f * f; f = BHI(u.x); ss += f * f; f = BLO(u.y); ss += f * f; f = BHI(u.y); ss += f * f;
    f = BLO(u.z); ss += f * f; f = BHI(u.z); ss += f * f; f = BLO(u.w); ss += f * f; f = BHI(u.w); ss += f * f;
  }
  ss += __shfl_xor(ss, 1);
  if (half == 0) sRow[row] = rsqrtf(ss / (float)K + 1e-6f);
}
DI void mla_item(const Params& p, int l, int item, char* smem) {
  bf16_t* sA = (bf16_t*)smem; bf16_t* sB = sA + 2 * GST; float* sRow = (float*)(sB + 2 * GST);
  const int lane = otid() & 63, wid = otid() >> 6, wm = wid >> 1, wn = wid & 1, fr = lane & 15, fq = lane >> 4;
  if (item < 768) {
    const int mt = item & 255, nt = item >> 8;
    const bf16_t* A = P_PROJ + (size_t)mt * 128 * PW + C_AQ;
    __syncthreads();
    row_scales(A, PW, 256, sRow);
    f32x4 acc[4][4]; zero_acc<4>(acc);
    gemm_mainloop<4>(acc, A, PW, P_WQT + ((size_t)l * 384 + nt * 128) * 256, 256, 256, sA, sB);
    if (nt < 2) {
#pragma unroll
      for (int mi = 0; mi < 4; ++mi)
#pragma unroll
        for (int ni = 0; ni < 4; ++ni) {
          int rl = wm * 64 + mi * 16 + fr; size_t t = (size_t)mt * 128 + rl; float s = sRow[rl] * QS96;
          int c = nt * 128 + wn * 64 + ni * 16 + fq * 4; int h = c >> 6, d = c & 63;
          uint2 o; o.x = pack2(acc[mi][ni][0] * s, acc[mi][ni][1] * s); o.y = pack2(acc[mi][ni][2] * s, acc[mi][ni][3] * s);
          *(uint2*)(P_QA + t * 384 + h * 96 + d) = o;
        }
    } else {
#pragma unroll
      for (int mi = 0; mi < 4; ++mi)
#pragma unroll
        for (int np = 0; np < 2; ++np) {
          int rl = wm * 64 + mi * 16 + fr; size_t t = (size_t)mt * 128 + rl; float s = sRow[rl] * QS96;
          int pos = (int)(t & (SEQ - 1)); int h = wn * 2 + np;
          const float* cs = P_ROPE + pos * 32 + fq * 4;
          float o1[4], o2[4];
#pragma unroll
          for (int j = 0; j < 4; ++j) {
            float x1 = acc[mi][np * 2][j] * s, x2 = acc[mi][np * 2 + 1][j] * s; float c = cs[j], sn = cs[16 + j];
            o1[j] = x1 * c - x2 * sn; o2[j] = x1 * sn + x2 * c;
          }
          uint2 a; a.x = pack2(o1[0], o1[1]); a.y = pack2(o1[2], o1[3]);
          uint2 b; b.x = pack2(o2[0], o2[1]); b.y = pack2(o2[2], o2[3]);
          *(uint2*)(P_QA + t * 384 + h * 96 + 64 + fq * 4) = a;
          *(uint2*)(P_QA + t * 384 + h * 96 + 80 + fq * 4) = b;
        }
    }
  } else if (item < 768 + 1024) {
    const int it = item - 768; const int mt = it & 255, h = it >> 8;
    const bf16_t* A = P_PROJ + (size_t)mt * 128 * PW + C_AKV;
    __syncthreads();
    row_scales(A, PW, 128, sRow);
    f32x4 acc[4][4]; zero_acc<4>(acc);
    gemm_mainloop<4>(acc, A, PW, P_WKVT + ((size_t)l * 512 + h * 128) * 128, 128, 128, sA, sB);
#pragma unroll
    for (int mi = 0; mi < 4; ++mi)
#pragma unroll
      for (int ni = 0; ni < 4; ++ni) {
        int rl = wm * 64 + mi * 16 + fr; size_t t = (size_t)mt * 128 + rl; float s = sRow[rl];
        int d = ni * 16 + fq * 4;
        uint2 o; o.x = pack2(acc[mi][ni][0] * s, acc[mi][ni][1] * s); o.y = pack2(acc[mi][ni][2] * s, acc[mi][ni][3] * s);
        if (wn == 0) *(uint2*)(P_KA + t * 384 + h * 96 + d) = o;
        else *(uint2*)(P_VA + t * 256 + h * 64 + d) = o;
      }
  } else {
    const int it = item - 1792;
    const int half = lane >> 5, pl = lane & 31;
    for (int i = 0; i < 32; ++i) {
      size_t t = (size_t)it * 128 + wid * 32 + i; int pos = (int)(t & (SEQ - 1));
      bf16_t* row = P_PROJ + t * PW;
#pragma unroll
      for (int s3 = 0; s3 < 3; ++s3) {
        int slot = s3 * 2 + half;
        bf16_t* hp = row + (slot < 4 ? C_BQ + slot * 64 : C_BK + (slot - 4) * 64);
        const float* g = (slot < 4 ? p.gq_g : p.gk_g) + l * 64;
        int d1, fi, ap;
        if (pl < 16) { d1 = pl; fi = pl; ap = pos >> 6; } else { d1 = 32 + (pl - 16); fi = pl - 16; ap = pos & 63; }
        float x1 = bf2f(hp[d1]), x2 = bf2f(hp[d1 + 16]);
        float ss = x1 * x1 + x2 * x2;
#pragma unroll
        for (int o = 16; o; o >>= 1) ss += __shfl_xor(ss, o);
        float sc = rsqrtf(ss * (1.0f / 64.0f) + 1e-6f);
        if (slot < 4) sc *= QS64;
        x1 = x1 * sc * g[d1]; x2 = x2 * sc * g[d1 + 16];
        float c = P_ROPE[ap * 32 + fi], sn = P_ROPE[ap * 32 + 16 + fi];
        hp[d1] = f2bf(x1 * c - x2 * sn); hp[d1 + 16] = f2bf(x1 * sn + x2 * c);
      }
      if (lane < 16) {
        float x1 = bf2f(row[C_AKR + lane]), x2 = bf2f(row[C_AKR + 16 + lane]);
        float c = P_ROPE[pos * 32 + lane], sn = P_ROPE[pos * 32 + 16 + lane];
        bf16_t o1 = f2bf(x1 * c - x2 * sn), o2 = f2bf(x1 * sn + x2 * c);
#pragma unroll
        for (int h = 0; h < 4; ++h) { P_KA[t * 384 + h * 96 + 64 + lane] = o1; P_KA[t * 384 + h * 96 + 80 + lane] = o2; }
      }
    }
  }
}

#define MFMA32(a, b, c) __builtin_amdgcn_mfma_f32_32x32x16_bf16((a), (b), (c), 0, 0, 0)
template <int OFF> DI bf16x4 tr_read(unsigned addr) {
  bf16x4 r; asm volatile("ds_read_b64_tr_b16 %0, %1 offset:%2" : "=&v"(r) : "v"(addr), "i"(OFF) : "memory"); return r;
}
DI float half_swap_max(float v) {
  auto rr = __builtin_amdgcn_permlane32_swap(__float_as_uint(v), __float_as_uint(v), false, false);
  return fmaxf(__uint_as_float(rr[0]), __uint_as_float(rr[1]));
}
DI float half_swap_sum(float v) {
  auto rr = __builtin_amdgcn_permlane32_swap(__float_as_uint(v), __float_as_uint(v), false, false);
  return __uint_as_float(rr[0]) + __uint_as_float(rr[1]);
}
DI bf16x8 pack8(const f32x16& p, int base) {
  u32x4 w = {pack2(p[base + 0], p[base + 1]), pack2(p[base + 2], p[base + 3]), pack2(p[base + 4], p[base + 5]), pack2(p[base + 6], p[base + 7])};
  return __builtin_bit_cast(bf16x8, w);
}
template <int DB, int VLD> DI void pv_block(f32x16& o, unsigned vb, bf16x8 pb0, bf16x8 pb1, bf16x8 pb2, bf16x8 pb3) {
  constexpr int RB = VLD * 2;
  bf16x4 l0 = tr_read<0 * RB + 64 * DB>(vb), h0 = tr_read<8 * RB + 64 * DB>(vb);
  bf16x4 l1 = tr_read<16 * RB + 64 * DB>(vb), h1 = tr_read<24 * RB + 64 * DB>(vb);
  bf16x4 l2 = tr_read<32 * RB + 64 * DB>(vb), h2 = tr_read<40 * RB + 64 * DB>(vb);
  bf16x4 l3 = tr_read<48 * RB + 64 * DB>(vb), h3 = tr_read<56 * RB + 64 * DB>(vb);
  asm volatile("s_waitcnt lgkmcnt(0)" ::: "memory"); __builtin_amdgcn_sched_barrier(0);
  o = MFMA32(__builtin_shufflevector(l0, h0, 0, 1, 2, 3, 4, 5, 6, 7), pb0, o);
  o = MFMA32(__builtin_shufflevector(l1, h1, 0, 1, 2, 3, 4, 5, 6, 7), pb1, o);
  o = MFMA32(__builtin_shufflevector(l2, h2, 0, 1, 2, 3, 4, 5, 6, 7), pb2, o);
  o = MFMA32(__builtin_shufflevector(l3, h3, 0, 1, 2, 3, 4, 5, 6, 7), pb3, o);
}
DI f32x16 splat16(float v) { f32x16 r;
#pragma unroll
  for (int i = 0; i < 16; ++i) r[i] = v;
  return r; }

template <int DQK, bool FIXEDM>
DI void attn_dense_mfma(const bf16_t* Qb, int ldq, const bf16_t* Kb, int ldk, const bf16_t* Vb, int ldv, bf16_t* gate_io, char* smem, bool store, float mbound) {
  constexpr int NS = DQK / 16, KLD = DQK + 8, VLD = 96, CPR = DQK / 8, NKC = (64 * CPR) / 256;
  constexpr int KBYTES = 64 * KLD * 2, VBYTES = 64 * VLD * 2;
  char* sKc = smem; char* sVc = smem + 2 * KBYTES;
  const int tid = otid(), lane = tid & 63, wid = tid >> 6, r = lane & 31, h = lane >> 5;
  bf16x8 qf[NS];
#pragma unroll
  for (int s = 0; s < NS; ++s) qf[s] = *(const bf16x8*)(Qb + (size_t)(wid * 32 + r) * ldq + 16 * s + 8 * h);
  const bf16_t* kp = Kb + (size_t)(tid >> 2) * ldk + (tid & 3) * (NKC * 8);
  const int kso = ((tid >> 2) * KLD + (tid & 3) * (NKC * 8)) * 2;
  const bf16_t* vp0 = Vb + (size_t)(tid >> 3) * ldv + (tid & 7) * 8;
  const bf16_t* vp1 = vp0 + (size_t)32 * ldv;
  const int vso = ((tid >> 3) * VLD + (tid & 7) * 8) * 2;
  const size_t kstep = (size_t)64 * ldk, vstep = (size_t)64 * ldv;
  u32x4 rk[NKC], rv[2];
#define KLOAD() do { _Pragma("unroll") for (int i = 0; i < NKC; ++i) rk[i] = *(const u32x4*)(kp + i * 8); kp += kstep; } while (0)
#define VLOAD() do { rv[0] = *(const u32x4*)vp0; rv[1] = *(const u32x4*)vp1; vp0 += vstep; vp1 += vstep; } while (0)
#define KSTORE(st) do { _Pragma("unroll") for (int i = 0; i < NKC; ++i) *(u32x4*)(sKc + (st) * KBYTES + kso + i * 16) = rk[i]; } while (0)
#define VSTORE(st) do { *(u32x4*)(sVc + (st) * VBYTES + vso) = rv[0]; *(u32x4*)(sVc + (st) * VBYTES + vso + 32 * VLD * 2) = rv[1]; } while (0)
#define QKT(P0, P1, st) do { \
    const bf16_t* sK = (const bf16_t*)(sKc + (st) * KBYTES) + r * KLD + 8 * h; \
    P0 = negm; P1 = negm; \
    _Pragma("unroll") for (int s = 0; s < NS; ++s) { \
      bf16x8 k0 = *(const bf16x8*)(sK + 16 * s); bf16x8 k1 = *(const bf16x8*)(sK + 32 * KLD + 16 * s); \
      P0 = MFMA32(k0, qf[s], P0); P1 = MFMA32(k1, qf[s], P1); } } while (0)
  const unsigned vb0 = (unsigned)(size_t)sVc + (unsigned)(((4 * h + ((lane & 15) >> 2)) * VLD + 16 * ((lane >> 4) & 1) + 4 * (lane & 3)) * 2);
  f32x16 o0 = splat16(0.f), o1 = splat16(0.f), negm = splat16(FIXEDM ? -mbound : 0.f);
  f32x16 pa0, pa1, pc0, pc1;
  float m_run = 0.f, l_run = 0.f;
  constexpr int NT = SEQ / 64;
  __syncthreads();
  KLOAD(); VLOAD(); KSTORE(0); VSTORE(0);
  KLOAD(); KSTORE(1);
  __syncthreads();
  QKT(pa0, pa1, 0);
  __syncthreads();
#define STEP(SC0, SC1, SN0, SN1, PAR, FIRST, LK, LV) do { \
    if (LK) KLOAD(); \
    if (LV) VLOAD(); \
    float pm = 0.f; \
    if (!FIXEDM) { pm = fmaxf(SC0[0], SC1[0]); \
    _Pragma("unroll") for (int i = 1; i < 16; i += 1) pm = fmaxf(fmaxf(pm, SC0[i]), SC1[i]); \
    pm = half_swap_max(pm); } \
    if (!FIXEDM && ((FIRST) || __any(pm > 8.0f))) { \
      float delta; \
      if (FIRST) delta = pm; \
      else { delta = fmaxf(pm, 0.f); float alpha = __builtin_amdgcn_exp2f(-delta); l_run *= alpha; \
        _Pragma("unroll") for (int i = 0; i < 16; ++i) { o0[i] *= alpha; o1[i] *= alpha; } } \
      m_run += delta; \
      _Pragma("unroll") for (int i = 0; i < 16; ++i) { SC0[i] -= delta; SC1[i] -= delta; } \
      negm = splat16(-m_run); \
    } \
    if (LV) QKT(SN0, SN1, (PAR) ^ 1); \
    float ls = 0.f; \
    _Pragma("unroll") for (int i = 0; i < 16; ++i) { SC0[i] = __builtin_amdgcn_exp2f(SC0[i]); SC1[i] = __builtin_amdgcn_exp2f(SC1[i]); ls += SC0[i] + SC1[i]; } \
    l_run += ls; \
    bf16x8 pb0 = pack8(SC0, 0), pb1 = pack8(SC0, 8), pb2 = pack8(SC1, 0), pb3 = pack8(SC1, 8); \
    const unsigned vb = vb0 + (PAR) * VBYTES; \
    pv_block<0, VLD>(o0, vb, pb0, pb1, pb2, pb3); \
    pv_block<1, VLD>(o1, vb, pb0, pb1, pb2, pb3); \
    if (LK) KSTORE(PAR); \
    if (LV) VSTORE((PAR) ^ 1); \
    __syncthreads(); } while (0)
  pc0 = negm; pc1 = negm;
  STEP(pa0, pa1, pc0, pc1, 0, true, 1, 1);
  STEP(pc0, pc1, pa0, pa1, 1, false, 1, 1);
  for (int j = 2; j < NT - 2; j += 2) {
    STEP(pa0, pa1, pc0, pc1, 0, false, 1, 1);
    STEP(pc0, pc1, pa0, pa1, 1, false, 1, 1);
  }
  STEP(pa0, pa1, pc0, pc1, 0, false, 0, 1);
  STEP(pc0, pc1, pa0, pa1, 1, false, 0, 0);
#undef STEP
#undef QKT
#undef KLOAD
#undef VLOAD
#undef KSTORE
#undef VSTORE
  if (!store) return;
  const float inv = 1.0f / half_swap_sum(l_run);
  bf16_t* grow = gate_io + (size_t)(wid * 32 + r) * PW;
#pragma unroll
  for (int db = 0; db < 2; ++db)
#pragma unroll
    for (int g4 = 0; g4 < 4; ++g4) {
      bf16_t* gp = grow + 32 * db + 8 * g4 + 4 * h;
      uint2 u = *(const uint2*)gp;
      float g[4] = {BLO(u.x), BHI(u.x), BLO(u.y), BHI(u.y)};
      float y[4];
#pragma unroll
      for (int e = 0; e < 4; ++e) { float ov = db == 0 ? o0[4 * g4 + e] : o1[4 * g4 + e]; y[e] = ov * inv * g[e] / (1.0f + __expf(-g[e])); }
      uint2 w; w.x = pack2(y[0], y[1]); w.y = pack2(y[2], y[3]);
      *(uint2*)gp = w;
    }
}
DI void dense_item(const Params& p, int l, int combo, int qblk, char* smem, bool store) {
  const int br = combo >> 4, bh = combo & 15, b = bh >> 2, h = bh & 3;
  const size_t t0 = (size_t)b * SEQ + qblk * 128;
  bf16_t* gate_io = P_PROJ + t0 * PW + C_GATE + br * 256 + h * 64;
  float bbound = 0.f;
  if (br != 0) {
    const int ln = otid() & 63;
    float gq = fabsf(p.gq_g[l * 64 + ln]), gk = fabsf(p.gk_g[l * 64 + ln]);
#pragma unroll
    for (int o = 32; o; o >>= 1) { gq = fmaxf(gq, __shfl_xor(gq, o)); gk = fmaxf(gk, __shfl_xor(gk, o)); }
    bbound = 64.0f * QS64 * 1.02f * gq * gk + 0.05f;
  }
  if (br == 0)
    attn_dense_mfma<96, false>(P_QA + t0 * 384 + h * 96, 384, P_KA + (size_t)b * SEQ * 384 + h * 96, 384, P_VA + (size_t)b * SEQ * 256 + h * 64, 256, gate_io, smem, store, 0.f);
  else {
    if (bbound <= 60.0f) attn_dense_mfma<64, true>(P_PROJ + t0 * PW + C_BQ + h * 64, PW, P_PROJ + (size_t)b * SEQ * PW + C_BK + (h >> 1) * 64, PW,
                        P_PROJ + (size_t)b * SEQ * PW + C_BV + (h >> 1) * 64, PW, gate_io, smem, store, bbound);
    else attn_dense_mfma<64, false>(P_PROJ + t0 * PW + C_BQ + h * 64, PW, P_PROJ + (size_t)b * SEQ * PW + C_BK + (h >> 1) * 64, PW,
                        P_PROJ + (size_t)b * SEQ * PW + C_BV + (h >> 1) * 64, PW, gate_io, smem, store, bbound);
  }
}

template <int W, bool SINK>
DI void attn_band_mfma(const bf16_t* Qb, size_t ldq, const bf16_t* Kb, const bf16_t* Vb, size_t ldk, int L, int i0,
                       const float* lut_g, float sink2, bf16_t* outp, size_t ldo, float* lse_out, size_t ldl, char* smem) {
  constexpr int NS = 4, KLD = 72, VLD = 96, NTW = (128 + 2 * W) / 64, LUTN = 2 * W + 1;
  constexpr int KBYTES = 64 * KLD * 2, VBYTES = 64 * VLD * 2;
  char* sKc = smem; char* sVc = smem + 2 * KBYTES; float* sLut = (float*)(smem + 2 * KBYTES + 2 * VBYTES);
  const int tid = otid(), lane = tid & 63, wid = tid >> 6, r = lane & 31, h = lane >> 5;
  __syncthreads();
  for (int e = tid; e < LUTN; e += 256) sLut[e] = lut_g[e];
  const int qi = i0 + wid * 32 + r;
  bf16x8 qf[NS];
#pragma unroll
  for (int s = 0; s < NS; ++s) qf[s] = *(const bf16x8*)(Qb + (size_t)qi * ldq + 16 * s + 8 * h);
  const int srow = tid >> 3, scc = tid & 7;
  u32x4 rk[2], rv[2];
#define BLOAD(k0) do { \
    rk[0] = *(const u32x4*)(Kb + (size_t)((k0) + srow) * ldk + scc * 8); rk[1] = *(const u32x4*)(Kb + (size_t)((k0) + srow + 32) * ldk + scc * 8); \
    rv[0] = *(const u32x4*)(Vb + (size_t)((k0) + srow) * ldk + scc * 8); rv[1] = *(const u32x4*)(Vb + (size_t)((k0) + srow + 32) * ldk + scc * 8); } while (0)
#define BSTORE(st) do { \
    *(u32x4*)(sKc + (st) * KBYTES + (srow * KLD + scc * 8) * 2) = rk[0]; *(u32x4*)(sKc + (st) * KBYTES + ((srow + 32) * KLD + scc * 8) * 2) = rk[1]; \
    *(u32x4*)(sVc + (st) * VBYTES + (srow * VLD + scc * 8) * 2) = rv[0]; *(u32x4*)(sVc + (st) * VBYTES + ((srow + 32) * VLD + scc * 8) * 2) = rv[1]; } while (0)
  const unsigned vb0 = (unsigned)(size_t)sVc + (unsigned)(((4 * h + ((lane & 15) >> 2)) * VLD + 16 * ((lane >> 4) & 1) + 4 * (lane & 3)) * 2);
  f32x16 o0 = splat16(0.f), o1 = splat16(0.f);
  float m_run = SINK ? sink2 : 0.f, l_run = (SINK && h == 0) ? 1.f : 0.f;
  bool seen = SINK;
  f32x16 negm = splat16(-m_run);
  const int lo = (i0 == 0) ? W / 64 : 0, hi = (i0 + 128 >= L) ? NTW - W / 64 : NTW;
  BLOAD(i0 - W + 64 * lo); BSTORE(0);
  __syncthreads();
  for (int j = lo; j < hi; ++j) {
    const int cur = (j - lo) & 1, k0 = i0 - W + 64 * j;
    if (j + 1 < hi) BLOAD(k0 + 64);
    const bf16_t* sK = (const bf16_t*)(sKc + cur * KBYTES);
    f32x16 p0 = negm, p1 = negm;
#pragma unroll
    for (int s = 0; s < NS; ++s) {
      bf16x8 k0f = *(const bf16x8*)(sK + r * KLD + 16 * s + 8 * h);
      bf16x8 k1f = *(const bf16x8*)(sK + (32 + r) * KLD + 16 * s + 8 * h);
      p0 = MFMA32(k0f, qf[s], p0);
      p1 = MFMA32(k1f, qf[s], p1);
    }
    const int offb = k0 + 4 * h - qi + W;
    float pm = -1e30f;
#pragma unroll
    for (int i = 0; i < 16; ++i) {
      int idx0 = offb + (i & 3) + 8 * (i >> 2), idx1 = idx0 + 32;
      int c0 = min(max(idx0, 0), 2 * W), c1 = min(max(idx1, 0), 2 * W);
      float b0 = sLut[c0], b1 = sLut[c1];
      p0[i] = ((unsigned)idx0 <= (unsigned)(2 * W)) ? p0[i] + b0 : -1e30f;
      p1[i] = ((unsigned)idx1 <= (unsigned)(2 * W)) ? p1[i] + b1 : -1e30f;
      pm = fmaxf(pm, fmaxf(p0[i], p1[i]));
    }
    pm = half_swap_max(pm);
    const bool has = pm > -1e29f;
    float delta = 0.f;
    if (has) { if (!seen) delta = pm; else if (pm > 8.0f) delta = pm; }
    if (__any(delta != 0.f)) {
      float alpha = seen ? __builtin_amdgcn_exp2f(-delta) : 1.0f;
      l_run *= alpha; m_run += delta;
#pragma unroll
      for (int i = 0; i < 16; ++i) { o0[i] *= alpha; o1[i] *= alpha; p0[i] -= delta; p1[i] -= delta; }
      negm = splat16(-m_run);
    }
    seen = seen || has;
    float ls = 0.f;
#pragma unroll
    for (int i = 0; i < 16; ++i) { p0[i] = __builtin_amdgcn_exp2f(p0[i]); p1[i] = __builtin_amdgcn_exp2f(p1[i]); ls += p0[i] + p1[i]; }
    l_run += ls;
    bf16x8 pb0 = pack8(p0, 0), pb1 = pack8(p0, 8), pb2 = pack8(p1, 0), pb3 = pack8(p1, 8);
    const unsigned vb = vb0 + cur * VBYTES;
    pv_block<0, VLD>(o0, vb, pb0, pb1, pb2, pb3);
    pv_block<1, VLD>(o1, vb, pb0, pb1, pb2, pb3);
    if (j + 1 < hi) BSTORE(cur ^ 1);
    __syncthreads();
  }
#undef BLOAD
#undef BSTORE
  const float ltot = half_swap_sum(l_run);
  const float inv = 1.0f / ltot;
  bf16_t* orow = outp + (size_t)qi * ldo;
  if (!SINK && h == 0) lse_out[(size_t)qi * ldl] = m_run + __log2f(ltot);
#pragma unroll
  for (int db = 0; db < 2; ++db)
#pragma unroll
    for (int g4 = 0; g4 < 4; ++g4) {
      bf16_t* gp = orow + 32 * db + 8 * g4 + 4 * h;
      float y[4];
      if (SINK) {
        uint2 u = *(const uint2*)gp;
        float g[4] = {BLO(u.x), BHI(u.x), BLO(u.y), BHI(u.y)};
#pragma unroll
        for (int e = 0; e < 4; ++e) { float ov = db == 0 ? o0[4 * g4 + e] : o1[4 * g4 + e]; y[e] = ov * inv * g[e] / (1.0f + __expf(-g[e])); }
      } else {
#pragma unroll
        for (int e = 0; e < 4; ++e) { float ov = db == 0 ? o0[4 * g4 + e] : o1[4 * g4 + e]; y[e] = ov * inv; }
      }
      uint2 w; w.x = pack2(y[0], y[1]); w.y = pack2(y[2], y[3]);
      *(uint2*)gp = w;
    }
}
DI void band_item(const Params& p, int l, int idx, char* smem) {
  if (idx < 3072) {
    const int g = idx >> 10, rem = idx & 1023, h = rem & 3, rem2 = rem >> 2, b = rem2 >> 6, u = rem2 & 63;
    const int sh = 2 * g, rr = 1 << sh;
    const int rho = u & (rr - 1), qblk = u >> sh;
    const size_t tok0 = (size_t)b * SEQ + rho;
    bf16_t* base = P_PROJ + tok0 * PW + g * 256 + h * 64;
    attn_band_mfma<64, false>(base + C_CQ, (size_t)rr * PW, base + C_CK, base + C_CV, (size_t)rr * PW, SEQ >> sh, qblk * 128,
                              P_LUTC + (g * 4 + h) * 129, 0.f, base + C_CQ, (size_t)rr * PW, P_LSE + tok0 * 12 + g * 4 + h, (size_t)rr * 12, smem);
  } else {
    const int it = idx - 3072, hq = it & 3, rem = it >> 2, b = rem >> 6, qblk = rem & 63;
    bf16_t* base = P_PROJ + (size_t)b * SEQ * PW;
    attn_band_mfma<128, true>(base + C_DQ + hq * 64, PW, base + C_DK + (hq >> 1) * 64, base + C_DV + (hq >> 1) * 64, PW, SEQ, qblk * 128,
                              P_LUTD + hq * 257, p.sink[l * 4 + hq] * LOG2E, base + C_GATE + 768 + hq * 64, PW, nullptr, 0, smem);
  }
}
DI void combine_c(const Params& p) {
  for (size_t u = (size_t)blockIdx.x * 256 + otid(); u < (size_t)32768 * 32; u += (size_t)gridDim.x * 256) {
    const size_t t = u >> 5; const int h = (int)(u >> 3) & 3, ch = (int)u & 7;
    const float* ls = P_LSE + t * 12 + h;
    float l0 = ls[0], l1 = ls[4], l2 = ls[8];
    float mx = fmaxf(l0, fmaxf(l1, l2));
    float a0 = __builtin_amdgcn_exp2f(l0 - mx), a1 = __builtin_amdgcn_exp2f(l1 - mx), a2 = __builtin_amdgcn_exp2f(l2 - mx);
    float inv = 1.0f / (a0 + a1 + a2); a0 *= inv; a1 *= inv; a2 *= inv;
    const bf16_t* row = P_PROJ + t * PW;
    uint4 x0 = *(const uint4*)(row + C_CQ + h * 64 + ch * 8), x1 = *(const uint4*)(row + C_CQ + 256 + h * 64 + ch * 8),
          x2 = *(const uint4*)(row + C_CQ + 512 + h * 64 + ch * 8);
    bf16_t* gp = P_PROJ + t * PW + C_GATE + 512 + h * 64 + ch * 8;
    uint4 gu = *(const uint4*)gp;
    unsigned xa[4] = {x0.x, x0.y, x0.z, x0.w}, xb[4] = {x1.x, x1.y, x1.z, x1.w}, xc[4] = {x2.x, x2.y, x2.z, x2.w}, gg[4] = {gu.x, gu.y, gu.z, gu.w};
    unsigned ov[4];
#pragma unroll
    for (int e = 0; e < 4; ++e) {
      float ylo = a0 * BLO(xa[e]) + a1 * BLO(xb[e]) + a2 * BLO(xc[e]);
      float yhi = a0 * BHI(xa[e]) + a1 * BHI(xb[e]) + a2 * BHI(xc[e]);
      float glo = BLO(gg[e]), ghi = BHI(gg[e]);
      ov[e] = pack2(ylo * glo / (1.0f + __expf(-glo)), yhi * ghi / (1.0f + __expf(-ghi)));
    }
    uint4 w; w.x = ov[0]; w.y = ov[1]; w.z = ov[2]; w.w = ov[3];
    *(uint4*)gp = w;
  }
}

DI void merge_tile(const Params& p, int l, int tile, char* smem) {
  bf16_t* sA = (bf16_t*)smem; bf16_t* sB = sA + 2 * GST;
  const int mt = tile & 255, nt = tile >> 8;
  unsigned sg[4][8][2];
  {
    f32x4 accG[4][8]; zero_acc8(accG);
    gemm_big(accG, P_XN + (size_t)mt * 128 * 1024, 1024, P_WMT + ((size_t)l * 4096 + nt * 64) * 1024, 1024, 1024, smem, 2048, 32,
             (otid() >> 7) * 1024 + ((otid() >> 2) & 31));
#pragma unroll
    for (int mi = 0; mi < 4; ++mi)
#pragma unroll
      for (int ni = 0; ni < 8; ++ni) {
        float s0 = 1.0f / (1.0f + __expf(-accG[mi][ni][0])), s1 = 1.0f / (1.0f + __expf(-accG[mi][ni][1]));
        float s2 = 1.0f / (1.0f + __expf(-accG[mi][ni][2])), s3 = 1.0f / (1.0f + __expf(-accG[mi][ni][3]));
        sg[mi][ni][0] = pack2(s0, s1); sg[mi][ni][1] = pack2(s2, s3);
      }
  }
  f32x4 accM[4][2]; zero_acc<2>(accM);
#pragma unroll 1
  for (int n = 0; n < 4; ++n) {
    f32x4 accB[4][2]; zero_acc<2>(accB);
    gemm_mainloop<2>(accB, P_PROJ + (size_t)mt * 128 * PW + C_GATE + n * 256, PW, P_WBT + ((size_t)(l * 4 + n) * 1024 + nt * 64) * 256, 256, 256, sA, sB);
#pragma unroll
    for (int mi = 0; mi < 4; ++mi)
#pragma unroll
      for (int ni = 0; ni < 2; ++ni) {
        accM[mi][ni][0] += accB[mi][ni][0] * BLO(sg[mi][ni][0]); accM[mi][ni][1] += accB[mi][ni][1] * BHI(sg[mi][ni][0]);
        accM[mi][ni][2] += accB[mi][ni][2] * BLO(sg[mi][ni][1]); accM[mi][ni][3] += accB[mi][ni][3] * BHI(sg[mi][ni][1]);
      }
#pragma unroll
    for (int mi = 0; mi < 4; ++mi)
#pragma unroll
      for (int k = 0; k < 6; ++k) { sg[mi][k][0] = sg[mi][k + 2][0]; sg[mi][k][1] = sg[mi][k + 2][1]; }
  }
  const int lane = otid() & 63, wid = otid() >> 6, wm = wid >> 1, wn = wid & 1, fr = lane & 15, fq = lane >> 4;
#pragma unroll
  for (int mi = 0; mi < 4; ++mi)
#pragma unroll
    for (int ni = 0; ni < 2; ++ni) {
      size_t row = (size_t)mt * 128 + wm * 64 + mi * 16 + fr; int col = nt * 64 + wn * 32 + ni * 16 + fq * 4;
      uint2 o; o.x = pack2(accM[mi][ni][0], accM[mi][ni][1]); o.y = pack2(accM[mi][ni][2], accM[mi][ni][3]);
      *(uint2*)(P_PROJ + row * PW + C_MERGED + col) = o;
    }
}

DI void outproj_tile(const Params& p, int l, int tile, char* smem) {
  const int mt = tile & 255, nt = tile >> 8;
  f32x4 acc[4][8]; zero_acc8(acc);
  gemm_big(acc, P_PROJ + (size_t)mt * 128 * PW + C_MERGED, PW, P_WOT + ((size_t)l * 1024 + nt * 256) * 1024, 1024, 1024, smem);
  const float* xin = l == 0 ? p.x : p.out;
  const int lane = otid() & 63, wid = otid() >> 6, wm = wid >> 1, wn = wid & 1, fr = lane & 15, fq = lane >> 4;
#pragma unroll
  for (int mi = 0; mi < 4; ++mi)
#pragma unroll
    for (int ni = 0; ni < 8; ++ni) {
      size_t row = (size_t)mt * 128 + wm * 64 + mi * 16 + fr; int col = nt * 256 + wn * 128 + ni * 16 + fq * 4;
      float4 xi = *(const float4*)(xin + row * 1024 + col);
      float4 o; o.x = xi.x + acc[mi][ni][0]; o.y = xi.y + acc[mi][ni][1]; o.z = xi.z + acc[mi][ni][2]; o.w = xi.w + acc[mi][ni][3];
      *(float4*)(p.out + row * 1024 + col) = o;
    }
}


#define XB_TMO      128
#define XB_XCNT(j)  (256  + 64 * (j))
#define XB_XSUB(j)  (1280 + 64 * (j))
#define XB_XGEN(j)  (2304 + 64 * (j))
#define XB_TOP      3328
#define XB_TOPGEN   3392
#define XCD_BAR_WORDS 3456
#define XB_SPIN_CAP (1u << 22)
#define LAS __attribute__((address_space(3)))
DI unsigned xb_ld(unsigned* p)              { return __hip_atomic_load(p, __ATOMIC_RELAXED, __HIP_MEMORY_SCOPE_AGENT); }
DI unsigned xb_add(unsigned* p, unsigned v) { return __hip_atomic_fetch_add(p, v, __ATOMIC_RELAXED, __HIP_MEMORY_SCOPE_AGENT); }
DI unsigned xb_xcc_id() { return (unsigned)__builtin_amdgcn_s_getreg((3 << 11) | 20) & 0xFu; }
#define XB_SPIN(cond, bar) do { unsigned _sp = 0; while (cond) { __builtin_amdgcn_s_sleep(1); \
    if ((++_sp & 255u) == 0u) { if (xb_ld(&(bar)[XB_TMO])) break; if (_sp > XB_SPIN_CAP) { atomicAdd(&(bar)[XB_TMO], 1u); break; } } } } while (0)
struct XcdBarrier { unsigned* bar; unsigned x; volatile LAS unsigned* st; };
DI XcdBarrier xcd_barrier_post(unsigned* bar, volatile LAS unsigned* st) {
  XcdBarrier b; b.bar = bar; b.x = xb_xcc_id(); b.st = st;
  if (threadIdx.x == 0) (void)xb_add(&bar[XB_XCNT(b.x)], 1u);
  return b;
}
DI void xcd_barrier_complete(unsigned* bar, unsigned x, unsigned& nloc, unsigned& nx) {
  const unsigned G = gridDim.x * gridDim.y * gridDim.z;
  unsigned sum, cnt, mine, sp = 0u;
  for (;;) {
    sum = 0u; cnt = 0u; mine = 0u;
#pragma unroll
    for (unsigned j = 0; j < 16; ++j) { const unsigned c = xb_ld(&bar[XB_XCNT(j)]); sum += c; cnt += (c > 0u) ? 1u : 0u; mine = (j == x) ? c : mine; }
    if (sum == G) break;
    __builtin_amdgcn_s_sleep(1);
    if ((++sp & 255u) == 0u) { if (xb_ld(&bar[XB_TMO])) break; if (sp > XB_SPIN_CAP) { atomicAdd(&bar[XB_TMO], 1u); break; } }
  }
  nloc = mine > 0u ? mine : 1u; nx = cnt > 0u ? cnt : 1u;
}
DI void xcd_barrier(const XcdBarrier& b) {
  asm volatile("s_waitcnt vmcnt(0)" ::: "memory");
  __syncthreads();
  if (threadIdx.x == 0) {
    unsigned* bar = b.bar;
    __builtin_amdgcn_s_waitcnt(0);
    unsigned nloc = b.st[0], nx = b.st[1];
    if (nloc == 0u) { xcd_barrier_complete(bar, b.x, nloc, nx); b.st[0] = nloc; b.st[1] = nx; }
    const unsigned old = xb_add(&bar[XB_XSUB(b.x)], 1u);
    const unsigned gen = old / nloc;
    if (old + 1u == (gen + 1u) * nloc) {
      __builtin_amdgcn_fence(__ATOMIC_RELEASE, "agent");
      asm volatile("s_waitcnt vmcnt(0)" ::: "memory");
      const unsigned og = xb_add(&bar[XB_TOP], 1u);
      const unsigned tg = og / nx;
      if (og + 1u == (tg + 1u) * nx) xb_add(&bar[XB_TOPGEN], 1u);
      else XB_SPIN(xb_ld(&bar[XB_TOPGEN]) == tg, bar);
      __builtin_amdgcn_fence(__ATOMIC_ACQUIRE, "agent");
      xb_add(&bar[XB_XGEN(b.x)], 1u);
      asm volatile("s_waitcnt vmcnt(0)" ::: "memory");
    } else {
      XB_SPIN(xb_ld(&bar[XB_XGEN(b.x)]) == gen, bar);
      __builtin_amdgcn_fence(__ATOMIC_ACQUIRE, "agent");
      asm volatile("s_waitcnt vmcnt(0)" ::: "memory");
    }
  }
  __syncthreads();
}

DI void run_phase(const Params& p, int ph, char* smem, bool never) {
  const int G = gridDim.x, B = blockIdx.x;
  if (ph == 0) {
    for (int i = B; i < 6097; i += G) prep_item(p, i, (float*)smem);
    for (int i = B; i < 1024; i += G) norm_rows_bf16(p.x, p.norm_g, P_XN, i);
  } else if (ph == 14) {
    for (int i = B; i < 1024; i += G) norm_rows_f32(p.out, p.final_g, i);
  } else if (ph == 7) {
    for (int i = B; i < 1024; i += G) norm_rows_bf16(p.out, p.norm_g + 1024, P_XN, i);
  } else {
    const int l = ph > 7 ? 1 : 0; const int s = ph > 7 ? ph - 8 : ph - 1;
    const int xcd = B & 7, lb = B >> 3, nl = G >> 3;
    if (s == 0) {
      for (int w = lb; w < 64 * 8 + 96; w += nl) {
        const int it = w >> 6, l64 = w & 63;
        int mt, nt;
        if (it < 8) { const int a = it >> 1, gn = it & 1; mt = 8 * (xcd + 8 * a) + (l64 & 7); nt = 8 * gn + (l64 >> 3); }
        else { const int q = (it - 8) * 64 + l64; const int ml = q / 3; mt = 8 * (xcd + 8 * (ml >> 3)) + (ml & 7); nt = 16 + q % 3; }
        inproj_tile(p, l, nt * 256 + mt, smem);
      }
    }
    else if (s == 1) { for (int i = B; i < 2048; i += G) mla_item(p, l, i, smem); }
    else if (s == 2) {
      const bool band_first = (lb & 1) == 0;
      if (band_first) for (int i = B; i < 4096; i += G) band_item(p, l, i, smem);
      for (int w = lb; w < 256; w += nl) dense_item(p, l, xcd + 8 * (w >> 6), w & 63, smem, true);
      if (!band_first) for (int i = B; i < 4096; i += G) band_item(p, l, i, smem);
    }
    else if (s == 3) { combine_c(p); }
    else if (s == 4) {
      for (int w = lb; w < 64 * 8; w += nl) {
        const int it = w >> 6, l64 = w & 63, a = it >> 1, gn = it & 1;
        const int mt = 8 * (xcd + 8 * a) + (l64 & 7), nt = 8 * gn + (l64 >> 3);
        merge_tile(p, l, nt * 256 + mt, smem);
      }
    }
    else {
      for (int w = lb; w < 64 * 2; w += nl) {
        const int a = w >> 6, l64 = w & 63;
        const int mt = 8 * (xcd + 8 * (2 * a + (l64 >> 5))) + (l64 & 7), nt = (l64 >> 3) & 3;
        outproj_tile(p, l, nt * 256 + mt, smem);
      }
    }
  }
}

__global__ void __launch_bounds__(256, 2) mega(Params p, int ph_lo, int ph_hi) {
  __shared__ __attribute__((aligned(16))) char smem[66048];
  __shared__ uint4 xb_words;
  cg::grid_group grid = cg::this_grid();
  if (threadIdx.x == 0) xb_words = make_uint4(0u, 0u, 0u, 0u);
  __syncthreads();
  XcdBarrier xb = xcd_barrier_post((unsigned*)(p.ws + OFF_BAR), (volatile LAS unsigned*)&xb_words);
  if (ph_hi == 12345) grid.sync();
  for (int ph = ph_lo; ph < ph_hi; ++ph) {
    run_phase(p, ph, smem, ph_hi == 12345);
    if (ph + 1 < ph_hi) xcd_barrier(xb);
  }
}

extern "C" void kernel_launch(void* const* d_in, const int* in_sizes, int n_in, void* d_out, int out_size, void* d_ws,
                              size_t ws_size, hipStream_t stream) {
  Params p{};
  p.x = (const float*)d_in[0]; p.norm_g = (const float*)d_in[1]; p.w_in = (const float*)d_in[2];
  p.q_norm_g = (const float*)d_in[3]; p.kv_norm_g = (const float*)d_in[4]; p.w_q_up = (const float*)d_in[5];
  p.w_kv_up = (const float*)d_in[6]; p.gq_g = (const float*)d_in[7]; p.gk_g = (const float*)d_in[8];
  p.sink = (const float*)d_in[9]; p.t5 = (const float*)d_in[10]; p.w_branch = (const float*)d_in[11];
  p.w_out = (const float*)d_in[12]; p.final_g = (const float*)d_in[13];
  p.out = (float*)d_out;
  p.ws = (char*)d_ws;
  if (WS_NEED > ws_size) { fprintf(stderr, "workspace too small: need %zu have %zu\n", (size_t)WS_NEED, ws_size); return; }

  static int grid_blocks = 0;
  if (!grid_blocks) {
    int dev = 0, cus = 0, per_cu = 0;
    hipGetDevice(&dev);
    hipDeviceGetAttribute(&cus, hipDeviceAttributeMultiprocessorCount, dev);
    hipOccupancyMaxActiveBlocksPerMultiprocessor(&per_cu, mega, 256, 0);
    if (per_cu < 1) per_cu = 1;
    if (per_cu > 2) per_cu = 2;
    grid_blocks = cus * per_cu;
  }
  hipMemsetAsync((char*)d_ws + OFF_BAR, 0, 16384, stream);
  int lo = 0, hi = 15;
  void* args[] = {&p, &lo, &hi};
  hipError_t e = hipLaunchCooperativeKernel((void*)mega, dim3(grid_blocks), dim3(256), args, 0, stream);
  if (e != hipSuccess) fprintf(stderr, "cooperative launch failed: %s (grid %d)\n", hipGetErrorString(e), grid_blocks);
}
```

```cpp
#include <hip/hip_runtime.h>
#include <hip/hip_cooperative_groups.h>
#include <cstdio>
namespace cg = cooperative_groups;

typedef unsigned short bf16_t;
using bf16x8 = __attribute__((ext_vector_type(8))) short;
using f32x4 = __attribute__((ext_vector_type(4))) float;
using u32x4 = __attribute__((ext_vector_type(4))) unsigned;
using f32x16 = __attribute__((ext_vector_type(16))) float;
using bf16x4 = __attribute__((ext_vector_type(4))) short;
#define DI __device__ __forceinline__

constexpr int SEQ = 8192;
constexpr int PW = 4864;
constexpr int C_BQ = 0, C_BK = 256, C_BV = 384, C_CQ = 512, C_CK = 1280, C_CV = 2048, C_DQ = 2816, C_DK = 3072,
              C_DV = 3200, C_GATE = 3328, C_AQ = 4352, C_AKV = 4608, C_AKR = 4736;
constexpr int C_MERGED = 512;

struct Params {
  const float* x; const float* norm_g; const float* w_in; const float* q_norm_g; const float* kv_norm_g;
  const float* w_q_up; const float* w_kv_up; const float* gq_g; const float* gk_g; const float* sink;
  const float* t5; const float* w_branch; const float* w_out; const float* final_g;
  float* out; char* ws;
};
constexpr size_t al256(size_t x) { return (x + 255) & ~(size_t)255; }
constexpr size_t OFF_W1T = 0;
constexpr size_t OFF_WMT = OFF_W1T + al256((size_t)2 * 4864 * 1024 * 2);
constexpr size_t OFF_WOT = OFF_WMT + al256((size_t)2 * 4096 * 1024 * 2);
constexpr size_t OFF_WBT = OFF_WOT + al256((size_t)2 * 1024 * 1024 * 2);
constexpr size_t OFF_WQT = OFF_WBT + al256((size_t)2 * 4 * 1024 * 256 * 2);
constexpr size_t OFF_WKVT = OFF_WQT + al256((size_t)2 * 384 * 256 * 2);
constexpr size_t OFF_ROPE = OFF_WKVT + al256((size_t)2 * 512 * 128 * 2);
constexpr size_t OFF_LUTC = OFF_ROPE + al256((size_t)8192 * 32 * 4);
constexpr size_t OFF_LUTD = OFF_LUTC + 8192;
constexpr size_t OFF_XN = OFF_LUTD + 8192;
constexpr size_t OFF_PROJ = OFF_XN + al256((size_t)32768 * 1024 * 2);
constexpr size_t OFF_QA = OFF_PROJ + al256((size_t)32768 * 4864 * 2);
constexpr size_t OFF_KA = OFF_QA + al256((size_t)32768 * 384 * 2);
constexpr size_t OFF_VA = OFF_KA + al256((size_t)32768 * 384 * 2);
constexpr size_t OFF_LSE = OFF_VA + al256((size_t)32768 * 256 * 2);
constexpr size_t OFF_BAR = OFF_LSE + al256((size_t)32768 * 12 * 4);
constexpr size_t WS_NEED = OFF_BAR + 16384;
#define WSP(T, OFF) ((T*)(p.ws + (OFF)))
#define P_W1T WSP(bf16_t, OFF_W1T)
#define P_WMT WSP(bf16_t, OFF_WMT)
#define P_WOT WSP(bf16_t, OFF_WOT)
#define P_WBT WSP(bf16_t, OFF_WBT)
#define P_WQT WSP(bf16_t, OFF_WQT)
#define P_WKVT WSP(bf16_t, OFF_WKVT)
#define P_ROPE WSP(float, OFF_ROPE)
#define P_LUTC WSP(float, OFF_LUTC)
#define P_LUTD WSP(float, OFF_LUTD)
#define P_XN WSP(bf16_t, OFF_XN)
#define P_PROJ WSP(bf16_t, OFF_PROJ)
#define P_QA WSP(bf16_t, OFF_QA)
#define P_KA WSP(bf16_t, OFF_KA)
#define P_VA WSP(bf16_t, OFF_VA)
#define P_LSE WSP(float, OFF_LSE)


DI unsigned short f2bf(float x) { unsigned u = __float_as_uint(x); u += 0x7fffu + ((u >> 16) & 1u); return (unsigned short)(u >> 16); }
DI float bf2f(unsigned short b) { return __uint_as_float(((unsigned)b) << 16); }
typedef __bf16 bf2_t __attribute__((ext_vector_type(2)));
typedef float f2_t __attribute__((ext_vector_type(2)));
DI unsigned pack2(float a, float b) { f2_t v = {a, b}; bf2_t r = __builtin_convertvector(v, bf2_t); return __builtin_bit_cast(unsigned, r); }
constexpr float LOG2E = 1.4426950408889634f;
constexpr float QS64 = 0.125f * LOG2E;
constexpr float QS96 = 0.10206207261596575f * LOG2E;
#define BLO(u) __uint_as_float((u) << 16)
#define BHI(u) __uint_as_float((u) & 0xffff0000u)
DI int otid() { int t; asm volatile("v_mov_b32 %0, %1" : "=v"(t) : "v"((int)threadIdx.x)); __builtin_assume(t >= 0 && t < 256); return t; }
DI float wave_sum(float v) {
#pragma unroll
  for (int o = 32; o; o >>= 1) v += __shfl_xor(v, o);
  return v;
}

DI int srccol(int mode, int n) {
  if (mode == 0) return n < 4352 ? n + 416 : (n < 4768 ? n - 4352 : -1);
  if (mode == 1) return 4768 + n;
  if (mode == 2) return n;
  return n < 256 ? (n >> 6) * 96 + (n & 63) : ((n - 256) >> 5) * 96 + 64 + ((n - 256) & 31);
}
DI void conv_tile(const float* __restrict__ src, int ld, int K, bf16_t* __restrict__ dst, int n0, int k0, int mode,
                  const float* __restrict__ rs, float* tile) {
  const int tx = otid() & 63, ty = otid() >> 6;
  __syncthreads();
  const int sc = srccol(mode, n0 + tx);
  const int nq = n0 + tx;
  const float cscale = (mode == 0 && ((nq >= C_CQ && nq < C_CQ + 768) || (nq >= C_DQ && nq < C_DQ + 256))) ? QS64 : 1.0f;
#pragma unroll
  for (int i = 0; i < 16; ++i) {
    int kk = ty + 4 * i;
    float v = sc >= 0 ? src[(size_t)(k0 + kk) * ld + sc] : 0.f;
    if (rs) v *= rs[k0 + kk];
    tile[kk * 65 + tx] = v * cscale;
  }
  __syncthreads();
#pragma unroll
  for (int i = 0; i < 16; ++i) {
    int nn = ty + 4 * i;
    dst[(size_t)(n0 + nn) * K + k0 + tx] = f2bf(tile[tx * 65 + nn]);
  }
}

DI int t5_bucket(int rel) {
  int n = rel < 0 ? -rel : rel;
  float nf = (float)(n < 1 ? 1 : n);
  int large = 8 + (int)(logf(nf / 8.0f) / 4.852030263919617f * 8.0f);
  if (large > 15) large = 15;
  return (rel > 0 ? 16 : 0) + (n < 8 ? n : large);
}

DI void prep_item(const Params& p, int item, float* tile) {
  if (item < 5584) {
    int l = item / 2792, r = item % 2792;
    const float* src; int ld, K, mode, t; bf16_t* dst; const float* rs = nullptr;
    if (r < 1216) { t = r; src = p.w_in + (size_t)l * 1024 * 8864; ld = 8864; K = 1024; mode = 0; dst = P_W1T + (size_t)l * 4864 * 1024; }
    else if (r < 2240) { t = r - 1216; src = p.w_in + (size_t)l * 1024 * 8864; ld = 8864; K = 1024; mode = 1; dst = P_WMT + (size_t)l * 4096 * 1024; }
    else if (r < 2496) { t = r - 2240; src = p.w_out + (size_t)l * 1024 * 1024; ld = 1024; K = 1024; mode = 2; dst = P_WOT + (size_t)l * 1024 * 1024; }
    else if (r < 2752) { t = r - 2496; int n = t >> 6; t &= 63; src = p.w_branch + (size_t)(l * 4 + n) * 256 * 1024; ld = 1024; K = 256; mode = 2; dst = P_WBT + (size_t)(l * 4 + n) * 1024 * 256; }
    else if (r < 2776) { t = r - 2752; src = p.w_q_up + (size_t)l * 256 * 384; ld = 384; K = 256; mode = 3; dst = P_WQT + (size_t)l * 384 * 256; rs = p.q_norm_g + l * 256; }
    else { t = r - 2776; src = p.w_kv_up + (size_t)l * 128 * 512; ld = 512; K = 128; mode = 2; dst = P_WKVT + (size_t)l * 512 * 128; rs = p.kv_norm_g + l * 128; }
    int kt = K / 64;
    conv_tile(src, ld, K, dst, (t / kt) * 64, (t % kt) * 64, mode, rs, tile);
  } else if (item < 5584 + 512) {
    int idx = (item - 5584) * 256 + otid();
    int pos = idx >> 4, i = idx & 15;
    double invd = 1.0;
    for (int k = 0; k < i; ++k) invd *= 0.5623413251903491;
    float inv = (float)invd;
    float ang = (float)pos * inv;
    double a = (double)ang;
    double kq = rint(a * 0.15915494309189535);
    double r = a - kq * 6.283185307179586;
    double r2 = r * r, ts = r, tc = 1.0, sn = r, cs = 1.0;
    for (int k = 1; k <= 14; ++k) {
      tc = -tc * r2 / (double)((2 * k - 1) * (2 * k));
      ts = -ts * r2 / (double)((2 * k) * (2 * k + 1));
      cs += tc; sn += ts;
    }
    P_ROPE[pos * 32 + i] = (float)cs;
    P_ROPE[pos * 32 + 16 + i] = (float)sn;
  } else {
    for (int e = otid(); e < 12 * 129; e += 256) {
      int gh = e / 129, off = e % 129 - 64; int g = gh >> 2;
      int r = g == 0 ? 1 : (g == 1 ? 4 : 16);
      P_LUTC[e] = p.t5[t5_bucket(off * r) * 16 + gh] * LOG2E;
    }
    for (int e = otid(); e < 4 * 257; e += 256) {
      int hq = e / 257, off = e % 257 - 128;
      P_LUTD[e] = p.t5[t5_bucket(off) * 16 + 12 + hq] * LOG2E;
    }
  }
}

DI void norm_rows_bf16(const float* __restrict__ src, const float* __restrict__ g, bf16_t* __restrict__ dst, int item) {
  const int lane = otid() & 63, wid = otid() >> 6;
  for (int i = 0; i < 8; ++i) {
    size_t row = (size_t)item * 32 + wid * 8 + i;
    const float4* s = (const float4*)(src + row * 1024);
    float4 v[4]; float ss = 0.f;
#pragma unroll
    for (int j = 0; j < 4; ++j) { v[j] = s[lane + 64 * j]; ss += v[j].x * v[j].x + v[j].y * v[j].y + v[j].z * v[j].z + v[j].w * v[j].w; }
    ss = wave_sum(ss);
    float sc = rsqrtf(ss * (1.0f / 1024.0f) + 1e-6f);
#pragma unroll
    for (int j = 0; j < 4; ++j) {
      float4 gg = ((const float4*)g)[lane + 64 * j];
      uint2 o; o.x = pack2(v[j].x * sc * gg.x, v[j].y * sc * gg.y); o.y = pack2(v[j].z * sc * gg.z, v[j].w * sc * gg.w);
      *(uint2*)(dst + row * 1024 + (lane + 64 * j) * 4) = o;
    }
  }
}
DI void norm_rows_f32(float* io, const float* __restrict__ g, int item) {
  const int lane = otid() & 63, wid = otid() >> 6;
  for (int i = 0; i < 8; ++i) {
    size_t row = (size_t)item * 32 + wid * 8 + i;
    float4* s = (float4*)(io + row * 1024);
    float4 v[4]; float ss = 0.f;
#pragma unroll
    for (int j = 0; j < 4; ++j) { v[j] = s[lane + 64 * j]; ss += v[j].x * v[j].x + v[j].y * v[j].y + v[j].z * v[j].z + v[j].w * v[j].w; }
    ss = wave_sum(ss);
    float sc = rsqrtf(ss * (1.0f / 1024.0f) + 1e-6f);
#pragma unroll
    for (int j = 0; j < 4; ++j) {
      float4 gg = ((const float4*)g)[lane + 64 * j];
      float4 o; o.x = v[j].x * sc * gg.x; o.y = v[j].y * sc * gg.y; o.z = v[j].z * sc * gg.z; o.w = v[j].w * sc * gg.w;
      s[lane + 64 * j] = o;
    }
  }
}

constexpr int LLD = 72;
constexpr int GST = 128 * 64;
template <int NT, bool LOWREG = false>
DI void gemm_mainloop(f32x4 (&acc)[4][NT], const bf16_t* A, int lda, const bf16_t* Bt, int ldb, int K, bf16_t* sA, bf16_t* sB, int bstride = 32) {
  constexpr int NB = NT;
  const int tid = otid(), lane = tid & 63, wid = tid >> 6;
  const int wm = wid >> 1, wn = wid & 1, fr = lane & 15, fq = lane >> 4;
  u32x4 ra[4], rb[NB];
  const int nk = K >> 6;
  const bf16_t* ap = A + (size_t)(tid >> 3) * lda + (tid & 7) * 8;
  const bf16_t* bp = Bt + (size_t)(tid >> 3) * ldb + (tid & 7) * 8;
  const int so = (tid >> 3) * 64 + (((tid & 7) ^ ((tid >> 4) & 7)) * 8);
  const int fsw = fr >> 1;
#define GLOAD(ko) do { \
    _Pragma("unroll") for (int i = 0; i < 4; ++i) ra[i] = *(const u32x4*)(ap + (size_t)(32 * i) * lda + (ko)); \
    _Pragma("unroll") for (int i = 0; i < NB; ++i) rb[i] = *(const u32x4*)(bp + (size_t)(bstride * i) * ldb + (ko)); } while (0)
#define GSTORE(st) do { \
    _Pragma("unroll") for (int i = 0; i < 4; ++i) *(u32x4*)(sA + (st) * GST + so + 32 * i * 64) = ra[i]; \
    _Pragma("unroll") for (int i = 0; i < NB; ++i) *(u32x4*)(sB + (st) * GST + so + 32 * i * 64) = rb[i]; } while (0)
#define GCOMPUTE(st) do { \
    const bf16_t* cA = sA + (st) * GST; const bf16_t* cB = sB + (st) * GST; \
    _Pragma("unroll") for (int ks = 0; ks < 2; ++ks) { \
      bf16x8 af[4], bfr[NT]; \
      _Pragma("unroll") for (int mi = 0; mi < 4; ++mi) af[mi] = *(const bf16x8*)(cA + (wm * 64 + mi * 16 + fr) * 64 + (((ks * 4 + fq) ^ fsw) * 8)); \
      _Pragma("unroll") for (int ni = 0; ni < NT; ++ni) bfr[ni] = *(const bf16x8*)(cB + (wn * NT * 16 + ni * 16 + fr) * 64 + (((ks * 4 + fq) ^ fsw) * 8)); \
      _Pragma("unroll") for (int mi = 0; mi < 4; ++mi) \
        _Pragma("unroll") for (int ni = 0; ni < NT; ++ni) acc[mi][ni] = __builtin_amdgcn_mfma_f32_16x16x32_bf16(bfr[ni], af[mi], acc[mi][ni], 0, 0, 0); \
    } } while (0)
  __syncthreads();
  GLOAD(0); GSTORE(0);
  if (nk > 1) GLOAD(64);
  __syncthreads();
  for (int kt = 0; kt < nk; ++kt) {
    const int cur = kt & 1;
    if (kt + 1 < nk) { GSTORE(cur ^ 1); if (kt + 2 < nk) GLOAD((kt + 2) * 64); }
    if (LOWREG) {
      const bf16_t* cA = sA + cur * GST; const bf16_t* cB = sB + cur * GST;
#pragma nounroll
      for (int ks = 0; ks < 2; ++ks) {
        bf16x8 af[4], bfr[NT];
#pragma unroll
        for (int mi = 0; mi < 4; ++mi) af[mi] = *(const bf16x8*)(cA + (wm * 64 + mi * 16 + fr) * 64 + (((ks * 4 + fq) ^ fsw) * 8));
#pragma unroll
        for (int ni = 0; ni < NT; ++ni) bfr[ni] = *(const bf16x8*)(cB + (wn * NT * 16 + ni * 16 + fr) * 64 + (((ks * 4 + fq) ^ fsw) * 8));
#pragma unroll
        for (int mi = 0; mi < 4; ++mi)
#pragma unroll
          for (int ni = 0; ni < NT; ++ni) acc[mi][ni] = __builtin_amdgcn_mfma_f32_16x16x32_bf16(bfr[ni], af[mi], acc[mi][ni], 0, 0, 0);
      }
    } else GCOMPUTE(cur);
    __syncthreads();
  }
#undef GLOAD
#undef GSTORE
#undef GCOMPUTE
}
template <int NT>
DI void zero_acc(f32x4 (&acc)[4][NT]) {
#pragma unroll
  for (int mi = 0; mi < 4; ++mi)
#pragma unroll
    for (int ni = 0; ni < NT; ++ni) acc[mi][ni] = f32x4{0.f, 0.f, 0.f, 0.f};
}


constexpr int BGA = 128 * 32, BGB = 256 * 32;
DI void gemm_big(f32x4 (&acc)[4][8], const bf16_t* A, int lda, const bf16_t* Bt, int ldb, int K, char* smem, int s1 = 64, int s2 = 128, int brow = -1) {
  bf16_t* sA = (bf16_t*)smem; bf16_t* sB = sA + 2 * BGA;
  const int tid = otid(), lane = tid & 63, wid = tid >> 6;
  const int wm = wid >> 1, wn = wid & 1, fr = lane & 15, fq = lane >> 4;
  const int nk = K >> 5;
  const bf16_t* ap = A + (size_t)(tid >> 2) * lda + (tid & 3) * 8;
  const bf16_t* bp = Bt + (size_t)(brow >= 0 ? brow : (tid >> 2)) * ldb + (tid & 3) * 8;
  const int so = (tid >> 2) * 32 + (((tid & 3) ^ (((tid >> 5) & 1) << 1)) * 8);
  const int fo = fr * 32 + ((fq ^ (((fr >> 3) & 1) << 1)) * 8);
  u32x4 ra[2], rb[4];
#define BLOADG(kt) do { \
    _Pragma("unroll") for (int i = 0; i < 2; ++i) ra[i] = *(const u32x4*)(ap + (size_t)(64 * i) * lda + (kt) * 32); \
    _Pragma("unroll") for (int i = 0; i < 4; ++i) rb[i] = *(const u32x4*)(bp + (size_t)((i & 1) * s1 + (i >> 1) * s2) * ldb + (kt) * 32); } while (0)
#define BSTOREG(st) do { \
    _Pragma("unroll") for (int i = 0; i < 2; ++i) *(u32x4*)(sA + (st) * BGA + so + 64 * i * 32) = ra[i]; \
    _Pragma("unroll") for (int i = 0; i < 4; ++i) *(u32x4*)(sB + (st) * BGB + so + 64 * i * 32) = rb[i]; } while (0)
  __syncthreads();
  BLOADG(0); BSTOREG(0);
  if (nk > 1) BLOADG(1);
  __syncthreads();
  for (int kt = 0; kt < nk; ++kt) {
    const int cur = kt & 1;
    if (kt + 1 < nk) { BSTOREG(cur ^ 1); if (kt + 2 < nk) BLOADG(kt + 2); }
    const bf16_t* cA = sA + cur * BGA + (wm * 64) * 32 + fo; const bf16_t* cB = sB + cur * BGB + (wn * 128) * 32 + fo;
    bf16x8 af[4];
#pragma unroll
    for (int mi = 0; mi < 4; ++mi) af[mi] = *(const bf16x8*)(cA + mi * 16 * 32);
#pragma unroll
    for (int nh = 0; nh < 2; ++nh) {
      bf16x8 bfr[4];
#pragma unroll
      for (int ni = 0; ni < 4; ++ni) bfr[ni] = *(const bf16x8*)(cB + (nh * 4 + ni) * 16 * 32);
#pragma unroll
      for (int mi = 0; mi < 4; ++mi)
#pragma unroll
        for (int ni = 0; ni < 4; ++ni) acc[mi][nh * 4 + ni] = __builtin_amdgcn_mfma_f32_16x16x32_bf16(bfr[ni], af[mi], acc[mi][nh * 4 + ni], 0, 0, 0);
    }
    __syncthreads();
  }
#undef BLOADG
#undef BSTOREG
}
DI void zero_acc8(f32x4 (&acc)[4][8]) {
#pragma unroll
  for (int mi = 0; mi < 4; ++mi)
#pragma unroll
    for (int ni = 0; ni < 8; ++ni) acc[mi][ni] = f32x4{0.f, 0.f, 0.f, 0.f};
}

DI void inproj_tile(const Params& p, int l, int tile, char* smem) {
  const int mt = tile & 255, nt = tile >> 8;
  f32x4 acc[4][8]; zero_acc8(acc);
  gemm_big(acc, P_XN + (size_t)mt * 128 * 1024, 1024, P_W1T + ((size_t)l * 4864 + nt * 256) * 1024, 1024, 1024, smem);
  const int lane = otid() & 63, wid = otid() >> 6, wm = wid >> 1, wn = wid & 1, fr = lane & 15, fq = lane >> 4;
#pragma unroll
  for (int mi = 0; mi < 4; ++mi)
#pragma unroll
    for (int ni = 0; ni < 8; ++ni) {
      size_t row = (size_t)mt * 128 + wm * 64 + mi * 16 + fr; int col = nt * 256 + wn * 128 + ni * 16 + fq * 4;
      uint2 o; o.x = pack2(acc[mi][ni][0], acc[mi][ni][1]); o.y = pack2(acc[mi][ni][2], acc[mi][ni][3]);
      *(uint2*)(P_PROJ + row * PW + col) = o;
    }
}

DI void row_scales(const bf16_t* A, int lda, int K, float* sRow) {
  const int row = otid() >> 1, half = otid() & 1;
  const int per = K >> 1;
  const bf16_t* a = A + (size_t)row * lda + half * per;
  float ss = 0.f;
  for (int c = 0; c < per; c += 8) {
    uint4 u = *(const uint4*)(a + c);
    float f;
    f = BLO(u.x); ss += f * f; f = BHI(u.x); ss += f * f; f = BLO(u.y); ss += f * f; f = BHI(u.y); ss += f * f;
    f = BLO(u.z); ss += f * f; f = BHI(u.z); ss += f * f; f = BLO(u.w); ss += f * f; f = BHI(u.w); ss += f * f;
  }
  ss += __shfl_xor(ss, 1);
  if (half == 0) sRow[row] = rsqrtf(ss / (float)K + 1e-6f);
}
DI void mla_item(const Params& p, int l, int item, char* smem) {
  bf16_t* sA = (bf16_t*)smem; bf16_t* sB = sA + 2 * GST; float* sRow = (float*)(sB + 2 * GST);
  const int lane = otid() & 63, wid = otid() >> 6, wm = wid >> 1, wn = wid & 1, fr = lane & 15, fq = lane >> 4;
  if (item < 768) {
    const int mt = item & 255, nt = item >> 8;
    const bf16_t* A = P_PROJ + (size_t)mt * 128 * PW + C_AQ;
    __syncthreads();
    row_scales(A, PW, 256, sRow);
    f32x4 acc[4][4]; zero_acc<4>(acc);
    gemm_mainloop<4>(acc, A, PW, P_WQT + ((size_t)l * 384 + nt * 128) * 256, 256, 256, sA, sB);
    if (nt < 2) {
#pragma unroll
      for (int mi = 0; mi < 4; ++mi)
#pragma unroll
        for (int ni = 0; ni < 4; ++ni) {
          int rl = wm * 64 + mi * 16 + fr; size_t t = (size_t)mt * 128 + rl; float s = sRow[rl] * QS96;
          int c = nt * 128 + wn * 64 + ni * 16 + fq * 4; int h = c >> 6, d = c & 63;
          uint2 o; o.x = pack2(acc[mi][ni][0] * s, acc[mi][ni][1] * s); o.y = pack2(acc[mi][ni][2] * s, acc[mi][ni][3] * s);
          *(uint2*)(P_QA + t * 384 + h * 96 + d) = o;
        }
    } else {
#pragma unroll
      for (int mi = 0; mi < 4; ++mi)
#pragma unroll
        for (int np = 0; np < 2; ++np) {
          int rl = wm * 64 + mi * 16 + fr; size_t t = (size_t)mt * 128 + rl; float s = sRow[rl] * QS96;
          int pos = (int)(t & (SEQ - 1)); int h = wn * 2 + np;
          const float* cs = P_ROPE + pos * 32 + fq * 4;
          float o1[4], o2[4];
#pragma unroll
          for (int j = 0; j < 4; ++j) {
            float x1 = acc[mi][np * 2][j] * s, x2 = acc[mi][np * 2 + 1][j] * s; float c = cs[j], sn = cs[16 + j];
            o1[j] = x1 * c - x2 * sn; o2[j] = x1 * sn + x2 * c;
          }
          uint2 a; a.x = pack2(o1[0], o1[1]); a.y = pack2(o1[2], o1[3]);
          uint2 b; b.x = pack2(o2[0], o2[1]); b.y = pack2(o2[2], o2[3]);
          *(uint2*)(P_QA + t * 384 + h * 96 + 64 + fq * 4) = a;
          *(uint2*)(P_QA + t * 384 + h * 96 + 80 + fq * 4) = b;
        }
    }
  } else if (item < 768 + 1024) {
    const int it = item - 768; const int mt = it & 255, h = it >> 8;
    const bf16_t* A = P_PROJ + (size_t)mt * 128 * PW + C_AKV;
    __syncthreads();
    row_scales(A, PW, 128, sRow);
    f32x4 acc[4][4]; zero_acc<4>(acc);
    gemm_mainloop<4>(acc, A, PW, P_WKVT + ((size_t)l * 512 + h * 128) * 128, 128, 128, sA, sB);
#pragma unroll
    for (int mi = 0; mi < 4; ++mi)
#pragma unroll
      for (int ni = 0; ni < 4; ++ni) {
        int rl = wm * 64 + mi * 16 + fr; size_t t = (size_t)mt * 128 + rl; float s = sRow[rl];
        int d = ni * 16 + fq * 4;
        uint2 o; o.x = pack2(acc[mi][ni][0] * s, acc[mi][ni][1] * s); o.y = pack2(acc[mi][ni][2] * s, acc[mi][ni][3] * s);
        if (wn == 0) *(uint2*)(P_KA + t * 384 + h * 96 + d) = o;
        else *(uint2*)(P_VA + t * 256 + h * 64 + d) = o;
      }
  } else {
    const int it = item - 1792;
    const int half = lane >> 5, pl = lane & 31;
    for (int i = 0; i < 32; ++i) {
      size_t t = (size_t)it * 128 + wid * 32 + i; int pos = (int)(t & (SEQ - 1));
      bf16_t* row = P_PROJ + t * PW;
#pragma unroll
      for (int s3 = 0; s3 < 3; ++s3) {
        int slot = s3 * 2 + half;
        bf16_t* hp = row + (slot < 4 ? C_BQ + slot * 64 : C_BK + (slot - 4) * 64);
        const float* g = (slot < 4 ? p.gq_g : p.gk_g) + l * 64;
        int d1, fi, ap;
        if (pl < 16) { d1 = pl; fi = pl; ap = pos >> 6; } else { d1 = 32 + (pl - 16); fi = pl - 16; ap = pos & 63; }
        float x1 = bf2f(hp[d1]), x2 = bf2f(hp[d1 + 16]);
        float ss = x1 * x1 + x2 * x2;
#pragma unroll
        for (int o = 16; o; o >>= 1) ss += __shfl_xor(ss, o);
        float sc = rsqrtf(ss * (1.0f / 64.0f) + 1e-6f);
        if (slot < 4) sc *= QS64;
        x1 = x1 * sc * g[d1]; x2 = x2 * sc * g[d1 + 16];
        float c = P_ROPE[ap * 32 + fi], sn = P_ROPE[ap * 32 + 16 + fi];
        hp[d1] = f2bf(x1 * c - x2 * sn); hp[d1 + 16] = f2bf(x1 * sn + x2 * c);
      }
      if (lane < 16) {
        float x1 = bf2f(row[C_AKR + lane]), x2 = bf2f(row[C_AKR + 16 + lane]);
        float c = P_ROPE[pos * 32 + lane], sn = P_ROPE[pos * 32 + 16 + lane];
        bf16_t o1 = f2bf(x1 * c - x2 * sn), o2 = f2bf(x1 * sn + x2 * c);
#pragma unroll
        for (int h = 0; h < 4; ++h) { P_KA[t * 384 + h * 96 + 64 + lane] = o1; P_KA[t * 384 + h * 96 + 80 + lane] = o2; }
      }
    }
  }
}

#define MFMA32(a, b, c) __builtin_amdgcn_mfma_f32_32x32x16_bf16((a), (b), (c), 0, 0, 0)
template <int OFF> DI bf16x4 tr_read(unsigned addr) {
  bf16x4 r; asm volatile("ds_read_b64_tr_b16 %0, %1 offset:%2" : "=&v"(r) : "v"(addr), "i"(OFF) : "memory"); return r;
}
DI float half_swap_max(float v) {
  auto rr = __builtin_amdgcn_permlane32_swap(__float_as_uint(v), __float_as_uint(v), false, false);
  return fmaxf(__uint_as_float(rr[0]), __uint_as_float(rr[1]));
}
DI float half_swap_sum(float v) {
  auto rr = __builtin_amdgcn_permlane32_swap(__float_as_uint(v), __float_as_uint(v), false, false);
  return __uint_as_float(rr[0]) + __uint_as_float(rr[1]);
}
DI bf16x8 pack8(const f32x16& p, int base) {
  u32x4 w = {pack2(p[base + 0], p[base + 1]), pack2(p[base + 2], p[base + 3]), pack2(p[base + 4], p[base + 5]), pack2(p[base + 6], p[base + 7])};
  return __builtin_bit_cast(bf16x8, w);
}
template <int DB, int VLD> DI void pv_block(f32x16& o, unsigned vb, bf16x8 pb0, bf16x8 pb1, bf16x8 pb2, bf16x8 pb3) {
  constexpr int RB = VLD * 2;
  bf16x4 l0 = tr_read<0 * RB + 64 * DB>(vb), h0 = tr_read<8 * RB + 64 * DB>(vb);
  bf16x4 l1 = tr_read<16 * RB + 64 * DB>(vb), h1 = tr_read<24 * RB + 64 * DB>(vb);
  bf16x4 l2 = tr_read<32 * RB + 64 * DB>(vb), h2 = tr_read<40 * RB + 64 * DB>(vb);
  bf16x4 l3 = tr_read<48 * RB + 64 * DB>(vb), h3 = tr_read<56 * RB + 64 * DB>(vb);
  asm volatile("s_waitcnt lgkmcnt(0)" ::: "memory"); __builtin_amdgcn_sched_barrier(0);
  o = MFMA32(__builtin_shufflevector(l0, h0, 0, 1, 2, 3, 4, 5, 6, 7), pb0, o);
  o = MFMA32(__builtin_shufflevector(l1, h1, 0, 1, 2, 3, 4, 5, 6, 7), pb1, o);
  o = MFMA32(__builtin_shufflevector(l2, h2, 0, 1, 2, 3, 4, 5, 6, 7), pb2, o);
  o = MFMA32(__builtin_shufflevector(l3, h3, 0, 1, 2, 3, 4, 5, 6, 7), pb3, o);
}
DI f32x16 splat16(float v) { f32x16 r;
#pragma unroll
  for (int i = 0; i < 16; ++i) r[i] = v;
  return r; }

template <int DQK, bool FIXEDM>
DI void attn_dense_mfma(const bf16_t* Qb, int ldq, const bf16_t* Kb, int ldk, const bf16_t* Vb, int ldv, bf16_t* gate_io, char* smem, bool store, float mbound) {
  constexpr int NS = DQK / 16, KLD = DQK + 8, VLD = 96, CPR = DQK / 8, NKC = (64 * CPR) / 256;
  constexpr int KBYTES = 64 * KLD * 2, VBYTES = 64 * VLD * 2;
  char* sKc = smem; char* sVc = smem + 2 * KBYTES;
  const int tid = otid(), lane = tid & 63, wid = tid >> 6, r = lane & 31, h = lane >> 5;
  bf16x8 qf[NS];
#pragma unroll
  for (int s = 0; s < NS; ++s) qf[s] = *(const bf16x8*)(Qb + (size_t)(wid * 32 + r) * ldq + 16 * s + 8 * h);
  const bf16_t* kp = Kb + (size_t)(tid >> 2) * ldk + (tid & 3) * (NKC * 8);
  const int kso = ((tid >> 2) * KLD + (tid & 3) * (NKC * 8)) * 2;
  const bf16_t* vp0 = Vb + (size_t)(tid >> 3) * ldv + (tid & 7) * 8;
  const bf16_t* vp1 = vp0 + (size_t)32 * ldv;
  const int vso = ((tid >> 3) * VLD + (tid & 7) * 8) * 2;
  const size_t kstep = (size_t)64 * ldk, vstep = (size_t)64 * ldv;
  u32x4 rk[NKC], rv[2];
#define KLOAD() do { _Pragma("unroll") for (int i = 0; i < NKC; ++i) rk[i] = *(const u32x4*)(kp + i * 8); kp += kstep; } while (0)
#define VLOAD() do { rv[0] = *(const u32x4*)vp0; rv[1] = *(const u32x4*)vp1; vp0 += vstep; vp1 += vstep; } while (0)
#define KSTORE(st) do { _Pragma("unroll") for (int i = 0; i < NKC; ++i) *(u32x4*)(sKc + (st) * KBYTES + kso + i * 16) = rk[i]; } while (0)
#define VSTORE(st) do { *(u32x4*)(sVc + (st) * VBYTES + vso) = rv[0]; *(u32x4*)(sVc + (st) * VBYTES + vso + 32 * VLD * 2) = rv[1]; } while (0)
#define QKT(P0, P1, st) do { \
    const bf16_t* sK = (const bf16_t*)(sKc + (st) * KBYTES) + r * KLD + 8 * h; \
    P0 = negm; P1 = negm; \
    _Pragma("unroll") for (int s = 0; s < NS; ++s) { \
      bf16x8 k0 = *(const bf16x8*)(sK + 16 * s); bf16x8 k1 = *(const bf16x8*)(sK + 32 * KLD + 16 * s); \
      P0 = MFMA32(k0, qf[s], P0); P1 = MFMA32(k1, qf[s], P1); } } while (0)
  const unsigned vb0 = (unsigned)(size_t)sVc + (unsigned)(((4 * h + ((lane & 15) >> 2)) * VLD + 16 * ((lane >> 4) & 1) + 4 * (lane & 3)) * 2);
  f32x16 o0 = splat16(0.f), o1 = splat16(0.f), negm = splat16(FIXEDM ? -mbound : 0.f);
  f32x16 pa0, pa1, pc0, pc1;
  float m_run = 0.f, l_run = 0.f;
  constexpr int NT = SEQ / 64;
  __syncthreads();
  KLOAD(); VLOAD(); KSTORE(0); VSTORE(0);
  KLOAD(); KSTORE(1);
  __syncthreads();
  QKT(pa0, pa1, 0);
  __syncthreads();
#define STEP(SC0, SC1, SN0, SN1, PAR, FIRST, LK, LV) do { \
    if (LK) KLOAD(); \
    if (LV) VLOAD(); \
    float pm = 0.f; \
    if (!FIXEDM) { pm = fmaxf(SC0[0], SC1[0]); \
    _Pragma("unroll") for (int i = 1; i < 16; i += 1) pm = fmaxf(fmaxf(pm, SC0[i]), SC1[i]); \
    pm = half_swap_max(pm); } \
    if (!FIXEDM && ((FIRST) || __any(pm > 8.0f))) { \
      float delta; \
      if (FIRST) delta = pm; \
      else { delta = fmaxf(pm, 0.f); float alpha = __builtin_amdgcn_exp2f(-delta); l_run *= alpha; \
        _Pragma("unroll") for (int i = 0; i < 16; ++i) { o0[i] *= alpha; o1[i] *= alpha; } } \
      m_run += delta; \
      _Pragma("unroll") for (int i = 0; i < 16; ++i) { SC0[i] -= delta; SC1[i] -= delta; } \
      negm = splat16(-m_run); \
    } \
    if (LV) QKT(SN0, SN1, (PAR) ^ 1); \
    float ls = 0.f; \
    _Pragma("unroll") for (int i = 0; i < 16; ++i) { SC0[i] = __builtin_amdgcn_exp2f(SC0[i]); SC1[i] = __builtin_amdgcn_exp2f(SC1[i]); ls += SC0[i] + SC1[i]; } \
    l_run += ls; \
    bf16x8 pb0 = pack8(SC0, 0), pb1 = pack8(SC0, 8), pb2 = pack8(SC1, 0), pb3 = pack8(SC1, 8); \
    const unsigned vb = vb0 + (PAR) * VBYTES; \
    pv_block<0, VLD>(o0, vb, pb0, pb1, pb2, pb3); \
    pv_block<1, VLD>(o1, vb, pb0, pb1, pb2, pb3); \
    if (LK) KSTORE(PAR); \
    if (LV) VSTORE((PAR) ^ 1); \
    __syncthreads(); } while (0)
  pc0 = negm; pc1 = negm;
  STEP(pa0, pa1, pc0, pc1, 0, true, 1, 1);
  STEP(pc0, pc1, pa0, pa1, 1, false, 1, 1);
  for (int j = 2; j < NT - 2; j += 2) {
    STEP(pa0, pa1, pc0, pc1, 0, false, 1, 1);
    STEP(pc0, pc1, pa0, pa1, 1, false, 1, 1);
  }
  STEP(pa0, pa1, pc0, pc1, 0, false, 0, 1);
  STEP(pc0, pc1, pa0, pa1, 1, false, 0, 0);
#undef STEP
#undef QKT
#undef KLOAD
#undef VLOAD
#undef KSTORE
#undef VSTORE
  if (!store) return;
  const float inv = 1.0f / half_swap_sum(l_run);
  bf16_t* grow = gate_io + (size_t)(wid * 32 + r) * PW;
#pragma unroll
  for (int db = 0; db < 2; ++db)
#pragma unroll
    for (int g4 = 0; g4 < 4; ++g4) {
      bf16_t* gp = grow + 32 * db + 8 * g4 + 4 * h;
      uint2 u = *(const uint2*)gp;
      float g[4] = {BLO(u.x), BHI(u.x), BLO(u.y), BHI(u.y)};
      float y[4];
#pragma unroll
      for (int e = 0; e < 4; ++e) { float ov = db == 0 ? o0[4 * g4 + e] : o1[4 * g4 + e]; y[e] = ov * inv * g[e] / (1.0f + __expf(-g[e])); }
      uint2 w; w.x = pack2(y[0], y[1]); w.y = pack2(y[2], y[3]);
      *(uint2*)gp = w;
    }
}
DI void dense_item(const Params& p, int l, int combo, int qblk, char* smem, bool store) {
  const int br = combo >> 4, bh = combo & 15, b = bh >> 2, h = bh & 3;
  const size_t t0 = (size_t)b * SEQ + qblk * 128;
  bf16_t* gate_io = P_PROJ + t0 * PW + C_GATE + br * 256 + h * 64;
  float bbound = 0.f;
  if (br != 0) {
    const int ln = otid() & 63;
    float gq = fabsf(p.gq_g[l * 64 + ln]), gk = fabsf(p.gk_g[l * 64 + ln]);
#pragma unroll
    for (int o = 32; o; o >>= 1) { gq = fmaxf(gq, __shfl_xor(gq, o)); gk = fmaxf(gk, __shfl_xor(gk, o)); }
    bbound = 64.0f * QS64 * 1.02f * gq * gk + 0.05f;
  }
  if (br == 0)
    attn_dense_mfma<96, false>(P_QA + t0 * 384 + h * 96, 384, P_KA + (size_t)b * SEQ * 384 + h * 96, 384, P_VA + (size_t)b * SEQ * 256 + h * 64, 256, gate_io, smem, store, 0.f);
  else {
    if (bbound <= 60.0f) attn_dense_mfma<64, true>(P_PROJ + t0 * PW + C_BQ + h * 64, PW, P_PROJ + (size_t)b * SEQ * PW + C_BK + (h >> 1) * 64, PW,
                        P_PROJ + (size_t)b * SEQ * PW + C_BV + (h >> 1) * 64, PW, gate_io, smem, store, bbound);
    else attn_dense_mfma<64, false>(P_PROJ + t0 * PW + C_BQ + h * 64, PW, P_PROJ + (size_t)b * SEQ * PW + C_BK + (h >> 1) * 64, PW,
                        P_PROJ + (size_t)b * SEQ * PW + C_BV + (h >> 1) * 64, PW, gate_io, smem, store, bbound);
  }
}

template <int W, bool SINK>
DI void attn_band_mfma(const bf16_t* Qb, size_t ldq, const bf16_t* Kb, const bf16_t* Vb, size_t ldk, int L, int i0,
                       const float* lut_g, float sink2, bf16_t* outp, size_t ldo, float* lse_out, size_t ldl, char* smem) {
  constexpr int NS = 4, KLD = 72, VLD = 96, NTW = (128 + 2 * W) / 64, LUTN = 2 * W + 1;
  constexpr int KBYTES = 64 * KLD * 2, VBYTES = 64 * VLD * 2;
  char* sKc = smem; char* sVc = smem + 2 * KBYTES; float* sLut = (float*)(smem + 2 * KBYTES + 2 * VBYTES);
  const int tid = otid(), lane = tid & 63, wid = tid >> 6, r = lane & 31, h = lane >> 5;
  __syncthreads();
  for (int e = tid; e < LUTN; e += 256) sLut[e] = lut_g[e];
  const int qi = i0 + wid * 32 + r;
  bf16x8 qf[NS];
#pragma unroll
  for (int s = 0; s < NS; ++s) qf[s] = *(const bf16x8*)(Qb + (size_t)qi * ldq + 16 * s + 8 * h);
  const int srow = tid >> 3, scc = tid & 7;
  u32x4 rk[2], rv[2];
#define BLOAD(k0) do { \
    rk[0] = *(const u32x4*)(Kb + (size_t)((k0) + srow) * ldk + scc * 8); rk[1] = *(const u32x4*)(Kb + (size_t)((k0) + srow + 32) * ldk + scc * 8); \
    rv[0] = *(const u32x4*)(Vb + (size_t)((k0) + srow) * ldk + scc * 8); rv[1] = *(const u32x4*)(Vb + (size_t)((k0) + srow + 32) * ldk + scc * 8); } while (0)
#define BSTORE(st) do { \
    *(u32x4*)(sKc + (st) * KBYTES + (srow * KLD + scc * 8) * 2) = rk[0]; *(u32x4*)(sKc + (st) * KBYTES + ((srow + 32) * KLD + scc * 8) * 2) = rk[1]; \
    *(u32x4*)(sVc + (st) * VBYTES + (srow * VLD + scc * 8) * 2) = rv[0]; *(u32x4*)(sVc + (st) * VBYTES + ((srow + 32) * VLD + scc * 8) * 2) = rv[1]; } while (0)
  const unsigned vb0 = (unsigned)(size_t)sVc + (unsigned)(((4 * h + ((lane & 15) >> 2)) * VLD + 16 * ((lane >> 4) & 1) + 4 * (lane & 3)) * 2);
  f32x16 o0 = splat16(0.f), o1 = splat16(0.f);
  float m_run = SINK ? sink2 : 0.f, l_run = (SINK && h == 0) ? 1.f : 0.f;
  bool seen = SINK;
  f32x16 negm = splat16(-m_run);
  const int lo = (i0 == 0) ? W / 64 : 0, hi = (i0 + 128 >= L) ? NTW - W / 64 : NTW;
  BLOAD(i0 - W + 64 * lo); BSTORE(0);
  __syncthreads();
  for (int j = lo; j < hi; ++j) {
    const int cur = (j - lo) & 1, k0 = i0 - W + 64 * j;
    if (j + 1 < hi) BLOAD(k0 + 64);
    const bf16_t* sK = (const bf16_t*)(sKc + cur * KBYTES);
    f32x16 p0 = negm, p1 = negm;
#pragma unroll
    for (int s = 0; s < NS; ++s) {
      bf16x8 k0f = *(const bf16x8*)(sK + r * KLD + 16 * s + 8 * h);
      bf16x8 k1f = *(const bf16x8*)(sK + (32 + r) * KLD + 16 * s + 8 * h);
      p0 = MFMA32(k0f, qf[s], p0);
      p1 = MFMA32(k1f, qf[s], p1);
    }
    const int offb = k0 + 4 * h - qi + W;
    float pm = -1e30f;
#pragma unroll
    for (int i = 0; i < 16; ++i) {
      int idx0 = offb + (i & 3) + 8 * (i >> 2), idx1 = idx0 + 32;
      int c0 = min(max(idx0, 0), 2 * W), c1 = min(max(idx1, 0), 2 * W);
      float b0 = sLut[c0], b1 = sLut[c1];
      p0[i] = ((unsigned)idx0 <= (unsigned)(2 * W)) ? p0[i] + b0 : -1e30f;
      p1[i] = ((unsigned)idx1 <= (unsigned)(2 * W)) ? p1[i] + b1 : -1e30f;
      pm = fmaxf(pm, fmaxf(p0[i], p1[i]));
    }
    pm = half_swap_max(pm);
    const bool has = pm > -1e29f;
    float delta = 0.f;
    if (has) { if (!seen) delta = pm; else if (pm > 8.0f) delta = pm; }
    if (__any(delta != 0.f)) {
      float alpha = seen ? __builtin_amdgcn_exp2f(-delta) : 1.0f;
      l_run *= alpha; m_run += delta;
#pragma unroll
      for (int i = 0; i < 16; ++i) { o0[i] *= alpha; o1[i] *= alpha; p0[i] -= delta; p1[i] -= delta; }
      negm = splat16(-m_run);
    }
    seen = seen || has;
    float ls = 0.f;
#pragma unroll
    for (int i = 0; i < 16; ++i) { p0[i] = __builtin_amdgcn_exp2f(p0[i]); p1[i] = __builtin_amdgcn_exp2f(p1[i]); ls += p0[i] + p1[i]; }
    l_run += ls;
    bf16x8 pb0 = pack8(p0, 0), pb1 = pack8(p0, 8), pb2 = pack8(p1, 0), pb3 = pack8(p1, 8);
    const unsigned vb = vb0 + cur * VBYTES;
    pv_block<0, VLD>(o0, vb, pb0, pb1, pb2, pb3);
    pv_block<1, VLD>(o1, vb, pb0, pb1, pb2, pb3);
    if (j + 1 < hi) BSTORE(cur ^ 1);
    __syncthreads();
  }
#undef BLOAD
#undef BSTORE
  const float ltot = half_swap_sum(l_run);
  const float inv = 1.0f / ltot;
  bf16_t* orow = outp + (size_t)qi * ldo;
  if (!SINK && h == 0) lse_out[(size_t)qi * ldl] = m_run + __log2f(ltot);
#pragma unroll
  for (int db = 0; db < 2; ++db)
#pragma unroll
    for (int g4 = 0; g4 < 4; ++g4) {
      bf16_t* gp = orow + 32 * db + 8 * g4 + 4 * h;
      float y[4];
      if (SINK) {
        uint2 u = *(const uint2*)gp;
        float g[4] = {BLO(u.x), BHI(u.x), BLO(u.y), BHI(u.y)};
#pragma unroll
        for (int e = 0; e < 4; ++e) { float ov = db == 0 ? o0[4 * g4 + e] : o1[4 * g4 + e]; y[e] = ov * inv * g[e] / (1.0f + __expf(-g[e])); }
      } else {
#pragma unroll
        for (int e = 0; e < 4; ++e) { float ov = db == 0 ? o0[4 * g4 + e] : o1[4 * g4 + e]; y[e] = ov * inv; }
      }
      uint2 w; w.x = pack2(y[0], y[1]); w.y = pack2(y[2], y[3]);
      *(uint2*)gp = w;
    }
}
DI void band_item(const Params& p, int l, int idx, char* smem) {
  if (idx < 3072) {
    const int g = idx >> 10, rem = idx & 1023, h = rem & 3, rem2 = rem >> 2, b = rem2 >> 6, u = rem2 & 63;
    const int sh = 2 * g, rr = 1 << sh;
    const int rho = u & (rr - 1), qblk = u >> sh;
    const size_t tok0 = (size_t)b * SEQ + rho;
    bf16_t* base = P_PROJ + tok0 * PW + g * 256 + h * 64;
    attn_band_mfma<64, false>(base + C_CQ, (size_t)rr * PW, base + C_CK, base + C_CV, (size_t)rr * PW, SEQ >> sh, qblk * 128,
                              P_LUTC + (g * 4 + h) * 129, 0.f, base + C_CQ, (size_t)rr * PW, P_LSE + tok0 * 12 + g * 4 + h, (size_t)rr * 12, smem);
  } else {
    const int it = idx - 3072, hq = it & 3, rem = it >> 2, b = rem >> 6, qblk = rem & 63;
    bf16_t* base = P_PROJ + (size_t)b * SEQ * PW;
    attn_band_mfma<128, true>(base + C_DQ + hq * 64, PW, base + C_DK + (hq >> 1) * 64, base + C_DV + (hq >> 1) * 64, PW, SEQ, qblk * 128,
                              P_LUTD + hq * 257, p.sink[l * 4 + hq] * LOG2E, base + C_GATE + 768 + hq * 64, PW, nullptr, 0, smem);
  }
}
DI void combine_c(const Params& p) {
  for (size_t u = (size_t)blockIdx.x * 256 + otid(); u < (size_t)32768 * 32; u += (size_t)gridDim.x * 256) {
    const size_t t = u >> 5; const int h = (int)(u >> 3) & 3, ch = (int)u & 7;
    const float* ls = P_LSE + t * 12 + h;
    float l0 = ls[0], l1 = ls[4], l2 = ls[8];
    float mx = fmaxf(l0, fmaxf(l1, l2));
    float a0 = __builtin_amdgcn_exp2f(l0 - mx), a1 = __builtin_amdgcn_exp2f(l1 - mx), a2 = __builtin_amdgcn_exp2f(l2 - mx);
    float inv = 1.0f / (a0 + a1 + a2); a0 *= inv; a1 *= inv; a2 *= inv;
    const bf16_t* row = P_PROJ + t * PW;
    uint4 x0 = *(const uint4*)(row + C_CQ + h * 64 + ch * 8), x1 = *(const uint4*)(row + C_CQ + 256 + h * 64 + ch * 8),
          x2 = *(const uint4*)(row + C_CQ + 512 + h * 64 + ch * 8);
    bf16_t* gp = P_PROJ + t * PW + C_GATE + 512 + h * 64 + ch * 8;
    uint4 gu = *(const uint4*)gp;
    unsigned xa[4] = {x0.x, x0.y, x0.z, x0.w}, xb[4] = {x1.x, x1.y, x1.z, x1.w}, xc[4] = {x2.x, x2.y, x2.z, x2.w}, gg[4] = {gu.x, gu.y, gu.z, gu.w};
    unsigned ov[4];
#pragma unroll
    for (int e = 0; e < 4; ++e) {
      float ylo = a0 * BLO(xa[e]) + a1 * BLO(xb[e]) + a2 * BLO(xc[e]);
      float yhi = a0 * BHI(xa[e]) + a1 * BHI(xb[e]) + a2 * BHI(xc[e]);
      float glo = BLO(gg[e]), ghi = BHI(gg[e]);
      ov[e] = pack2(ylo * glo / (1.0f + __expf(-glo)), yhi * ghi / (1.0f + __expf(-ghi)));
    }
    uint4 w; w.x = ov[0]; w.y = ov[1]; w.z = ov[2]; w.w = ov[3];
    *(uint4*)gp = w;
  }
}

DI void merge_tile(const Params& p, int l, int tile, char* smem) {
  bf16_t* sA = (bf16_t*)smem; bf16_t* sB = sA + 2 * GST;
  const int mt = tile & 255, nt = tile >> 8;
  unsigned sg[4][8][2];
  {
    f32x4 accG[4][8]; zero_acc8(accG);
    gemm_big(accG, P_XN + (size_t)mt * 128 * 1024, 1024, P_WMT + ((size_t)l * 4096 + nt * 64) * 1024, 1024, 1024, smem, 2048, 32,
             (otid() >> 7) * 1024 + ((otid() >> 2) & 31));
#pragma unroll
    for (int mi = 0; mi < 4; ++mi)
#pragma unroll
      for (int ni = 0; ni < 8; ++ni) {
        float s0 = 1.0f / (1.0f + __expf(-accG[mi][ni][0])), s1 = 1.0f / (1.0f + __expf(-accG[mi][ni][1]));
        float s2 = 1.0f / (1.0f + __expf(-accG[mi][ni][2])), s3 = 1.0f / (1.0f + __expf(-accG[mi][ni][3]));
        sg[mi][ni][0] = pack2(s0, s1); sg[mi][ni][1] = pack2(s2, s3);
      }
  }
  f32x4 accM[4][2]; zero_acc<2>(accM);
#pragma unroll 1
  for (int n = 0; n < 4; ++n) {
    f32x4 accB[4][2]; zero_acc<2>(accB);
    gemm_mainloop<2>(accB, P_PROJ + (size_t)mt * 128 * PW + C_GATE + n * 256, PW, P_WBT + ((size_t)(l * 4 + n) * 1024 + nt * 64) * 256, 256, 256, sA, sB);
#pragma unroll
    for (int mi = 0; mi < 4; ++mi)
#pragma unroll
      for (int ni = 0; ni < 2; ++ni) {
        accM[mi][ni][0] += accB[mi][ni][0] * BLO(sg[mi][ni][0]); accM[mi][ni][1] += accB[mi][ni][1] * BHI(sg[mi][ni][0]);
        accM[mi][ni][2] += accB[mi][ni][2] * BLO(sg[mi][ni][1]); accM[mi][ni][3] += accB[mi][ni][3] * BHI(sg[mi][ni][1]);
      }
#pragma unroll
    for (int mi = 0; mi < 4; ++mi)
#pragma unroll
      for (int k = 0; k < 6; ++k) { sg[mi][k][0] = sg[mi][k + 2][0]; sg[mi][k][1] = sg[mi][k + 2][1]; }
  }
  const int lane = otid() & 63, wid = otid() >> 6, wm = wid >> 1, wn = wid & 1, fr = lane & 15, fq = lane >> 4;
#pragma unroll
  for (int mi = 0; mi < 4; ++mi)
#pragma unroll
    for (int ni = 0; ni < 2; ++ni) {
      size_t row = (size_t)mt * 128 + wm * 64 + mi * 16 + fr; int col = nt * 64 + wn * 32 + ni * 16 + fq * 4;
      uint2 o; o.x = pack2(accM[mi][ni][0], accM[mi][ni][1]); o.y = pack2(accM[mi][ni][2], accM[mi][ni][3]);
      *(uint2*)(P_PROJ + row * PW + C_MERGED + col) = o;
    }
}

DI void outproj_tile(const Params& p, int l, int tile, char* smem) {
  const int mt = tile & 255, nt = tile >> 8;
  f32x4 acc[4][8]; zero_acc8(acc);
  gemm_big(acc, P_PROJ + (size_t)mt * 128 * PW + C_MERGED, PW, P_WOT + ((size_t)l * 1024 + nt * 256) * 1024, 1024, 1024, smem);
  const float* xin = l == 0 ? p.x : p.out;
  const int lane = otid() & 63, wid = otid() >> 6, wm = wid >> 1, wn = wid & 1, fr = lane & 15, fq = lane >> 4;
#pragma unroll
  for (int mi = 0; mi < 4; ++mi)
#pragma unroll
    for (int ni = 0; ni < 8; ++ni) {
      size_t row = (size_t)mt * 128 + wm * 64 + mi * 16 + fr; int col = nt * 256 + wn * 128 + ni * 16 + fq * 4;
      float4 xi = *(const float4*)(xin + row * 1024 + col);
      float4 o; o.x = xi.x + acc[mi][ni][0]; o.y = xi.y + acc[mi][ni][1]; o.z = xi.z + acc[mi][ni][2]; o.w = xi.w + acc[mi][ni][3];
      *(float4*)(p.out + row * 1024 + col) = o;
    }
}


#define XB_TMO      128
#define XB_XCNT(j)  (256  + 64 * (j))
#define XB_XSUB(j)  (1280 + 64 * (j))
#define XB_XGEN(j)  (2304 + 64 * (j))
#define XB_TOP      3328
#define XB_TOPGEN   3392
#define XCD_BAR_WORDS 3456
#define XB_SPIN_CAP (1u << 22)
#define LAS __attribute__((address_space(3)))
DI unsigned xb_ld(unsigned* p)              { return __hip_atomic_load(p, __ATOMIC_RELAXED, __HIP_MEMORY_SCOPE_AGENT); }
DI unsigned xb_add(unsigned* p, unsigned v) { return __hip_atomic_fetch_add(p, v, __ATOMIC_RELAXED, __HIP_MEMORY_SCOPE_AGENT); }
DI unsigned xb_xcc_id() { return (unsigned)__builtin_amdgcn_s_getreg((3 << 11) | 20) & 0xFu; }
#define XB_SPIN(cond, bar) do { unsigned _sp = 0; while (cond) { __builtin_amdgcn_s_sleep(1); \
    if ((++_sp & 255u) == 0u) { if (xb_ld(&(bar)[XB_TMO])) break; if (_sp > XB_SPIN_CAP) { atomicAdd(&(bar)[XB_TMO], 1u); break; } } } } while (0)
struct XcdBarrier { unsigned* bar; unsigned x; volatile LAS unsigned* st; };
DI XcdBarrier xcd_barrier_post(unsigned* bar, volatile LAS unsigned* st) {
  XcdBarrier b; b.bar = bar; b.x = xb_xcc_id(); b.st = st;
  if (threadIdx.x == 0) (void)xb_add(&bar[XB_XCNT(b.x)], 1u);
  return b;
}
DI void xcd_barrier_complete(unsigned* bar, unsigned x, unsigned& nloc, unsigned& nx) {
  const unsigned G = gridDim.x * gridDim.y * gridDim.z;
  unsigned sum, cnt, mine, sp = 0u;
  for (;;) {
    sum = 0u; cnt = 0u; mine = 0u;
#pragma unroll
    for (unsigned j = 0; j < 16; ++j) { const unsigned c = xb_ld(&bar[XB_XCNT(j)]); sum += c; cnt += (c > 0u) ? 1u : 0u; mine = (j == x) ? c : mine; }
    if (sum == G) break;
    __builtin_amdgcn_s_sleep(1);
    if ((++sp & 255u) == 0u) { if (xb_ld(&bar[XB_TMO])) break; if (sp > XB_SPIN_CAP) { atomicAdd(&bar[XB_TMO], 1u); break; } }
  }
  nloc = mine > 0u ? mine : 1u; nx = cnt > 0u ? cnt : 1u;
}
DI void xcd_barrier(const XcdBarrier& b) {
  asm volatile("s_waitcnt vmcnt(0)" ::: "memory");
  __syncthreads();
  if (threadIdx.x == 0) {
    unsigned* bar = b.bar;
    __builtin_amdgcn_s_waitcnt(0);
    unsigned nloc = b.st[0], nx = b.st[1];
    if (nloc == 0u) { xcd_barrier_complete(bar, b.x, nloc, nx); b.st[0] = nloc; b.st[1] = nx; }
    const unsigned old = xb_add(&bar[XB_XSUB(b.x)], 1u);
    const unsigned gen = old / nloc;
    if (old + 1u == (gen + 1u) * nloc) {
      __builtin_amdgcn_fence(__ATOMIC_RELEASE, "agent");
      asm volatile("s_waitcnt vmcnt(0)" ::: "memory");
      const unsigned og = xb_add(&bar[XB_TOP], 1u);
      const unsigned tg = og / nx;
      if (og + 1u == (tg + 1u) * nx) xb_add(&bar[XB_TOPGEN], 1u);
      else XB_SPIN(xb_ld(&bar[XB_TOPGEN]) == tg, bar);
      __builtin_amdgcn_fence(__ATOMIC_ACQUIRE, "agent");
      xb_add(&bar[XB_XGEN(b.x)], 1u);
      asm volatile("s_waitcnt vmcnt(0)" ::: "memory");
    } else {
      XB_SPIN(xb_ld(&bar[XB_XGEN(b.x)]) == gen, bar);
      __builtin_amdgcn_fence(__ATOMIC_ACQUIRE, "agent");
      asm volatile("s_waitcnt vmcnt(0)" ::: "memory");
    }
  }
  __syncthreads();
}

DI void run_phase(const Params& p, int ph, char* smem, bool never) {
  const int G = gridDim.x, B = blockIdx.x;
  if (ph == 0) {
    for (int i = B; i < 6097; i += G) prep_item(p, i, (float*)smem);
    for (int i = B; i < 1024; i += G) norm_rows_bf16(p.x, p.norm_g, P_XN, i);
  } else if (ph == 14) {
    for (int i = B; i < 1024; i += G) norm_rows_f32(p.out, p.final_g, i);
  } else if (ph == 7) {
    for (int i = B; i < 1024; i += G) norm_rows_bf16(p.out, p.norm_g + 1024, P_XN, i);
  } else {
    const int l = ph > 7 ? 1 : 0; const int s = ph > 7 ? ph - 8 : ph - 1;
    const int xcd = B & 7, lb = B >> 3, nl = G >> 3;
    if (s == 0) {
      for (int w = lb; w < 64 * 8 + 96; w += nl) {
        const int it = w >> 6, l64 = w & 63;
        int mt, nt;
        if (it < 8) { const int a = it >> 1, gn = it & 1; mt = 8 * (xcd + 8 * a) + (l64 & 7); nt = 8 * gn + (l64 >> 3); }
        else { const int q = (it - 8) * 64 + l64; const int ml = q / 3; mt = 8 * (xcd + 8 * (ml >> 3)) + (ml & 7); nt = 16 + q % 3; }
        inproj_tile(p, l, nt * 256 + mt, smem);
      }
    }
    else if (s == 1) { for (int i = B; i < 2048; i += G) mla_item(p, l, i, smem); }
    else if (s == 2) {
#ifdef REP_DENSE
      for (int w = lb; w < 256; w += nl) dense_item(p, l, xcd + 8 * (w >> 6), w & 63, smem, never);
#endif
      for (int w = lb; w < 256; w += nl) { const int k = w >> 6, ck = ((k & 1) << 1 | (k >> 1)) ^ 1; dense_item(p, l, xcd + 8 * ck, w & 63, smem, true); }
      for (int i = B; i < 4096; i += G) band_item(p, l, i, smem);
    }
    else if (s == 3) { combine_c(p); }
    else if (s == 4) {
      for (int w = lb; w < 64 * 8; w += nl) {
        const int it = w >> 6, l64 = w & 63, a = it >> 1, gn = it & 1;
        const int mt = 8 * (xcd + 8 * a) + (l64 & 7), nt = 8 * gn + (l64 >> 3);
        merge_tile(p, l, nt * 256 + mt, smem);
      }
    }
    else {
      for (int w = lb; w < 64 * 2; w += nl) {
        const int a = w >> 6, l64 = w & 63;
        const int mt = 8 * (xcd + 8 * (2 * a + (l64 >> 5))) + (l64 & 7), nt = (l64 >> 3) & 3;
        outproj_tile(p, l, nt * 256 + mt, smem);
      }
    }
  }
}

__global__ void __launch_bounds__(256, 2) mega(Params p, int ph_lo, int ph_hi) {
  __shared__ __attribute__((aligned(16))) char smem[66048];
  __shared__ uint4 xb_words;
  cg::grid_group grid = cg::this_grid();
  if (threadIdx.x == 0) xb_words = make_uint4(0u, 0u, 0u, 0u);
  __syncthreads();
  XcdBarrier xb = xcd_barrier_post((unsigned*)(p.ws + OFF_BAR), (volatile LAS unsigned*)&xb_words);
  if (ph_hi == 12345) grid.sync();
  for (int ph = ph_lo; ph < ph_hi; ++ph) {
    run_phase(p, ph, smem, ph_hi == 12345);
    if (ph + 1 < ph_hi) xcd_barrier(xb);
  }
}

extern "C" void kernel_launch(void* const* d_in, const int* in_sizes, int n_in, void* d_out, int out_size, void* d_ws,
                              size_t ws_size, hipStream_t stream) {
  Params p{};
  p.x = (const float*)d_in[0]; p.norm_g = (const float*)d_in[1]; p.w_in = (const float*)d_in[2];
  p.q_norm_g = (const float*)d_in[3]; p.kv_norm_g = (const float*)d_in[4]; p.w_q_up = (const float*)d_in[5];
  p.w_kv_up = (const float*)d_in[6]; p.gq_g = (const float*)d_in[7]; p.gk_g = (const float*)d_in[8];
  p.sink = (const float*)d_in[9]; p.t5 = (const float*)d_in[10]; p.w_branch = (const float*)d_in[11];
  p.w_out = (const float*)d_in[12]; p.final_g = (const float*)d_in[13];
  p.out = (float*)d_out;
  p.ws = (char*)d_ws;
  if (WS_NEED > ws_size) { fprintf(stderr, "workspace too small: need %zu have %zu\n", (size_t)WS_NEED, ws_size); return; }

  static int grid_blocks = 0;
  if (!grid_blocks) {
    int dev = 0, cus = 0, per_cu = 0;
    hipGetDevice(&dev);
    hipDeviceGetAttribute(&cus, hipDeviceAttributeMultiprocessorCount, dev);
    hipOccupancyMaxActiveBlocksPerMultiprocessor(&per_cu, mega, 256, 0);
    if (per_cu < 1) per_cu = 1;
    if (per_cu > 2) per_cu = 2;
    grid_blocks = cus * per_cu;
  }
  hipMemsetAsync((char*)d_ws + OFF_BAR, 0, 16384, stream);
  int lo = 0, hi = 15;
  void* args[] = {&p, &lo, &hi};
  hipError_t e = hipLaunchCooperativeKernel((void*)mega, dim3(grid_blocks), dim3(256), args, 0, stream);
  if (e != hipSuccess) fprintf(stderr, "cooperative launch failed: %s (grid %d)\n", hipGetErrorString(e), grid_blocks);
}
```

```cpp
#include <hip/hip_runtime.h>
#include <hip/hip_cooperative_groups.h>
#include <cstdio>
namespace cg = cooperative_groups;

typedef unsigned short bf16_t;
using bf16x8 = __attribute__((ext_vector_type(8))) short;
using f32x4 = __attribute__((ext_vector_type(4))) float;
using u32x4 = __attribute__((ext_vector_type(4))) unsigned;
using f32x16 = __attribute__((ext_vector_type(16))) float;
using bf16x4 = __attribute__((ext_vector_type(4))) short;
#define DI __device__ __forceinline__

constexpr int SEQ = 8192;
constexpr int PW = 4864;
constexpr int C_BQ = 0, C_BK = 256, C_BV = 384, C_CQ = 512, C_CK = 1280, C_CV = 2048, C_DQ = 2816, C_DK = 3072,
              C_DV = 3200, C_GATE = 3328, C_AQ = 4352, C_AKV = 4608, C_AKR = 4736;
constexpr int C_MERGED = 512;

struct Params {
  const float* x; const float* norm_g; const float* w_in; const float* q_norm_g; const float* kv_norm_g;
  const float* w_q_up; const float* w_kv_up; const float* gq_g; const float* gk_g; const float* sink;
  const float* t5; const float* w_branch; const float* w_out; const float* final_g;
  float* out; char* ws;
};
constexpr size_t al256(size_t x) { return (x + 255) & ~(size_t)255; }
constexpr size_t OFF_W1T = 0;
constexpr size_t OFF_WMT = OFF_W1T + al256((size_t)2 * 4864 * 1024 * 2);
constexpr size_t OFF_WOT = OFF_WMT + al256((size_t)2 * 4096 * 1024 * 2);
constexpr size_t OFF_WBT = OFF_WOT + al256((size_t)2 * 1024 * 1024 * 2);
constexpr size_t OFF_WQT = OFF_WBT + al256((size_t)2 * 4 * 1024 * 256 * 2);
constexpr size_t OFF_WKVT = OFF_WQT + al256((size_t)2 * 384 * 256 * 2);
constexpr size_t OFF_ROPE = OFF_WKVT + al256((size_t)2 * 512 * 128 * 2);
constexpr size_t OFF_LUTC = OFF_ROPE + al256((size_t)8192 * 32 * 4);
constexpr size_t OFF_LUTD = OFF_LUTC + 8192;
constexpr size_t OFF_XN = OFF_LUTD + 8192;
constexpr size_t OFF_PROJ = OFF_XN + al256((size_t)32768 * 1024 * 2);
constexpr size_t OFF_QA = OFF_PROJ + al256((size_t)32768 * 4864 * 2);
constexpr size_t OFF_KA = OFF_QA + al256((size_t)32768 * 384 * 2);
constexpr size_t OFF_VA = OFF_KA + al256((size_t)32768 * 384 * 2);
constexpr size_t OFF_LSE = OFF_VA + al256((size_t)32768 * 256 * 2);
constexpr size_t OFF_BAR = OFF_LSE + al256((size_t)32768 * 12 * 4);
constexpr size_t WS_NEED = OFF_BAR + 16384;
#define WSP(T, OFF) ((T*)(p.ws + (OFF)))
#define P_W1T WSP(bf16_t, OFF_W1T)
#define P_WMT WSP(bf16_t, OFF_WMT)
#define P_WOT WSP(bf16_t, OFF_WOT)
#define P_WBT WSP(bf16_t, OFF_WBT)
#define P_WQT WSP(bf16_t, OFF_WQT)
#define P_WKVT WSP(bf16_t, OFF_WKVT)
#define P_ROPE WSP(float, OFF_ROPE)
#define P_LUTC WSP(float, OFF_LUTC)
#define P_LUTD WSP(float, OFF_LUTD)
#define P_XN WSP(bf16_t, OFF_XN)
#define P_PROJ WSP(bf16_t, OFF_PROJ)
#define P_QA WSP(bf16_t, OFF_QA)
#define P_KA WSP(bf16_t, OFF_KA)
#define P_VA WSP(bf16_t, OFF_VA)
#define P_LSE WSP(float, OFF_LSE)


DI unsigned short f2bf(float x) { unsigned u = __float_as_uint(x); u += 0x7fffu + ((u >> 16) & 1u); return (unsigned short)(u >> 16); }
DI float bf2f(unsigned short b) { return __uint_as_float(((unsigned)b) << 16); }
typedef __bf16 bf2_t __attribute__((ext_vector_type(2)));
typedef float f2_t __attribute__((ext_vector_type(2)));
DI unsigned pack2(float a, float b) { f2_t v = {a, b}; bf2_t r = __builtin_convertvector(v, bf2_t); return __builtin_bit_cast(unsigned, r); }
constexpr float LOG2E = 1.4426950408889634f;
constexpr float QS64 = 0.125f * LOG2E;
constexpr float QS96 = 0.10206207261596575f * LOG2E;
#define BLO(u) __uint_as_float((u) << 16)
#define BHI(u) __uint_as_float((u) & 0xffff0000u)
DI int otid() { int t; asm volatile("v_mov_b32 %0, %1" : "=v"(t) : "v"((int)threadIdx.x)); __builtin_assume(t >= 0 && t < 256); return t; }
DI float wave_sum(float v) {
#pragma unroll
  for (int o = 32; o; o >>= 1) v += __shfl_xor(v, o);
  return v;
}

DI int srccol(int mode, int n) {
  if (mode == 0) return n < 4352 ? n + 416 : (n < 4768 ? n - 4352 : -1);
  if (mode == 1) return 4768 + n;
  if (mode == 2) return n;
  return n < 256 ? (n >> 6) * 96 + (n & 63) : ((n - 256) >> 5) * 96 + 64 + ((n - 256) & 31);
}
DI void conv_tile(const float* __restrict__ src, int ld, int K, bf16_t* __restrict__ dst, int n0, int k0, int mode,
                  const float* __restrict__ rs, float* tile) {
  const int tx = otid() & 63, ty = otid() >> 6;
  __syncthreads();
  const int sc = srccol(mode, n0 + tx);
  const int nq = n0 + tx;
  const float cscale = (mode == 0 && ((nq >= C_CQ && nq < C_CQ + 768) || (nq >= C_DQ && nq < C_DQ + 256))) ? QS64 : 1.0f;
#pragma unroll
  for (int i = 0; i < 16; ++i) {
    int kk = ty + 4 * i;
    float v = sc >= 0 ? src[(size_t)(k0 + kk) * ld + sc] : 0.f;
    if (rs) v *= rs[k0 + kk];
    tile[kk * 65 + tx] = v * cscale;
  }
  __syncthreads();
#pragma unroll
  for (int i = 0; i < 16; ++i) {
    int nn = ty + 4 * i;
    dst[(size_t)(n0 + nn) * K + k0 + tx] = f2bf(tile[tx * 65 + nn]);
  }
}

DI int t5_bucket(int rel) {
  int n = rel < 0 ? -rel : rel;
  float nf = (float)(n < 1 ? 1 : n);
  int large = 8 + (int)(logf(nf / 8.0f) / 4.852030263919617f * 8.0f);
  if (large > 15) large = 15;
  return (rel > 0 ? 16 : 0) + (n < 8 ? n : large);
}

DI void prep_item(const Params& p, int item, float* tile) {
  if (item < 5584) {
    int l = item / 2792, r = item % 2792;
    const float* src; int ld, K, mode, t; bf16_t* dst; const float* rs = nullptr;
    if (r < 1216) { t = r; src = p.w_in + (size_t)l * 1024 * 8864; ld = 8864; K = 1024; mode = 0; dst = P_W1T + (size_t)l * 4864 * 1024; }
    else if (r < 2240) { t = r - 1216; src = p.w_in + (size_t)l * 1024 * 8864; ld = 8864; K = 1024; mode = 1; dst = P_WMT + (size_t)l * 4096 * 1024; }
    else if (r < 2496) { t = r - 2240; src = p.w_out + (size_t)l * 1024 * 1024; ld = 1024; K = 1024; mode = 2; dst = P_WOT + (size_t)l * 1024 * 1024; }
    else if (r < 2752) { t = r - 2496; int n = t >> 6; t &= 63; src = p.w_branch + (size_t)(l * 4 + n) * 256 * 1024; ld = 1024; K = 256; mode = 2; dst = P_WBT + (size_t)(l * 4 + n) * 1024 * 256; }
    else if (r < 2776) { t = r - 2752; src = p.w_q_up + (size_t)l * 256 * 384; ld = 384; K = 256; mode = 3; dst = P_WQT + (size_t)l * 384 * 256; rs = p.q_norm_g + l * 256; }
    else { t = r - 2776; src = p.w_kv_up + (size_t)l * 128 * 512; ld = 512; K = 128; mode = 2; dst = P_WKVT + (size_t)l * 512 * 128; rs = p.kv_norm_g + l * 128; }
    int kt = K / 64;
    conv_tile(src, ld, K, dst, (t / kt) * 64, (t % kt) * 64, mode, rs, tile);
  } else if (item < 5584 + 512) {
    int idx = (item - 5584) * 256 + otid();
    int pos = idx >> 4, i = idx & 15;
    double invd = 1.0;
    for (int k = 0; k < i; ++k) invd *= 0.5623413251903491;
    float inv = (float)invd;
    float ang = (float)pos * inv;
    double a = (double)ang;
    double kq = rint(a * 0.15915494309189535);
    double r = a - kq * 6.283185307179586;
    double r2 = r * r, ts = r, tc = 1.0, sn = r, cs = 1.0;
    for (int k = 1; k <= 14; ++k) {
      tc = -tc * r2 / (double)((2 * k - 1) * (2 * k));
      ts = -ts * r2 / (double)((2 * k) * (2 * k + 1));
      cs += tc; sn += ts;
    }
    P_ROPE[pos * 32 + i] = (float)cs;
    P_ROPE[pos * 32 + 16 + i] = (float)sn;
  } else {
    for (int e = otid(); e < 12 * 129; e += 256) {
      int gh = e / 129, off = e % 129 - 64; int g = gh >> 2;
      int r = g == 0 ? 1 : (g == 1 ? 4 : 16);
      P_LUTC[e] = p.t5[t5_bucket(off * r) * 16 + gh] * LOG2E;
    }
    for (int e = otid(); e < 4 * 257; e += 256) {
      int hq = e / 257, off = e % 257 - 128;
      P_LUTD[e] = p.t5[t5_bucket(off) * 16 + 12 + hq] * LOG2E;
    }
  }
}

DI void norm_rows_bf16(const float* __restrict__ src, const float* __restrict__ g, bf16_t* __restrict__ dst, int item) {
  const int lane = otid() & 63, wid = otid() >> 6;
  for (int i = 0; i < 8; ++i) {
    size_t row = (size_t)item * 32 + wid * 8 + i;
    const float4* s = (const float4*)(src + row * 1024);
    float4 v[4]; float ss = 0.f;
#pragma unroll
    for (int j = 0; j < 4; ++j) { v[j] = s[lane + 64 * j]; ss += v[j].x * v[j].x + v[j].y * v[j].y + v[j].z * v[j].z + v[j].w * v[j].w; }
    ss = wave_sum(ss);
    float sc = rsqrtf(ss * (1.0f / 1024.0f) + 1e-6f);
#pragma unroll
    for (int j = 0; j < 4; ++j) {
      float4 gg = ((const float4*)g)[lane + 64 * j];
      uint2 o; o.x = pack2(v[j].x * sc * gg.x, v[j].y * sc * gg.y); o.y = pack2(v[j].z * sc * gg.z, v[j].w * sc * gg.w);
      *(uint2*)(dst + row * 1024 + (lane + 64 * j) * 4) = o;
    }
  }
}
DI void norm_rows_f32(float* io, const float* __restrict__ g, int item) {
  const int lane = otid() & 63, wid = otid() >> 6;
  for (int i = 0; i < 8; ++i) {
    size_t row = (size_t)item * 32 + wid * 8 + i;
    float4* s = (float4*)(io + row * 1024);
    float4 v[4]; float ss = 0.f;
#pragma unroll
    for (int j = 0; j < 4; ++j) { v[j] = s[lane + 64 * j]; ss += v[j].x * v[j].x + v[j].y * v[j].y + v[j].z * v[j].z + v[j].w * v[j].w; }
    ss = wave_sum(ss);
    float sc = rsqrtf(ss * (1.0f / 1024.0f) + 1e-6f);
#pragma unroll
    for (int j = 0; j < 4; ++j) {
      float4 gg = ((const float4*)g)[lane + 64 * j];
      float4 o; o.x = v[j].x * sc * gg.x; o.y = v[j].y * sc * gg.y; o.z = v[j].z * sc * gg.z; o.w = v[j].w * sc * gg.w;
      s[lane + 64 * j] = o;
    }
  }
}

constexpr int LLD = 72;
constexpr int GST = 128 * 64;
template <int NT, bool LOWREG = false>
DI void gemm_mainloop(f32x4 (&acc)[4][NT], const bf16_t* A, int lda, const bf16_t* Bt, int ldb, int K, bf16_t* sA, bf16_t* sB, int bstride = 32) {
  constexpr int NB = NT;
  const int tid = otid(), lane = tid & 63, wid = tid >> 6;
  const int wm = wid >> 1, wn = wid & 1, fr = lane & 15, fq = lane >> 4;
  u32x4 ra[4], rb[NB];
  const int nk = K >> 6;
  const bf16_t* ap = A + (size_t)(tid >> 3) * lda + (tid & 7) * 8;
  const bf16_t* bp = Bt + (size_t)(tid >> 3) * ldb + (tid & 7) * 8;
  const int so = (tid >> 3) * 64 + (((tid & 7) ^ ((tid >> 4) & 7)) * 8);
  const int fsw = fr >> 1;
#define GLOAD(ko) do { \
    _Pragma("unroll") for (int i = 0; i < 4; ++i) ra[i] = *(const u32x4*)(ap + (size_t)(32 * i) * lda + (ko)); \
    _Pragma("unroll") for (int i = 0; i < NB; ++i) rb[i] = *(const u32x4*)(bp + (size_t)(bstride * i) * ldb + (ko)); } while (0)
#define GSTORE(st) do { \
    _Pragma("unroll") for (int i = 0; i < 4; ++i) *(u32x4*)(sA + (st) * GST + so + 32 * i * 64) = ra[i]; \
    _Pragma("unroll") for (int i = 0; i < NB; ++i) *(u32x4*)(sB + (st) * GST + so + 32 * i * 64) = rb[i]; } while (0)
#define GCOMPUTE(st) do { \
    const bf16_t* cA = sA + (st) * GST; const bf16_t* cB = sB + (st) * GST; \
    _Pragma("unroll") for (int ks = 0; ks < 2; ++ks) { \
      bf16x8 af[4], bfr[NT]; \
      _Pragma("unroll") for (int mi = 0; mi < 4; ++mi) af[mi] = *(const bf16x8*)(cA + (wm * 64 + mi * 16 + fr) * 64 + (((ks * 4 + fq) ^ fsw) * 8)); \
      _Pragma("unroll") for (int ni = 0; ni < NT; ++ni) bfr[ni] = *(const bf16x8*)(cB + (wn * NT * 16 + ni * 16 + fr) * 64 + (((ks * 4 + fq) ^ fsw) * 8)); \
      _Pragma("unroll") for (int mi = 0; mi < 4; ++mi) \
        _Pragma("unroll") for (int ni = 0; ni < NT; ++ni) acc[mi][ni] = __builtin_amdgcn_mfma_f32_16x16x32_bf16(bfr[ni], af[mi], acc[mi][ni], 0, 0, 0); \
    } } while (0)
  __syncthreads();
  GLOAD(0); GSTORE(0);
  if (nk > 1) GLOAD(64);
  __syncthreads();
  for (int kt = 0; kt < nk; ++kt) {
    const int cur = kt & 1;
    if (kt + 1 < nk) { GSTORE(cur ^ 1); if (kt + 2 < nk) GLOAD((kt + 2) * 64); }
    if (LOWREG) {
      const bf16_t* cA = sA + cur * GST; const bf16_t* cB = sB + cur * GST;
#pragma nounroll
      for (int ks = 0; ks < 2; ++ks) {
        bf16x8 af[4], bfr[NT];
#pragma unroll
        for (int mi = 0; mi < 4; ++mi) af[mi] = *(const bf16x8*)(cA + (wm * 64 + mi * 16 + fr) * 64 + (((ks * 4 + fq) ^ fsw) * 8));
#pragma unroll
        for (int ni = 0; ni < NT; ++ni) bfr[ni] = *(const bf16x8*)(cB + (wn * NT * 16 + ni * 16 + fr) * 64 + (((ks * 4 + fq) ^ fsw) * 8));
#pragma unroll
        for (int mi = 0; mi < 4; ++mi)
#pragma unroll
          for (int ni = 0; ni < NT; ++ni) acc[mi][ni] = __builtin_amdgcn_mfma_f32_16x16x32_bf16(bfr[ni], af[mi], acc[mi][ni], 0, 0, 0);
      }
    } else GCOMPUTE(cur);
    __syncthreads();
  }
#undef GLOAD
#undef GSTORE
#undef GCOMPUTE
}
template <int NT>
DI void zero_acc(f32x4 (&acc)[4][NT]) {
#pragma unroll
  for (int mi = 0; mi < 4; ++mi)
#pragma unroll
    for (int ni = 0; ni < NT; ++ni) acc[mi][ni] = f32x4{0.f, 0.f, 0.f, 0.f};
}


constexpr int BGA = 128 * 32, BGB = 256 * 32;
DI void gemm_big(f32x4 (&acc)[4][8], const bf16_t* A, int lda, const bf16_t* Bt, int ldb, int K, char* smem, int s1 = 64, int s2 = 128, int brow = -1) {
  bf16_t* sA = (bf16_t*)smem; bf16_t* sB = sA + 2 * BGA;
  const int tid = otid(), lane = tid & 63, wid = tid >> 6;
  const int wm = wid >> 1, wn = wid & 1, fr = lane & 15, fq = lane >> 4;
  const int nk = K >> 5;
  const bf16_t* ap = A + (size_t)(tid >> 2) * lda + (tid & 3) * 8;
  const bf16_t* bp = Bt + (size_t)(brow >= 0 ? brow : (tid >> 2)) * ldb + (tid & 3) * 8;
  const int so = (tid >> 2) * 32 + (((tid & 3) ^ (((tid >> 5) & 1) << 1)) * 8);
  const int fo = fr * 32 + ((fq ^ (((fr >> 3) & 1) << 1)) * 8);
  u32x4 ra[2], rb[4];
#define BLOADG(kt) do { \
    _Pragma("unroll") for (int i = 0; i < 2; ++i) ra[i] = *(const u32x4*)(ap + (size_t)(64 * i) * lda + (kt) * 32); \
    _Pragma("unroll") for (int i = 0; i < 4; ++i) rb[i] = *(const u32x4*)(bp + (size_t)((i & 1) * s1 + (i >> 1) * s2) * ldb + (kt) * 32); } while (0)
#define BSTOREG(st) do { \
    _Pragma("unroll") for (int i = 0; i < 2; ++i) *(u32x4*)(sA + (st) * BGA + so + 64 * i * 32) = ra[i]; \
    _Pragma("unroll") for (int i = 0; i < 4; ++i) *(u32x4*)(sB + (st) * BGB + so + 64 * i * 32) = rb[i]; } while (0)
  __syncthreads();
  BLOADG(0); BSTOREG(0);
  if (nk > 1) BLOADG(1);
  __syncthreads();
  for (int kt = 0; kt < nk; ++kt) {
    const int cur = kt & 1;
    if (kt + 1 < nk) { BSTOREG(cur ^ 1); if (kt + 2 < nk) BLOADG(kt + 2); }
    const bf16_t* cA = sA + cur * BGA + (wm * 64) * 32 + fo; const bf16_t* cB = sB + cur * BGB + (wn * 128) * 32 + fo;
    bf16x8 af[4];
#pragma unroll
    for (int mi = 0; mi < 4; ++mi) af[mi] = *(const bf16x8*)(cA + mi * 16 * 32);
#pragma unroll
    for (int nh = 0; nh < 2; ++nh) {
      bf16x8 bfr[4];
#pragma unroll
      for (int ni = 0; ni < 4; ++ni) bfr[ni] = *(const bf16x8*)(cB + (nh * 4 + ni) * 16 * 32);
#pragma unroll
      for (int mi = 0; mi < 4; ++mi)
#pragma unroll
        for (int ni = 0; ni < 4; ++ni) acc[mi][nh * 4 + ni] = __builtin_amdgcn_mfma_f32_16x16x32_bf16(bfr[ni], af[mi], acc[mi][nh * 4 + ni], 0, 0, 0);
    }
    __syncthreads();
  }
#undef BLOADG
#undef BSTOREG
}
DI void zero_acc8(f32x4 (&acc)[4][8]) {
#pragma unroll
  for (int mi = 0; mi < 4; ++mi)
#pragma unroll
    for (int ni = 0; ni < 8; ++ni) acc[mi][ni] = f32x4{0.f, 0.f, 0.f, 0.f};
}

DI void inproj_tile(const Params& p, int l, int tile, char* smem) {
  const int mt = tile & 255, nt = tile >> 8;
  f32x4 acc[4][8]; zero_acc8(acc);
  gemm_big(acc, P_XN + (size_t)mt * 128 * 1024, 1024, P_W1T + ((size_t)l * 4864 + nt * 256) * 1024, 1024, 1024, smem);
  const int lane = otid() & 63, wid = otid() >> 6, wm = wid >> 1, wn = wid & 1, fr = lane & 15, fq = lane >> 4;
#pragma unroll
  for (int mi = 0; mi < 4; ++mi)
#pragma unroll
    for (int ni = 0; ni < 8; ++ni) {
      size_t row = (size_t)mt * 128 + wm * 64 + mi * 16 + fr; int col = nt * 256 + wn * 128 + ni * 16 + fq * 4;
      uint2 o; o.x = pack2(acc[mi][ni][0], acc[mi][ni][1]); o.y = pack2(acc[mi][ni][2], acc[mi][ni][3]);
      *(uint2*)(P_PROJ + row * PW + col) = o;
    }
}

DI void row_scales(const bf16_t* A, int lda, int K, float* sRow) {
  const int row = otid() >> 1, half = otid() & 1;
  const int per = K >> 1;
  const bf16_t* a = A + (size_t)row * lda + half * per;
  float ss = 0.f;
  for (int c = 0; c < per; c += 8) {
    uint4 u = *(const uint4*)(a + c);
    float f;
    f = BLO(u.x); ss += f * f; f = BHI(u.x); ss += f * f; f = BLO(u.y); ss += f * f; f = BHI(u.y); ss += f * f;
    f = BLO(u.z); ss += f * f; f = BHI(u.z); ss += f * f; f = BLO(u.w); ss += f * f; f = BHI(u.w); ss += f * f;
  }
  ss += __shfl_xor(ss, 1);
  if (half == 0) sRow[row] = rsqrtf(ss / (float)K + 1e-6f);
}
DI void mla_item(const Params& p, int l, int item, char* smem) {
  bf16_t* sA = (bf16_t*)smem; bf16_t* sB = sA + 2 * GST; float* sRow = (float*)(sB + 2 * GST);
  const int lane = otid() & 63, wid = otid() >> 6, wm = wid >> 1, wn = wid & 1, fr = lane & 15, fq = lane >> 4;
  if (item < 768) {
    const int mt = item & 255, nt = item >> 8;
    const bf16_t* A = P_PROJ + (size_t)mt * 128 * PW + C_AQ;
    __syncthreads();
    row_scales(A, PW, 256, sRow);
    f32x4 acc[4][4]; zero_acc<4>(acc);
    gemm_mainloop<4>(acc, A, PW, P_WQT + ((size_t)l * 384 + nt * 128) * 256, 256, 256, sA, sB);
    if (nt < 2) {
#pragma unroll
      for (int mi = 0; mi < 4; ++mi)
#pragma unroll
        for (int ni = 0; ni < 4; ++ni) {
          int rl = wm * 64 + mi * 16 + fr; size_t t = (size_t)mt * 128 + rl; float s = sRow[rl] * QS96;
          int c = nt * 128 + wn * 64 + ni * 16 + fq * 4; int h = c >> 6, d = c & 63;
          uint2 o; o.x = pack2(acc[mi][ni][0] * s, acc[mi][ni][1] * s); o.y = pack2(acc[mi][ni][2] * s, acc[mi][ni][3] * s);
          *(uint2*)(P_QA + t * 384 + h * 96 + d) = o;
        }
    } else {
#pragma unroll
      for (int mi = 0; mi < 4; ++mi)
#pragma unroll
        for (int np = 0; np < 2; ++np) {
          int rl = wm * 64 + mi * 16 + fr; size_t t = (size_t)mt * 128 + rl; float s = sRow[rl] * QS96;
          int pos = (int)(t & (SEQ - 1)); int h = wn * 2 + np;
          const float* cs = P_ROPE + pos * 32 + fq * 4;
          float o1[4], o2[4];
#pragma unroll
          for (int j = 0; j < 4; ++j) {
            float x1 = acc[mi][np * 2][j] * s, x2 = acc[mi][np * 2 + 1][j] * s; float c = cs[j], sn = cs[16 + j];
            o1[j] = x1 * c - x2 * sn; o2[j] = x1 * sn + x2 * c;
          }
          uint2 a; a.x = pack2(o1[0], o1[1]); a.y = pack2(o1[2], o1[3]);
          uint2 b; b.x = pack2(o2[0], o2[1]); b.y = pack2(o2[2], o2[3]);
          *(uint2*)(P_QA + t * 384 + h * 96 + 64 + fq * 4) = a;
          *(uint2*)(P_QA + t * 384 + h * 96 + 80 + fq * 4) = b;
        }
    }
  } else if (item < 768 + 1024) {
    const int it = item - 768; const int mt = it & 255, h = it >> 8;
    const bf16_t* A = P_PROJ + (size_t)mt * 128 * PW + C_AKV;
    __syncthreads();
    row_scales(A, PW, 128, sRow);
    f32x4 acc[4][4]; zero_acc<4>(acc);
    gemm_mainloop<4>(acc, A, PW, P_WKVT + ((size_t)l * 512 + h * 128) * 128, 128, 128, sA, sB);
#pragma unroll
    for (int mi = 0; mi < 4; ++mi)
#pragma unroll
      for (int ni = 0; ni < 4; ++ni) {
        int rl = wm * 64 + mi * 16 + fr; size_t t = (size_t)mt * 128 + rl; float s = sRow[rl];
        int d = ni * 16 + fq * 4;
        uint2 o; o.x = pack2(acc[mi][ni][0] * s, acc[mi][ni][1] * s); o.y = pack2(acc[mi][ni][2] * s, acc[mi][ni][3] * s);
        if (wn == 0) *(uint2*)(P_KA + t * 384 + h * 96 + d) = o;
        else *(uint2*)(P_VA + t * 256 + h * 64 + d) = o;
      }
  } else {
    const int it = item - 1792;
    const int half = lane >> 5, pl = lane & 31;
    for (int i = 0; i < 32; ++i) {
      size_t t = (size_t)it * 128 + wid * 32 + i; int pos = (int)(t & (SEQ - 1));
      bf16_t* row = P_PROJ + t * PW;
#pragma unroll
      for (int s3 = 0; s3 < 3; ++s3) {
        int slot = s3 * 2 + half;
        bf16_t* hp = row + (slot < 4 ? C_BQ + slot * 64 : C_BK + (slot - 4) * 64);
        const float* g = (slot < 4 ? p.gq_g : p.gk_g) + l * 64;
        int d1, fi, ap;
        if (pl < 16) { d1 = pl; fi = pl; ap = pos >> 6; } else { d1 = 32 + (pl - 16); fi = pl - 16; ap = pos & 63; }
        float x1 = bf2f(hp[d1]), x2 = bf2f(hp[d1 + 16]);
        float ss = x1 * x1 + x2 * x2;
#pragma unroll
        for (int o = 16; o; o >>= 1) ss += __shfl_xor(ss, o);
        float sc = rsqrtf(ss * (1.0f / 64.0f) + 1e-6f);
        if (slot < 4) sc *= QS64;
        x1 = x1 * sc * g[d1]; x2 = x2 * sc * g[d1 + 16];
        float c = P_ROPE[ap * 32 + fi], sn = P_ROPE[ap * 32 + 16 + fi];
        hp[d1] = f2bf(x1 * c - x2 * sn); hp[d1 + 16] = f2bf(x1 * sn + x2 * c);
      }
      if (lane < 16) {
        float x1 = bf2f(row[C_AKR + lane]), x2 = bf2f(row[C_AKR + 16 + lane]);
        float c = P_ROPE[pos * 32 + lane], sn = P_ROPE[pos * 32 + 16 + lane];
        bf16_t o1 = f2bf(x1 * c - x2 * sn), o2 = f2bf(x1 * sn + x2 * c);
#pragma unroll
        for (int h = 0; h < 4; ++h) { P_KA[t * 384 + h * 96 + 64 + lane] = o1; P_KA[t * 384 + h * 96 + 80 + lane] = o2; }
      }
    }
  }
}

#define MFMA32(a, b, c) __builtin_amdgcn_mfma_f32_32x32x16_bf16((a), (b), (c), 0, 0, 0)
template <int OFF> DI bf16x4 tr_read(unsigned addr) {
  bf16x4 r; asm volatile("ds_read_b64_tr_b16 %0, %1 offset:%2" : "=&v"(r) : "v"(addr), "i"(OFF) : "memory"); return r;
}
DI float half_swap_max(float v) {
  auto rr = __builtin_amdgcn_permlane32_swap(__float_as_uint(v), __float_as_uint(v), false, false);
  return fmaxf(__uint_as_float(rr[0]), __uint_as_float(rr[1]));
}
DI float half_swap_sum(float v) {
  auto rr = __builtin_amdgcn_permlane32_swap(__float_as_uint(v), __float_as_uint(v), false, false);
  return __uint_as_float(rr[0]) + __uint_as_float(rr[1]);
}
DI bf16x8 pack8(const f32x16& p, int base) {
  u32x4 w = {pack2(p[base + 0], p[base + 1]), pack2(p[base + 2], p[base + 3]), pack2(p[base + 4], p[base + 5]), pack2(p[base + 6], p[base + 7])};
  return __builtin_bit_cast(bf16x8, w);
}
template <int DB, int VLD> DI void pv_block(f32x16& o, unsigned vb, bf16x8 pb0, bf16x8 pb1, bf16x8 pb2, bf16x8 pb3) {
  constexpr int RB = VLD * 2;
  bf16x4 l0 = tr_read<0 * RB + 64 * DB>(vb), h0 = tr_read<8 * RB + 64 * DB>(vb);
  bf16x4 l1 = tr_read<16 * RB + 64 * DB>(vb), h1 = tr_read<24 * RB + 64 * DB>(vb);
  bf16x4 l2 = tr_read<32 * RB + 64 * DB>(vb), h2 = tr_read<40 * RB + 64 * DB>(vb);
  bf16x4 l3 = tr_read<48 * RB + 64 * DB>(vb), h3 = tr_read<56 * RB + 64 * DB>(vb);
  asm volatile("s_waitcnt lgkmcnt(0)" ::: "memory"); __builtin_amdgcn_sched_barrier(0);
  o = MFMA32(__builtin_shufflevector(l0, h0, 0, 1, 2, 3, 4, 5, 6, 7), pb0, o);
  o = MFMA32(__builtin_shufflevector(l1, h1, 0, 1, 2, 3, 4, 5, 6, 7), pb1, o);
  o = MFMA32(__builtin_shufflevector(l2, h2, 0, 1, 2, 3, 4, 5, 6, 7), pb2, o);
  o = MFMA32(__builtin_shufflevector(l3, h3, 0, 1, 2, 3, 4, 5, 6, 7), pb3, o);
}
DI f32x16 splat16(float v) { f32x16 r;
#pragma unroll
  for (int i = 0; i < 16; ++i) r[i] = v;
  return r; }

template <int DQK, bool FIXEDM>
DI void attn_dense_mfma(const bf16_t* Qb, int ldq, const bf16_t* Kb, int ldk, const bf16_t* Vb, int ldv, bf16_t* gate_io, char* smem, bool store, float mbound) {
  constexpr int NS = DQK / 16, KLD = DQK + 8, VLD = 96, CPR = DQK / 8, NKC = (64 * CPR) / 256;
  constexpr int KBYTES = 64 * KLD * 2, VBYTES = 64 * VLD * 2;
  char* sKc = smem; char* sVc = smem + 2 * KBYTES;
  const int tid = otid(), lane = tid & 63, wid = tid >> 6, r = lane & 31, h = lane >> 5;
  bf16x8 qf[NS];
#pragma unroll
  for (int s = 0; s < NS; ++s) qf[s] = *(const bf16x8*)(Qb + (size_t)(wid * 32 + r) * ldq + 16 * s + 8 * h);
  const bf16_t* kp = Kb + (size_t)(tid >> 2) * ldk + (tid & 3) * (NKC * 8);
  const int kso = ((tid >> 2) * KLD + (tid & 3) * (NKC * 8)) * 2;
  const bf16_t* vp0 = Vb + (size_t)(tid >> 3) * ldv + (tid & 7) * 8;
  const bf16_t* vp1 = vp0 + (size_t)32 * ldv;
  const int vso = ((tid >> 3) * VLD + (tid & 7) * 8) * 2;
  const size_t kstep = (size_t)64 * ldk, vstep = (size_t)64 * ldv;
  u32x4 rk[NKC], rv[2];
#define KLOAD() do { _Pragma("unroll") for (int i = 0; i < NKC; ++i) rk[i] = *(const u32x4*)(kp + i * 8); kp += kstep; } while (0)
#define VLOAD() do { rv[0] = *(const u32x4*)vp0; rv[1] = *(const u32x4*)vp1; vp0 += vstep; vp1 += vstep; } while (0)
#define KSTORE(st) do { _Pragma("unroll") for (int i = 0; i < NKC; ++i) *(u32x4*)(sKc + (st) * KBYTES + kso + i * 16) = rk[i]; } while (0)
#define VSTORE(st) do { *(u32x4*)(sVc + (st) * VBYTES + vso) = rv[0]; *(u32x4*)(sVc + (st) * VBYTES + vso + 32 * VLD * 2) = rv[1]; } while (0)
#define QKT(P0, P1, st) do { \
    const bf16_t* sK = (const bf16_t*)(sKc + (st) * KBYTES) + r * KLD + 8 * h; \
    P0 = negm; P1 = negm; \
    _Pragma("unroll") for (int s = 0; s < NS; ++s) { \
      bf16x8 k0 = *(const bf16x8*)(sK + 16 * s); bf16x8 k1 = *(const bf16x8*)(sK + 32 * KLD + 16 * s); \
      P0 = MFMA32(k0, qf[s], P0); P1 = MFMA32(k1, qf[s], P1); } } while (0)
  const unsigned vb0 = (unsigned)(size_t)sVc + (unsigned)(((4 * h + ((lane & 15) >> 2)) * VLD + 16 * ((lane >> 4) & 1) + 4 * (lane & 3)) * 2);
  f32x16 o0 = splat16(0.f), o1 = splat16(0.f), negm = splat16(FIXEDM ? -mbound : 0.f);
  f32x16 pa0, pa1, pc0, pc1;
  float m_run = 0.f, l_run = 0.f;
  constexpr int NT = SEQ / 64;
  __syncthreads();
  KLOAD(); VLOAD(); KSTORE(0); VSTORE(0);
  KLOAD(); KSTORE(1);
  __syncthreads();
  QKT(pa0, pa1, 0);
  __syncthreads();
#define STEP(SC0, SC1, SN0, SN1, PAR, FIRST, LK, LV) do { \
    if (LK) KLOAD(); \
    if (LV) VLOAD(); \
    float pm = 0.f; \
    if (!FIXEDM) { pm = fmaxf(SC0[0], SC1[0]); \
    _Pragma("unroll") for (int i = 1; i < 16; i += 1) pm = fmaxf(fmaxf(pm, SC0[i]), SC1[i]); \
    pm = half_swap_max(pm); } \
    if (!FIXEDM && ((FIRST) || __any(pm > 8.0f))) { \
      float delta; \
      if (FIRST) delta = pm; \
      else { delta = fmaxf(pm, 0.f); float alpha = __builtin_amdgcn_exp2f(-delta); l_run *= alpha; \
        _Pragma("unroll") for (int i = 0; i < 16; ++i) { o0[i] *= alpha; o1[i] *= alpha; } } \
      m_run += delta; \
      _Pragma("unroll") for (int i = 0; i < 16; ++i) { SC0[i] -= delta; SC1[i] -= delta; } \
      negm = splat16(-m_run); \
    } \
    if (LV) QKT(SN0, SN1, (PAR) ^ 1); \
    float ls = 0.f; \
    _Pragma("unroll") for (int i = 0; i < 16; ++i) { SC0[i] = __builtin_amdgcn_exp2f(SC0[i]); SC1[i] = __builtin_amdgcn_exp2f(SC1[i]); ls += SC0[i] + SC1[i]; } \
    l_run += ls; \
    bf16x8 pb0 = pack8(SC0, 0), pb1 = pack8(SC0, 8), pb2 = pack8(SC1, 0), pb3 = pack8(SC1, 8); \
    const unsigned vb = vb0 + (PAR) * VBYTES; \
    pv_block<0, VLD>(o0, vb, pb0, pb1, pb2, pb3); \
    pv_block<1, VLD>(o1, vb, pb0, pb1, pb2, pb3); \
    if (LK) KSTORE(PAR); \
    if (LV) VSTORE((PAR) ^ 1); \
    __syncthreads(); } while (0)
  pc0 = negm; pc1 = negm;
  STEP(pa0, pa1, pc0, pc1, 0, true, 1, 1);
  STEP(pc0, pc1, pa0, pa1, 1, false, 1, 1);
  for (int j = 2; j < NT - 2; j += 2) {
    STEP(pa0, pa1, pc0, pc1, 0, false, 1, 1);
    STEP(pc0, pc1, pa0, pa1, 1, false, 1, 1);
  }
  STEP(pa0, pa1, pc0, pc1, 0, false, 0, 1);
  STEP(pc0, pc1, pa0, pa1, 1, false, 0, 0);
#undef STEP
#undef QKT
#undef KLOAD
#undef VLOAD
#undef KSTORE
#undef VSTORE
  if (!store) return;
  const float inv = 1.0f / half_swap_sum(l_run);
  bf16_t* grow = gate_io + (size_t)(wid * 32 + r) * PW;
#pragma unroll
  for (int db = 0; db < 2; ++db)
#pragma unroll
    for (int g4 = 0; g4 < 4; ++g4) {
      bf16_t* gp = grow + 32 * db + 8 * g4 + 4 * h;
      uint2 u = *(const uint2*)gp;
      float g[4] = {BLO(u.x), BHI(u.x), BLO(u.y), BHI(u.y)};
      float y[4];
#pragma unroll
      for (int e = 0; e < 4; ++e) { float ov = db == 0 ? o0[4 * g4 + e] : o1[4 * g4 + e]; y[e] = ov * inv * g[e] / (1.0f + __expf(-g[e])); }
      uint2 w; w.x = pack2(y[0], y[1]); w.y = pack2(y[2], y[3]);
      *(uint2*)gp = w;
    }
}
DI void dense_item(const Params& p, int l, int combo, int qblk, char* smem, bool store) {
  const int br = combo >> 4, bh = combo & 15, b = bh >> 2, h = bh & 3;
  const size_t t0 = (size_t)b * SEQ + qblk * 128;
  bf16_t* gate_io = P_PROJ + t0 * PW + C_GATE + br * 256 + h * 64;
  float bbound = 0.f;
  if (br != 0) {
    const int ln = otid() & 63;
    float gq = fabsf(p.gq_g[l * 64 + ln]), gk = fabsf(p.gk_g[l * 64 + ln]);
#pragma unroll
    for (int o = 32; o; o >>= 1) { gq = fmaxf(gq, __shfl_xor(gq, o)); gk = fmaxf(gk, __shfl_xor(gk, o)); }
    bbound = 64.0f * QS64 * 1.02f * gq * gk + 0.05f;
  }
  if (br == 0)
    attn_dense_mfma<96, false>(P_QA + t0 * 384 + h * 96, 384, P_KA + (size_t)b * SEQ * 384 + h * 96, 384, P_VA + (size_t)b * SEQ * 256 + h * 64, 256, gate_io, smem, store, 0.f);
  else {
    if (bbound <= 60.0f) attn_dense_mfma<64, true>(P_PROJ + t0 * PW + C_BQ + h * 64, PW, P_PROJ + (size_t)b * SEQ * PW + C_BK + (h >> 1) * 64, PW,
                        P_PROJ + (size_t)b * SEQ * PW + C_BV + (h >> 1) * 64, PW, gate_io, smem, store, bbound);
    else attn_dense_mfma<64, false>(P_PROJ + t0 * PW + C_BQ + h * 64, PW, P_PROJ + (size_t)b * SEQ * PW + C_BK + (h >> 1) * 64, PW,
                        P_PROJ + (size_t)b * SEQ * PW + C_BV + (h >> 1) * 64, PW, gate_io, smem, store, bbound);
  }
}

template <int W, bool SINK>
DI void attn_band_mfma(const bf16_t* Qb, size_t ldq, const bf16_t* Kb, const bf16_t* Vb, size_t ldk, int L, int i0,
                       const float* lut_g, float sink2, bf16_t* outp, size_t ldo, float* lse_out, size_t ldl, char* smem) {
  constexpr int NS = 4, KLD = 72, VLD = 96, NTW = (128 + 2 * W) / 64, LUTN = 2 * W + 1;
  constexpr int KBYTES = 64 * KLD * 2, VBYTES = 64 * VLD * 2;
  char* sKc = smem; char* sVc = smem + 2 * KBYTES; float* sLut = (float*)(smem + 2 * KBYTES + 2 * VBYTES);
  const int tid = otid(), lane = tid & 63, wid = tid >> 6, r = lane & 31, h = lane >> 5;
  __syncthreads();
  for (int e = tid; e < LUTN; e += 256) sLut[e] = lut_g[e];
  const int qi = i0 + wid * 32 + r;
  bf16x8 qf[NS];
#pragma unroll
  for (int s = 0; s < NS; ++s) qf[s] = *(const bf16x8*)(Qb + (size_t)qi * ldq + 16 * s + 8 * h);
  const int srow = tid >> 3, scc = tid & 7;
  u32x4 rk[2], rv[2];
#define BLOAD(k0) do { \
    rk[0] = *(const u32x4*)(Kb + (size_t)((k0) + srow) * ldk + scc * 8); rk[1] = *(const u32x4*)(Kb + (size_t)((k0) + srow + 32) * ldk + scc * 8); \
    rv[0] = *(const u32x4*)(Vb + (size_t)((k0) + srow) * ldk + scc * 8); rv[1] = *(const u32x4*)(Vb + (size_t)((k0) + srow + 32) * ldk + scc * 8); } while (0)
#define BSTORE(st) do { \
    *(u32x4*)(sKc + (st) * KBYTES + (srow * KLD + scc * 8) * 2) = rk[0]; *(u32x4*)(sKc + (st) * KBYTES + ((srow + 32) * KLD + scc * 8) * 2) = rk[1]; \
    *(u32x4*)(sVc + (st) * VBYTES + (srow * VLD + scc * 8) * 2) = rv[0]; *(u32x4*)(sVc + (st) * VBYTES + ((srow + 32) * VLD + scc * 8) * 2) = rv[1]; } while (0)
  const unsigned vb0 = (unsigned)(size_t)sVc + (unsigned)(((4 * h + ((lane & 15) >> 2)) * VLD + 16 * ((lane >> 4) & 1) + 4 * (lane & 3)) * 2);
  f32x16 o0 = splat16(0.f), o1 = splat16(0.f);
  float m_run = SINK ? sink2 : 0.f, l_run = (SINK && h == 0) ? 1.f : 0.f;
  bool seen = SINK;
  f32x16 negm = splat16(-m_run);
  const int lo = (i0 == 0) ? W / 64 : 0, hi = (i0 + 128 >= L) ? NTW - W / 64 : NTW;
  BLOAD(i0 - W + 64 * lo); BSTORE(0);
  __syncthreads();
  for (int j = lo; j < hi; ++j) {
    const int cur = (j - lo) & 1, k0 = i0 - W + 64 * j;
    if (j + 1 < hi) BLOAD(k0 + 64);
    const bf16_t* sK = (const bf16_t*)(sKc + cur * KBYTES);
    f32x16 p0 = negm, p1 = negm;
#pragma unroll
    for (int s = 0; s < NS; ++s) {
      bf16x8 k0f = *(const bf16x8*)(sK + r * KLD + 16 * s + 8 * h);
      bf16x8 k1f = *(const bf16x8*)(sK + (32 + r) * KLD + 16 * s + 8 * h);
      p0 = MFMA32(k0f, qf[s], p0);
      p1 = MFMA32(k1f, qf[s], p1);
    }
    const int offb = k0 + 4 * h - qi + W;
    float pm = -1e30f;
#pragma unroll
    for (int i = 0; i < 16; ++i) {
      int idx0 = offb + (i & 3) + 8 * (i >> 2), idx1 = idx0 + 32;
      int c0 = min(max(idx0, 0), 2 * W), c1 = min(max(idx1, 0), 2 * W);
      float b0 = sLut[c0], b1 = sLut[c1];
      p0[i] = ((unsigned)idx0 <= (unsigned)(2 * W)) ? p0[i] + b0 : -1e30f;
      p1[i] = ((unsigned)idx1 <= (unsigned)(2 * W)) ? p1[i] + b1 : -1e30f;
      pm = fmaxf(pm, fmaxf(p0[i], p1[i]));
    }
    pm = half_swap_max(pm);
    const bool has = pm > -1e29f;
    float delta = 0.f;
    if (has) { if (!seen) delta = pm; else if (pm > 8.0f) delta = pm; }
    if (__any(delta != 0.f)) {
      float alpha = seen ? __builtin_amdgcn_exp2f(-delta) : 1.0f;
      l_run *= alpha; m_run += delta;
#pragma unroll
      for (int i = 0; i < 16; ++i) { o0[i] *= alpha; o1[i] *= alpha; p0[i] -= delta; p1[i] -= delta; }
      negm = splat16(-m_run);
    }
    seen = seen || has;
    float ls = 0.f;
#pragma unroll
    for (int i = 0; i < 16; ++i) { p0[i] = __builtin_amdgcn_exp2f(p0[i]); p1[i] = __builtin_amdgcn_exp2f(p1[i]); ls += p0[i] + p1[i]; }
    l_run += ls;
    bf16x8 pb0 = pack8(p0, 0), pb1 = pack8(p0, 8), pb2 = pack8(p1, 0), pb3 = pack8(p1, 8);
    const unsigned vb = vb0 + cur * VBYTES;
    pv_block<0, VLD>(o0, vb, pb0, pb1, pb2, pb3);
    pv_block<1, VLD>(o1, vb, pb0, pb1, pb2, pb3);
    if (j + 1 < hi) BSTORE(cur ^ 1);
    __syncthreads();
  }
#undef BLOAD
#undef BSTORE
  const float ltot = half_swap_sum(l_run);
  const float inv = 1.0f / ltot;
  bf16_t* orow = outp + (size_t)qi * ldo;
  if (!SINK && h == 0) lse_out[(size_t)qi * ldl] = m_run + __log2f(ltot);
#pragma unroll
  for (int db = 0; db < 2; ++db)
#pragma unroll
    for (int g4 = 0; g4 < 4; ++g4) {
      bf16_t* gp = orow + 32 * db + 8 * g4 + 4 * h;
      float y[4];
      if (SINK) {
        uint2 u = *(const uint2*)gp;
        float g[4] = {BLO(u.x), BHI(u.x), BLO(u.y), BHI(u.y)};
#pragma unroll
        for (int e = 0; e < 4; ++e) { float ov = db == 0 ? o0[4 * g4 + e] : o1[4 * g4 + e]; y[e] = ov * inv * g[e] / (1.0f + __expf(-g[e])); }
      } else {
#pragma unroll
        for (int e = 0; e < 4; ++e) { float ov = db == 0 ? o0[4 * g4 + e] : o1[4 * g4 + e]; y[e] = ov * inv; }
      }
      uint2 w; w.x = pack2(y[0], y[1]); w.y = pack2(y[2], y[3]);
      *(uint2*)gp = w;
    }
}
DI void band_item(const Params& p, int l, int idx, char* smem) {
  if (idx < 3072) {
    const int g = idx >> 10, rem = idx & 1023, h = rem & 3, rem2 = rem >> 2, b = 3 - (rem2 >> 6), u = rem2 & 63;
    const int sh = 2 * g, rr = 1 << sh;
    const int rho = u & (rr - 1), qblk = u >> sh;
    const size_t tok0 = (size_t)b * SEQ + rho;
    bf16_t* base = P_PROJ + tok0 * PW + g * 256 + h * 64;
    attn_band_mfma<64, false>(base + C_CQ, (size_t)rr * PW, base + C_CK, base + C_CV, (size_t)rr * PW, SEQ >> sh, qblk * 128,
                              P_LUTC + (g * 4 + h) * 129, 0.f, base + C_CQ, (size_t)rr * PW, P_LSE + tok0 * 12 + g * 4 + h, (size_t)rr * 12, smem);
  } else {
    const int it = idx - 3072, hq = it & 3, rem = it >> 2, b = 3 - (rem >> 6), qblk = rem & 63;
    bf16_t* base = P_PROJ + (size_t)b * SEQ * PW;
    attn_band_mfma<128, true>(base + C_DQ + hq * 64, PW, base + C_DK + (hq >> 1) * 64, base + C_DV + (hq >> 1) * 64, PW, SEQ, qblk * 128,
                              P_LUTD + hq * 257, p.sink[l * 4 + hq] * LOG2E, base + C_GATE + 768 + hq * 64, PW, nullptr, 0, smem);
  }
}
DI void combine_c(const Params& p) {
  for (size_t u = (size_t)blockIdx.x * 256 + otid(); u < (size_t)32768 * 32; u += (size_t)gridDim.x * 256) {
    const size_t t = u >> 5; const int h = (int)(u >> 3) & 3, ch = (int)u & 7;
    const float* ls = P_LSE + t * 12 + h;
    float l0 = ls[0], l1 = ls[4], l2 = ls[8];
    float mx = fmaxf(l0, fmaxf(l1, l2));
    float a0 = __builtin_amdgcn_exp2f(l0 - mx), a1 = __builtin_amdgcn_exp2f(l1 - mx), a2 = __builtin_amdgcn_exp2f(l2 - mx);
    float inv = 1.0f / (a0 + a1 + a2); a0 *= inv; a1 *= inv; a2 *= inv;
    const bf16_t* row = P_PROJ + t * PW;
    uint4 x0 = *(const uint4*)(row + C_CQ + h * 64 + ch * 8), x1 = *(const uint4*)(row + C_CQ + 256 + h * 64 + ch * 8),
          x2 = *(const uint4*)(row + C_CQ + 512 + h * 64 + ch * 8);
    bf16_t* gp = P_PROJ + t * PW + C_GATE + 512 + h * 64 + ch * 8;
    uint4 gu = *(const uint4*)gp;
    unsigned xa[4] = {x0.x, x0.y, x0.z, x0.w}, xb[4] = {x1.x, x1.y, x1.z, x1.w}, xc[4] = {x2.x, x2.y, x2.z, x2.w}, gg[4] = {gu.x, gu.y, gu.z, gu.w};
    unsigned ov[4];
#pragma unroll
    for (int e = 0; e < 4; ++e) {
      float ylo = a0 * BLO(xa[e]) + a1 * BLO(xb[e]) + a2 * BLO(xc[e]);
      float yhi = a0 * BHI(xa[e]) + a1 * BHI(xb[e]) + a2 * BHI(xc[e]);
      float glo = BLO(gg[e]), ghi = BHI(gg[e]);
      ov[e] = pack2(ylo * glo / (1.0f + __expf(-glo)), yhi * ghi / (1.0f + __expf(-ghi)));
    }
    uint4 w; w.x = ov[0]; w.y = ov[1]; w.z = ov[2]; w.w = ov[3];
    *(uint4*)gp = w;
  }
}

DI void merge_tile(const Params& p, int l, int tile, char* smem) {
  bf16_t* sA = (bf16_t*)smem; bf16_t* sB = sA + 2 * GST;
  const int mt = tile & 255, nt = tile >> 8;
  unsigned sg[4][8][2];
  {
    f32x4 accG[4][8]; zero_acc8(accG);
    gemm_big(accG, P_XN + (size_t)mt * 128 * 1024, 1024, P_WMT + ((size_t)l * 4096 + nt * 64) * 1024, 1024, 1024, smem, 2048, 32,
             (otid() >> 7) * 1024 + ((otid() >> 2) & 31));
#pragma unroll
    for (int mi = 0; mi < 4; ++mi)
#pragma unroll
      for (int ni = 0; ni < 8; ++ni) {
        float s0 = 1.0f / (1.0f + __expf(-accG[mi][ni][0])), s1 = 1.0f / (1.0f + __expf(-accG[mi][ni][1]));
        float s2 = 1.0f / (1.0f + __expf(-accG[mi][ni][2])), s3 = 1.0f / (1.0f + __expf(-accG[mi][ni][3]));
        sg[mi][ni][0] = pack2(s0, s1); sg[mi][ni][1] = pack2(s2, s3);
      }
  }
  f32x4 accM[4][2]; zero_acc<2>(accM);
#pragma unroll 1
  for (int n = 0; n < 4; ++n) {
    f32x4 accB[4][2]; zero_acc<2>(accB);
    gemm_mainloop<2>(accB, P_PROJ + (size_t)mt * 128 * PW + C_GATE + n * 256, PW, P_WBT + ((size_t)(l * 4 + n) * 1024 + nt * 64) * 256, 256, 256, sA, sB);
#pragma unroll
    for (int mi = 0; mi < 4; ++mi)
#pragma unroll
      for (int ni = 0; ni < 2; ++ni) {
        accM[mi][ni][0] += accB[mi][ni][0] * BLO(sg[mi][ni][0]); accM[mi][ni][1] += accB[mi][ni][1] * BHI(sg[mi][ni][0]);
        accM[mi][ni][2] += accB[mi][ni][2] * BLO(sg[mi][ni][1]); accM[mi][ni][3] += accB[mi][ni][3] * BHI(sg[mi][ni][1]);
      }
#pragma unroll
    for (int mi = 0; mi < 4; ++mi)
#pragma unroll
      for (int k = 0; k < 6; ++k) { sg[mi][k][0] = sg[mi][k + 2][0]; sg[mi][k][1] = sg[mi][k + 2][1]; }
  }
  const int lane = otid() & 63, wid = otid() >> 6, wm = wid >> 1, wn = wid & 1, fr = lane & 15, fq = lane >> 4;
#pragma unroll
  for (int mi = 0; mi < 4; ++mi)
#pragma unroll
    for (int ni = 0; ni < 2; ++ni) {
      size_t row = (size_t)mt * 128 + wm * 64 + mi * 16 + fr; int col = nt * 64 + wn * 32 + ni * 16 + fq * 4;
      uint2 o; o.x = pack2(accM[mi][ni][0], accM[mi][ni][1]); o.y = pack2(accM[mi][ni][2], accM[mi][ni][3]);
      *(uint2*)(P_PROJ + row * PW + C_MERGED + col) = o;
    }
}

DI void outproj_tile(const Params& p, int l, int tile, char* smem) {
  const int mt = tile & 255, nt = tile >> 8;
  f32x4 acc[4][8]; zero_acc8(acc);
  gemm_big(acc, P_PROJ + (size_t)mt * 128 * PW + C_MERGED, PW, P_WOT + ((size_t)l * 1024 + nt * 256) * 1024, 1024, 1024, smem);
  const float* xin = l == 0 ? p.x : p.out;
  const int lane = otid() & 63, wid = otid() >> 6, wm = wid >> 1, wn = wid & 1, fr = lane & 15, fq = lane >> 4;
#pragma unroll
  for (int mi = 0; mi < 4; ++mi)
#pragma unroll
    for (int ni = 0; ni < 8; ++ni) {
      size_t row = (size_t)mt * 128 + wm * 64 + mi * 16 + fr; int col = nt * 256 + wn * 128 + ni * 16 + fq * 4;
      float4 xi = *(const float4*)(xin + row * 1024 + col);
      float4 o; o.x = xi.x + acc[mi][ni][0]; o.y = xi.y + acc[mi][ni][1]; o.z = xi.z + acc[mi][ni][2]; o.w = xi.w + acc[mi][ni][3];
      *(float4*)(p.out + row * 1024 + col) = o;
    }
}


#define XB_TMO      128
#define XB_XCNT(j)  (256  + 64 * (j))
#define XB_XSUB(j)  (1280 + 64 * (j))
#define XB_XGEN(j)  (2304 + 64 * (j))
#define XB_TOP      3328
#define XB_TOPGEN   3392
#define XCD_BAR_WORDS 3456
#define XB_SPIN_CAP (1u << 22)
#define LAS __attribute__((address_space(3)))
DI unsigned xb_ld(unsigned* p)              { return __hip_atomic_load(p, __ATOMIC_RELAXED, __HIP_MEMORY_SCOPE_AGENT); }
DI unsigned xb_add(unsigned* p, unsigned v) { return __hip_atomic_fetch_add(p, v, __ATOMIC_RELAXED, __HIP_MEMORY_SCOPE_AGENT); }
DI unsigned xb_xcc_id() { return (unsigned)__builtin_amdgcn_s_getreg((3 << 11) | 20) & 0xFu; }
#define XB_SPIN(cond, bar) do { unsigned _sp = 0; while (cond) { __builtin_amdgcn_s_sleep(1); \
    if ((++_sp & 255u) == 0u) { if (xb_ld(&(bar)[XB_TMO])) break; if (_sp > XB_SPIN_CAP) { atomicAdd(&(bar)[XB_TMO], 1u); break; } } } } while (0)
struct XcdBarrier { unsigned* bar; unsigned x; volatile LAS unsigned* st; };
DI XcdBarrier xcd_barrier_post(unsigned* bar, volatile LAS unsigned* st) {
  XcdBarrier b; b.bar = bar; b.x = xb_xcc_id(); b.st = st;
  if (threadIdx.x == 0) (void)xb_add(&bar[XB_XCNT(b.x)], 1u);
  return b;
}
DI void xcd_barrier_complete(unsigned* bar, unsigned x, unsigned& nloc, unsigned& nx) {
  const unsigned G = gridDim.x * gridDim.y * gridDim.z;
  unsigned sum, cnt, mine, sp = 0u;
  for (;;) {
    sum = 0u; cnt = 0u; mine = 0u;
#pragma unroll
    for (unsigned j = 0; j < 16; ++j) { const unsigned c = xb_ld(&bar[XB_XCNT(j)]); sum += c; cnt += (c > 0u) ? 1u : 0u; mine = (j == x) ? c : mine; }
    if (sum == G) break;
    __builtin_amdgcn_s_sleep(1);
    if ((++sp & 255u) == 0u) { if (xb_ld(&bar[XB_TMO])) break; if (sp > XB_SPIN_CAP) { atomicAdd(&bar[XB_TMO], 1u); break; } }
  }
  nloc = mine > 0u ? mine : 1u; nx = cnt > 0u ? cnt : 1u;
}
DI void xcd_barrier(const XcdBarrier& b) {
  asm volatile("s_waitcnt vmcnt(0)" ::: "memory");
  __syncthreads();
  if (threadIdx.x == 0) {
    unsigned* bar = b.bar;
    __builtin_amdgcn_s_waitcnt(0);
    unsigned nloc = b.st[0], nx = b.st[1];
    if (nloc == 0u) { xcd_barrier_complete(bar, b.x, nloc, nx); b.st[0] = nloc; b.st[1] = nx; }
    const unsigned old = xb_add(&bar[XB_XSUB(b.x)], 1u);
    const unsigned gen = old / nloc;
    if (old + 1u == (gen + 1u) * nloc) {
      __builtin_amdgcn_fence(__ATOMIC_RELEASE, "agent");
      asm volatile("s_waitcnt vmcnt(0)" ::: "memory");
      const unsigned og = xb_add(&bar[XB_TOP], 1u);
      const unsigned tg = og / nx;
      if (og + 1u == (tg + 1u) * nx) xb_add(&bar[XB_TOPGEN], 1u);
      else XB_SPIN(xb_ld(&bar[XB_TOPGEN]) == tg, bar);
      __builtin_amdgcn_fence(__ATOMIC_ACQUIRE, "agent");
      xb_add(&bar[XB_XGEN(b.x)], 1u);
      asm volatile("s_waitcnt vmcnt(0)" ::: "memory");
    } else {
      XB_SPIN(xb_ld(&bar[XB_XGEN(b.x)]) == gen, bar);
      __builtin_amdgcn_fence(__ATOMIC_ACQUIRE, "agent");
      asm volatile("s_waitcnt vmcnt(0)" ::: "memory");
    }
  }
  __syncthreads();
}

DI void run_phase(const Params& p, int ph, char* smem, bool never) {
  const int G = gridDim.x, B = blockIdx.x;
  if (ph == 0) {
    for (int i = B; i < 6097; i += G) prep_item(p, i, (float*)smem);
    for (int i = B; i < 1024; i += G) norm_rows_bf16(p.x, p.norm_g, P_XN, i);
  } else if (ph == 14) {
    for (int i = B; i < 1024; i += G) norm_rows_f32(p.out, p.final_g, i);
  } else if (ph == 7) {
    for (int i = B; i < 1024; i += G) norm_rows_bf16(p.out, p.norm_g + 1024, P_XN, i);
  } else {
    const int l = ph > 7 ? 1 : 0; const int s = ph > 7 ? ph - 8 : ph - 1;
    const int xcd = B & 7, lb = B >> 3, nl = G >> 3;
    if (s == 0) {
      for (int w = lb; w < 64 * 8 + 96; w += nl) {
        const int it = w >> 6, l64 = w & 63;
        int mt, nt;
        if (it < 8) { const int a = it >> 1, gn = it & 1; mt = 8 * (xcd + 8 * a) + (l64 & 7); nt = 8 * gn + (l64 >> 3); }
        else { const int q = (it - 8) * 64 + l64; const int ml = q / 3; mt = 8 * (xcd + 8 * (ml >> 3)) + (ml & 7); nt = 16 + q % 3; }
        inproj_tile(p, l, nt * 256 + mt, smem);
      }
    }
    else if (s == 1) { for (int i = B; i < 2048; i += G) mla_item(p, l, i, smem); }
    else if (s == 2) {
#ifdef REP_DENSE
      for (int w = lb; w < 256; w += nl) dense_item(p, l, xcd + 8 * (w >> 6), w & 63, smem, never);
#endif
      for (int i = B; i < 4096; i += G) band_item(p, l, i, smem);
      for (int w = lb; w < 256; w += nl) { const int k = w >> 6, ck = ((k & 1) << 1 | (k >> 1)) ^ 1; dense_item(p, l, xcd + 8 * ck, w & 63, smem, true); }
    }
    else if (s == 3) { combine_c(p); }
    else if (s == 4) {
      for (int w = lb; w < 64 * 8; w += nl) {
        const int it = w >> 6, l64 = w & 63, a = it >> 1, gn = it & 1;
        const int mt = 8 * (xcd + 8 * a) + (l64 & 7), nt = 8 * gn + (l64 >> 3);
        merge_tile(p, l, nt * 256 + mt, smem);
      }
    }
    else {
      for (int w = lb; w < 64 * 2; w += nl) {
        const int a = w >> 6, l64 = w & 63;
        const int mt = 8 * (xcd + 8 * (2 * a + (l64 >> 5))) + (l64 & 7), nt = (l64 >> 3) & 3;
        outproj_tile(p, l, nt * 256 + mt, smem);
      }
    }
  }
}

__global__ void __launch_bounds__(256, 2) mega(Params p, int ph_lo, int ph_hi) {
  __shared__ __attribute__((aligned(16))) char smem[66048];
  __shared__ uint4 xb_words;
  cg::grid_group grid = cg::this_grid();
  if (threadIdx.x == 0) xb_words = make_uint4(0u, 0u, 0u, 0u);
  __syncthreads();
  XcdBarrier xb = xcd_barrier_post((unsigned*)(p.ws + OFF_BAR), (volatile LAS unsigned*)&xb_words);
  if (ph_hi == 12345) grid.sync();
  for (int ph = ph_lo; ph < ph_hi; ++ph) {
    run_phase(p, ph, smem, ph_hi == 12345);
    if (ph + 1 < ph_hi) xcd_barrier(xb);
  }
}

extern "C" void kernel_launch(void* const* d_in, const int* in_sizes, int n_in, void* d_out, int out_size, void* d_ws,
                              size_t ws_size, hipStream_t stream) {
  Params p{};
  p.x = (const float*)d_in[0]; p.norm_g = (const float*)d_in[1]; p.w_in = (const float*)d_in[2];
  p.q_norm_g = (const float*)d_in[3]; p.kv_norm_g = (const float*)d_in[4]; p.w_q_up = (const float*)d_in[5];
  p.w_kv_up = (const float*)d_in[6]; p.gq_g = (const float*)d_in[7]; p.gk_g = (const float*)d_in[8];
  p.sink = (const float*)d_in[9]; p.t5 = (const float*)d_in[10]; p.w_branch = (const float*)d_in[11];
  p.w_out = (const float*)d_in[12]; p.final_g = (const float*)d_in[13];
  p.out = (float*)d_out;
  p.ws = (char*)d_ws;
  if (WS_NEED > ws_size) { fprintf(stderr, "workspace too small: need %zu have %zu\n", (size_t)WS_NEED, ws_size); return; }

  static int grid_blocks = 0;
  if (!grid_blocks) {
    int dev = 0, cus = 0, per_cu = 0;
    hipGetDevice(&dev);
    hipDeviceGetAttribute(&cus, hipDeviceAttributeMultiprocessorCount, dev);
    hipOccupancyMaxActiveBlocksPerMultiprocessor(&per_cu, mega, 256, 0);
    if (per_cu < 1) per_cu = 1;
    if (per_cu > 2) per_cu = 2;
    grid_blocks = cus * per_cu;
  }
  hipMemsetAsync((char*)d_ws + OFF_BAR, 0, 16384, stream);
  int lo = 0, hi = 15;
  void* args[] = {&p, &lo, &hi};
  hipError_t e = hipLaunchCooperativeKernel((void*)mega, dim3(grid_blocks), dim3(256), args, 0, stream);
  if (e != hipSuccess) fprintf(stderr, "cooperative launch failed: %s (grid %d)\n", hipGetErrorString(e), grid_blocks);
}
```

```cpp
#include <hip/hip_runtime.h>
#include <hip/hip_cooperative_groups.h>
#include <cstdio>
namespace cg = cooperative_groups;

typedef unsigned short bf16_t;
using bf16x8 = __attribute__((ext_vector_type(8))) short;
using f32x4 = __attribute__((ext_vector_type(4))) float;
using u32x4 = __attribute__((ext_vector_type(4))) unsigned;
using f32x16 = __attribute__((ext_vector_type(16))) float;
using bf16x4 = __attribute__((ext_vector_type(4))) short;
#define DI __device__ __forceinline__

constexpr int SEQ = 8192;
constexpr int PW = 4864;
constexpr int C_BQ = 0, C_BK = 256, C_BV = 384, C_CQ = 512, C_CK = 1280, C_CV = 2048, C_DQ = 2816, C_DK = 3072,
              C_DV = 3200, C_GATE = 3328, C_AQ = 4352, C_AKV = 4608, C_AKR = 4736;
constexpr int C_MERGED = 512;

struct Params {
  const float* x; const float* norm_g; const float* w_in; const float* q_norm_g; const float* kv_norm_g;
  const float* w_q_up; const float* w_kv_up; const float* gq_g; const float* gk_g; const float* sink;
  const float* t5; const float* w_branch; const float* w_out; const float* final_g;
  float* out; char* ws;
};
constexpr size_t al256(size_t x) { return (x + 255) & ~(size_t)255; }
constexpr size_t OFF_W1T = 0;
constexpr size_t OFF_WMT = OFF_W1T + al256((size_t)2 * 4864 * 1024 * 2);
constexpr size_t OFF_WOT = OFF_WMT + al256((size_t)2 * 4096 * 1024 * 2);
constexpr size_t OFF_WBT = OFF_WOT + al256((size_t)2 * 1024 * 1024 * 2);
constexpr size_t OFF_WQT = OFF_WBT + al256((size_t)2 * 4 * 1024 * 256 * 2);
constexpr size_t OFF_WKVT = OFF_WQT + al256((size_t)2 * 384 * 256 * 2);
constexpr size_t OFF_ROPE = OFF_WKVT + al256((size_t)2 * 512 * 128 * 2);
constexpr size_t OFF_LUTC = OFF_ROPE + al256((size_t)8192 * 32 * 4);
constexpr size_t OFF_LUTD = OFF_LUTC + 8192;
constexpr size_t OFF_XN = OFF_LUTD + 8192;
constexpr size_t OFF_PROJ = OFF_XN + al256((size_t)32768 * 1024 * 2);
constexpr size_t OFF_QA = OFF_PROJ + al256((size_t)32768 * 4864 * 2);
constexpr size_t OFF_KA = OFF_QA + al256((size_t)32768 * 384 * 2);
constexpr size_t OFF_VA = OFF_KA + al256((size_t)32768 * 384 * 2);
constexpr size_t OFF_LSE = OFF_VA + al256((size_t)32768 * 256 * 2);
constexpr size_t OFF_BAR = OFF_LSE + al256((size_t)32768 * 12 * 4);
constexpr size_t WS_NEED = OFF_BAR + 16384;
#define WSP(T, OFF) ((T*)(p.ws + (OFF)))
#define P_W1T WSP(bf16_t, OFF_W1T)
#define P_WMT WSP(bf16_t, OFF_WMT)
#define P_WOT WSP(bf16_t, OFF_WOT)
#define P_WBT WSP(bf16_t, OFF_WBT)
#define P_WQT WSP(bf16_t, OFF_WQT)
#define P_WKVT WSP(bf16_t, OFF_WKVT)
#define P_ROPE WSP(float, OFF_ROPE)
#define P_LUTC WSP(float, OFF_LUTC)
#define P_LUTD WSP(float, OFF_LUTD)
#define P_XN WSP(bf16_t, OFF_XN)
#define P_PROJ WSP(bf16_t, OFF_PROJ)
#define P_QA WSP(bf16_t, OFF_QA)
#define P_KA WSP(bf16_t, OFF_KA)
#define P_VA WSP(bf16_t, OFF_VA)
#define P_LSE WSP(float, OFF_LSE)


DI unsigned short f2bf(float x) { unsigned u = __float_as_uint(x); u += 0x7fffu + ((u >> 16) & 1u); return (unsigned short)(u >> 16); }
DI float bf2f(unsigned short b) { return __uint_as_float(((unsigned)b) << 16); }
typedef __bf16 bf2_t __attribute__((ext_vector_type(2)));
typedef float f2_t __attribute__((ext_vector_type(2)));
DI unsigned pack2(float a, float b) { f2_t v = {a, b}; bf2_t r = __builtin_convertvector(v, bf2_t); return __builtin_bit_cast(unsigned, r); }
constexpr float LOG2E = 1.4426950408889634f;
constexpr float QS64 = 0.125f * LOG2E;
constexpr float QS96 = 0.10206207261596575f * LOG2E;
#define BLO(u) __uint_as_float((u) << 16)
#define BHI(u) __uint_as_float((u) & 0xffff0000u)
DI int otid() { int t; asm volatile("v_mov_b32 %0, %1" : "=v"(t) : "v"((int)threadIdx.x)); __builtin_assume(t >= 0 && t < 256); return t; }
DI float wave_sum(float v) {
#pragma unroll
  for (int o = 32; o; o >>= 1) v += __shfl_xor(v, o);
  return v;
}

DI int srccol(int mode, int n) {
  if (mode == 0) return n < 4352 ? n + 416 : (n < 4768 ? n - 4352 : -1);
  if (mode == 1) return 4768 + n;
  if (mode == 2) return n;
  return n < 256 ? (n >> 6) * 96 + (n & 63) : ((n - 256) >> 5) * 96 + 64 + ((n - 256) & 31);
}
DI void conv_tile(const float* __restrict__ src, int ld, int K, bf16_t* __restrict__ dst, int n0, int k0, int mode,
                  const float* __restrict__ rs, float* tile) {
  const int tx = otid() & 63, ty = otid() >> 6;
  __syncthreads();
  const int sc = srccol(mode, n0 + tx);
  const int nq = n0 + tx;
  const float cscale = (mode == 0 && ((nq >= C_CQ && nq < C_CQ + 768) || (nq >= C_DQ && nq < C_DQ + 256))) ? QS64 : 1.0f;
#pragma unroll
  for (int i = 0; i < 16; ++i) {
    int kk = ty + 4 * i;
    float v = sc >= 0 ? src[(size_t)(k0 + kk) * ld + sc] : 0.f;
    if (rs) v *= rs[k0 + kk];
    tile[kk * 65 + tx] = v * cscale;
  }
  __syncthreads();
#pragma unroll
  for (int i = 0; i < 16; ++i) {
    int nn = ty + 4 * i;
    dst[(size_t)(n0 + nn) * K + k0 + tx] = f2bf(tile[tx * 65 + nn]);
  }
}

DI int t5_bucket(int rel) {
  int n = rel < 0 ? -rel : rel;
  float nf = (float)(n < 1 ? 1 : n);
  int large = 8 + (int)(logf(nf / 8.0f) / 4.852030263919617f * 8.0f);
  if (large > 15) large = 15;
  return (rel > 0 ? 16 : 0) + (n < 8 ? n : large);
}

DI void prep_item(const Params& p, int item, float* tile) {
  if (item < 5584) {
    int l = item / 2792, r = item % 2792;
    const float* src; int ld, K, mode, t; bf16_t* dst; const float* rs = nullptr;
    if (r < 1216) { t = r; src = p.w_in + (size_t)l * 1024 * 8864; ld = 8864; K = 1024; mode = 0; dst = P_W1T + (size_t)l * 4864 * 1024; }
    else if (r < 2240) { t = r - 1216; src = p.w_in + (size_t)l * 1024 * 8864; ld = 8864; K = 1024; mode = 1; dst = P_WMT + (size_t)l * 4096 * 1024; }
    else if (r < 2496) { t = r - 2240; src = p.w_out + (size_t)l * 1024 * 1024; ld = 1024; K = 1024; mode = 2; dst = P_WOT + (size_t)l * 1024 * 1024; }
    else if (r < 2752) { t = r - 2496; int n = t >> 6; t &= 63; src = p.w_branch + (size_t)(l * 4 + n) * 256 * 1024; ld = 1024; K = 256; mode = 2; dst = P_WBT + (size_t)(l * 4 + n) * 1024 * 256; }
    else if (r < 2776) { t = r - 2752; src = p.w_q_up + (size_t)l * 256 * 384; ld = 384; K = 256; mode = 3; dst = P_WQT + (size_t)l * 384 * 256; rs = p.q_norm_g + l * 256; }
    else { t = r - 2776; src = p.w_kv_up + (size_t)l * 128 * 512; ld = 512; K = 128; mode = 2; dst = P_WKVT + (size_t)l * 512 * 128; rs = p.kv_norm_g + l * 128; }
    int kt = K / 64;
    conv_tile(src, ld, K, dst, (t / kt) * 64, (t % kt) * 64, mode, rs, tile);
  } else if (item < 5584 + 512) {
    int idx = (item - 5584) * 256 + otid();
    int pos = idx >> 4, i = idx & 15;
    double invd = 1.0;
    for (int k = 0; k < i; ++k) invd *= 0.5623413251903491;
    float inv = (float)invd;
    float ang = (float)pos * inv;
    double a = (double)ang;
    double kq = rint(a * 0.15915494309189535);
    double r = a - kq * 6.283185307179586;
    double r2 = r * r, ts = r, tc = 1.0, sn = r, cs = 1.0;
    for (int k = 1; k <= 14; ++k) {
      tc = -tc * r2 / (double)((2 * k - 1) * (2 * k));
      ts = -ts * r2 / (double)((2 * k) * (2 * k + 1));
      cs += tc; sn += ts;
    }
    P_ROPE[pos * 32 + i] = (float)cs;
    P_ROPE[pos * 32 + 16 + i] = (float)sn;
  } else {
    for (int e = otid(); e < 12 * 129; e += 256) {
      int gh = e / 129, off = e % 129 - 64; int g = gh >> 2;
      int r = g == 0 ? 1 : (g == 1 ? 4 : 16);
      P_LUTC[e] = p.t5[t5_bucket(off * r) * 16 + gh] * LOG2E;
    }
    for (int e = otid(); e < 4 * 257; e += 256) {
      int hq = e / 257, off = e % 257 - 128;
      P_LUTD[e] = p.t5[t5_bucket(off) * 16 + 12 + hq] * LOG2E;
    }
  }
}

DI void norm_rows_bf16(const float* __restrict__ src, const float* __restrict__ g, bf16_t* __restrict__ dst, int item) {
  const int lane = otid() & 63, wid = otid() >> 6;
  for (int i = 0; i < 8; ++i) {
    size_t row = (size_t)item * 32 + wid * 8 + i;
    const float4* s = (const float4*)(src + row * 1024);
    float4 v[4]; float ss = 0.f;
#pragma unroll
    for (int j = 0; j < 4; ++j) { v[j] = s[lane + 64 * j]; ss += v[j].x * v[j].x + v[j].y * v[j].y + v[j].z * v[j].z + v[j].w * v[j].w; }
    ss = wave_sum(ss);
    float sc = rsqrtf(ss * (1.0f / 1024.0f) + 1e-6f);
#pragma unroll
    for (int j = 0; j < 4; ++j) {
      float4 gg = ((const float4*)g)[lane + 64 * j];
      uint2 o; o.x = pack2(v[j].x * sc * gg.x, v[j].y * sc * gg.y); o.y = pack2(v[j].z * sc * gg.z, v[j].w * sc * gg.w);
      *(uint2*)(dst + row * 1024 + (lane + 64 * j) * 4) = o;
    }
  }
}
DI void norm_rows_f32(float* io, const float* __restrict__ g, int item) {
  const int lane = otid() & 63, wid = otid() >> 6;
  for (int i = 0; i < 8; ++i) {
    size_t row = (size_t)item * 32 + wid * 8 + i;
    float4* s = (float4*)(io + row * 1024);
    float4 v[4]; float ss = 0.f;
#pragma unroll
    for (int j = 0; j < 4; ++j) { v[j] = s[lane + 64 * j]; ss += v[j].x * v[j].x + v[j].y * v[j].y + v[j].z * v[j].z + v[j].w * v[j].w; }
    ss = wave_sum(ss);
    float sc = rsqrtf(ss * (1.0f / 1024.0f) + 1e-6f);
#pragma unroll
    for (int j = 0; j < 4; ++j) {
      float4 gg = ((const float4*)g)[lane + 64 * j];
      float4 o; o.x = v[j].x * sc * gg.x; o.y = v[j].y * sc * gg.y; o.z = v[j].z * sc * gg.z; o.w = v[j].w * sc * gg.w;
      s[lane + 64 * j] = o;
    }
  }
}

constexpr int LLD = 72;
constexpr int GST = 128 * 64;
template <int NT, bool LOWREG = false>
DI void gemm_mainloop(f32x4 (&acc)[4][NT], const bf16_t* A, int lda, const bf16_t* Bt, int ldb, int K, bf16_t* sA, bf16_t* sB, int bstride = 32) {
  constexpr int NB = NT;
  const int tid = otid(), lane = tid & 63, wid = tid >> 6;
  const int wm = wid >> 1, wn = wid & 1, fr = lane & 15, fq = lane >> 4;
  u32x4 ra[4], rb[NB];
  const int nk = K >> 6;
  const bf16_t* ap = A + (size_t)(tid >> 3) * lda + (tid & 7) * 8;
  const bf16_t* bp = Bt + (size_t)(tid >> 3) * ldb + (tid & 7) * 8;
  const int so = (tid >> 3) * 64 + (((tid & 7) ^ ((tid >> 4) & 7)) * 8);
  const int fsw = fr >> 1;
#define GLOAD(ko) do { \
    _Pragma("unroll") for (int i = 0; i < 4; ++i) ra[i] = *(const u32x4*)(ap + (size_t)(32 * i) * lda + (ko)); \
    _Pragma("unroll") for (int i = 0; i < NB; ++i) rb[i] = *(const u32x4*)(bp + (size_t)(bstride * i) * ldb + (ko)); } while (0)
#define GSTORE(st) do { \
    _Pragma("unroll") for (int i = 0; i < 4; ++i) *(u32x4*)(sA + (st) * GST + so + 32 * i * 64) = ra[i]; \
    _Pragma("unroll") for (int i = 0; i < NB; ++i) *(u32x4*)(sB + (st) * GST + so + 32 * i * 64) = rb[i]; } while (0)
#define GCOMPUTE(st) do { \
    const bf16_t* cA = sA + (st) * GST; const bf16_t* cB = sB + (st) * GST; \
    _Pragma("unroll") for (int ks = 0; ks < 2; ++ks) { \
      bf16x8 af[4], bfr[NT]; \
      _Pragma("unroll") for (int mi = 0; mi < 4; ++mi) af[mi] = *(const bf16x8*)(cA + (wm * 64 + mi * 16 + fr) * 64 + (((ks * 4 + fq) ^ fsw) * 8)); \
      _Pragma("unroll") for (int ni = 0; ni < NT; ++ni) bfr[ni] = *(const bf16x8*)(cB + (wn * NT * 16 + ni * 16 + fr) * 64 + (((ks * 4 + fq) ^ fsw) * 8)); \
      _Pragma("unroll") for (int mi = 0; mi < 4; ++mi) \
        _Pragma("unroll") for (int ni = 0; ni < NT; ++ni) acc[mi][ni] = __builtin_amdgcn_mfma_f32_16x16x32_bf16(bfr[ni], af[mi], acc[mi][ni], 0, 0, 0); \
    } } while (0)
  __syncthreads();
  GLOAD(0); GSTORE(0);
  if (nk > 1) GLOAD(64);
  __syncthreads();
  for (int kt = 0; kt < nk; ++kt) {
    const int cur = kt & 1;
    if (kt + 1 < nk) { GSTORE(cur ^ 1); if (kt + 2 < nk) GLOAD((kt + 2) * 64); }
    if (LOWREG) {
      const bf16_t* cA = sA + cur * GST; const bf16_t* cB = sB + cur * GST;
#pragma nounroll
      for (int ks = 0; ks < 2; ++ks) {
        bf16x8 af[4], bfr[NT];
#pragma unroll
        for (int mi = 0; mi < 4; ++mi) af[mi] = *(const bf16x8*)(cA + (wm * 64 + mi * 16 + fr) * 64 + (((ks * 4 + fq) ^ fsw) * 8));
#pragma unroll
        for (int ni = 0; ni < NT; ++ni) bfr[ni] = *(const bf16x8*)(cB + (wn * NT * 16 + ni * 16 + fr) * 64 + (((ks * 4 + fq) ^ fsw) * 8));
#pragma unroll
        for (int mi = 0; mi < 4; ++mi)
#pragma unroll
          for (int ni = 0; ni < NT; ++ni) acc[mi][ni] = __builtin_amdgcn_mfma_f32_16x16x32_bf16(bfr[ni], af[mi], acc[mi][ni], 0, 0, 0);
      }
    } else GCOMPUTE(cur);
    __syncthreads();
  }
#undef GLOAD
#undef GSTORE
#undef GCOMPUTE
}
template <int NT>
DI void zero_acc(f32x4 (&acc)[4][NT]) {
#pragma unroll
  for (int mi = 0; mi < 4; ++mi)
#pragma unroll
    for (int ni = 0; ni < NT; ++ni) acc[mi][ni] = f32x4{0.f, 0.f, 0.f, 0.f};
}


constexpr int BGA = 128 * 32, BGB = 256 * 32;
DI void gemm_big(f32x4 (&acc)[4][8], const bf16_t* A, int lda, const bf16_t* Bt, int ldb, int K, char* smem, int s1 = 64, int s2 = 128, int brow = -1) {
  bf16_t* sA = (bf16_t*)smem; bf16_t* sB = sA + 2 * BGA;
  const int tid = otid(), lane = tid & 63, wid = tid >> 6;
  const int wm = wid >> 1, wn = wid & 1, fr = lane & 15, fq = lane >> 4;
  const int nk = K >> 5;
  const bf16_t* ap = A + (size_t)(tid >> 2) * lda + (tid & 3) * 8;
  const bf16_t* bp = Bt + (size_t)(brow >= 0 ? brow : (tid >> 2)) * ldb + (tid & 3) * 8;
  const int so = (tid >> 2) * 32 + (((tid & 3) ^ (((tid >> 5) & 1) << 1)) * 8);
  const int fo = fr * 32 + ((fq ^ (((fr >> 3) & 1) << 1)) * 8);
  u32x4 ra[2], rb[4];
#define BLOADG(kt) do { \
    _Pragma("unroll") for (int i = 0; i < 2; ++i) ra[i] = *(const u32x4*)(ap + (size_t)(64 * i) * lda + (kt) * 32); \
    _Pragma("unroll") for (int i = 0; i < 4; ++i) rb[i] = *(const u32x4*)(bp + (size_t)((i & 1) * s1 + (i >> 1) * s2) * ldb + (kt) * 32); } while (0)
#define BSTOREG(st) do { \
    _Pragma("unroll") for (int i = 0; i < 2; ++i) *(u32x4*)(sA + (st) * BGA + so + 64 * i * 32) = ra[i]; \
    _Pragma("unroll") for (int i = 0; i < 4; ++i) *(u32x4*)(sB + (st) * BGB + so + 64 * i * 32) = rb[i]; } while (0)
  __syncthreads();
  BLOADG(0); BSTOREG(0);
  if (nk > 1) BLOADG(1);
  __syncthreads();
  for (int kt = 0; kt < nk; ++kt) {
    const int cur = kt & 1;
    if (kt + 1 < nk) { BSTOREG(cur ^ 1); if (kt + 2 < nk) BLOADG(kt + 2); }
    const bf16_t* cA = sA + cur * BGA + (wm * 64) * 32 + fo; const bf16_t* cB = sB + cur * BGB + (wn * 128) * 32 + fo;
    bf16x8 af[4];
#pragma unroll
    for (int mi = 0; mi < 4; ++mi) af[mi] = *(const bf16x8*)(cA + mi * 16 * 32);
#pragma unroll
    for (int nh = 0; nh < 2; ++nh) {
      bf16x8 bfr[4];
#pragma unroll
      for (int ni = 0; ni < 4; ++ni) bfr[ni] = *(const bf16x8*)(cB + (nh * 4 + ni) * 16 * 32);
#pragma unroll
      for (int mi = 0; mi < 4; ++mi)
#pragma unroll
        for (int ni = 0; ni < 4; ++ni) acc[mi][nh * 4 + ni] = __builtin_amdgcn_mfma_f32_16x16x32_bf16(bfr[ni], af[mi], acc[mi][nh * 4 + ni], 0, 0, 0);
    }
    __syncthreads();
  }
#undef BLOADG
#undef BSTOREG
}
DI void zero_acc8(f32x4 (&acc)[4][8]) {
#pragma unroll
  for (int mi = 0; mi < 4; ++mi)
#pragma unroll
    for (int ni = 0; ni < 8; ++ni) acc[mi][ni] = f32x4{0.f, 0.f, 0.f, 0.f};
}

DI uint4 widen16(uint2 a, uint2 b) {
  auto rx = __builtin_amdgcn_permlane16_swap(a.x, b.x, false, false);
  auto ry = __builtin_amdgcn_permlane16_swap(a.y, b.y, false, false);
  uint4 w; w.x = rx[0]; w.y = ry[0]; w.z = rx[1]; w.w = ry[1];
  return w;
}
DI void inproj_tile(const Params& p, int l, int tile, char* smem) {
  const int mt = tile & 255, nt = tile >> 8;
  f32x4 acc[4][8]; zero_acc8(acc);
  gemm_big(acc, P_XN + (size_t)mt * 128 * 1024, 1024, P_W1T + ((size_t)l * 4864 + nt * 256) * 1024, 1024, 1024, smem);
  const int lane = otid() & 63, wid = otid() >> 6, wm = wid >> 1, wn = wid & 1, fr = lane & 15, fq = lane >> 4;
#pragma unroll
  for (int mi = 0; mi < 4; ++mi)
#pragma unroll
    for (int np = 0; np < 4; ++np) {
      size_t row = (size_t)mt * 128 + wm * 64 + mi * 16 + fr; int col = nt * 256 + wn * 128 + (2 * np + (fq & 1)) * 16 + (fq >> 1) * 8;
      uint2 a, b;
      a.x = pack2(acc[mi][2 * np][0], acc[mi][2 * np][1]); a.y = pack2(acc[mi][2 * np][2], acc[mi][2 * np][3]);
      b.x = pack2(acc[mi][2 * np + 1][0], acc[mi][2 * np + 1][1]); b.y = pack2(acc[mi][2 * np + 1][2], acc[mi][2 * np + 1][3]);
      *(uint4*)(P_PROJ + row * PW + col) = widen16(a, b);
    }
}

DI void row_scales(const bf16_t* A, int lda, int K, float* sRow) {
  const int row = otid() >> 1, half = otid() & 1;
  const int per = K >> 1;
  const bf16_t* a = A + (size_t)row * lda + half * per;
  float ss = 0.f;
  for (int c = 0; c < per; c += 8) {
    uint4 u = *(const uint4*)(a + c);
    float f;
    f = BLO(u.x); ss += f * f; f = BHI(u.x); ss += f * f; f = BLO(u.y); ss += f * f; f = BHI(u.y); ss += f * f;
    f = BLO(u.z); ss += f * f; f = BHI(u.z); ss += f * f; f = BLO(u.w); ss += f * f; f = BHI(u.w); ss += f * f;
  }
  ss += __shfl_xor(ss, 1);
  if (half == 0) sRow[row] = rsqrtf(ss / (float)K + 1e-6f);
}
DI void mla_item(const Params& p, int l, int item, char* smem) {
  bf16_t* sA = (bf16_t*)smem; bf16_t* sB = sA + 2 * GST; float* sRow = (float*)(sB + 2 * GST);
  const int lane = otid() & 63, wid = otid() >> 6, wm = wid >> 1, wn = wid & 1, fr = lane & 15, fq = lane >> 4;
  if (item < 768) {
    const int mt = item & 255, nt = item >> 8;
    const bf16_t* A = P_PROJ + (size_t)mt * 128 * PW + C_AQ;
    __syncthreads();
    row_scales(A, PW, 256, sRow);
    f32x4 acc[4][4]; zero_acc<4>(acc);
    gemm_mainloop<4>(acc, A, PW, P_WQT + ((size_t)l * 384 + nt * 128) * 256, 256, 256, sA, sB);
    if (nt < 2) {
#pragma unroll
      for (int mi = 0; mi < 4; ++mi)
#pragma unroll
        for (int ni = 0; ni < 4; ++ni) {
          int rl = wm * 64 + mi * 16 + fr; size_t t = (size_t)mt * 128 + rl; float s = sRow[rl] * QS96;
          int c = nt * 128 + wn * 64 + ni * 16 + fq * 4; int h = c >> 6, d = c & 63;
          uint2 o; o.x = pack2(acc[mi][ni][0] * s, acc[mi][ni][1] * s); o.y = pack2(acc[mi][ni][2] * s, acc[mi][ni][3] * s);
          *(uint2*)(P_QA + t * 384 + h * 96 + d) = o;
        }
    } else {
#pragma unroll
      for (int mi = 0; mi < 4; ++mi)
#pragma unroll
        for (int np = 0; np < 2; ++np) {
          int rl = wm * 64 + mi * 16 + fr; size_t t = (size_t)mt * 128 + rl; float s = sRow[rl] * QS96;
          int pos = (int)(t & (SEQ - 1)); int h = wn * 2 + np;
          const float* cs = P_ROPE + pos * 32 + fq * 4;
          float o1[4], o2[4];
#pragma unroll
          for (int j = 0; j < 4; ++j) {
            float x1 = acc[mi][np * 2][j] * s, x2 = acc[mi][np * 2 + 1][j] * s; float c = cs[j], sn = cs[16 + j];
            o1[j] = x1 * c - x2 * sn; o2[j] = x1 * sn + x2 * c;
          }
          uint2 a; a.x = pack2(o1[0], o1[1]); a.y = pack2(o1[2], o1[3]);
          uint2 b; b.x = pack2(o2[0], o2[1]); b.y = pack2(o2[2], o2[3]);
          *(uint2*)(P_QA + t * 384 + h * 96 + 64 + fq * 4) = a;
          *(uint2*)(P_QA + t * 384 + h * 96 + 80 + fq * 4) = b;
        }
    }
  } else if (item < 768 + 1024) {
    const int it = item - 768; const int mt = it & 255, h = it >> 8;
    const bf16_t* A = P_PROJ + (size_t)mt * 128 * PW + C_AKV;
    __syncthreads();
    row_scales(A, PW, 128, sRow);
    f32x4 acc[4][4]; zero_acc<4>(acc);
    gemm_mainloop<4>(acc, A, PW, P_WKVT + ((size_t)l * 512 + h * 128) * 128, 128, 128, sA, sB);
#pragma unroll
    for (int mi = 0; mi < 4; ++mi)
#pragma unroll
      for (int ni = 0; ni < 4; ++ni) {
        int rl = wm * 64 + mi * 16 + fr; size_t t = (size_t)mt * 128 + rl; float s = sRow[rl];
        int d = ni * 16 + fq * 4;
        uint2 o; o.x = pack2(acc[mi][ni][0] * s, acc[mi][ni][1] * s); o.y = pack2(acc[mi][ni][2] * s, acc[mi][ni][3] * s);
        if (wn == 0) *(uint2*)(P_KA + t * 384 + h * 96 + d) = o;
        else *(uint2*)(P_VA + t * 256 + h * 64 + d) = o;
      }
  } else {
    const int it = item - 1792;
    const int half = lane >> 5, pl = lane & 31;
    for (int i = 0; i < 32; ++i) {
      size_t t = (size_t)it * 128 + wid * 32 + i; int pos = (int)(t & (SEQ - 1));
      bf16_t* row = P_PROJ + t * PW;
#pragma unroll
      for (int s3 = 0; s3 < 3; ++s3) {
        int slot = s3 * 2 + half;
        bf16_t* hp = row + (slot < 4 ? C_BQ + slot * 64 : C_BK + (slot - 4) * 64);
        const float* g = (slot < 4 ? p.gq_g : p.gk_g) + l * 64;
        int d1, fi, ap;
        if (pl < 16) { d1 = pl; fi = pl; ap = pos >> 6; } else { d1 = 32 + (pl - 16); fi = pl - 16; ap = pos & 63; }
        float x1 = bf2f(hp[d1]), x2 = bf2f(hp[d1 + 16]);
        float ss = x1 * x1 + x2 * x2;
#pragma unroll
        for (int o = 16; o; o >>= 1) ss += __shfl_xor(ss, o);
        float sc = rsqrtf(ss * (1.0f / 64.0f) + 1e-6f);
        if (slot < 4) sc *= QS64;
        x1 = x1 * sc * g[d1]; x2 = x2 * sc * g[d1 + 16];
        float c = P_ROPE[ap * 32 + fi], sn = P_ROPE[ap * 32 + 16 + fi];
        hp[d1] = f2bf(x1 * c - x2 * sn); hp[d1 + 16] = f2bf(x1 * sn + x2 * c);
      }
      if (lane < 16) {
        float x1 = bf2f(row[C_AKR + lane]), x2 = bf2f(row[C_AKR + 16 + lane]);
        float c = P_ROPE[pos * 32 + lane], sn = P_ROPE[pos * 32 + 16 + lane];
        bf16_t o1 = f2bf(x1 * c - x2 * sn), o2 = f2bf(x1 * sn + x2 * c);
#pragma unroll
        for (int h = 0; h < 4; ++h) { P_KA[t * 384 + h * 96 + 64 + lane] = o1; P_KA[t * 384 + h * 96 + 80 + lane] = o2; }
      }
    }
  }
}

#define MFMA32(a, b, c) __builtin_amdgcn_mfma_f32_32x32x16_bf16((a), (b), (c), 0, 0, 0)
template <int OFF> DI bf16x4 tr_read(unsigned addr) {
  bf16x4 r; asm volatile("ds_read_b64_tr_b16 %0, %1 offset:%2" : "=&v"(r) : "v"(addr), "i"(OFF) : "memory"); return r;
}
DI float half_swap_max(float v) {
  auto rr = __builtin_amdgcn_permlane32_swap(__float_as_uint(v), __float_as_uint(v), false, false);
  return fmaxf(__uint_as_float(rr[0]), __uint_as_float(rr[1]));
}
DI float half_swap_sum(float v) {
  auto rr = __builtin_amdgcn_permlane32_swap(__float_as_uint(v), __float_as_uint(v), false, false);
  return __uint_as_float(rr[0]) + __uint_as_float(rr[1]);
}
DI bf16x8 pack8(const f32x16& p, int base) {
  u32x4 w = {pack2(p[base + 0], p[base + 1]), pack2(p[base + 2], p[base + 3]), pack2(p[base + 4], p[base + 5]), pack2(p[base + 6], p[base + 7])};
  return __builtin_bit_cast(bf16x8, w);
}
template <int DB, int VLD> DI void pv_block(f32x16& o, unsigned vb, bf16x8 pb0, bf16x8 pb1, bf16x8 pb2, bf16x8 pb3) {
  constexpr int RB = VLD * 2;
  bf16x4 l0 = tr_read<0 * RB + 64 * DB>(vb), h0 = tr_read<8 * RB + 64 * DB>(vb);
  bf16x4 l1 = tr_read<16 * RB + 64 * DB>(vb), h1 = tr_read<24 * RB + 64 * DB>(vb);
  bf16x4 l2 = tr_read<32 * RB + 64 * DB>(vb), h2 = tr_read<40 * RB + 64 * DB>(vb);
  bf16x4 l3 = tr_read<48 * RB + 64 * DB>(vb), h3 = tr_read<56 * RB + 64 * DB>(vb);
  asm volatile("s_waitcnt lgkmcnt(0)" ::: "memory"); __builtin_amdgcn_sched_barrier(0);
  o = MFMA32(__builtin_shufflevector(l0, h0, 0, 1, 2, 3, 4, 5, 6, 7), pb0, o);
  o = MFMA32(__builtin_shufflevector(l1, h1, 0, 1, 2, 3, 4, 5, 6, 7), pb1, o);
  o = MFMA32(__builtin_shufflevector(l2, h2, 0, 1, 2, 3, 4, 5, 6, 7), pb2, o);
  o = MFMA32(__builtin_shufflevector(l3, h3, 0, 1, 2, 3, 4, 5, 6, 7), pb3, o);
}
DI f32x16 splat16(float v) { f32x16 r;
#pragma unroll
  for (int i = 0; i < 16; ++i) r[i] = v;
  return r; }

template <int DQK, bool FIXEDM>
DI void attn_dense_mfma(const bf16_t* Qb, int ldq, const bf16_t* Kb, int ldk, const bf16_t* Vb, int ldv, bf16_t* gate_io, char* smem, bool store, float mbound) {
  constexpr int NS = DQK / 16, KLD = DQK + 8, VLD = 96, CPR = DQK / 8, NKC = (64 * CPR) / 256;
  constexpr int KBYTES = 64 * KLD * 2, VBYTES = 64 * VLD * 2;
  char* sKc = smem; char* sVc = smem + 2 * KBYTES;
  const int tid = otid(), lane = tid & 63, wid = tid >> 6, r = lane & 31, h = lane >> 5;
  bf16x8 qf[NS];
#pragma unroll
  for (int s = 0; s < NS; ++s) qf[s] = *(const bf16x8*)(Qb + (size_t)(wid * 32 + r) * ldq + 16 * s + 8 * h);
  const bf16_t* kp = Kb + (size_t)(tid >> 2) * ldk + (tid & 3) * (NKC * 8);
  const int kso = ((tid >> 2) * KLD + (tid & 3) * (NKC * 8)) * 2;
  const bf16_t* vp0 = Vb + (size_t)(tid >> 3) * ldv + (tid & 7) * 8;
  const bf16_t* vp1 = vp0 + (size_t)32 * ldv;
  const int vso = ((tid >> 3) * VLD + (tid & 7) * 8) * 2;
  const size_t kstep = (size_t)64 * ldk, vstep = (size_t)64 * ldv;
  u32x4 rk[NKC], rv[2];
#define KLOAD() do { _Pragma("unroll") for (int i = 0; i < NKC; ++i) rk[i] = *(const u32x4*)(kp + i * 8); kp += kstep; } while (0)
#define VLOAD() do { rv[0] = *(const u32x4*)vp0; rv[1] = *(const u32x4*)vp1; vp0 += vstep; vp1 += vstep; } while (0)
#define KSTORE(st) do { _Pragma("unroll") for (int i = 0; i < NKC; ++i) *(u32x4*)(sKc + (st) * KBYTES + kso + i * 16) = rk[i]; } while (0)
#define VSTORE(st) do { *(u32x4*)(sVc + (st) * VBYTES + vso) = rv[0]; *(u32x4*)(sVc + (st) * VBYTES + vso + 32 * VLD * 2) = rv[1]; } while (0)
#define QKT(P0, P1, st) do { \
    const bf16_t* sK = (const bf16_t*)(sKc + (st) * KBYTES) + r * KLD + 8 * h; \
    P0 = negm; P1 = negm; \
    _Pragma("unroll") for (int s = 0; s < NS; ++s) { \
      bf16x8 k0 = *(const bf16x8*)(sK + 16 * s); bf16x8 k1 = *(const bf16x8*)(sK + 32 * KLD + 16 * s); \
      P0 = MFMA32(k0, qf[s], P0); P1 = MFMA32(k1, qf[s], P1); } } while (0)
  const unsigned vb0 = (unsigned)(size_t)sVc + (unsigned)(((4 * h + ((lane & 15) >> 2)) * VLD + 16 * ((lane >> 4) & 1) + 4 * (lane & 3)) * 2);
  f32x16 o0 = splat16(0.f), o1 = splat16(0.f), negm = splat16(FIXEDM ? -mbound : 0.f);
  f32x16 pa0, pa1, pc0, pc1;
  float m_run = 0.f, l_run = 0.f;
  constexpr int NT = SEQ / 64;
  __syncthreads();
  KLOAD(); VLOAD(); KSTORE(0); VSTORE(0);
  KLOAD(); KSTORE(1);
  __syncthreads();
  QKT(pa0, pa1, 0);
  __syncthreads();
#define STEP(SC0, SC1, SN0, SN1, PAR, FIRST, LK, LV) do { \
    if (LK) KLOAD(); \
    if (LV) VLOAD(); \
    float pm = 0.f; \
    if (!FIXEDM) { pm = fmaxf(SC0[0], SC1[0]); \
    _Pragma("unroll") for (int i = 1; i < 16; i += 1) pm = fmaxf(fmaxf(pm, SC0[i]), SC1[i]); \
    pm = half_swap_max(pm); } \
    if (!FIXEDM && ((FIRST) || __any(pm > 8.0f))) { \
      float delta; \
      if (FIRST) delta = pm; \
      else { delta = fmaxf(pm, 0.f); float alpha = __builtin_amdgcn_exp2f(-delta); l_run *= alpha; \
        _Pragma("unroll") for (int i = 0; i < 16; ++i) { o0[i] *= alpha; o1[i] *= alpha; } } \
      m_run += delta; \
      _Pragma("unroll") for (int i = 0; i < 16; ++i) { SC0[i] -= delta; SC1[i] -= delta; } \
      negm = splat16(-m_run); \
    } \
    if (LV) QKT(SN0, SN1, (PAR) ^ 1); \
    float ls = 0.f; \
    _Pragma("unroll") for (int i = 0; i < 16; ++i) { SC0[i] = __builtin_amdgcn_exp2f(SC0[i]); SC1[i] = __builtin_amdgcn_exp2f(SC1[i]); ls += SC0[i] + SC1[i]; } \
    l_run += ls; \
    bf16x8 pb0 = pack8(SC0, 0), pb1 = pack8(SC0, 8), pb2 = pack8(SC1, 0), pb3 = pack8(SC1, 8); \
    const unsigned vb = vb0 + (PAR) * VBYTES; \
    pv_block<0, VLD>(o0, vb, pb0, pb1, pb2, pb3); \
    pv_block<1, VLD>(o1, vb, pb0, pb1, pb2, pb3); \
    if (LK) KSTORE(PAR); \
    if (LV) VSTORE((PAR) ^ 1); \
    __syncthreads(); } while (0)
  pc0 = negm; pc1 = negm;
  STEP(pa0, pa1, pc0, pc1, 0, true, 1, 1);
  STEP(pc0, pc1, pa0, pa1, 1, false, 1, 1);
  for (int j = 2; j < NT - 2; j += 2) {
    STEP(pa0, pa1, pc0, pc1, 0, false, 1, 1);
    STEP(pc0, pc1, pa0, pa1, 1, false, 1, 1);
  }
  STEP(pa0, pa1, pc0, pc1, 0, false, 0, 1);
  STEP(pc0, pc1, pa0, pa1, 1, false, 0, 0);
#undef STEP
#undef QKT
#undef KLOAD
#undef VLOAD
#undef KSTORE
#undef VSTORE
  if (!store) return;
  const float inv = 1.0f / half_swap_sum(l_run);
  bf16_t* grow = gate_io + (size_t)(wid * 32 + r) * PW;
#pragma unroll
  for (int db = 0; db < 2; ++db)
#pragma unroll
    for (int g4 = 0; g4 < 4; ++g4) {
      bf16_t* gp = grow + 32 * db + 8 * g4 + 4 * h;
      uint2 u = *(const uint2*)gp;
      float g[4] = {BLO(u.x), BHI(u.x), BLO(u.y), BHI(u.y)};
      float y[4];
#pragma unroll
      for (int e = 0; e < 4; ++e) { float ov = db == 0 ? o0[4 * g4 + e] : o1[4 * g4 + e]; y[e] = ov * inv * g[e] / (1.0f + __expf(-g[e])); }
      uint2 w; w.x = pack2(y[0], y[1]); w.y = pack2(y[2], y[3]);
      *(uint2*)gp = w;
    }
}
DI void dense_item(const Params& p, int l, int combo, int qblk, char* smem, bool store) {
  const int br = combo >> 4, bh = combo & 15, b = bh >> 2, h = bh & 3;
  const size_t t0 = (size_t)b * SEQ + qblk * 128;
  bf16_t* gate_io = P_PROJ + t0 * PW + C_GATE + br * 256 + h * 64;
  float bbound = 0.f;
  if (br != 0) {
    const int ln = otid() & 63;
    float gq = fabsf(p.gq_g[l * 64 + ln]), gk = fabsf(p.gk_g[l * 64 + ln]);
#pragma unroll
    for (int o = 32; o; o >>= 1) { gq = fmaxf(gq, __shfl_xor(gq, o)); gk = fmaxf(gk, __shfl_xor(gk, o)); }
    bbound = 64.0f * QS64 * 1.02f * gq * gk + 0.05f;
  }
  if (br == 0)
    attn_dense_mfma<96, false>(P_QA + t0 * 384 + h * 96, 384, P_KA + (size_t)b * SEQ * 384 + h * 96, 384, P_VA + (size_t)b * SEQ * 256 + h * 64, 256, gate_io, smem, store, 0.f);
  else {
    if (bbound <= 60.0f) attn_dense_mfma<64, true>(P_PROJ + t0 * PW + C_BQ + h * 64, PW, P_PROJ + (size_t)b * SEQ * PW + C_BK + (h >> 1) * 64, PW,
                        P_PROJ + (size_t)b * SEQ * PW + C_BV + (h >> 1) * 64, PW, gate_io, smem, store, bbound);
    else attn_dense_mfma<64, false>(P_PROJ + t0 * PW + C_BQ + h * 64, PW, P_PROJ + (size_t)b * SEQ * PW + C_BK + (h >> 1) * 64, PW,
                        P_PROJ + (size_t)b * SEQ * PW + C_BV + (h >> 1) * 64, PW, gate_io, smem, store, bbound);
  }
}

template <int W, bool SINK>
DI void attn_band_mfma(const bf16_t* Qb, size_t ldq, const bf16_t* Kb, const bf16_t* Vb, size_t ldk, int L, int i0,
                       const float* lut_g, float sink2, bf16_t* outp, size_t ldo, float* lse_out, size_t ldl, char* smem) {
  constexpr int NS = 4, KLD = 72, VLD = 96, NTW = (128 + 2 * W) / 64, LUTN = 2 * W + 1;
  constexpr int KBYTES = 64 * KLD * 2, VBYTES = 64 * VLD * 2;
  char* sKc = smem; char* sVc = smem + 2 * KBYTES; float* sLut = (float*)(smem + 2 * KBYTES + 2 * VBYTES);
  const int tid = otid(), lane = tid & 63, wid = tid >> 6, r = lane & 31, h = lane >> 5;
  __syncthreads();
  for (int e = tid; e < LUTN; e += 256) sLut[e] = lut_g[e];
  const int qi = i0 + wid * 32 + r;
  bf16x8 qf[NS];
#pragma unroll
  for (int s = 0; s < NS; ++s) qf[s] = *(const bf16x8*)(Qb + (size_t)qi * ldq + 16 * s + 8 * h);
  const int srow = tid >> 3, scc = tid & 7;
  u32x4 rk[2], rv[2];
#define BLOAD(k0) do { \
    rk[0] = *(const u32x4*)(Kb + (size_t)((k0) + srow) * ldk + scc * 8); rk[1] = *(const u32x4*)(Kb + (size_t)((k0) + srow + 32) * ldk + scc * 8); \
    rv[0] = *(const u32x4*)(Vb + (size_t)((k0) + srow) * ldk + scc * 8); rv[1] = *(const u32x4*)(Vb + (size_t)((k0) + srow + 32) * ldk + scc * 8); } while (0)
#define BSTORE(st) do { \
    *(u32x4*)(sKc + (st) * KBYTES + (srow * KLD + scc * 8) * 2) = rk[0]; *(u32x4*)(sKc + (st) * KBYTES + ((srow + 32) * KLD + scc * 8) * 2) = rk[1]; \
    *(u32x4*)(sVc + (st) * VBYTES + (srow * VLD + scc * 8) * 2) = rv[0]; *(u32x4*)(sVc + (st) * VBYTES + ((srow + 32) * VLD + scc * 8) * 2) = rv[1]; } while (0)
  const unsigned vb0 = (unsigned)(size_t)sVc + (unsigned)(((4 * h + ((lane & 15) >> 2)) * VLD + 16 * ((lane >> 4) & 1) + 4 * (lane & 3)) * 2);
  f32x16 o0 = splat16(0.f), o1 = splat16(0.f);
  float m_run = SINK ? sink2 : 0.f, l_run = (SINK && h == 0) ? 1.f : 0.f;
  bool seen = SINK;
  f32x16 negm = splat16(-m_run);
  const int lo = (i0 == 0) ? W / 64 : 0, hi = (i0 + 128 >= L) ? NTW - W / 64 : NTW;
  BLOAD(i0 - W + 64 * lo); BSTORE(0);
  __syncthreads();
  for (int j = lo; j < hi; ++j) {
    const int cur = (j - lo) & 1, k0 = i0 - W + 64 * j;
    if (j + 1 < hi) BLOAD(k0 + 64);
    const bf16_t* sK = (const bf16_t*)(sKc + cur * KBYTES);
    f32x16 p0 = negm, p1 = negm;
#pragma unroll
    for (int s = 0; s < NS; ++s) {
      bf16x8 k0f = *(const bf16x8*)(sK + r * KLD + 16 * s + 8 * h);
      bf16x8 k1f = *(const bf16x8*)(sK + (32 + r) * KLD + 16 * s + 8 * h);
      p0 = MFMA32(k0f, qf[s], p0);
      p1 = MFMA32(k1f, qf[s], p1);
    }
    const int offb = k0 + 4 * h - qi + W;
    float pm = -1e30f;
#pragma unroll
    for (int i = 0; i < 16; ++i) {
      int idx0 = offb + (i & 3) + 8 * (i >> 2), idx1 = idx0 + 32;
      int c0 = min(max(idx0, 0), 2 * W), c1 = min(max(idx1, 0), 2 * W);
      float b0 = sLut[c0], b1 = sLut[c1];
      p0[i] = ((unsigned)idx0 <= (unsigned)(2 * W)) ? p0[i] + b0 : -1e30f;
      p1[i] = ((unsigned)idx1 <= (unsigned)(2 * W)) ? p1[i] + b1 : -1e30f;
      pm = fmaxf(pm, fmaxf(p0[i], p1[i]));
    }
    pm = half_swap_max(pm);
    const bool has = pm > -1e29f;
    float delta = 0.f;
    if (has) { if (!seen) delta = pm; else if (pm > 8.0f) delta = pm; }
    if (__any(delta != 0.f)) {
      float alpha = seen ? __builtin_amdgcn_exp2f(-delta) : 1.0f;
      l_run *= alpha; m_run += delta;
#pragma unroll
      for (int i = 0; i < 16; ++i) { o0[i] *= alpha; o1[i] *= alpha; p0[i] -= delta; p1[i] -= delta; }
      negm = splat16(-m_run);
    }
    seen = seen || has;
    float ls = 0.f;
#pragma unroll
    for (int i = 0; i < 16; ++i) { p0[i] = __builtin_amdgcn_exp2f(p0[i]); p1[i] = __builtin_amdgcn_exp2f(p1[i]); ls += p0[i] + p1[i]; }
    l_run += ls;
    bf16x8 pb0 = pack8(p0, 0), pb1 = pack8(p0, 8), pb2 = pack8(p1, 0), pb3 = pack8(p1, 8);
    const unsigned vb = vb0 + cur * VBYTES;
    pv_block<0, VLD>(o0, vb, pb0, pb1, pb2, pb3);
    pv_block<1, VLD>(o1, vb, pb0, pb1, pb2, pb3);
    if (j + 1 < hi) BSTORE(cur ^ 1);
    __syncthreads();
  }
#undef BLOAD
#undef BSTORE
  const float ltot = half_swap_sum(l_run);
  const float inv = 1.0f / ltot;
  bf16_t* orow = outp + (size_t)qi * ldo;
  if (!SINK && h == 0) lse_out[(size_t)qi * ldl] = m_run + __log2f(ltot);
#pragma unroll
  for (int db = 0; db < 2; ++db)
#pragma unroll
    for (int g4 = 0; g4 < 4; ++g4) {
      bf16_t* gp = orow + 32 * db + 8 * g4 + 4 * h;
      float y[4];
      if (SINK) {
        uint2 u = *(const uint2*)gp;
        float g[4] = {BLO(u.x), BHI(u.x), BLO(u.y), BHI(u.y)};
#pragma unroll
        for (int e = 0; e < 4; ++e) { float ov = db == 0 ? o0[4 * g4 + e] : o1[4 * g4 + e]; y[e] = ov * inv * g[e] / (1.0f + __expf(-g[e])); }
      } else {
#pragma unroll
        for (int e = 0; e < 4; ++e) { float ov = db == 0 ? o0[4 * g4 + e] : o1[4 * g4 + e]; y[e] = ov * inv; }
      }
      uint2 w; w.x = pack2(y[0], y[1]); w.y = pack2(y[2], y[3]);
      *(uint2*)gp = w;
    }
}
DI void band_item(const Params& p, int l, int idx, char* smem) {
  if (idx < 3072) {
    const int g = idx >> 10, rem = idx & 1023, h = rem & 3, rem2 = rem >> 2, b = 3 - (rem2 >> 6), u = rem2 & 63;
    const int sh = 2 * g, rr = 1 << sh;
    const int rho = u & (rr - 1), qblk = u >> sh;
    const size_t tok0 = (size_t)b * SEQ + rho;
    bf16_t* base = P_PROJ + tok0 * PW + g * 256 + h * 64;
    attn_band_mfma<64, false>(base + C_CQ, (size_t)rr * PW, base + C_CK, base + C_CV, (size_t)rr * PW, SEQ >> sh, qblk * 128,
                              P_LUTC + (g * 4 + h) * 129, 0.f, base + C_CQ, (size_t)rr * PW, P_LSE + tok0 * 12 + g * 4 + h, (size_t)rr * 12, smem);
  } else {
    const int it = idx - 3072, hq = it & 3, rem = it >> 2, b = 3 - (rem >> 6), qblk = rem & 63;
    bf16_t* base = P_PROJ + (size_t)b * SEQ * PW;
    attn_band_mfma<128, true>(base + C_DQ + hq * 64, PW, base + C_DK + (hq >> 1) * 64, base + C_DV + (hq >> 1) * 64, PW, SEQ, qblk * 128,
                              P_LUTD + hq * 257, p.sink[l * 4 + hq] * LOG2E, base + C_GATE + 768 + hq * 64, PW, nullptr, 0, smem);
  }
}
DI void combine_c(const Params& p) {
  for (size_t u = (size_t)blockIdx.x * 256 + otid(); u < (size_t)32768 * 32; u += (size_t)gridDim.x * 256) {
    const size_t t = u >> 5; const int h = (int)(u >> 3) & 3, ch = (int)u & 7;
    const float* ls = P_LSE + t * 12 + h;
    float l0 = ls[0], l1 = ls[4], l2 = ls[8];
    float mx = fmaxf(l0, fmaxf(l1, l2));
    float a0 = __builtin_amdgcn_exp2f(l0 - mx), a1 = __builtin_amdgcn_exp2f(l1 - mx), a2 = __builtin_amdgcn_exp2f(l2 - mx);
    float inv = 1.0f / (a0 + a1 + a2); a0 *= inv; a1 *= inv; a2 *= inv;
    const bf16_t* row = P_PROJ + t * PW;
    uint4 x0 = *(const uint4*)(row + C_CQ + h * 64 + ch * 8), x1 = *(const uint4*)(row + C_CQ + 256 + h * 64 + ch * 8),
          x2 = *(const uint4*)(row + C_CQ + 512 + h * 64 + ch * 8);
    bf16_t* gp = P_PROJ + t * PW + C_GATE + 512 + h * 64 + ch * 8;
    uint4 gu = *(const uint4*)gp;
    unsigned xa[4] = {x0.x, x0.y, x0.z, x0.w}, xb[4] = {x1.x, x1.y, x1.z, x1.w}, xc[4] = {x2.x, x2.y, x2.z, x2.w}, gg[4] = {gu.x, gu.y, gu.z, gu.w};
    unsigned ov[4];
#pragma unroll
    for (int e = 0; e < 4; ++e) {
      float ylo = a0 * BLO(xa[e]) + a1 * BLO(xb[e]) + a2 * BLO(xc[e]);
      float yhi = a0 * BHI(xa[e]) + a1 * BHI(xb[e]) + a2 * BHI(xc[e]);
      float glo = BLO(gg[e]), ghi = BHI(gg[e]);
      ov[e] = pack2(ylo * glo / (1.0f + __expf(-glo)), yhi * ghi / (1.0f + __expf(-ghi)));
    }
    uint4 w; w.x = ov[0]; w.y = ov[1]; w.z = ov[2]; w.w = ov[3];
    *(uint4*)gp = w;
  }
}

DI void merge_tile(const Params& p, int l, int tile, char* smem) {
  bf16_t* sA = (bf16_t*)smem; bf16_t* sB = sA + 2 * GST;
  const int mt = tile & 255, nt = tile >> 8;
  unsigned sg[4][8][2];
  {
    f32x4 accG[4][8]; zero_acc8(accG);
    gemm_big(accG, P_XN + (size_t)mt * 128 * 1024, 1024, P_WMT + ((size_t)l * 4096 + nt * 64) * 1024, 1024, 1024, smem, 2048, 32,
             (otid() >> 7) * 1024 + ((otid() >> 2) & 31));
#pragma unroll
    for (int mi = 0; mi < 4; ++mi)
#pragma unroll
      for (int ni = 0; ni < 8; ++ni) {
        float s0 = 1.0f / (1.0f + __expf(-accG[mi][ni][0])), s1 = 1.0f / (1.0f + __expf(-accG[mi][ni][1]));
        float s2 = 1.0f / (1.0f + __expf(-accG[mi][ni][2])), s3 = 1.0f / (1.0f + __expf(-accG[mi][ni][3]));
        sg[mi][ni][0] = pack2(s0, s1); sg[mi][ni][1] = pack2(s2, s3);
      }
  }
  f32x4 accM[4][2]; zero_acc<2>(accM);
#pragma unroll 1
  for (int n = 0; n < 4; ++n) {
    f32x4 accB[4][2]; zero_acc<2>(accB);
    gemm_mainloop<2>(accB, P_PROJ + (size_t)mt * 128 * PW + C_GATE + n * 256, PW, P_WBT + ((size_t)(l * 4 + n) * 1024 + nt * 64) * 256, 256, 256, sA, sB);
#pragma unroll
    for (int mi = 0; mi < 4; ++mi)
#pragma unroll
      for (int ni = 0; ni < 2; ++ni) {
        accM[mi][ni][0] += accB[mi][ni][0] * BLO(sg[mi][ni][0]); accM[mi][ni][1] += accB[mi][ni][1] * BHI(sg[mi][ni][0]);
        accM[mi][ni][2] += accB[mi][ni][2] * BLO(sg[mi][ni][1]); accM[mi][ni][3] += accB[mi][ni][3] * BHI(sg[mi][ni][1]);
      }
#pragma unroll
    for (int mi = 0; mi < 4; ++mi)
#pragma unroll
      for (int k = 0; k < 6; ++k) { sg[mi][k][0] = sg[mi][k + 2][0]; sg[mi][k][1] = sg[mi][k + 2][1]; }
  }
  const int lane = otid() & 63, wid = otid() >> 6, wm = wid >> 1, wn = wid & 1, fr = lane & 15, fq = lane >> 4;
#pragma unroll
  for (int mi = 0; mi < 4; ++mi)
    {
      size_t row = (size_t)mt * 128 + wm * 64 + mi * 16 + fr; int col = nt * 64 + wn * 32 + (fq & 1) * 16 + (fq >> 1) * 8;
      uint2 a, b;
      a.x = pack2(accM[mi][0][0], accM[mi][0][1]); a.y = pack2(accM[mi][0][2], accM[mi][0][3]);
      b.x = pack2(accM[mi][1][0], accM[mi][1][1]); b.y = pack2(accM[mi][1][2], accM[mi][1][3]);
      *(uint4*)(P_PROJ + row * PW + C_MERGED + col) = widen16(a, b);
    }
}

DI void outproj_tile(const Params& p, int l, int tile, char* smem) {
  const int mt = tile & 255, nt = tile >> 8;
  f32x4 acc[4][8]; zero_acc8(acc);
  gemm_big(acc, P_PROJ + (size_t)mt * 128 * PW + C_MERGED, PW, P_WOT + ((size_t)l * 1024 + nt * 256) * 1024, 1024, 1024, smem);
  const float* xin = l == 0 ? p.x : p.out;
  const int lane = otid() & 63, wid = otid() >> 6, wm = wid >> 1, wn = wid & 1, fr = lane & 15, fq = lane >> 4;
#pragma unroll
  for (int mi = 0; mi < 4; ++mi)
#pragma unroll
    for (int ni = 0; ni < 8; ++ni) {
      size_t row = (size_t)mt * 128 + wm * 64 + mi * 16 + fr; int col = nt * 256 + wn * 128 + ni * 16 + fq * 4;
      float4 xi = *(const float4*)(xin + row * 1024 + col);
      float4 o; o.x = xi.x + acc[mi][ni][0]; o.y = xi.y + acc[mi][ni][1]; o.z = xi.z + acc[mi][ni][2]; o.w = xi.w + acc[mi][ni][3];
      *(float4*)(p.out + row * 1024 + col) = o;
    }
}


#define XB_TMO      128
#define XB_XCNT(j)  (256  + 64 * (j))
#define XB_XSUB(j)  (1280 + 64 * (j))
#define XB_XGEN(j)  (2304 + 64 * (j))
#define XB_TOP      3328
#define XB_TOPGEN   3392
#define XCD_BAR_WORDS 3456
#define XB_SPIN_CAP (1u << 22)
#define LAS __attribute__((address_space(3)))
DI unsigned xb_ld(unsigned* p)              { return __hip_atomic_load(p, __ATOMIC_RELAXED, __HIP_MEMORY_SCOPE_AGENT); }
DI unsigned xb_add(unsigned* p, unsigned v) { return __hip_atomic_fetch_add(p, v, __ATOMIC_RELAXED, __HIP_MEMORY_SCOPE_AGENT); }
DI unsigned xb_xcc_id() { return (unsigned)__builtin_amdgcn_s_getreg((3 << 11) | 20) & 0xFu; }
#define XB_SPIN(cond, bar) do { unsigned _sp = 0; while (cond) { __builtin_amdgcn_s_sleep(1); \
    if ((++_sp & 255u) == 0u) { if (xb_ld(&(bar)[XB_TMO])) break; if (_sp > XB_SPIN_CAP) { atomicAdd(&(bar)[XB_TMO], 1u); break; } } } } while (0)
struct XcdBarrier { unsigned* bar; unsigned x; volatile LAS unsigned* st; };
DI XcdBarrier xcd_barrier_post(unsigned* bar, volatile LAS unsigned* st) {
  XcdBarrier b; b.bar = bar; b.x = xb_xcc_id(); b.st = st;
  if (threadIdx.x == 0) (void)xb_add(&bar[XB_XCNT(b.x)], 1u);
  return b;
}
DI void xcd_barrier_complete(unsigned* bar, unsigned x, unsigned& nloc, unsigned& nx) {
  const unsigned G = gridDim.x * gridDim.y * gridDim.z;
  unsigned sum, cnt, mine, sp = 0u;
  for (;;) {
    sum = 0u; cnt = 0u; mine = 0u;
#pragma unroll
    for (unsigned j = 0; j < 16; ++j) { const unsigned c = xb_ld(&bar[XB_XCNT(j)]); sum += c; cnt += (c > 0u) ? 1u : 0u; mine = (j == x) ? c : mine; }
    if (sum == G) break;
    __builtin_amdgcn_s_sleep(1);
    if ((++sp & 255u) == 0u) { if (xb_ld(&bar[XB_TMO])) break; if (sp > XB_SPIN_CAP) { atomicAdd(&bar[XB_TMO], 1u); break; } }
  }
  nloc = mine > 0u ? mine : 1u; nx = cnt > 0u ? cnt : 1u;
}
DI void xcd_barrier(const XcdBarrier& b) {
  asm volatile("s_waitcnt vmcnt(0)" ::: "memory");
  __syncthreads();
  if (threadIdx.x == 0) {
    unsigned* bar = b.bar;
    __builtin_amdgcn_s_waitcnt(0);
    unsigned nloc = b.st[0], nx = b.st[1];
    if (nloc == 0u) { xcd_barrier_complete(bar, b.x, nloc, nx); b.st[0] = nloc; b.st[1] = nx; }
    const unsigned old = xb_add(&bar[XB_XSUB(b.x)], 1u);
    const unsigned gen = old / nloc;
    if (old + 1u == (gen + 1u) * nloc) {
      __builtin_amdgcn_fence(__ATOMIC_RELEASE, "agent");
      asm volatile("s_waitcnt vmcnt(0)" ::: "memory");
      const unsigned og = xb_add(&bar[XB_TOP], 1u);
      const unsigned tg = og / nx;
      if (og + 1u == (tg + 1u) * nx) xb_add(&bar[XB_TOPGEN], 1u);
      else XB_SPIN(xb_ld(&bar[XB_TOPGEN]) == tg, bar);
      __builtin_amdgcn_fence(__ATOMIC_ACQUIRE, "agent");
      xb_add(&bar[XB_XGEN(b.x)], 1u);
      asm volatile("s_waitcnt vmcnt(0)" ::: "memory");
    } else {
      XB_SPIN(xb_ld(&bar[XB_XGEN(b.x)]) == gen, bar);
      __builtin_amdgcn_fence(__ATOMIC_ACQUIRE, "agent");
      asm volatile("s_waitcnt vmcnt(0)" ::: "memory");
    }
  }
  __syncthreads();
}

DI void run_phase(const Params& p, int ph, char* smem, bool never) {
  const int G = gridDim.x, B = blockIdx.x;
  if (ph == 0) {
    for (int i = B; i < 6097; i += G) prep_item(p, i, (float*)smem);
    for (int i = B; i < 1024; i += G) norm_rows_bf16(p.x, p.norm_g, P_XN, i);
  } else if (ph == 14) {
    for (int i = B; i < 1024; i += G) norm_rows_f32(p.out, p.final_g, i);
  } else if (ph == 7) {
    for (int i = B; i < 1024; i += G) norm_rows_bf16(p.out, p.norm_g + 1024, P_XN, i);
  } else {
    const int l = ph > 7 ? 1 : 0; const int s = ph > 7 ? ph - 8 : ph - 1;
    const int xcd = B & 7, lb = B >> 3, nl = G >> 3;
    if (s == 0) {
      for (int w = lb; w < 64 * 8 + 96; w += nl) {
        const int it = w >> 6, l64 = w & 63;
        int mt, nt;
        if (it < 8) { const int a = it >> 1, gn = it & 1; mt = 8 * (xcd + 8 * a) + (l64 & 7); nt = 8 * gn + (l64 >> 3); }
        else { const int q = (it - 8) * 64 + l64; const int ml = q / 3; mt = 8 * (xcd + 8 * (ml >> 3)) + (ml & 7); nt = 16 + q % 3; }
        inproj_tile(p, l, nt * 256 + mt, smem);
      }
    }
    else if (s == 1) { for (int i = B; i < 2048; i += G) mla_item(p, l, i, smem); }
    else if (s == 2) {
#ifdef REP_DENSE
      for (int w = lb; w < 256; w += nl) dense_item(p, l, xcd + 8 * (w >> 6), w & 63, smem, never);
#endif
      for (int i = B; i < 4096; i += G) band_item(p, l, i, smem);
      for (int w = lb; w < 256; w += nl) { const int k = w >> 6, ck = ((k & 1) << 1 | (k >> 1)) ^ 1; dense_item(p, l, xcd + 8 * ck, w & 63, smem, true); }
    }
    else if (s == 3) { combine_c(p); }
    else if (s == 4) {
      for (int w = lb; w < 64 * 8; w += nl) {
        const int it = w >> 6, l64 = w & 63, a = it >> 1, gn = it & 1;
        const int mt = 8 * (xcd + 8 * a) + (l64 & 7), nt = 8 * gn + (l64 >> 3);
        merge_tile(p, l, nt * 256 + mt, smem);
      }
    }
    else {
      for (int w = lb; w < 64 * 2; w += nl) {
        const int a = w >> 6, l64 = w & 63;
        const int mt = 8 * (xcd + 8 * (2 * a + (l64 >> 5))) + (l64 & 7), nt = (l64 >> 3) & 3;
        outproj_tile(p, l, nt * 256 + mt, smem);
      }
    }
  }
}

__global__ void __launch_bounds__(256, 2) mega(Params p, int ph_lo, int ph_hi) {
  __shared__ __attribute__((aligned(16))) char smem[66048];
  __shared__ uint4 xb_words;
  cg::grid_group grid = cg::this_grid();
  if (threadIdx.x == 0) xb_words = make_uint4(0u, 0u, 0u, 0u);
  __syncthreads();
  XcdBarrier xb = xcd_barrier_post((unsigned*)(p.ws + OFF_BAR), (volatile LAS unsigned*)&xb_words);
  if (ph_hi == 12345) grid.sync();
  for (int ph = ph_lo; ph < ph_hi; ++ph) {
    run_phase(p, ph, smem, ph_hi == 12345);
    if (ph + 1 < ph_hi) xcd_barrier(xb);
  }
}

extern "C" void kernel_launch(void* const* d_in, const int* in_sizes, int n_in, void* d_out, int out_size, void* d_ws,
                              size_t ws_size, hipStream_t stream) {
  Params p{};
  p.x = (const float*)d_in[0]; p.norm_g = (const float*)d_in[1]; p.w_in = (const float*)d_in[2];
  p.q_norm_g = (const float*)d_in[3]; p.kv_norm_g = (const float*)d_in[4]; p.w_q_up = (const float*)d_in[5];
  p.w_kv_up = (const float*)d_in[6]; p.gq_g = (const float*)d_in[7]; p.gk_g = (const float*)d_in[8];
  p.sink = (const float*)d_in[9]; p.t5 = (const float*)d_in[10]; p.w_branch = (const float*)d_in[11];
  p.w_out = (const float*)d_in[12]; p.final_g = (const float*)d_in[13];
  p.out = (float*)d_out;
  p.ws = (char*)d_ws;
  if (WS_NEED > ws_size) { fprintf(stderr, "workspace too small: need %zu have %zu\n", (size_t)WS_NEED, ws_size); return; }

  static int grid_blocks = 0;
  if (!grid_blocks) {
    int dev = 0, cus = 0, per_cu = 0;
    hipGetDevice(&dev);
    hipDeviceGetAttribute(&cus, hipDeviceAttributeMultiprocessorCount, dev);
    hipOccupancyMaxActiveBlocksPerMultiprocessor(&per_cu, mega, 256, 0);
    if (per_cu < 1) per_cu = 1;
    if (per_cu > 2) per_cu = 2;
    grid_blocks = cus * per_cu;
  }
  hipMemsetAsync((char*)d_ws + OFF_BAR, 0, 16384, stream);
  int lo = 0, hi = 15;
  void* args[] = {&p, &lo, &hi};
  hipError_t e = hipLaunchCooperativeKernel((void*)mega, dim3(grid_blocks), dim3(256), args, 0, stream);
  if (e != hipSuccess) fprintf(stderr, "cooperative launch failed: %s (grid %d)\n", hipGetErrorString(e), grid_blocks);
}
```

```cpp
#include <hip/hip_runtime.h>
#include <hip/hip_cooperative_groups.h>
#include <cstdio>
namespace cg = cooperative_groups;

typedef unsigned short bf16_t;
using bf16x8 = __attribute__((ext_vector_type(8))) short;
using f32x4 = __attribute__((ext_vector_type(4))) float;
using u32x4 = __attribute__((ext_vector_type(4))) unsigned;
using f32x16 = __attribute__((ext_vector_type(16))) float;
using bf16x4 = __attribute__((ext_vector_type(4))) short;
#define DI __device__ __forceinline__

constexpr int SEQ = 8192;
constexpr int PW = 4864;
constexpr int C_BQ = 0, C_BK = 256, C_BV = 384, C_CQ = 512, C_CK = 1280, C_CV = 2048, C_DQ = 2816, C_DK = 3072,
              C_DV = 3200, C_GATE = 3328, C_AQ = 4352, C_AKV = 4608, C_AKR = 4736;
constexpr int C_MERGED = 512;

struct Params {
  const float* x; const float* norm_g; const float* w_in; const float* q_norm_g; const float* kv_norm_g;
  const float* w_q_up; const float* w_kv_up; const float* gq_g; const float* gk_g; const float* sink;
  const float* t5; const float* w_branch; const float* w_out; const float* final_g;
  float* out; char* ws;
};
constexpr size_t al256(size_t x) { return (x + 255) & ~(size_t)255; }
constexpr size_t OFF_W1T = 0;
constexpr size_t OFF_WMT = OFF_W1T + al256((size_t)2 * 4864 * 1024 * 2);
constexpr size_t OFF_WOT = OFF_WMT + al256((size_t)2 * 4096 * 1024 * 2);
constexpr size_t OFF_WBT = OFF_WOT + al256((size_t)2 * 1024 * 1024 * 2);
constexpr size_t OFF_WQT = OFF_WBT + al256((size_t)2 * 4 * 1024 * 256 * 2);
constexpr size_t OFF_WKVT = OFF_WQT + al256((size_t)2 * 384 * 256 * 2);
constexpr size_t OFF_ROPE = OFF_WKVT + al256((size_t)2 * 512 * 128 * 2);
constexpr size_t OFF_LUTC = OFF_ROPE + al256((size_t)8192 * 32 * 4);
constexpr size_t OFF_LUTD = OFF_LUTC + 8192;
constexpr size_t OFF_XN = OFF_LUTD + 8192;
constexpr size_t OFF_PROJ = OFF_XN + al256((size_t)32768 * 1024 * 2);
constexpr size_t OFF_QA = OFF_PROJ + al256((size_t)32768 * 4864 * 2);
constexpr size_t OFF_KA = OFF_QA + al256((size_t)32768 * 384 * 2);
constexpr size_t OFF_VA = OFF_KA + al256((size_t)32768 * 384 * 2);
constexpr size_t OFF_LSE = OFF_VA + al256((size_t)32768 * 256 * 2);
constexpr size_t OFF_BAR = OFF_LSE + al256((size_t)32768 * 12 * 4);
constexpr size_t WS_NEED = OFF_BAR + 16384;
#define WSP(T, OFF) ((T*)(p.ws + (OFF)))
#define P_W1T WSP(bf16_t, OFF_W1T)
#define P_WMT WSP(bf16_t, OFF_WMT)
#define P_WOT WSP(bf16_t, OFF_WOT)
#define P_WBT WSP(bf16_t, OFF_WBT)
#define P_WQT WSP(bf16_t, OFF_WQT)
#define P_WKVT WSP(bf16_t, OFF_WKVT)
#define P_ROPE WSP(float, OFF_ROPE)
#define P_LUTC WSP(float, OFF_LUTC)
#define P_LUTD WSP(float, OFF_LUTD)
#define P_XN WSP(bf16_t, OFF_XN)
#define P_PROJ WSP(bf16_t, OFF_PROJ)
#define P_QA WSP(bf16_t, OFF_QA)
#define P_KA WSP(bf16_t, OFF_KA)
#define P_VA WSP(bf16_t, OFF_VA)
#define P_LSE WSP(float, OFF_LSE)


DI unsigned short f2bf(float x) { unsigned u = __float_as_uint(x); u += 0x7fffu + ((u >> 16) & 1u); return (unsigned short)(u >> 16); }
DI float bf2f(unsigned short b) { return __uint_as_float(((unsigned)b) << 16); }
typedef __bf16 bf2_t __attribute__((ext_vector_type(2)));
typedef float f2_t __attribute__((ext_vector_type(2)));
DI unsigned pack2(float a, float b) { f2_t v = {a, b}; bf2_t r = __builtin_convertvector(v, bf2_t); return __builtin_bit_cast(unsigned, r); }
constexpr float LOG2E = 1.4426950408889634f;
constexpr float QS64 = 0.125f * LOG2E;
constexpr float QS96 = 0.10206207261596575f * LOG2E;
#define BLO(u) __uint_as_float((u) << 16)
#define BHI(u) __uint_as_float((u) & 0xffff0000u)
DI int otid() { int t; asm volatile("v_mov_b32 %0, %1" : "=v"(t) : "v"((int)threadIdx.x)); __builtin_assume(t >= 0 && t < 256); return t; }
DI float wave_sum(float v) {
#pragma unroll
  for (int o = 32; o; o >>= 1) v += __shfl_xor(v, o);
  return v;
}

DI int srccol(int mode, int n) {
  if (mode == 0) return n < 4352 ? n + 416 : (n < 4768 ? n - 4352 : -1);
  if (mode == 1) return 4768 + n;
  if (mode == 2) return n;
  return n < 256 ? (n >> 6) * 96 + (n & 63) : ((n - 256) >> 5) * 96 + 64 + ((n - 256) & 31);
}
DI void conv_tile(const float* __restrict__ src, int ld, int K, bf16_t* __restrict__ dst, int n0, int k0, int mode,
                  const float* __restrict__ rs, float* tile, int dld) {
  const int tid = otid();
  __syncthreads();
  {
    const int kk = tid >> 4, n4 = (tid & 15) * 4;
    const int nq = n0 + n4;
    const int sc = srccol(mode, nq);
    const float cscale = (mode == 0 && ((nq >= C_CQ && nq < C_CQ + 768) || (nq >= C_DQ && nq < C_DQ + 256))) ? QS64 : 1.0f;
#pragma unroll
    for (int i = 0; i < 4; ++i) {
      const int k = kk + 16 * i;
      float4 v = make_float4(0.f, 0.f, 0.f, 0.f);
      if (sc >= 0) v = *(const float4*)(src + (size_t)(k0 + k) * ld + sc);
      const float sc2 = (rs ? rs[k0 + k] : 1.0f) * cscale;
      float* tp = tile + k * 65 + n4;
      tp[0] = v.x * sc2; tp[1] = v.y * sc2; tp[2] = v.z * sc2; tp[3] = v.w * sc2;
    }
  }
  __syncthreads();
  {
    const int nn = tid >> 2, kq = (tid & 3) * 16;
    unsigned w[8];
#pragma unroll
    for (int j = 0; j < 8; ++j) w[j] = pack2(tile[(kq + 2 * j) * 65 + nn], tile[(kq + 2 * j + 1) * 65 + nn]);
    uint4* dp = (uint4*)(dst + (size_t)(n0 + nn) * dld + k0 + kq);
    uint4 w0, w1; w0.x = w[0]; w0.y = w[1]; w0.z = w[2]; w0.w = w[3]; w1.x = w[4]; w1.y = w[5]; w1.z = w[6]; w1.w = w[7];
    dp[0] = w0; dp[1] = w1;
  }
}

DI int t5_bucket(int rel) {
  int n = rel < 0 ? -rel : rel;
  float nf = (float)(n < 1 ? 1 : n);
  int large = 8 + (int)(logf(nf / 8.0f) / 4.852030263919617f * 8.0f);
  if (large > 15) large = 15;
  return (rel > 0 ? 16 : 0) + (n < 8 ? n : large);
}

DI void prep_item(const Params& p, int item, float* tile) {
  if (item < 5584) {
    int l = item / 2792, r = item % 2792;
    const float* src; int ld, K, mode, t; bf16_t* dst; const float* rs = nullptr;
    if (r < 1216) { t = r; src = p.w_in + (size_t)l * 1024 * 8864; ld = 8864; K = 1024; mode = 0; dst = P_W1T + (size_t)l * 4864 * 1024; }
    else if (r < 2240) { t = r - 1216; src = p.w_in + (size_t)l * 1024 * 8864; ld = 8864; K = 1024; mode = 1; dst = P_WMT + (size_t)l * 4096 * 1024; }
    else if (r < 2496) { t = r - 2240; src = p.w_out + (size_t)l * 1024 * 1024; ld = 1024; K = 1024; mode = 2; dst = P_WOT + (size_t)l * 1024 * 1024; }
    else if (r < 2752) { t = r - 2496; int n = t >> 6; t &= 63; src = p.w_branch + (size_t)(l * 4 + n) * 256 * 1024; ld = 1024; K = 256; mode = 2; dst = P_WBT + (size_t)(l * 4 + n) * 1024 * 256; }
    else if (r < 2776) { t = r - 2752; src = p.w_q_up + (size_t)l * 256 * 384; ld = 384; K = 256; mode = 3; dst = P_WQT + (size_t)l * 384 * 256; rs = p.q_norm_g + l * 256; }
    else { t = r - 2776; src = p.w_kv_up + (size_t)l * 128 * 512; ld = 512; K = 128; mode = 2; dst = P_WKVT + (size_t)l * 512 * 128; rs = p.kv_norm_g + l * 128; }
    int kt = K / 64;
    conv_tile(src, ld, K, dst, (t / kt) * 64, (t % kt) * 64, mode, rs, tile, K);
  } else if (item < 5584 + 512) {
    int idx = (item - 5584) * 256 + otid();
    int pos = idx >> 4, i = idx & 15;
    double invd = 1.0;
    for (int k = 0; k < i; ++k) invd *= 0.5623413251903491;
    float inv = (float)invd;
    float ang = (float)pos * inv;
    double a = (double)ang;
    double kq = rint(a * 0.15915494309189535);
    double r = a - kq * 6.283185307179586;
    double r2 = r * r, ts = r, tc = 1.0, sn = r, cs = 1.0;
    for (int k = 1; k <= 14; ++k) {
      tc = -tc * r2 / (double)((2 * k - 1) * (2 * k));
      ts = -ts * r2 / (double)((2 * k) * (2 * k + 1));
      cs += tc; sn += ts;
    }
    P_ROPE[pos * 32 + i] = (float)cs;
    P_ROPE[pos * 32 + 16 + i] = (float)sn;
  } else {
    for (int e = otid(); e < 12 * 129; e += 256) {
      int gh = e / 129, off = e % 129 - 64; int g = gh >> 2;
      int r = g == 0 ? 1 : (g == 1 ? 4 : 16);
      P_LUTC[e] = p.t5[t5_bucket(off * r) * 16 + gh] * LOG2E;
    }
    for (int e = otid(); e < 4 * 257; e += 256) {
      int hq = e / 257, off = e % 257 - 128;
      P_LUTD[e] = p.t5[t5_bucket(off) * 16 + 12 + hq] * LOG2E;
    }
  }
}

DI void norm_rows_bf16(const float* __restrict__ src, const float* __restrict__ g, bf16_t* __restrict__ dst, int item) {
  const int lane = otid() & 63, wid = otid() >> 6;
  for (int i = 0; i < 8; ++i) {
    size_t row = (size_t)item * 32 + wid * 8 + i;
    const float4* s = (const float4*)(src + row * 1024);
    float4 v[4]; float ss = 0.f;
#pragma unroll
    for (int j = 0; j < 4; ++j) { v[j] = s[lane + 64 * j]; ss += v[j].x * v[j].x + v[j].y * v[j].y + v[j].z * v[j].z + v[j].w * v[j].w; }
    ss = wave_sum(ss);
    float sc = rsqrtf(ss * (1.0f / 1024.0f) + 1e-6f);
#pragma unroll
    for (int j = 0; j < 4; ++j) {
      float4 gg = ((const float4*)g)[lane + 64 * j];
      uint2 o; o.x = pack2(v[j].x * sc * gg.x, v[j].y * sc * gg.y); o.y = pack2(v[j].z * sc * gg.z, v[j].w * sc * gg.w);
      *(uint2*)(dst + row * 1024 + (lane + 64 * j) * 4) = o;
    }
  }
}
DI void norm_rows_f32(float* io, const float* __restrict__ g, int item) {
  const int lane = otid() & 63, wid = otid() >> 6;
  for (int i = 0; i < 8; ++i) {
    size_t row = (size_t)item * 32 + wid * 8 + i;
    float4* s = (float4*)(io + row * 1024);
    float4 v[4]; float ss = 0.f;
#pragma unroll
    for (int j = 0; j < 4; ++j) { v[j] = s[lane + 64 * j]; ss += v[j].x * v[j].x + v[j].y * v[j].y + v[j].z * v[j].z + v[j].w * v[j].w; }
    ss = wave_sum(ss);
    float sc = rsqrtf(ss * (1.0f / 1024.0f) + 1e-6f);
#pragma unroll
    for (int j = 0; j < 4; ++j) {
      float4 gg = ((const float4*)g)[lane + 64 * j];
      float4 o; o.x = v[j].x * sc * gg.x; o.y = v[j].y * sc * gg.y; o.z = v[j].z * sc * gg.z; o.w = v[j].w * sc * gg.w;
      s[lane + 64 * j] = o;
    }
  }
}

constexpr int LLD = 72;
constexpr int GST = 128 * 64;
template <int NT, bool LOWREG = false>
DI void gemm_mainloop(f32x4 (&acc)[4][NT], const bf16_t* A, int lda, const bf16_t* Bt, int ldb, int K, bf16_t* sA, bf16_t* sB, int bstride = 32) {
  constexpr int NB = NT;
  const int tid = otid(), lane = tid & 63, wid = tid >> 6;
  const int wm = wid >> 1, wn = wid & 1, fr = lane & 15, fq = lane >> 4;
  u32x4 ra[4], rb[NB];
  const int nk = K >> 6;
  const bf16_t* ap = A + (size_t)(tid >> 3) * lda + (tid & 7) * 8;
  const bf16_t* bp = Bt + (size_t)(tid >> 3) * ldb + (tid & 7) * 8;
  const int so = (tid >> 3) * 64 + (((tid & 7) ^ ((tid >> 4) & 7)) * 8);
  const int fsw = fr >> 1;
#define GLOAD(ko) do { \
    _Pragma("unroll") for (int i = 0; i < 4; ++i) ra[i] = *(const u32x4*)(ap + (size_t)(32 * i) * lda + (ko)); \
    _Pragma("unroll") for (int i = 0; i < NB; ++i) rb[i] = *(const u32x4*)(bp + (size_t)(bstride * i) * ldb + (ko)); } while (0)
#define GSTORE(st) do { \
    _Pragma("unroll") for (int i = 0; i < 4; ++i) *(u32x4*)(sA + (st) * GST + so + 32 * i * 64) = ra[i]; \
    _Pragma("unroll") for (int i = 0; i < NB; ++i) *(u32x4*)(sB + (st) * GST + so + 32 * i * 64) = rb[i]; } while (0)
#define GCOMPUTE(st) do { \
    const bf16_t* cA = sA + (st) * GST; const bf16_t* cB = sB + (st) * GST; \
    _Pragma("unroll") for (int ks = 0; ks < 2; ++ks) { \
      bf16x8 af[4], bfr[NT]; \
      _Pragma("unroll") for (int mi = 0; mi < 4; ++mi) af[mi] = *(const bf16x8*)(cA + (wm * 64 + mi * 16 + fr) * 64 + (((ks * 4 + fq) ^ fsw) * 8)); \
      _Pragma("unroll") for (int ni = 0; ni < NT; ++ni) bfr[ni] = *(const bf16x8*)(cB + (wn * NT * 16 + ni * 16 + fr) * 64 + (((ks * 4 + fq) ^ fsw) * 8)); \
      _Pragma("unroll") for (int mi = 0; mi < 4; ++mi) \
        _Pragma("unroll") for (int ni = 0; ni < NT; ++ni) acc[mi][ni] = __builtin_amdgcn_mfma_f32_16x16x32_bf16(bfr[ni], af[mi], acc[mi][ni], 0, 0, 0); \
    } } while (0)
  __syncthreads();
  GLOAD(0); GSTORE(0);
  if (nk > 1) GLOAD(64);
  __syncthreads();
  for (int kt = 0; kt < nk; ++kt) {
    const int cur = kt & 1;
    if (kt + 1 < nk) { GSTORE(cur ^ 1); if (kt + 2 < nk) GLOAD((kt + 2) * 64); }
    if (LOWREG) {
      const bf16_t* cA = sA + cur * GST; const bf16_t* cB = sB + cur * GST;
#pragma nounroll
      for (int ks = 0; ks < 2; ++ks) {
        bf16x8 af[4], bfr[NT];
#pragma unroll
        for (int mi = 0; mi < 4; ++mi) af[mi] = *(const bf16x8*)(cA + (wm * 64 + mi * 16 + fr) * 64 + (((ks * 4 + fq) ^ fsw) * 8));
#pragma unroll
        for (int ni = 0; ni < NT; ++ni) bfr[ni] = *(const bf16x8*)(cB + (wn * NT * 16 + ni * 16 + fr) * 64 + (((ks * 4 + fq) ^ fsw) * 8));
#pragma unroll
        for (int mi = 0; mi < 4; ++mi)
#pragma unroll
          for (int ni = 0; ni < NT; ++ni) acc[mi][ni] = __builtin_amdgcn_mfma_f32_16x16x32_bf16(bfr[ni], af[mi], acc[mi][ni], 0, 0, 0);
      }
    } else GCOMPUTE(cur);
    __syncthreads();
  }
#undef GLOAD
#undef GSTORE
#undef GCOMPUTE
}
template <int NT>
DI void zero_acc(f32x4 (&acc)[4][NT]) {
#pragma unroll
  for (int mi = 0; mi < 4; ++mi)
#pragma unroll
    for (int ni = 0; ni < NT; ++ni) acc[mi][ni] = f32x4{0.f, 0.f, 0.f, 0.f};
}


constexpr int BGA = 128 * 32, BGB = 256 * 32;
DI void gemm_big(f32x4 (&acc)[4][8], const bf16_t* A, int lda, const bf16_t* Bt, int ldb, int K, char* smem, int s1 = 64, int s2 = 128, int brow = -1) {
  bf16_t* sA = (bf16_t*)smem; bf16_t* sB = sA + 2 * BGA;
  const int tid = otid(), lane = tid & 63, wid = tid >> 6;
  const int wm = wid >> 1, wn = wid & 1, fr = lane & 15, fq = lane >> 4;
  const int nk = K >> 5;
  const bf16_t* ap = A + (size_t)(tid >> 2) * lda + (tid & 3) * 8;
  const bf16_t* bp = Bt + (size_t)(brow >= 0 ? brow : (tid >> 2)) * ldb + (tid & 3) * 8;
  const int so = (tid >> 2) * 32 + (((tid & 3) ^ (((tid >> 5) & 1) << 1)) * 8);
  const int fo = fr * 32 + ((fq ^ (((fr >> 3) & 1) << 1)) * 8);
  u32x4 ra[2], rb[4];
#define BLOADG(kt) do { \
    _Pragma("unroll") for (int i = 0; i < 2; ++i) ra[i] = *(const u32x4*)(ap + (size_t)(64 * i) * lda + (kt) * 32); \
    _Pragma("unroll") for (int i = 0; i < 4; ++i) rb[i] = *(const u32x4*)(bp + (size_t)((i & 1) * s1 + (i >> 1) * s2) * ldb + (kt) * 32); } while (0)
#define BSTOREG(st) do { \
    _Pragma("unroll") for (int i = 0; i < 2; ++i) *(u32x4*)(sA + (st) * BGA + so + 64 * i * 32) = ra[i]; \
    _Pragma("unroll") for (int i = 0; i < 4; ++i) *(u32x4*)(sB + (st) * BGB + so + 64 * i * 32) = rb[i]; } while (0)
  __syncthreads();
  BLOADG(0); BSTOREG(0);
  if (nk > 1) BLOADG(1);
  __syncthreads();
  for (int kt = 0; kt < nk; ++kt) {
    const int cur = kt & 1;
    if (kt + 1 < nk) { BSTOREG(cur ^ 1); if (kt + 2 < nk) BLOADG(kt + 2); }
    const bf16_t* cA = sA + cur * BGA + (wm * 64) * 32 + fo; const bf16_t* cB = sB + cur * BGB + (wn * 128) * 32 + fo;
    bf16x8 af[4];
#pragma unroll
    for (int mi = 0; mi < 4; ++mi) af[mi] = *(const bf16x8*)(cA + mi * 16 * 32);
#pragma unroll
    for (int nh = 0; nh < 2; ++nh) {
      bf16x8 bfr[4];
#pragma unroll
      for (int ni = 0; ni < 4; ++ni) bfr[ni] = *(const bf16x8*)(cB + (nh * 4 + ni) * 16 * 32);
#pragma unroll
      for (int mi = 0; mi < 4; ++mi)
#pragma unroll
        for (int ni = 0; ni < 4; ++ni) acc[mi][nh * 4 + ni] = __builtin_amdgcn_mfma_f32_16x16x32_bf16(bfr[ni], af[mi], acc[mi][nh * 4 + ni], 0, 0, 0);
    }
    __syncthreads();
  }
#undef BLOADG
#undef BSTOREG
}
DI void zero_acc8(f32x4 (&acc)[4][8]) {
#pragma unroll
  for (int mi = 0; mi < 4; ++mi)
#pragma unroll
    for (int ni = 0; ni < 8; ++ni) acc[mi][ni] = f32x4{0.f, 0.f, 0.f, 0.f};
}

DI uint4 widen16(uint2 a, uint2 b) {
  auto rx = __builtin_amdgcn_permlane16_swap(a.x, b.x, false, false);
  auto ry = __builtin_amdgcn_permlane16_swap(a.y, b.y, false, false);
  uint4 w; w.x = rx[0]; w.y = ry[0]; w.z = rx[1]; w.w = ry[1];
  return w;
}
DI void inproj_tile(const Params& p, int l, int tile, char* smem) {
  const int mt = tile & 255, nt = tile >> 8;
  f32x4 acc[4][8]; zero_acc8(acc);
  gemm_big(acc, P_XN + (size_t)mt * 128 * 1024, 1024, P_W1T + ((size_t)l * 4864 + nt * 256) * 1024, 1024, 1024, smem);
  const int lane = otid() & 63, wid = otid() >> 6, wm = wid >> 1, wn = wid & 1, fr = lane & 15, fq = lane >> 4;
#pragma unroll
  for (int mi = 0; mi < 4; ++mi)
#pragma unroll
    for (int np = 0; np < 4; ++np) {
      size_t row = (size_t)mt * 128 + wm * 64 + mi * 16 + fr; int col = nt * 256 + wn * 128 + (2 * np + (fq & 1)) * 16 + (fq >> 1) * 8;
      uint2 a, b;
      a.x = pack2(acc[mi][2 * np][0], acc[mi][2 * np][1]); a.y = pack2(acc[mi][2 * np][2], acc[mi][2 * np][3]);
      b.x = pack2(acc[mi][2 * np + 1][0], acc[mi][2 * np + 1][1]); b.y = pack2(acc[mi][2 * np + 1][2], acc[mi][2 * np + 1][3]);
      *(uint4*)(P_PROJ + row * PW + col) = widen16(a, b);
    }
}

DI void row_scales(const bf16_t* A, int lda, int K, float* sRow) {
  const int row = otid() >> 1, half = otid() & 1;
  const int per = K >> 1;
  const bf16_t* a = A + (size_t)row * lda + half * per;
  float ss = 0.f;
  for (int c = 0; c < per; c += 8) {
    uint4 u = *(const uint4*)(a + c);
    float f;
    f = BLO(u.x); ss += f * f; f = BHI(u.x); ss += f * f; f = BLO(u.y); ss += f * f; f = BHI(u.y); ss += f * f;
    f = BLO(u.z); ss += f * f; f = BHI(u.z); ss += f * f; f = BLO(u.w); ss += f * f; f = BHI(u.w); ss += f * f;
  }
  ss += __shfl_xor(ss, 1);
  if (half == 0) sRow[row] = rsqrtf(ss / (float)K + 1e-6f);
}
DI void mla_item(const Params& p, int l, int item, char* smem) {
  bf16_t* sA = (bf16_t*)smem; bf16_t* sB = sA + 2 * GST; float* sRow = (float*)(sB + 2 * GST);
  const int lane = otid() & 63, wid = otid() >> 6, wm = wid >> 1, wn = wid & 1, fr = lane & 15, fq = lane >> 4;
  if (item < 768) {
    const int mt = item & 255, nt = item >> 8;
    const bf16_t* A = P_PROJ + (size_t)mt * 128 * PW + C_AQ;
    __syncthreads();
    row_scales(A, PW, 256, sRow);
    f32x4 acc[4][4]; zero_acc<4>(acc);
    gemm_mainloop<4>(acc, A, PW, P_WQT + ((size_t)l * 384 + nt * 128) * 256, 256, 256, sA, sB);
    if (nt < 2) {
#pragma unroll
      for (int mi = 0; mi < 4; ++mi)
#pragma unroll
        for (int ni = 0; ni < 4; ++ni) {
          int rl = wm * 64 + mi * 16 + fr; size_t t = (size_t)mt * 128 + rl; float s = sRow[rl] * QS96;
          int c = nt * 128 + wn * 64 + ni * 16 + fq * 4; int h = c >> 6, d = c & 63;
          uint2 o; o.x = pack2(acc[mi][ni][0] * s, acc[mi][ni][1] * s); o.y = pack2(acc[mi][ni][2] * s, acc[mi][ni][3] * s);
          *(uint2*)(P_QA + t * 384 + h * 96 + d) = o;
        }
    } else {
#pragma unroll
      for (int mi = 0; mi < 4; ++mi)
#pragma unroll
        for (int np = 0; np < 2; ++np) {
          int rl = wm * 64 + mi * 16 + fr; size_t t = (size_t)mt * 128 + rl; float s = sRow[rl] * QS96;
          int pos = (int)(t & (SEQ - 1)); int h = wn * 2 + np;
          const float* cs = P_ROPE + pos * 32 + fq * 4;
          float o1[4], o2[4];
#pragma unroll
          for (int j = 0; j < 4; ++j) {
            float x1 = acc[mi][np * 2][j] * s, x2 = acc[mi][np * 2 + 1][j] * s; float c = cs[j], sn = cs[16 + j];
            o1[j] = x1 * c - x2 * sn; o2[j] = x1 * sn + x2 * c;
          }
          uint2 a; a.x = pack2(o1[0], o1[1]); a.y = pack2(o1[2], o1[3]);
          uint2 b; b.x = pack2(o2[0], o2[1]); b.y = pack2(o2[2], o2[3]);
          *(uint2*)(P_QA + t * 384 + h * 96 + 64 + fq * 4) = a;
          *(uint2*)(P_QA + t * 384 + h * 96 + 80 + fq * 4) = b;
        }
    }
  } else if (item < 768 + 1024) {
    const int it = item - 768; const int mt = it & 255, h = it >> 8;
    const bf16_t* A = P_PROJ + (size_t)mt * 128 * PW + C_AKV;
    __syncthreads();
    row_scales(A, PW, 128, sRow);
    f32x4 acc[4][4]; zero_acc<4>(acc);
    gemm_mainloop<4>(acc, A, PW, P_WKVT + ((size_t)l * 512 + h * 128) * 128, 128, 128, sA, sB);
#pragma unroll
    for (int mi = 0; mi < 4; ++mi)
#pragma unroll
      for (int ni = 0; ni < 4; ++ni) {
        int rl = wm * 64 + mi * 16 + fr; size_t t = (size_t)mt * 128 + rl; float s = sRow[rl];
        int d = ni * 16 + fq * 4;
        uint2 o; o.x = pack2(acc[mi][ni][0] * s, acc[mi][ni][1] * s); o.y = pack2(acc[mi][ni][2] * s, acc[mi][ni][3] * s);
        if (wn == 0) *(uint2*)(P_KA + t * 384 + h * 96 + d) = o;
        else *(uint2*)(P_VA + t * 256 + h * 64 + d) = o;
      }
  } else {
    const int it = item - 1792;
    const int half = lane >> 5, pl = lane & 31;
    for (int i = 0; i < 32; ++i) {
      size_t t = (size_t)it * 128 + wid * 32 + i; int pos = (int)(t & (SEQ - 1));
      bf16_t* row = P_PROJ + t * PW;
#pragma unroll
      for (int s3 = 0; s3 < 3; ++s3) {
        int slot = s3 * 2 + half;
        bf16_t* hp = row + (slot < 4 ? C_BQ + slot * 64 : C_BK + (slot - 4) * 64);
        const float* g = (slot < 4 ? p.gq_g : p.gk_g) + l * 64;
        int d1, fi, ap;
        if (pl < 16) { d1 = pl; fi = pl; ap = pos >> 6; } else { d1 = 32 + (pl - 16); fi = pl - 16; ap = pos & 63; }
        float x1 = bf2f(hp[d1]), x2 = bf2f(hp[d1 + 16]);
        float ss = x1 * x1 + x2 * x2;
#pragma unroll
        for (int o = 16; o; o >>= 1) ss += __shfl_xor(ss, o);
        float sc = rsqrtf(ss * (1.0f / 64.0f) + 1e-6f);
        if (slot < 4) sc *= QS64;
        x1 = x1 * sc * g[d1]; x2 = x2 * sc * g[d1 + 16];
        float c = P_ROPE[ap * 32 + fi], sn = P_ROPE[ap * 32 + 16 + fi];
        hp[d1] = f2bf(x1 * c - x2 * sn); hp[d1 + 16] = f2bf(x1 * sn + x2 * c);
      }
      if (lane < 16) {
        float x1 = bf2f(row[C_AKR + lane]), x2 = bf2f(row[C_AKR + 16 + lane]);
        float c = P_ROPE[pos * 32 + lane], sn = P_ROPE[pos * 32 + 16 + lane];
        bf16_t o1 = f2bf(x1 * c - x2 * sn), o2 = f2bf(x1 * sn + x2 * c);
#pragma unroll
        for (int h = 0; h < 4; ++h) { P_KA[t * 384 + h * 96 + 64 + lane] = o1; P_KA[t * 384 + h * 96 + 80 + lane] = o2; }
      }
    }
  }
}

#define MFMA32(a, b, c) __builtin_amdgcn_mfma_f32_32x32x16_bf16((a), (b), (c), 0, 0, 0)
template <int OFF> DI bf16x4 tr_read(unsigned addr) {
  bf16x4 r; asm volatile("ds_read_b64_tr_b16 %0, %1 offset:%2" : "=&v"(r) : "v"(addr), "i"(OFF) : "memory"); return r;
}
DI float half_swap_max(float v) {
  auto rr = __builtin_amdgcn_permlane32_swap(__float_as_uint(v), __float_as_uint(v), false, false);
  return fmaxf(__uint_as_float(rr[0]), __uint_as_float(rr[1]));
}
DI float half_swap_sum(float v) {
  auto rr = __builtin_amdgcn_permlane32_swap(__float_as_uint(v), __float_as_uint(v), false, false);
  return __uint_as_float(rr[0]) + __uint_as_float(rr[1]);
}
DI bf16x8 pack8(const f32x16& p, int base) {
  u32x4 w = {pack2(p[base + 0], p[base + 1]), pack2(p[base + 2], p[base + 3]), pack2(p[base + 4], p[base + 5]), pack2(p[base + 6], p[base + 7])};
  return __builtin_bit_cast(bf16x8, w);
}
template <int DB, int VLD> DI void pv_block(f32x16& o, unsigned vb, bf16x8 pb0, bf16x8 pb1, bf16x8 pb2, bf16x8 pb3) {
  constexpr int RB = VLD * 2;
  bf16x4 l0 = tr_read<0 * RB + 64 * DB>(vb), h0 = tr_read<8 * RB + 64 * DB>(vb);
  bf16x4 l1 = tr_read<16 * RB + 64 * DB>(vb), h1 = tr_read<24 * RB + 64 * DB>(vb);
  bf16x4 l2 = tr_read<32 * RB + 64 * DB>(vb), h2 = tr_read<40 * RB + 64 * DB>(vb);
  bf16x4 l3 = tr_read<48 * RB + 64 * DB>(vb), h3 = tr_read<56 * RB + 64 * DB>(vb);
  asm volatile("s_waitcnt lgkmcnt(0)" ::: "memory"); __builtin_amdgcn_sched_barrier(0);
  o = MFMA32(__builtin_shufflevector(l0, h0, 0, 1, 2, 3, 4, 5, 6, 7), pb0, o);
  o = MFMA32(__builtin_shufflevector(l1, h1, 0, 1, 2, 3, 4, 5, 6, 7), pb1, o);
  o = MFMA32(__builtin_shufflevector(l2, h2, 0, 1, 2, 3, 4, 5, 6, 7), pb2, o);
  o = MFMA32(__builtin_shufflevector(l3, h3, 0, 1, 2, 3, 4, 5, 6, 7), pb3, o);
}
DI f32x16 splat16(float v) { f32x16 r;
#pragma unroll
  for (int i = 0; i < 16; ++i) r[i] = v;
  return r; }

template <int DQK, bool FIXEDM>
DI void attn_dense_mfma(const bf16_t* Qb, int ldq, const bf16_t* Kb, int ldk, const bf16_t* Vb, int ldv, bf16_t* gate_io, char* smem, bool store, float mbound) {
  constexpr int NS = DQK / 16, KLD = DQK + 8, VLD = 96, CPR = DQK / 8, NKC = (64 * CPR) / 256;
  constexpr int KBYTES = 64 * KLD * 2, VBYTES = 64 * VLD * 2;
  char* sKc = smem; char* sVc = smem + 2 * KBYTES;
  const int tid = otid(), lane = tid & 63, wid = tid >> 6, r = lane & 31, h = lane >> 5;
  bf16x8 qf[NS];
#pragma unroll
  for (int s = 0; s < NS; ++s) qf[s] = *(const bf16x8*)(Qb + (size_t)(wid * 32 + r) * ldq + 16 * s + 8 * h);
  const bf16_t* kp = Kb + (size_t)(tid >> 2) * ldk + (tid & 3) * (NKC * 8);
  const int kso = ((tid >> 2) * KLD + (tid & 3) * (NKC * 8)) * 2;
  const bf16_t* vp0 = Vb + (size_t)(tid >> 3) * ldv + (tid & 7) * 8;
  const bf16_t* vp1 = vp0 + (size_t)32 * ldv;
  const int vso = ((tid >> 3) * VLD + (tid & 7) * 8) * 2;
  const size_t kstep = (size_t)64 * ldk, vstep = (size_t)64 * ldv;
  u32x4 rk[NKC], rv[2];
#define KLOAD() do { _Pragma("unroll") for (int i = 0; i < NKC; ++i) rk[i] = *(const u32x4*)(kp + i * 8); kp += kstep; } while (0)
#define VLOAD() do { rv[0] = *(const u32x4*)vp0; rv[1] = *(const u32x4*)vp1; vp0 += vstep; vp1 += vstep; } while (0)
#define KSTORE(st) do { _Pragma("unroll") for (int i = 0; i < NKC; ++i) *(u32x4*)(sKc + (st) * KBYTES + kso + i * 16) = rk[i]; } while (0)
#define VSTORE(st) do { *(u32x4*)(sVc + (st) * VBYTES + vso) = rv[0]; *(u32x4*)(sVc + (st) * VBYTES + vso + 32 * VLD * 2) = rv[1]; } while (0)
#define QKT(P0, P1, st) do { \
    const bf16_t* sK = (const bf16_t*)(sKc + (st) * KBYTES) + r * KLD + 8 * h; \
    P0 = negm; P1 = negm; \
    _Pragma("unroll") for (int s = 0; s < NS; ++s) { \
      bf16x8 k0 = *(const bf16x8*)(sK + 16 * s); bf16x8 k1 = *(const bf16x8*)(sK + 32 * KLD + 16 * s); \
      P0 = MFMA32(k0, qf[s], P0); P1 = MFMA32(k1, qf[s], P1); } } while (0)
  const unsigned vb0 = (unsigned)(size_t)sVc + (unsigned)(((4 * h + ((lane & 15) >> 2)) * VLD + 16 * ((lane >> 4) & 1) + 4 * (lane & 3)) * 2);
  f32x16 o0 = splat16(0.f), o1 = splat16(0.f), negm = splat16(FIXEDM ? -mbound : 0.f);
  f32x16 pa0, pa1, pc0, pc1;
  float m_run = 0.f, l_run = 0.f;
  constexpr int NT = SEQ / 64;
  __syncthreads();
  KLOAD(); VLOAD(); KSTORE(0); VSTORE(0);
  KLOAD(); KSTORE(1);
  __syncthreads();
  QKT(pa0, pa1, 0);
  __syncthreads();
#define STEP(SC0, SC1, SN0, SN1, PAR, FIRST, LK, LV) do { \
    if (LK) KLOAD(); \
    if (LV) VLOAD(); \
    float pm = 0.f; \
    if (!FIXEDM) { pm = fmaxf(SC0[0], SC1[0]); \
    _Pragma("unroll") for (int i = 1; i < 16; i += 1) pm = fmaxf(fmaxf(pm, SC0[i]), SC1[i]); \
    pm = half_swap_max(pm); } \
    if (!FIXEDM && ((FIRST) || __any(pm > 8.0f))) { \
      float delta; \
      if (FIRST) delta = pm; \
      else { delta = fmaxf(pm, 0.f); float alpha = __builtin_amdgcn_exp2f(-delta); l_run *= alpha; \
        _Pragma("unroll") for (int i = 0; i < 16; ++i) { o0[i] *= alpha; o1[i] *= alpha; } } \
      m_run += delta; \
      _Pragma("unroll") for (int i = 0; i < 16; ++i) { SC0[i] -= delta; SC1[i] -= delta; } \
      negm = splat16(-m_run); \
    } \
    if (LV) QKT(SN0, SN1, (PAR) ^ 1); \
    float ls = 0.f; \
    _Pragma("unroll") for (int i = 0; i < 16; ++i) { SC0[i] = __builtin_amdgcn_exp2f(SC0[i]); SC1[i] = __builtin_amdgcn_exp2f(SC1[i]); ls += SC0[i] + SC1[i]; } \
    l_run += ls; \
    bf16x8 pb0 = pack8(SC0, 0), pb1 = pack8(SC0, 8), pb2 = pack8(SC1, 0), pb3 = pack8(SC1, 8); \
    const unsigned vb = vb0 + (PAR) * VBYTES; \
    pv_block<0, VLD>(o0, vb, pb0, pb1, pb2, pb3); \
    pv_block<1, VLD>(o1, vb, pb0, pb1, pb2, pb3); \
    if (LK) KSTORE(PAR); \
    if (LV) VSTORE((PAR) ^ 1); \
    __syncthreads(); } while (0)
  pc0 = negm; pc1 = negm;
  STEP(pa0, pa1, pc0, pc1, 0, true, 1, 1);
  STEP(pc0, pc1, pa0, pa1, 1, false, 1, 1);
  for (int j = 2; j < NT - 2; j += 2) {
    STEP(pa0, pa1, pc0, pc1, 0, false, 1, 1);
    STEP(pc0, pc1, pa0, pa1, 1, false, 1, 1);
  }
  STEP(pa0, pa1, pc0, pc1, 0, false, 0, 1);
  STEP(pc0, pc1, pa0, pa1, 1, false, 0, 0);
#undef STEP
#undef QKT
#undef KLOAD
#undef VLOAD
#undef KSTORE
#undef VSTORE
  if (!store) return;
  const float inv = 1.0f / half_swap_sum(l_run);
  bf16_t* grow = gate_io + (size_t)(wid * 32 + r) * PW;
#pragma unroll
  for (int db = 0; db < 2; ++db)
#pragma unroll
    for (int g4 = 0; g4 < 4; ++g4) {
      bf16_t* gp = grow + 32 * db + 8 * g4 + 4 * h;
      uint2 u = *(const uint2*)gp;
      float g[4] = {BLO(u.x), BHI(u.x), BLO(u.y), BHI(u.y)};
      float y[4];
#pragma unroll
      for (int e = 0; e < 4; ++e) { float ov = db == 0 ? o0[4 * g4 + e] : o1[4 * g4 + e]; y[e] = ov * inv * g[e] / (1.0f + __expf(-g[e])); }
      uint2 w; w.x = pack2(y[0], y[1]); w.y = pack2(y[2], y[3]);
      *(uint2*)gp = w;
    }
}
DI void dense_item(const Params& p, int l, int combo, int qblk, char* smem, bool store) {
  const int br = combo >> 4, bh = combo & 15, b = bh >> 2, h = bh & 3;
  const size_t t0 = (size_t)b * SEQ + qblk * 128;
  bf16_t* gate_io = P_PROJ + t0 * PW + C_GATE + br * 256 + h * 64;
  float bbound = 0.f;
  if (br != 0) {
    const int ln = otid() & 63;
    float gq = fabsf(p.gq_g[l * 64 + ln]), gk = fabsf(p.gk_g[l * 64 + ln]);
#pragma unroll
    for (int o = 32; o; o >>= 1) { gq = fmaxf(gq, __shfl_xor(gq, o)); gk = fmaxf(gk, __shfl_xor(gk, o)); }
    bbound = 64.0f * QS64 * 1.02f * gq * gk + 0.05f;
  }
  if (br == 0)
    attn_dense_mfma<96, false>(P_QA + t0 * 384 + h * 96, 384, P_KA + (size_t)b * SEQ * 384 + h * 96, 384, P_VA + (size_t)b * SEQ * 256 + h * 64, 256, gate_io, smem, store, 0.f);
  else {
    if (bbound <= 60.0f) attn_dense_mfma<64, true>(P_PROJ + t0 * PW + C_BQ + h * 64, PW, P_PROJ + (size_t)b * SEQ * PW + C_BK + (h >> 1) * 64, PW,
                        P_PROJ + (size_t)b * SEQ * PW + C_BV + (h >> 1) * 64, PW, gate_io, smem, store, bbound);
    else attn_dense_mfma<64, false>(P_PROJ + t0 * PW + C_BQ + h * 64, PW, P_PROJ + (size_t)b * SEQ * PW + C_BK + (h >> 1) * 64, PW,
                        P_PROJ + (size_t)b * SEQ * PW + C_BV + (h >> 1) * 64, PW, gate_io, smem, store, bbound);
  }
}

template <int W, bool SINK>
DI void attn_band_mfma(const bf16_t* Qb, size_t ldq, const bf16_t* Kb, const bf16_t* Vb, size_t ldk, int L, int i0,
                       const float* lut_g, float sink2, bf16_t* outp, size_t ldo, float* lse_out, size_t ldl, char* smem) {
  constexpr int NS = 4, KLD = 72, VLD = 96, NTW = (128 + 2 * W) / 64, LUTN = 2 * W + 1;
  constexpr int KBYTES = 64 * KLD * 2, VBYTES = 64 * VLD * 2;
  char* sKc = smem; char* sVc = smem + 2 * KBYTES; float* sLut = (float*)(smem + 2 * KBYTES + 2 * VBYTES);
  const int tid = otid(), lane = tid & 63, wid = tid >> 6, r = lane & 31, h = lane >> 5;
  __syncthreads();
  for (int e = tid; e < LUTN; e += 256) sLut[e] = lut_g[e];
  const int qi = i0 + wid * 32 + r;
  bf16x8 qf[NS];
#pragma unroll
  for (int s = 0; s < NS; ++s) qf[s] = *(const bf16x8*)(Qb + (size_t)qi * ldq + 16 * s + 8 * h);
  const int srow = tid >> 3, scc = tid & 7;
  u32x4 rk[2], rv[2];
#define BLOAD(k0) do { \
    rk[0] = *(const u32x4*)(Kb + (size_t)((k0) + srow) * ldk + scc * 8); rk[1] = *(const u32x4*)(Kb + (size_t)((k0) + srow + 32) * ldk + scc * 8); \
    rv[0] = *(const u32x4*)(Vb + (size_t)((k0) + srow) * ldk + scc * 8); rv[1] = *(const u32x4*)(Vb + (size_t)((k0) + srow + 32) * ldk + scc * 8); } while (0)
#define BSTORE(st) do { \
    *(u32x4*)(sKc + (st) * KBYTES + (srow * KLD + scc * 8) * 2) = rk[0]; *(u32x4*)(sKc + (st) * KBYTES + ((srow + 32) * KLD + scc * 8) * 2) = rk[1]; \
    *(u32x4*)(sVc + (st) * VBYTES + (srow * VLD + scc * 8) * 2) = rv[0]; *(u32x4*)(sVc + (st) * VBYTES + ((srow + 32) * VLD + scc * 8) * 2) = rv[1]; } while (0)
  const unsigned vb0 = (unsigned)(size_t)sVc + (unsigned)(((4 * h + ((lane & 15) >> 2)) * VLD + 16 * ((lane >> 4) & 1) + 4 * (lane & 3)) * 2);
  f32x16 o0 = splat16(0.f), o1 = splat16(0.f);
  float m_run = SINK ? sink2 : 0.f, l_run = (SINK && h == 0) ? 1.f : 0.f;
  bool seen = SINK;
  f32x16 negm = splat16(-m_run);
  const int lo = (i0 == 0) ? W / 64 : 0, hi = (i0 + 128 >= L) ? NTW - W / 64 : NTW;
  BLOAD(i0 - W + 64 * lo); BSTORE(0);
  __syncthreads();
  for (int j = lo; j < hi; ++j) {
    const int cur = (j - lo) & 1, k0 = i0 - W + 64 * j;
    if (j + 1 < hi) BLOAD(k0 + 64);
    const bf16_t* sK = (const bf16_t*)(sKc + cur * KBYTES);
    f32x16 p0 = negm, p1 = negm;
#pragma unroll
    for (int s = 0; s < NS; ++s) {
      bf16x8 k0f = *(const bf16x8*)(sK + r * KLD + 16 * s + 8 * h);
      bf16x8 k1f = *(const bf16x8*)(sK + (32 + r) * KLD + 16 * s + 8 * h);
      p0 = MFMA32(k0f, qf[s], p0);
      p1 = MFMA32(k1f, qf[s], p1);
    }
    const int offb = k0 + 4 * h - qi + W;
    float pm = -1e30f;
#pragma unroll
    for (int i = 0; i < 16; ++i) {
      int idx0 = offb + (i & 3) + 8 * (i >> 2), idx1 = idx0 + 32;
      int c0 = min(max(idx0, 0), 2 * W), c1 = min(max(idx1, 0), 2 * W);
      float b0 = sLut[c0], b1 = sLut[c1];
      p0[i] = ((unsigned)idx0 <= (unsigned)(2 * W)) ? p0[i] + b0 : -1e30f;
      p1[i] = ((unsigned)idx1 <= (unsigned)(2 * W)) ? p1[i] + b1 : -1e30f;
      pm = fmaxf(pm, fmaxf(p0[i], p1[i]));
    }
    pm = half_swap_max(pm);
    const bool has = pm > -1e29f;
    float delta = 0.f;
    if (has) { if (!seen) delta = pm; else if (pm > 8.0f) delta = pm; }
    if (__any(delta != 0.f)) {
      float alpha = seen ? __builtin_amdgcn_exp2f(-delta) : 1.0f;
      l_run *= alpha; m_run += delta;
#pragma unroll
      for (int i = 0; i < 16; ++i) { o0[i] *= alpha; o1[i] *= alpha; p0[i] -= delta; p1[i] -= delta; }
      negm = splat16(-m_run);
    }
    seen = seen || has;
    float ls = 0.f;
#pragma unroll
    for (int i = 0; i < 16; ++i) { p0[i] = __builtin_amdgcn_exp2f(p0[i]); p1[i] = __builtin_amdgcn_exp2f(p1[i]); ls += p0[i] + p1[i]; }
    l_run += ls;
    bf16x8 pb0 = pack8(p0, 0), pb1 = pack8(p0, 8), pb2 = pack8(p1, 0), pb3 = pack8(p1, 8);
    const unsigned vb = vb0 + cur * VBYTES;
    pv_block<0, VLD>(o0, vb, pb0, pb1, pb2, pb3);
    pv_block<1, VLD>(o1, vb, pb0, pb1, pb2, pb3);
    if (j + 1 < hi) BSTORE(cur ^ 1);
    __syncthreads();
  }
#undef BLOAD
#undef BSTORE
  const float ltot = half_swap_sum(l_run);
  const float inv = 1.0f / ltot;
  bf16_t* orow = outp + (size_t)qi * ldo;
  if (!SINK && h == 0) lse_out[(size_t)qi * ldl] = m_run + __log2f(ltot);
#pragma unroll
  for (int db = 0; db < 2; ++db)
#pragma unroll
    for (int kp = 0; kp < 2; ++kp) {
      uint2 w2[2];
#pragma unroll
      for (int gg = 0; gg < 2; ++gg) {
        const int g4 = 2 * kp + gg;
        float y[4];
        if (SINK) {
          uint2 u = *(const uint2*)(orow + 32 * db + 8 * g4 + 4 * h);
          float g[4] = {BLO(u.x), BHI(u.x), BLO(u.y), BHI(u.y)};
#pragma unroll
          for (int e = 0; e < 4; ++e) { float ov = db == 0 ? o0[4 * g4 + e] : o1[4 * g4 + e]; y[e] = ov * inv * g[e] / (1.0f + __expf(-g[e])); }
        } else {
#pragma unroll
          for (int e = 0; e < 4; ++e) { float ov = db == 0 ? o0[4 * g4 + e] : o1[4 * g4 + e]; y[e] = ov * inv; }
        }
        w2[gg].x = pack2(y[0], y[1]); w2[gg].y = pack2(y[2], y[3]);
      }
      auto rx = __builtin_amdgcn_permlane32_swap(w2[0].x, w2[1].x, false, false);
      auto ry = __builtin_amdgcn_permlane32_swap(w2[0].y, w2[1].y, false, false);
      uint4 w; w.x = rx[0]; w.y = ry[0]; w.z = rx[1]; w.w = ry[1];
      *(uint4*)(orow + 32 * db + 16 * kp + 8 * h) = w;
    }
}
DI void band_item(const Params& p, int l, int idx, char* smem) {
  if (idx < 3072) {
    const int g = idx >> 10, rem = idx & 1023, h = rem & 3, rem2 = rem >> 2, b = 3 - (rem2 >> 6), u = rem2 & 63;
    const int sh = 2 * g, rr = 1 << sh;
    const int rho = u & (rr - 1), qblk = u >> sh;
    const size_t tok0 = (size_t)b * SEQ + rho;
    bf16_t* base = P_PROJ + tok0 * PW + g * 256 + h * 64;
    attn_band_mfma<64, false>(base + C_CQ, (size_t)rr * PW, base + C_CK, base + C_CV, (size_t)rr * PW, SEQ >> sh, qblk * 128,
                              P_LUTC + (g * 4 + h) * 129, 0.f, base + C_CQ, (size_t)rr * PW, P_LSE + tok0 * 12 + g * 4 + h, (size_t)rr * 12, smem);
  } else {
    const int it = idx - 3072, hq = it & 3, rem = it >> 2, b = 3 - (rem >> 6), qblk = rem & 63;
    bf16_t* base = P_PROJ + (size_t)b * SEQ * PW;
    attn_band_mfma<128, true>(base + C_DQ + hq * 64, PW, base + C_DK + (hq >> 1) * 64, base + C_DV + (hq >> 1) * 64, PW, SEQ, qblk * 128,
                              P_LUTD + hq * 257, p.sink[l * 4 + hq] * LOG2E, base + C_GATE + 768 + hq * 64, PW, nullptr, 0, smem);
  }
}
DI void combine_c(const Params& p) {
  for (size_t u = (size_t)blockIdx.x * 256 + otid(); u < (size_t)32768 * 32; u += (size_t)gridDim.x * 256) {
    const size_t t = u >> 5; const int h = (int)(u >> 3) & 3, ch = (int)u & 7;
    const float* ls = P_LSE + t * 12 + h;
    float l0 = ls[0], l1 = ls[4], l2 = ls[8];
    float mx = fmaxf(l0, fmaxf(l1, l2));
    float a0 = __builtin_amdgcn_exp2f(l0 - mx), a1 = __builtin_amdgcn_exp2f(l1 - mx), a2 = __builtin_amdgcn_exp2f(l2 - mx);
    float inv = 1.0f / (a0 + a1 + a2); a0 *= inv; a1 *= inv; a2 *= inv;
    const bf16_t* row = P_PROJ + t * PW;
    uint4 x0 = *(const uint4*)(row + C_CQ + h * 64 + ch * 8), x1 = *(const uint4*)(row + C_CQ + 256 + h * 64 + ch * 8),
          x2 = *(const uint4*)(row + C_CQ + 512 + h * 64 + ch * 8);
    bf16_t* gp = P_PROJ + t * PW + C_GATE + 512 + h * 64 + ch * 8;
    uint4 gu = *(const uint4*)gp;
    unsigned xa[4] = {x0.x, x0.y, x0.z, x0.w}, xb[4] = {x1.x, x1.y, x1.z, x1.w}, xc[4] = {x2.x, x2.y, x2.z, x2.w}, gg[4] = {gu.x, gu.y, gu.z, gu.w};
    unsigned ov[4];
#pragma unroll
    for (int e = 0; e < 4; ++e) {
      float ylo = a0 * BLO(xa[e]) + a1 * BLO(xb[e]) + a2 * BLO(xc[e]);
      float yhi = a0 * BHI(xa[e]) + a1 * BHI(xb[e]) + a2 * BHI(xc[e]);
      float glo = BLO(gg[e]), ghi = BHI(gg[e]);
      ov[e] = pack2(ylo * glo / (1.0f + __expf(-glo)), yhi * ghi / (1.0f + __expf(-ghi)));
    }
    uint4 w; w.x = ov[0]; w.y = ov[1]; w.z = ov[2]; w.w = ov[3];
    *(uint4*)gp = w;
  }
}

DI void merge_tile(const Params& p, int l, int tile, char* smem) {
  bf16_t* sA = (bf16_t*)smem; bf16_t* sB = sA + 2 * GST;
  const int mt = tile & 255, nt = tile >> 8;
  unsigned sg[4][8][2];
  {
    f32x4 accG[4][8]; zero_acc8(accG);
    gemm_big(accG, P_XN + (size_t)mt * 128 * 1024, 1024, P_WMT + ((size_t)l * 4096 + nt * 64) * 1024, 1024, 1024, smem, 2048, 32,
             (otid() >> 7) * 1024 + ((otid() >> 2) & 31));
#pragma unroll
    for (int mi = 0; mi < 4; ++mi)
#pragma unroll
      for (int ni = 0; ni < 8; ++ni) {
        float s0 = 1.0f / (1.0f + __expf(-accG[mi][ni][0])), s1 = 1.0f / (1.0f + __expf(-accG[mi][ni][1]));
        float s2 = 1.0f / (1.0f + __expf(-accG[mi][ni][2])), s3 = 1.0f / (1.0f + __expf(-accG[mi][ni][3]));
        sg[mi][ni][0] = pack2(s0, s1); sg[mi][ni][1] = pack2(s2, s3);
      }
  }
  f32x4 accM[4][2]; zero_acc<2>(accM);
#pragma unroll 1
  for (int n = 0; n < 4; ++n) {
    f32x4 accB[4][2]; zero_acc<2>(accB);
    gemm_mainloop<2>(accB, P_PROJ + (size_t)mt * 128 * PW + C_GATE + n * 256, PW, P_WBT + ((size_t)(l * 4 + n) * 1024 + nt * 64) * 256, 256, 256, sA, sB);
#pragma unroll
    for (int mi = 0; mi < 4; ++mi)
#pragma unroll
      for (int ni = 0; ni < 2; ++ni) {
        accM[mi][ni][0] += accB[mi][ni][0] * BLO(sg[mi][ni][0]); accM[mi][ni][1] += accB[mi][ni][1] * BHI(sg[mi][ni][0]);
        accM[mi][ni][2] += accB[mi][ni][2] * BLO(sg[mi][ni][1]); accM[mi][ni][3] += accB[mi][ni][3] * BHI(sg[mi][ni][1]);
      }
#pragma unroll
    for (int mi = 0; mi < 4; ++mi)
#pragma unroll
      for (int k = 0; k < 6; ++k) { sg[mi][k][0] = sg[mi][k + 2][0]; sg[mi][k][1] = sg[mi][k + 2][1]; }
  }
  const int lane = otid() & 63, wid = otid() >> 6, wm = wid >> 1, wn = wid & 1, fr = lane & 15, fq = lane >> 4;
#pragma unroll
  for (int mi = 0; mi < 4; ++mi)
    {
      size_t row = (size_t)mt * 128 + wm * 64 + mi * 16 + fr; int col = nt * 64 + wn * 32 + (fq & 1) * 16 + (fq >> 1) * 8;
      uint2 a, b;
      a.x = pack2(accM[mi][0][0], accM[mi][0][1]); a.y = pack2(accM[mi][0][2], accM[mi][0][3]);
      b.x = pack2(accM[mi][1][0], accM[mi][1][1]); b.y = pack2(accM[mi][1][2], accM[mi][1][3]);
      *(uint4*)(P_PROJ + row * PW + C_MERGED + col) = widen16(a, b);
    }
}

DI void outproj_tile(const Params& p, int l, int tile, char* smem) {
  const int mt = tile & 255, nt = tile >> 8;
  f32x4 acc[4][8]; zero_acc8(acc);
  gemm_big(acc, P_PROJ + (size_t)mt * 128 * PW + C_MERGED, PW, P_WOT + ((size_t)l * 1024 + nt * 256) * 1024, 1024, 1024, smem);
  const float* xin = l == 0 ? p.x : p.out;
  const int lane = otid() & 63, wid = otid() >> 6, wm = wid >> 1, wn = wid & 1, fr = lane & 15, fq = lane >> 4;
#pragma unroll
  for (int mi = 0; mi < 4; ++mi)
#pragma unroll
    for (int ni = 0; ni < 8; ++ni) {
      size_t row = (size_t)mt * 128 + wm * 64 + mi * 16 + fr; int col = nt * 256 + wn * 128 + ni * 16 + fq * 4;
      float4 xi = *(const float4*)(xin + row * 1024 + col);
      float4 o; o.x = xi.x + acc[mi][ni][0]; o.y = xi.y + acc[mi][ni][1]; o.z = xi.z + acc[mi][ni][2]; o.w = xi.w + acc[mi][ni][3];
      *(float4*)(p.out + row * 1024 + col) = o;
    }
}


#define XB_TMO      128
#define XB_XCNT(j)  (256  + 64 * (j))
#define XB_XSUB(j)  (1280 + 64 * (j))
#define XB_XGEN(j)  (2304 + 64 * (j))
#define XB_TOP      3328
#define XB_TOPGEN   3392
#define XCD_BAR_WORDS 3456
#define XB_SPIN_CAP (1u << 22)
#define LAS __attribute__((address_space(3)))
DI unsigned xb_ld(unsigned* p)              { return __hip_atomic_load(p, __ATOMIC_RELAXED, __HIP_MEMORY_SCOPE_AGENT); }
DI unsigned xb_add(unsigned* p, unsigned v) { return __hip_atomic_fetch_add(p, v, __ATOMIC_RELAXED, __HIP_MEMORY_SCOPE_AGENT); }
DI unsigned xb_xcc_id() { return (unsigned)__builtin_amdgcn_s_getreg((3 << 11) | 20) & 0xFu; }
#define XB_SPIN(cond, bar) do { unsigned _sp = 0; while (cond) { __builtin_amdgcn_s_sleep(1); \
    if ((++_sp & 255u) == 0u) { if (xb_ld(&(bar)[XB_TMO])) break; if (_sp > XB_SPIN_CAP) { atomicAdd(&(bar)[XB_TMO], 1u); break; } } } } while (0)
struct XcdBarrier { unsigned* bar; unsigned x; volatile LAS unsigned* st; };
DI XcdBarrier xcd_barrier_post(unsigned* bar, volatile LAS unsigned* st) {
  XcdBarrier b; b.bar = bar; b.x = xb_xcc_id(); b.st = st;
  if (threadIdx.x == 0) (void)xb_add(&bar[XB_XCNT(b.x)], 1u);
  return b;
}
DI void xcd_barrier_complete(unsigned* bar, unsigned x, unsigned& nloc, unsigned& nx) {
  const unsigned G = gridDim.x * gridDim.y * gridDim.z;
  unsigned sum, cnt, mine, sp = 0u;
  for (;;) {
    sum = 0u; cnt = 0u; mine = 0u;
#pragma unroll
    for (unsigned j = 0; j < 16; ++j) { const unsigned c = xb_ld(&bar[XB_XCNT(j)]); sum += c; cnt += (c > 0u) ? 1u : 0u; mine = (j == x) ? c : mine; }
    if (sum == G) break;
    __builtin_amdgcn_s_sleep(1);
    if ((++sp & 255u) == 0u) { if (xb_ld(&bar[XB_TMO])) break; if (sp > XB_SPIN_CAP) { atomicAdd(&bar[XB_TMO], 1u); break; } }
  }
  nloc = mine > 0u ? mine : 1u; nx = cnt > 0u ? cnt : 1u;
}
DI void xcd_barrier(const XcdBarrier& b) {
  asm volatile("s_waitcnt vmcnt(0)" ::: "memory");
  __syncthreads();
  if (threadIdx.x == 0) {
    unsigned* bar = b.bar;
    __builtin_amdgcn_s_waitcnt(0);
    unsigned nloc = b.st[0], nx = b.st[1];
    if (nloc == 0u) { xcd_barrier_complete(bar, b.x, nloc, nx); b.st[0] = nloc; b.st[1] = nx; }
    const unsigned old = xb_add(&bar[XB_XSUB(b.x)], 1u);
    const unsigned gen = old / nloc;
    if (old + 1u == (gen + 1u) * nloc) {
      __builtin_amdgcn_fence(__ATOMIC_RELEASE, "agent");
      asm volatile("s_waitcnt vmcnt(0)" ::: "memory");
      const unsigned og = xb_add(&bar[XB_TOP], 1u);
      const unsigned tg = og / nx;
      if (og + 1u == (tg + 1u) * nx) xb_add(&bar[XB_TOPGEN], 1u);
      else XB_SPIN(xb_ld(&bar[XB_TOPGEN]) == tg, bar);
      __builtin_amdgcn_fence(__ATOMIC_ACQUIRE, "agent");
      xb_add(&bar[XB_XGEN(b.x)], 1u);
      asm volatile("s_waitcnt vmcnt(0)" ::: "memory");
    } else {
      XB_SPIN(xb_ld(&bar[XB_XGEN(b.x)]) == gen, bar);
      __builtin_amdgcn_fence(__ATOMIC_ACQUIRE, "agent");
      asm volatile("s_waitcnt vmcnt(0)" ::: "memory");
    }
  }
  __syncthreads();
}

DI void run_phase(const Params& p, int ph, char* smem, bool never) {
  const int G = gridDim.x, B = blockIdx.x;
  if (ph == 0) {
    for (int i = B; i < 6097; i += G) prep_item(p, i, (float*)smem);
    for (int i = B; i < 1024; i += G) norm_rows_bf16(p.x, p.norm_g, P_XN, i);
  } else if (ph == 14) {
    for (int i = B; i < 1024; i += G) norm_rows_f32(p.out, p.final_g, i);
  } else if (ph == 7) {
    for (int i = B; i < 1024; i += G) norm_rows_bf16(p.out, p.norm_g + 1024, P_XN, i);
  } else {
    const int l = ph > 7 ? 1 : 0; const int s = ph > 7 ? ph - 8 : ph - 1;
    const int xcd = B & 7, lb = B >> 3, nl = G >> 3;
    if (s == 0) {
      for (int w = lb; w < 64 * 8 + 96; w += nl) {
        const int it = w >> 6, l64 = w & 63;
        int mt, nt;
        if (it < 8) { const int a = it >> 1, gn = it & 1; mt = 8 * (xcd + 8 * a) + (l64 & 7); nt = 8 * gn + (l64 >> 3); }
        else { const int q = (it - 8) * 64 + l64; const int ml = q / 3; mt = 8 * (xcd + 8 * (ml >> 3)) + (ml & 7); nt = 16 + q % 3; }
        inproj_tile(p, l, nt * 256 + mt, smem);
      }
    }
    else if (s == 1) { for (int i = B; i < 2048; i += G) mla_item(p, l, i, smem); }
    else if (s == 2) {
#ifdef REP_DENSE
      for (int w = lb; w < 256; w += nl) dense_item(p, l, xcd + 8 * (w >> 6), w & 63, smem, never);
#endif
      for (int i = B; i < 4096; i += G) band_item(p, l, i, smem);
      for (int w = lb; w < 256; w += nl) { const int k = w >> 6, ck = ((k & 1) << 1 | (k >> 1)) ^ 1; dense_item(p, l, xcd + 8 * ck, w & 63, smem, true); }
    }
    else if (s == 3) { combine_c(p); }
    else if (s == 4) {
      for (int w = lb; w < 64 * 8; w += nl) {
        const int it = w >> 6, l64 = w & 63, a = it >> 1, gn = it & 1;
        const int mt = 8 * (xcd + 8 * a) + (l64 & 7), nt = 8 * gn + (l64 >> 3);
        merge_tile(p, l, nt * 256 + mt, smem);
      }
    }
    else {
      for (int w = lb; w < 64 * 2; w += nl) {
        const int a = w >> 6, l64 = w & 63;
        const int mt = 8 * (xcd + 8 * (2 * a + (l64 >> 5))) + (l64 & 7), nt = (l64 >> 3) & 3;
        outproj_tile(p, l, nt * 256 + mt, smem);
      }
    }
  }
}

__global__ void __launch_bounds__(256, 2) mega(Params p, int ph_lo, int ph_hi) {
  __shared__ __attribute__((aligned(16))) char smem[66048];
  __shared__ uint4 xb_words;
  cg::grid_group grid = cg::this_grid();
  if (threadIdx.x == 0) xb_words = make_uint4(0u, 0u, 0u, 0u);
  __syncthreads();
  XcdBarrier xb = xcd_barrier_post((unsigned*)(p.ws + OFF_BAR), (volatile LAS unsigned*)&xb_words);
  if (ph_hi == 12345) grid.sync();
  for (int ph = ph_lo; ph < ph_hi; ++ph) {
    run_phase(p, ph, smem, ph_hi == 12345);
    if (ph + 1 < ph_hi) xcd_barrier(xb);
  }
}

extern "C" void kernel_launch(void* const* d_in, const int* in_sizes, int n_in, void* d_out, int out_size, void* d_ws,
                              size_t ws_size, hipStream_t stream) {
  Params p{};
  p.x = (const float*)d_in[0]; p.norm_g = (const float*)d_in[1]; p.w_in = (const float*)d_in[2];
  p.q_norm_g = (const float*)d_in[3]; p.kv_norm_g = (const float*)d_in[4]; p.w_q_up = (const float*)d_in[5];
  p.w_kv_up = (const float*)d_in[6]; p.gq_g = (const float*)d_in[7]; p.gk_g = (const float*)d_in[8];
  p.sink = (const float*)d_in[9]; p.t5 = (const float*)d_in[10]; p.w_branch = (const float*)d_in[11];
  p.w_out = (const float*)d_in[12]; p.final_g = (const float*)d_in[13];
  p.out = (float*)d_out;
  p.ws = (char*)d_ws;
  if (WS_NEED > ws_size) { fprintf(stderr, "workspace too small: need %zu have %zu\n", (size_t)WS_NEED, ws_size); return; }

  static int grid_blocks = 0;
  if (!grid_blocks) {
    int dev = 0, cus = 0, per_cu = 0;
    hipGetDevice(&dev);
    hipDeviceGetAttribute(&cus, hipDeviceAttributeMultiprocessorCount, dev);
    hipOccupancyMaxActiveBlocksPerMultiprocessor(&per_cu, mega, 256, 0);
    if (per_cu < 1) per_cu = 1;
    if (per_cu > 2) per_cu = 2;
    grid_blocks = cus * per_cu;
  }
  hipMemsetAsync((char*)d_ws + OFF_BAR, 0, 16384, stream);
  int lo = 0, hi = 15;
  void* args[] = {&p, &lo, &hi};
  hipError_t e = hipLaunchCooperativeKernel((void*)mega, dim3(grid_blocks), dim3(256), args, 0, stream);
  if (e != hipSuccess) fprintf(stderr, "cooperative launch failed: %s (grid %d)\n", hipGetErrorString(e), grid_blocks);
}
```

```cpp
#include <hip/hip_runtime.h>
#include <hip/hip_cooperative_groups.h>
#include <cstdio>
namespace cg = cooperative_groups;

typedef unsigned short bf16_t;
using bf16x8 = __attribute__((ext_vector_type(8))) short;
using f32x4 = __attribute__((ext_vector_type(4))) float;
using u32x4 = __attribute__((ext_vector_type(4))) unsigned;
using f32x16 = __attribute__((ext_vector_type(16))) float;
using bf16x4 = __attribute__((ext_vector_type(4))) short;
#define DI __device__ __forceinline__

constexpr int SEQ = 8192;
constexpr int PW = 4864;
constexpr int C_BQ = 0, C_BK = 256, C_BV = 384, C_CQ = 512, C_CK = 1280, C_CV = 2048, C_DQ = 2816, C_DK = 3072,
              C_DV = 3200, C_GATE = 3328, C_AQ = 4352, C_AKV = 4608, C_AKR = 4736;
constexpr int C_MERGED = 512;

struct Params {
  const float* x; const float* norm_g; const float* w_in; const float* q_norm_g; const float* kv_norm_g;
  const float* w_q_up; const float* w_kv_up; const float* gq_g; const float* gk_g; const float* sink;
  const float* t5; const float* w_branch; const float* w_out; const float* final_g;
  float* out; char* ws;
};
constexpr size_t al256(size_t x) { return (x + 255) & ~(size_t)255; }
constexpr size_t OFF_W1T = 0;
constexpr size_t OFF_WMT = OFF_W1T + al256((size_t)2 * 4864 * 1024 * 2);
constexpr size_t OFF_WOT = OFF_WMT + al256((size_t)2 * 4096 * 1024 * 2);
constexpr size_t OFF_WBT = OFF_WOT + al256((size_t)2 * 1024 * 1024 * 2);
constexpr size_t OFF_WQT = OFF_WBT + al256((size_t)2 * 4 * 1024 * 256 * 2);
constexpr size_t OFF_WKVT = OFF_WQT + al256((size_t)2 * 384 * 256 * 2);
constexpr size_t OFF_ROPE = OFF_WKVT + al256((size_t)2 * 512 * 128 * 2);
constexpr size_t OFF_LUTC = OFF_ROPE + al256((size_t)8192 * 32 * 4);
constexpr size_t OFF_LUTD = OFF_LUTC + 8192;
constexpr size_t OFF_XN = OFF_LUTD + 8192;
constexpr size_t OFF_PROJ = OFF_XN + al256((size_t)32768 * 1024 * 2);
constexpr size_t OFF_QA = OFF_PROJ + al256((size_t)32768 * 4864 * 2);
constexpr size_t OFF_KA = OFF_QA + al256((size_t)32768 * 384 * 2);
constexpr size_t OFF_VA = OFF_KA + al256((size_t)32768 * 384 * 2);
constexpr size_t OFF_LSE = OFF_VA + al256((size_t)32768 * 256 * 2);
constexpr size_t OFF_BAR = OFF_LSE + al256((size_t)32768 * 12 * 4);
constexpr size_t WS_NEED = OFF_BAR + 16384;
#define WSP(T, OFF) ((T*)(p.ws + (OFF)))
#define P_W1T WSP(bf16_t, OFF_W1T)
#define P_WMT WSP(bf16_t, OFF_WMT)
#define P_WOT WSP(bf16_t, OFF_WOT)
#define P_WBT WSP(bf16_t, OFF_WBT)
#define P_WQT WSP(bf16_t, OFF_WQT)
#define P_WKVT WSP(bf16_t, OFF_WKVT)
#define P_ROPE WSP(float, OFF_ROPE)
#define P_LUTC WSP(float, OFF_LUTC)
#define P_LUTD WSP(float, OFF_LUTD)
#define P_XN WSP(bf16_t, OFF_XN)
#define P_PROJ WSP(bf16_t, OFF_PROJ)
#define P_QA WSP(bf16_t, OFF_QA)
#define P_KA WSP(bf16_t, OFF_KA)
#define P_VA WSP(bf16_t, OFF_VA)
#define P_LSE WSP(float, OFF_LSE)


DI unsigned short f2bf(float x) { unsigned u = __float_as_uint(x); u += 0x7fffu + ((u >> 16) & 1u); return (unsigned short)(u >> 16); }
DI float bf2f(unsigned short b) { return __uint_as_float(((unsigned)b) << 16); }
typedef __bf16 bf2_t __attribute__((ext_vector_type(2)));
typedef float f2_t __attribute__((ext_vector_type(2)));
DI unsigned pack2(float a, float b) { f2_t v = {a, b}; bf2_t r = __builtin_convertvector(v, bf2_t); return __builtin_bit_cast(unsigned, r); }
constexpr float LOG2E = 1.4426950408889634f;
constexpr float QS64 = 0.125f * LOG2E;
constexpr float QS96 = 0.10206207261596575f * LOG2E;
#define BLO(u) __uint_as_float((u) << 16)
#define BHI(u) __uint_as_float((u) & 0xffff0000u)
DI int otid() { int t; asm volatile("v_mov_b32 %0, %1" : "=v"(t) : "v"((int)threadIdx.x)); __builtin_assume(t >= 0 && t < 256); return t; }
DI float wave_sum(float v) {
#pragma unroll
  for (int o = 32; o; o >>= 1) v += __shfl_xor(v, o);
  return v;
}

DI int srccol(int mode, int n) {
  if (mode == 0) return n < 4352 ? n + 416 : (n < 4768 ? n - 4352 : -1);
  if (mode == 1) return 4768 + n;
  if (mode == 2) return n;
  return n < 256 ? (n >> 6) * 96 + (n & 63) : ((n - 256) >> 5) * 96 + 64 + ((n - 256) & 31);
}
DI void conv_tile(const float* __restrict__ src, int ld, int K, bf16_t* __restrict__ dst, int n0, int k0, int mode,
                  const float* __restrict__ rs, float* tile, int dld) {
  const int tid = otid();
  __syncthreads();
  {
    const int kk = tid >> 4, n4 = (tid & 15) * 4;
    const int nq = n0 + n4;
    const int sc = srccol(mode, nq);
    const float cscale = (mode == 0 && ((nq >= C_CQ && nq < C_CQ + 768) || (nq >= C_DQ && nq < C_DQ + 256))) ? QS64 : 1.0f;
#pragma unroll
    for (int i = 0; i < 4; ++i) {
      const int k = kk + 16 * i;
      float4 v = make_float4(0.f, 0.f, 0.f, 0.f);
      if (sc >= 0) v = *(const float4*)(src + (size_t)(k0 + k) * ld + sc);
      const float sc2 = (rs ? rs[k0 + k] : 1.0f) * cscale;
      float* tp = tile + k * 65 + n4;
      tp[0] = v.x * sc2; tp[1] = v.y * sc2; tp[2] = v.z * sc2; tp[3] = v.w * sc2;
    }
  }
  __syncthreads();
  {
    const int nn = tid >> 2, kq = (tid & 3) * 16;
    unsigned w[8];
#pragma unroll
    for (int j = 0; j < 8; ++j) w[j] = pack2(tile[(kq + 2 * j) * 65 + nn], tile[(kq + 2 * j + 1) * 65 + nn]);
    uint4* dp = (uint4*)(dst + (size_t)(n0 + nn) * dld + k0 + kq);
    uint4 w0, w1; w0.x = w[0]; w0.y = w[1]; w0.z = w[2]; w0.w = w[3]; w1.x = w[4]; w1.y = w[5]; w1.z = w[6]; w1.w = w[7];
    dp[0] = w0; dp[1] = w1;
  }
}

DI int t5_bucket(int rel) {
  int n = rel < 0 ? -rel : rel;
  float nf = (float)(n < 1 ? 1 : n);
  int large = 8 + (int)(logf(nf / 8.0f) / 4.852030263919617f * 8.0f);
  if (large > 15) large = 15;
  return (rel > 0 ? 16 : 0) + (n < 8 ? n : large);
}

DI void prep_item(const Params& p, int item, float* tile) {
  if (item < 5584) {
    int l = item / 2792, r = item % 2792;
    const float* src; int ld, K, mode, t; bf16_t* dst; const float* rs = nullptr;
    if (r < 1216) { t = r; src = p.w_in + (size_t)l * 1024 * 8864; ld = 8864; K = 1024; mode = 0; dst = P_W1T + (size_t)l * 4864 * 1024; }
    else if (r < 2240) { t = r - 1216; src = p.w_in + (size_t)l * 1024 * 8864; ld = 8864; K = 1024; mode = 1; dst = P_WMT + (size_t)l * 4096 * 1024; }
    else if (r < 2496) { t = r - 2240; src = p.w_out + (size_t)l * 1024 * 1024; ld = 1024; K = 1024; mode = 2; dst = P_WOT + (size_t)l * 1024 * 1024; }
    else if (r < 2752) { t = r - 2496; int n = t >> 6; t &= 63; src = p.w_branch + (size_t)(l * 4 + n) * 256 * 1024; ld = 1024; K = 256; mode = 2; dst = P_WBT + (size_t)(l * 4 + n) * 1024 * 256; }
    else if (r < 2776) { t = r - 2752; src = p.w_q_up + (size_t)l * 256 * 384; ld = 384; K = 256; mode = 3; dst = P_WQT + (size_t)l * 384 * 256; rs = p.q_norm_g + l * 256; }
    else { t = r - 2776; src = p.w_kv_up + (size_t)l * 128 * 512; ld = 512; K = 128; mode = 2; dst = P_WKVT + (size_t)l * 512 * 128; rs = p.kv_norm_g + l * 128; }
    int kt = K / 64;
    conv_tile(src, ld, K, dst, (t / kt) * 64, (t % kt) * 64, mode, rs, tile, K);
  } else if (item < 5584 + 512) {
    int idx = (item - 5584) * 256 + otid();
    int pos = idx >> 4, i = idx & 15;
    double invd = 1.0;
    for (int k = 0; k < i; ++k) invd *= 0.5623413251903491;
    float inv = (float)invd;
    float ang = (float)pos * inv;
    double a = (double)ang;
    double kq = rint(a * 0.15915494309189535);
    double r = a - kq * 6.283185307179586;
    double r2 = r * r, ts = r, tc = 1.0, sn = r, cs = 1.0;
    for (int k = 1; k <= 14; ++k) {
      tc = -tc * r2 / (double)((2 * k - 1) * (2 * k));
      ts = -ts * r2 / (double)((2 * k) * (2 * k + 1));
      cs += tc; sn += ts;
    }
    P_ROPE[pos * 32 + i] = (float)cs;
    P_ROPE[pos * 32 + 16 + i] = (float)sn;
  } else {
    for (int e = otid(); e < 12 * 129; e += 256) {
      int gh = e / 129, off = e % 129 - 64; int g = gh >> 2;
      int r = g == 0 ? 1 : (g == 1 ? 4 : 16);
      P_LUTC[e] = p.t5[t5_bucket(off * r) * 16 + gh] * LOG2E;
    }
    for (int e = otid(); e < 4 * 257; e += 256) {
      int hq = e / 257, off = e % 257 - 128;
      P_LUTD[e] = p.t5[t5_bucket(off) * 16 + 12 + hq] * LOG2E;
    }
  }
}

DI void norm_rows_bf16(const float* __restrict__ src, const float* __restrict__ g, bf16_t* __restrict__ dst, int item) {
  const int lane = otid() & 63, wid = otid() >> 6;
  for (int i = 0; i < 8; ++i) {
    size_t row = (size_t)item * 32 + wid * 8 + i;
    const float4* s = (const float4*)(src + row * 1024);
    float4 v[4]; float ss = 0.f;
#pragma unroll
    for (int j = 0; j < 4; ++j) { v[j] = s[2 * lane + (j & 1) + 128 * (j >> 1)]; ss += v[j].x * v[j].x + v[j].y * v[j].y + v[j].z * v[j].z + v[j].w * v[j].w; }
    ss = wave_sum(ss);
    float sc = rsqrtf(ss * (1.0f / 1024.0f) + 1e-6f);
#pragma unroll
    for (int jj = 0; jj < 2; ++jj) {
      float4 g0 = ((const float4*)g)[2 * lane + 128 * jj], g1 = ((const float4*)g)[2 * lane + 1 + 128 * jj];
      const float4 a = v[2 * jj], c = v[2 * jj + 1];
      uint4 o; o.x = pack2(a.x * sc * g0.x, a.y * sc * g0.y); o.y = pack2(a.z * sc * g0.z, a.w * sc * g0.w);
      o.z = pack2(c.x * sc * g1.x, c.y * sc * g1.y); o.w = pack2(c.z * sc * g1.z, c.w * sc * g1.w);
      *(uint4*)(dst + row * 1024 + (2 * lane + 128 * jj) * 4) = o;
    }
  }
}
DI void norm_rows_f32(float* io, const float* __restrict__ g, int item) {
  const int lane = otid() & 63, wid = otid() >> 6;
  for (int i = 0; i < 8; ++i) {
    size_t row = (size_t)item * 32 + wid * 8 + i;
    float4* s = (float4*)(io + row * 1024);
    float4 v[4]; float ss = 0.f;
#pragma unroll
    for (int j = 0; j < 4; ++j) { v[j] = s[lane + 64 * j]; ss += v[j].x * v[j].x + v[j].y * v[j].y + v[j].z * v[j].z + v[j].w * v[j].w; }
    ss = wave_sum(ss);
    float sc = rsqrtf(ss * (1.0f / 1024.0f) + 1e-6f);
#pragma unroll
    for (int j = 0; j < 4; ++j) {
      float4 gg = ((const float4*)g)[lane + 64 * j];
      float4 o; o.x = v[j].x * sc * gg.x; o.y = v[j].y * sc * gg.y; o.z = v[j].z * sc * gg.z; o.w = v[j].w * sc * gg.w;
      s[lane + 64 * j] = o;
    }
  }
}

constexpr int LLD = 72;
constexpr int GST = 128 * 64;
template <int NT, bool LOWREG = false>
DI void gemm_mainloop(f32x4 (&acc)[4][NT], const bf16_t* A, int lda, const bf16_t* Bt, int ldb, int K, bf16_t* sA, bf16_t* sB, int bstride = 32) {
  constexpr int NB = NT;
  const int tid = otid(), lane = tid & 63, wid = tid >> 6;
  const int wm = wid >> 1, wn = wid & 1, fr = lane & 15, fq = lane >> 4;
  u32x4 ra[4], rb[NB];
  const int nk = K >> 6;
  const bf16_t* ap = A + (size_t)(tid >> 3) * lda + (tid & 7) * 8;
  const bf16_t* bp = Bt + (size_t)(tid >> 3) * ldb + (tid & 7) * 8;
  const int so = (tid >> 3) * 64 + (((tid & 7) ^ ((tid >> 4) & 7)) * 8);
  const int fsw = fr >> 1;
#define GLOAD(ko) do { \
    _Pragma("unroll") for (int i = 0; i < 4; ++i) ra[i] = *(const u32x4*)(ap + (size_t)(32 * i) * lda + (ko)); \
    _Pragma("unroll") for (int i = 0; i < NB; ++i) rb[i] = *(const u32x4*)(bp + (size_t)(bstride * i) * ldb + (ko)); } while (0)
#define GSTORE(st) do { \
    _Pragma("unroll") for (int i = 0; i < 4; ++i) *(u32x4*)(sA + (st) * GST + so + 32 * i * 64) = ra[i]; \
    _Pragma("unroll") for (int i = 0; i < NB; ++i) *(u32x4*)(sB + (st) * GST + so + 32 * i * 64) = rb[i]; } while (0)
#define GCOMPUTE(st) do { \
    const bf16_t* cA = sA + (st) * GST; const bf16_t* cB = sB + (st) * GST; \
    _Pragma("unroll") for (int ks = 0; ks < 2; ++ks) { \
      bf16x8 af[4], bfr[NT]; \
      _Pragma("unroll") for (int mi = 0; mi < 4; ++mi) af[mi] = *(const bf16x8*)(cA + (wm * 64 + mi * 16 + fr) * 64 + (((ks * 4 + fq) ^ fsw) * 8)); \
      _Pragma("unroll") for (int ni = 0; ni < NT; ++ni) bfr[ni] = *(const bf16x8*)(cB + (wn * NT * 16 + ni * 16 + fr) * 64 + (((ks * 4 + fq) ^ fsw) * 8)); \
      _Pragma("unroll") for (int mi = 0; mi < 4; ++mi) \
        _Pragma("unroll") for (int ni = 0; ni < NT; ++ni) acc[mi][ni] = __builtin_amdgcn_mfma_f32_16x16x32_bf16(bfr[ni], af[mi], acc[mi][ni], 0, 0, 0); \
    } } while (0)
  __syncthreads();
  GLOAD(0); GSTORE(0);
  if (nk > 1) GLOAD(64);
  __syncthreads();
  for (int kt = 0; kt < nk; ++kt) {
    const int cur = kt & 1;
    if (kt + 1 < nk) { GSTORE(cur ^ 1); if (kt + 2 < nk) GLOAD((kt + 2) * 64); }
    if (LOWREG) {
      const bf16_t* cA = sA + cur * GST; const bf16_t* cB = sB + cur * GST;
#pragma nounroll
      for (int ks = 0; ks < 2; ++ks) {
        bf16x8 af[4], bfr[NT];
#pragma unroll
        for (int mi = 0; mi < 4; ++mi) af[mi] = *(const bf16x8*)(cA + (wm * 64 + mi * 16 + fr) * 64 + (((ks * 4 + fq) ^ fsw) * 8));
#pragma unroll
        for (int ni = 0; ni < NT; ++ni) bfr[ni] = *(const bf16x8*)(cB + (wn * NT * 16 + ni * 16 + fr) * 64 + (((ks * 4 + fq) ^ fsw) * 8));
#pragma unroll
        for (int mi = 0; mi < 4; ++mi)
#pragma unroll
          for (int ni = 0; ni < NT; ++ni) acc[mi][ni] = __builtin_amdgcn_mfma_f32_16x16x32_bf16(bfr[ni], af[mi], acc[mi][ni], 0, 0, 0);
      }
    } else GCOMPUTE(cur);
    __syncthreads();
  }
#undef GLOAD
#undef GSTORE
#undef GCOMPUTE
}
template <int NT>
DI void zero_acc(f32x4 (&acc)[4][NT]) {
#pragma unroll
  for (int mi = 0; mi < 4; ++mi)
#pragma unroll
    for (int ni = 0; ni < NT; ++ni) acc[mi][ni] = f32x4{0.f, 0.f, 0.f, 0.f};
}


constexpr int BGA = 128 * 32, BGB = 256 * 32;
DI void gemm_big(f32x4 (&acc)[4][8], const bf16_t* A, int lda, const bf16_t* Bt, int ldb, int K, char* smem, int s1 = 64, int s2 = 128, int brow = -1) {
  bf16_t* sA = (bf16_t*)smem; bf16_t* sB = sA + 2 * BGA;
  const int tid = otid(), lane = tid & 63, wid = tid >> 6;
  const int wm = wid >> 1, wn = wid & 1, fr = lane & 15, fq = lane >> 4;
  const int nk = K >> 5;
  const bf16_t* ap = A + (size_t)(tid >> 2) * lda + (tid & 3) * 8;
  const bf16_t* bp = Bt + (size_t)(brow >= 0 ? brow : (tid >> 2)) * ldb + (tid & 3) * 8;
  const int so = (tid >> 2) * 32 + (((tid & 3) ^ (((tid >> 5) & 1) << 1)) * 8);
  const int fo = fr * 32 + ((fq ^ (((fr >> 3) & 1) << 1)) * 8);
  u32x4 ra[2], rb[4];
#define BLOADG(kt) do { \
    _Pragma("unroll") for (int i = 0; i < 2; ++i) ra[i] = *(const u32x4*)(ap + (size_t)(64 * i) * lda + (kt) * 32); \
    _Pragma("unroll") for (int i = 0; i < 4; ++i) rb[i] = *(const u32x4*)(bp + (size_t)((i & 1) * s1 + (i >> 1) * s2) * ldb + (kt) * 32); } while (0)
#define BSTOREG(st) do { \
    _Pragma("unroll") for (int i = 0; i < 2; ++i) *(u32x4*)(sA + (st) * BGA + so + 64 * i * 32) = ra[i]; \
    _Pragma("unroll") for (int i = 0; i < 4; ++i) *(u32x4*)(sB + (st) * BGB + so + 64 * i * 32) = rb[i]; } while (0)
  __syncthreads();
  BLOADG(0); BSTOREG(0);
  if (nk > 1) BLOADG(1);
  __syncthreads();
  for (int kt = 0; kt < nk; ++kt) {
    const int cur = kt & 1;
    if (kt + 1 < nk) { BSTOREG(cur ^ 1); if (kt + 2 < nk) BLOADG(kt + 2); }
    const bf16_t* cA = sA + cur * BGA + (wm * 64) * 32 + fo; const bf16_t* cB = sB + cur * BGB + (wn * 128) * 32 + fo;
    bf16x8 af[4];
#pragma unroll
    for (int mi = 0; mi < 4; ++mi) af[mi] = *(const bf16x8*)(cA + mi * 16 * 32);
#pragma unroll
    for (int nh = 0; nh < 2; ++nh) {
      bf16x8 bfr[4];
#pragma unroll
      for (int ni = 0; ni < 4; ++ni) bfr[ni] = *(const bf16x8*)(cB + (nh * 4 + ni) * 16 * 32);
#pragma unroll
      for (int mi = 0; mi < 4; ++mi)
#pragma unroll
        for (int ni = 0; ni < 4; ++ni) acc[mi][nh * 4 + ni] = __builtin_amdgcn_mfma_f32_16x16x32_bf16(bfr[ni], af[mi], acc[mi][nh * 4 + ni], 0, 0, 0);
    }
    __syncthreads();
  }
#undef BLOADG
#undef BSTOREG
}
DI void zero_acc8(f32x4 (&acc)[4][8]) {
#pragma unroll
  for (int mi = 0; mi < 4; ++mi)
#pragma unroll
    for (int ni = 0; ni < 8; ++ni) acc[mi][ni] = f32x4{0.f, 0.f, 0.f, 0.f};
}

DI uint4 widen16(uint2 a, uint2 b) {
  auto rx = __builtin_amdgcn_permlane16_swap(a.x, b.x, false, false);
  auto ry = __builtin_amdgcn_permlane16_swap(a.y, b.y, false, false);
  uint4 w; w.x = rx[0]; w.y = ry[0]; w.z = rx[1]; w.w = ry[1];
  return w;
}
DI void inproj_tile(const Params& p, int l, int tile, char* smem) {
  const int mt = tile & 255, nt = tile >> 8;
  f32x4 acc[4][8]; zero_acc8(acc);
  gemm_big(acc, P_XN + (size_t)mt * 128 * 1024, 1024, P_W1T + ((size_t)l * 4864 + nt * 256) * 1024, 1024, 1024, smem);
  const int lane = otid() & 63, wid = otid() >> 6, wm = wid >> 1, wn = wid & 1, fr = lane & 15, fq = lane >> 4;
#pragma unroll
  for (int mi = 0; mi < 4; ++mi)
#pragma unroll
    for (int np = 0; np < 4; ++np) {
      size_t row = (size_t)mt * 128 + wm * 64 + mi * 16 + fr; int col = nt * 256 + wn * 128 + (2 * np + (fq & 1)) * 16 + (fq >> 1) * 8;
      uint2 a, b;
      a.x = pack2(acc[mi][2 * np][0], acc[mi][2 * np][1]); a.y = pack2(acc[mi][2 * np][2], acc[mi][2 * np][3]);
      b.x = pack2(acc[mi][2 * np + 1][0], acc[mi][2 * np + 1][1]); b.y = pack2(acc[mi][2 * np + 1][2], acc[mi][2 * np + 1][3]);
      *(uint4*)(P_PROJ + row * PW + col) = widen16(a, b);
    }
}

DI void row_scales(const bf16_t* A, int lda, int K, float* sRow) {
  const int row = otid() >> 1, half = otid() & 1;
  const int per = K >> 1;
  const bf16_t* a = A + (size_t)row * lda + half * per;
  float ss = 0.f;
  for (int c = 0; c < per; c += 8) {
    uint4 u = *(const uint4*)(a + c);
    float f;
    f = BLO(u.x); ss += f * f; f = BHI(u.x); ss += f * f; f = BLO(u.y); ss += f * f; f = BHI(u.y); ss += f * f;
    f = BLO(u.z); ss += f * f; f = BHI(u.z); ss += f * f; f = BLO(u.w); ss += f * f; f = BHI(u.w); ss += f * f;
  }
  ss += __shfl_xor(ss, 1);
  if (half == 0) sRow[row] = rsqrtf(ss / (float)K + 1e-6f);
}
DI void mla_item(const Params& p, int l, int item, char* smem) {
  bf16_t* sA = (bf16_t*)smem; bf16_t* sB = sA + 2 * GST; float* sRow = (float*)(sB + 2 * GST);
  const int lane = otid() & 63, wid = otid() >> 6, wm = wid >> 1, wn = wid & 1, fr = lane & 15, fq = lane >> 4;
  if (item < 768) {
    const int mt = item & 255, nt = item >> 8;
    const bf16_t* A = P_PROJ + (size_t)mt * 128 * PW + C_AQ;
    __syncthreads();
    row_scales(A, PW, 256, sRow);
    f32x4 acc[4][4]; zero_acc<4>(acc);
    gemm_mainloop<4>(acc, A, PW, P_WQT + ((size_t)l * 384 + nt * 128) * 256, 256, 256, sA, sB);
    if (nt < 2) {
#pragma unroll
      for (int mi = 0; mi < 4; ++mi)
#pragma unroll
        for (int np = 0; np < 2; ++np) {
          int rl = wm * 64 + mi * 16 + fr; size_t t = (size_t)mt * 128 + rl; float s = sRow[rl] * QS96;
          int c = nt * 128 + wn * 64 + (2 * np + (fq & 1)) * 16 + (fq >> 1) * 8; int h = c >> 6, d = c & 63;
          uint2 a, b;
          a.x = pack2(acc[mi][2 * np][0] * s, acc[mi][2 * np][1] * s); a.y = pack2(acc[mi][2 * np][2] * s, acc[mi][2 * np][3] * s);
          b.x = pack2(acc[mi][2 * np + 1][0] * s, acc[mi][2 * np + 1][1] * s); b.y = pack2(acc[mi][2 * np + 1][2] * s, acc[mi][2 * np + 1][3] * s);
          *(uint4*)(P_QA + t * 384 + h * 96 + d) = widen16(a, b);
        }
    } else {
#pragma unroll
      for (int mi = 0; mi < 4; ++mi)
#pragma unroll
        for (int np = 0; np < 2; ++np) {
          int rl = wm * 64 + mi * 16 + fr; size_t t = (size_t)mt * 128 + rl; float s = sRow[rl] * QS96;
          int pos = (int)(t & (SEQ - 1)); int h = wn * 2 + np;
          const float* cs = P_ROPE + pos * 32 + fq * 4;
          float o1[4], o2[4];
#pragma unroll
          for (int j = 0; j < 4; ++j) {
            float x1 = acc[mi][np * 2][j] * s, x2 = acc[mi][np * 2 + 1][j] * s; float c = cs[j], sn = cs[16 + j];
            o1[j] = x1 * c - x2 * sn; o2[j] = x1 * sn + x2 * c;
          }
          uint2 a; a.x = pack2(o1[0], o1[1]); a.y = pack2(o1[2], o1[3]);
          uint2 b; b.x = pack2(o2[0], o2[1]); b.y = pack2(o2[2], o2[3]);
          *(uint4*)(P_QA + t * 384 + h * 96 + 64 + (fq & 1) * 16 + (fq >> 1) * 8) = widen16(a, b);
        }
    }
  } else if (item < 768 + 1024) {
    const int it = item - 768; const int mt = it & 255, h = it >> 8;
    const bf16_t* A = P_PROJ + (size_t)mt * 128 * PW + C_AKV;
    __syncthreads();
    row_scales(A, PW, 128, sRow);
    f32x4 acc[4][4]; zero_acc<4>(acc);
    gemm_mainloop<4>(acc, A, PW, P_WKVT + ((size_t)l * 512 + h * 128) * 128, 128, 128, sA, sB);
#pragma unroll
    for (int mi = 0; mi < 4; ++mi)
#pragma unroll
      for (int np = 0; np < 2; ++np) {
        int rl = wm * 64 + mi * 16 + fr; size_t t = (size_t)mt * 128 + rl; float s = sRow[rl];
        int d = (2 * np + (fq & 1)) * 16 + (fq >> 1) * 8;
        uint2 a, b;
        a.x = pack2(acc[mi][2 * np][0] * s, acc[mi][2 * np][1] * s); a.y = pack2(acc[mi][2 * np][2] * s, acc[mi][2 * np][3] * s);
        b.x = pack2(acc[mi][2 * np + 1][0] * s, acc[mi][2 * np + 1][1] * s); b.y = pack2(acc[mi][2 * np + 1][2] * s, acc[mi][2 * np + 1][3] * s);
        const uint4 w = widen16(a, b);
        if (wn == 0) *(uint4*)(P_KA + t * 384 + h * 96 + d) = w;
        else *(uint4*)(P_VA + t * 256 + h * 64 + d) = w;
      }
  } else {
    const int it = item - 1792, tid = otid();
#pragma unroll 1
    for (int rep = 0; rep < 3; ++rep) {
      const int u = rep * 256 + tid, tl = u / 6, slot = u - tl * 6;
      const size_t t = (size_t)it * 128 + tl; const int pos = (int)(t & (SEQ - 1));
      bf16_t* hp = P_PROJ + t * PW + (slot < 4 ? C_BQ + slot * 64 : C_BK + (slot - 4) * 64);
      const float* g = (slot < 4 ? p.gq_g : p.gk_g) + l * 64;
      uint4 q[8];
#pragma unroll
      for (int c = 0; c < 8; ++c) q[c] = *(const uint4*)(hp + c * 8);
      float ss = 0.f;
#pragma unroll
      for (int c = 0; c < 8; ++c) {
        float f;
        f = BLO(q[c].x); ss += f * f; f = BHI(q[c].x); ss += f * f; f = BLO(q[c].y); ss += f * f; f = BHI(q[c].y); ss += f * f;
        f = BLO(q[c].z); ss += f * f; f = BHI(q[c].z); ss += f * f; f = BLO(q[c].w); ss += f * f; f = BHI(q[c].w); ss += f * f;
      }
      float sc = rsqrtf(ss * (1.0f / 64.0f) + 1e-6f);
      if (slot < 4) sc *= QS64;
#pragma unroll
      for (int pi = 0; pi < 4; ++pi) {
        const int c = (pi & 1) + (pi >> 1) * 4;
        const float* tab = P_ROPE + ((pi >> 1) ? (pos & 63) : (pos >> 6)) * 32 + (pi & 1) * 8;
        const float4 c0 = *(const float4*)(tab), c1 = *(const float4*)(tab + 4), s0 = *(const float4*)(tab + 16), s1 = *(const float4*)(tab + 20);
        const float cs[8] = {c0.x, c0.y, c0.z, c0.w, c1.x, c1.y, c1.z, c1.w}, sn[8] = {s0.x, s0.y, s0.z, s0.w, s1.x, s1.y, s1.z, s1.w};
        const float4 ga0 = *(const float4*)(g + c * 8), ga1 = *(const float4*)(g + c * 8 + 4), gb0 = *(const float4*)(g + c * 8 + 16), gb1 = *(const float4*)(g + c * 8 + 20);
        const float ga[8] = {ga0.x, ga0.y, ga0.z, ga0.w, ga1.x, ga1.y, ga1.z, ga1.w}, gb[8] = {gb0.x, gb0.y, gb0.z, gb0.w, gb1.x, gb1.y, gb1.z, gb1.w};
        const unsigned ua[4] = {q[c].x, q[c].y, q[c].z, q[c].w}, ub[4] = {q[c + 2].x, q[c + 2].y, q[c + 2].z, q[c + 2].w};
        unsigned oa[4], ob[4];
#pragma unroll
        for (int e = 0; e < 4; ++e) {
          const float x1l = BLO(ua[e]) * sc * ga[2 * e], x1h = BHI(ua[e]) * sc * ga[2 * e + 1];
          const float x2l = BLO(ub[e]) * sc * gb[2 * e], x2h = BHI(ub[e]) * sc * gb[2 * e + 1];
          oa[e] = pack2(x1l * cs[2 * e] - x2l * sn[2 * e], x1h * cs[2 * e + 1] - x2h * sn[2 * e + 1]);
          ob[e] = pack2(x1l * sn[2 * e] + x2l * cs[2 * e], x1h * sn[2 * e + 1] + x2h * cs[2 * e + 1]);
        }
        uint4 wa, wb; wa.x = oa[0]; wa.y = oa[1]; wa.z = oa[2]; wa.w = oa[3]; wb.x = ob[0]; wb.y = ob[1]; wb.z = ob[2]; wb.w = ob[3];
        *(uint4*)(hp + c * 8) = wa; *(uint4*)(hp + (c + 2) * 8) = wb;
      }
    }
    if (tid < 128) {
      const size_t t = (size_t)it * 128 + tid; const int pos = (int)(t & (SEQ - 1));
      const bf16_t* src = P_PROJ + t * PW + C_AKR;
      uint4 q[4];
#pragma unroll
      for (int c = 0; c < 4; ++c) q[c] = *(const uint4*)(src + c * 8);
      uint4 w[4];
#pragma unroll
      for (int c = 0; c < 2; ++c) {
        const float* tab = P_ROPE + pos * 32 + c * 8;
        const float4 c0 = *(const float4*)(tab), c1 = *(const float4*)(tab + 4), s0 = *(const float4*)(tab + 16), s1 = *(const float4*)(tab + 20);
        const float cs[8] = {c0.x, c0.y, c0.z, c0.w, c1.x, c1.y, c1.z, c1.w}, sn[8] = {s0.x, s0.y, s0.z, s0.w, s1.x, s1.y, s1.z, s1.w};
        const unsigned ua[4] = {q[c].x, q[c].y, q[c].z, q[c].w}, ub[4] = {q[c + 2].x, q[c + 2].y, q[c + 2].z, q[c + 2].w};
        unsigned oa[4], ob[4];
#pragma unroll
        for (int e = 0; e < 4; ++e) {
          const float x1l = BLO(ua[e]), x1h = BHI(ua[e]), x2l = BLO(ub[e]), x2h = BHI(ub[e]);
          oa[e] = pack2(x1l * cs[2 * e] - x2l * sn[2 * e], x1h * cs[2 * e + 1] - x2h * sn[2 * e + 1]);
          ob[e] = pack2(x1l * sn[2 * e] + x2l * cs[2 * e], x1h * sn[2 * e + 1] + x2h * cs[2 * e + 1]);
        }
        w[c].x = oa[0]; w[c].y = oa[1]; w[c].z = oa[2]; w[c].w = oa[3];
        w[c + 2].x = ob[0]; w[c + 2].y = ob[1]; w[c + 2].z = ob[2]; w[c + 2].w = ob[3];
      }
#pragma unroll
      for (int h = 0; h < 4; ++h)
#pragma unroll
        for (int c = 0; c < 4; ++c) *(uint4*)(P_KA + t * 384 + h * 96 + 64 + c * 8) = w[c];
    }
  }
}

#define MFMA32(a, b, c) __builtin_amdgcn_mfma_f32_32x32x16_bf16((a), (b), (c), 0, 0, 0)
template <int OFF> DI bf16x4 tr_read(unsigned addr) {
  bf16x4 r; asm volatile("ds_read_b64_tr_b16 %0, %1 offset:%2" : "=&v"(r) : "v"(addr), "i"(OFF) : "memory"); return r;
}
DI float half_swap_max(float v) {
  auto rr = __builtin_amdgcn_permlane32_swap(__float_as_uint(v), __float_as_uint(v), false, false);
  return fmaxf(__uint_as_float(rr[0]), __uint_as_float(rr[1]));
}
DI float half_swap_sum(float v) {
  auto rr = __builtin_amdgcn_permlane32_swap(__float_as_uint(v), __float_as_uint(v), false, false);
  return __uint_as_float(rr[0]) + __uint_as_float(rr[1]);
}
DI bf16x8 pack8(const f32x16& p, int base) {
  u32x4 w = {pack2(p[base + 0], p[base + 1]), pack2(p[base + 2], p[base + 3]), pack2(p[base + 4], p[base + 5]), pack2(p[base + 6], p[base + 7])};
  return __builtin_bit_cast(bf16x8, w);
}
template <int DB, int VLD> DI void pv_block(f32x16& o, unsigned vb, bf16x8 pb0, bf16x8 pb1, bf16x8 pb2, bf16x8 pb3) {
  constexpr int RB = VLD * 2;
  bf16x4 l0 = tr_read<0 * RB + 64 * DB>(vb), h0 = tr_read<8 * RB + 64 * DB>(vb);
  bf16x4 l1 = tr_read<16 * RB + 64 * DB>(vb), h1 = tr_read<24 * RB + 64 * DB>(vb);
  bf16x4 l2 = tr_read<32 * RB + 64 * DB>(vb), h2 = tr_read<40 * RB + 64 * DB>(vb);
  bf16x4 l3 = tr_read<48 * RB + 64 * DB>(vb), h3 = tr_read<56 * RB + 64 * DB>(vb);
  asm volatile("s_waitcnt lgkmcnt(0)" ::: "memory"); __builtin_amdgcn_sched_barrier(0);
  o = MFMA32(__builtin_shufflevector(l0, h0, 0, 1, 2, 3, 4, 5, 6, 7), pb0, o);
  o = MFMA32(__builtin_shufflevector(l1, h1, 0, 1, 2, 3, 4, 5, 6, 7), pb1, o);
  o = MFMA32(__builtin_shufflevector(l2, h2, 0, 1, 2, 3, 4, 5, 6, 7), pb2, o);
  o = MFMA32(__builtin_shufflevector(l3, h3, 0, 1, 2, 3, 4, 5, 6, 7), pb3, o);
}
DI f32x16 splat16(float v) { f32x16 r;
#pragma unroll
  for (int i = 0; i < 16; ++i) r[i] = v;
  return r; }

template <int DQK, bool FIXEDM>
DI void attn_dense_mfma(const bf16_t* Qb, int ldq, const bf16_t* Kb, int ldk, const bf16_t* Vb, int ldv, bf16_t* gate_io, char* smem, bool store, float mbound) {
  constexpr int NS = DQK / 16, KLD = DQK + 8, VLD = 96, CPR = DQK / 8, NKC = (64 * CPR) / 256;
  constexpr int KBYTES = 64 * KLD * 2, VBYTES = 64 * VLD * 2;
  char* sKc = smem; char* sVc = smem + 2 * KBYTES;
  const int tid = otid(), lane = tid & 63, wid = tid >> 6, r = lane & 31, h = lane >> 5;
  bf16x8 qf[NS];
#pragma unroll
  for (int s = 0; s < NS; ++s) qf[s] = *(const bf16x8*)(Qb + (size_t)(wid * 32 + r) * ldq + 16 * s + 8 * h);
  const bf16_t* kp = Kb + (size_t)(tid >> 2) * ldk + (tid & 3) * (NKC * 8);
  const int kso = ((tid >> 2) * KLD + (tid & 3) * (NKC * 8)) * 2;
  const bf16_t* vp0 = Vb + (size_t)(tid >> 3) * ldv + (tid & 7) * 8;
  const bf16_t* vp1 = vp0 + (size_t)32 * ldv;
  const int vso = ((tid >> 3) * VLD + (tid & 7) * 8) * 2;
  const size_t kstep = (size_t)64 * ldk, vstep = (size_t)64 * ldv;
  u32x4 rk[NKC], rv[2];
#define KLOAD() do { _Pragma("unroll") for (int i = 0; i < NKC; ++i) rk[i] = *(const u32x4*)(kp + i * 8); kp += kstep; } while (0)
#define VLOAD() do { rv[0] = *(const u32x4*)vp0; rv[1] = *(const u32x4*)vp1; vp0 += vstep; vp1 += vstep; } while (0)
#define KSTORE(st) do { _Pragma("unroll") for (int i = 0; i < NKC; ++i) *(u32x4*)(sKc + (st) * KBYTES + kso + i * 16) = rk[i]; } while (0)
#define VSTORE(st) do { *(u32x4*)(sVc + (st) * VBYTES + vso) = rv[0]; *(u32x4*)(sVc + (st) * VBYTES + vso + 32 * VLD * 2) = rv[1]; } while (0)
#define QKT(P0, P1, st) do { \
    const bf16_t* sK = (const bf16_t*)(sKc + (st) * KBYTES) + r * KLD + 8 * h; \
    P0 = negm; P1 = negm; \
    _Pragma("unroll") for (int s = 0; s < NS; ++s) { \
      bf16x8 k0 = *(const bf16x8*)(sK + 16 * s); bf16x8 k1 = *(const bf16x8*)(sK + 32 * KLD + 16 * s); \
      P0 = MFMA32(k0, qf[s], P0); P1 = MFMA32(k1, qf[s], P1); } } while (0)
  const unsigned vb0 = (unsigned)(size_t)sVc + (unsigned)(((4 * h + ((lane & 15) >> 2)) * VLD + 16 * ((lane >> 4) & 1) + 4 * (lane & 3)) * 2);
  f32x16 o0 = splat16(0.f), o1 = splat16(0.f), negm = splat16(FIXEDM ? -mbound : 0.f);
  f32x16 pa0, pa1, pc0, pc1;
  float m_run = 0.f, l_run = 0.f;
  constexpr int NT = SEQ / 64;
  __syncthreads();
  KLOAD(); VLOAD(); KSTORE(0); VSTORE(0);
  KLOAD(); KSTORE(1);
  __syncthreads();
  QKT(pa0, pa1, 0);
  __syncthreads();
#define STEP(SC0, SC1, SN0, SN1, PAR, FIRST, LK, LV) do { \
    if (LK) KLOAD(); \
    if (LV) VLOAD(); \
    float pm = 0.f; \
    if (!FIXEDM) { pm = fmaxf(SC0[0], SC1[0]); \
    _Pragma("unroll") for (int i = 1; i < 16; i += 1) pm = fmaxf(fmaxf(pm, SC0[i]), SC1[i]); \
    pm = half_swap_max(pm); } \
    if (!FIXEDM && ((FIRST) || __any(pm > 8.0f))) { \
      float delta; \
      if (FIRST) delta = pm; \
      else { delta = fmaxf(pm, 0.f); float alpha = __builtin_amdgcn_exp2f(-delta); l_run *= alpha; \
        _Pragma("unroll") for (int i = 0; i < 16; ++i) { o0[i] *= alpha; o1[i] *= alpha; } } \
      m_run += delta; \
      _Pragma("unroll") for (int i = 0; i < 16; ++i) { SC0[i] -= delta; SC1[i] -= delta; } \
      negm = splat16(-m_run); \
    } \
    if (LV) QKT(SN0, SN1, (PAR) ^ 1); \
    float ls = 0.f; \
    _Pragma("unroll") for (int i = 0; i < 16; ++i) { SC0[i] = __builtin_amdgcn_exp2f(SC0[i]); SC1[i] = __builtin_amdgcn_exp2f(SC1[i]); ls += SC0[i] + SC1[i]; } \
    l_run += ls; \
    bf16x8 pb0 = pack8(SC0, 0), pb1 = pack8(SC0, 8), pb2 = pack8(SC1, 0), pb3 = pack8(SC1, 8); \
    const unsigned vb = vb0 + (PAR) * VBYTES; \
    pv_block<0, VLD>(o0, vb, pb0, pb1, pb2, pb3); \
    pv_block<1, VLD>(o1, vb, pb0, pb1, pb2, pb3); \
    if (LK) KSTORE(PAR); \
    if (LV) VSTORE((PAR) ^ 1); \
    __syncthreads(); } while (0)
  pc0 = negm; pc1 = negm;
  STEP(pa0, pa1, pc0, pc1, 0, true, 1, 1);
  STEP(pc0, pc1, pa0, pa1, 1, false, 1, 1);
  for (int j = 2; j < NT - 2; j += 2) {
    STEP(pa0, pa1, pc0, pc1, 0, false, 1, 1);
    STEP(pc0, pc1, pa0, pa1, 1, false, 1, 1);
  }
  STEP(pa0, pa1, pc0, pc1, 0, false, 0, 1);
  STEP(pc0, pc1, pa0, pa1, 1, false, 0, 0);
#undef STEP
#undef QKT
#undef KLOAD
#undef VLOAD
#undef KSTORE
#undef VSTORE
  if (!store) return;
  const float inv = 1.0f / half_swap_sum(l_run);
  bf16_t* grow = gate_io + (size_t)(wid * 32 + r) * PW;
#pragma unroll
  for (int db = 0; db < 2; ++db)
#pragma unroll
    for (int g4 = 0; g4 < 4; ++g4) {
      bf16_t* gp = grow + 32 * db + 8 * g4 + 4 * h;
      uint2 u = *(const uint2*)gp;
      float g[4] = {BLO(u.x), BHI(u.x), BLO(u.y), BHI(u.y)};
      float y[4];
#pragma unroll
      for (int e = 0; e < 4; ++e) { float ov = db == 0 ? o0[4 * g4 + e] : o1[4 * g4 + e]; y[e] = ov * inv * g[e] / (1.0f + __expf(-g[e])); }
      uint2 w; w.x = pack2(y[0], y[1]); w.y = pack2(y[2], y[3]);
      *(uint2*)gp = w;
    }
}
DI void dense_item(const Params& p, int l, int combo, int qblk, char* smem, bool store) {
  const int br = combo >> 4, bh = combo & 15, b = bh >> 2, h = bh & 3;
  const size_t t0 = (size_t)b * SEQ + qblk * 128;
  bf16_t* gate_io = P_PROJ + t0 * PW + C_GATE + br * 256 + h * 64;
  float bbound = 0.f;
  if (br != 0) {
    const int ln = otid() & 63;
    float gq = fabsf(p.gq_g[l * 64 + ln]), gk = fabsf(p.gk_g[l * 64 + ln]);
#pragma unroll
    for (int o = 32; o; o >>= 1) { gq = fmaxf(gq, __shfl_xor(gq, o)); gk = fmaxf(gk, __shfl_xor(gk, o)); }
    bbound = 64.0f * QS64 * 1.02f * gq * gk + 0.05f;
  }
  if (br == 0)
    attn_dense_mfma<96, false>(P_QA + t0 * 384 + h * 96, 384, P_KA + (size_t)b * SEQ * 384 + h * 96, 384, P_VA + (size_t)b * SEQ * 256 + h * 64, 256, gate_io, smem, store, 0.f);
  else {
    if (bbound <= 60.0f) attn_dense_mfma<64, true>(P_PROJ + t0 * PW + C_BQ + h * 64, PW, P_PROJ + (size_t)b * SEQ * PW + C_BK + (h >> 1) * 64, PW,
                        P_PROJ + (size_t)b * SEQ * PW + C_BV + (h >> 1) * 64, PW, gate_io, smem, store, bbound);
    else attn_dense_mfma<64, false>(P_PROJ + t0 * PW + C_BQ + h * 64, PW, P_PROJ + (size_t)b * SEQ * PW + C_BK + (h >> 1) * 64, PW,
                        P_PROJ + (size_t)b * SEQ * PW + C_BV + (h >> 1) * 64, PW, gate_io, smem, store, bbound);
  }
}

template <int W, bool SINK>
DI void attn_band_mfma(const bf16_t* Qb, size_t ldq, const bf16_t* Kb, const bf16_t* Vb, size_t ldk, int L, int i0,
                       const float* lut_g, float sink2, bf16_t* outp, size_t ldo, float* lse_out, size_t ldl, char* smem) {
  constexpr int NS = 4, KLD = 72, VLD = 96, NTW = (128 + 2 * W) / 64, LUTN = 2 * W + 1;
  constexpr int KBYTES = 64 * KLD * 2, VBYTES = 64 * VLD * 2;
  char* sKc = smem; char* sVc = smem + 2 * KBYTES; float* sLut = (float*)(smem + 2 * KBYTES + 2 * VBYTES);
  const int tid = otid(), lane = tid & 63, wid = tid >> 6, r = lane & 31, h = lane >> 5;
  __syncthreads();
  for (int e = tid; e < LUTN; e += 256) sLut[e] = lut_g[e];
  const int qi = i0 + wid * 32 + r;
  bf16x8 qf[NS];
#pragma unroll
  for (int s = 0; s < NS; ++s) qf[s] = *(const bf16x8*)(Qb + (size_t)qi * ldq + 16 * s + 8 * h);
  const int srow = tid >> 3, scc = tid & 7;
  u32x4 rk[2], rv[2];
#define BLOAD(k0) do { \
    rk[0] = *(const u32x4*)(Kb + (size_t)((k0) + srow) * ldk + scc * 8); rk[1] = *(const u32x4*)(Kb + (size_t)((k0) + srow + 32) * ldk + scc * 8); \
    rv[0] = *(const u32x4*)(Vb + (size_t)((k0) + srow) * ldk + scc * 8); rv[1] = *(const u32x4*)(Vb + (size_t)((k0) + srow + 32) * ldk + scc * 8); } while (0)
#define BSTORE(st) do { \
    *(u32x4*)(sKc + (st) * KBYTES + (srow * KLD + scc * 8) * 2) = rk[0]; *(u32x4*)(sKc + (st) * KBYTES + ((srow + 32) * KLD + scc * 8) * 2) = rk[1]; \
    *(u32x4*)(sVc + (st) * VBYTES + (srow * VLD + scc * 8) * 2) = rv[0]; *(u32x4*)(sVc + (st) * VBYTES + ((srow + 32) * VLD + scc * 8) * 2) = rv[1]; } while (0)
  const unsigned vb0 = (unsigned)(size_t)sVc + (unsigned)(((4 * h + ((lane & 15) >> 2)) * VLD + 16 * ((lane >> 4) & 1) + 4 * (lane & 3)) * 2);
  f32x16 o0 = splat16(0.f), o1 = splat16(0.f);
  float m_run = SINK ? sink2 : 0.f, l_run = (SINK && h == 0) ? 1.f : 0.f;
  bool seen = SINK;
  f32x16 negm = splat16(-m_run);
  const int lo = (i0 == 0) ? W / 64 : 0, hi = (i0 + 128 >= L) ? NTW - W / 64 : NTW;
  BLOAD(i0 - W + 64 * lo); BSTORE(0);
  __syncthreads();
  for (int j = lo; j < hi; ++j) {
    const int cur = (j - lo) & 1, k0 = i0 - W + 64 * j;
    if (j + 1 < hi) BLOAD(k0 + 64);
    const bf16_t* sK = (const bf16_t*)(sKc + cur * KBYTES);
    f32x16 p0 = negm, p1 = negm;
#pragma unroll
    for (int s = 0; s < NS; ++s) {
      bf16x8 k0f = *(const bf16x8*)(sK + r * KLD + 16 * s + 8 * h);
      bf16x8 k1f = *(const bf16x8*)(sK + (32 + r) * KLD + 16 * s + 8 * h);
      p0 = MFMA32(k0f, qf[s], p0);
      p1 = MFMA32(k1f, qf[s], p1);
    }
    const int offb = k0 + 4 * h - qi + W;
    float pm = -1e30f;
#pragma unroll
    for (int i = 0; i < 16; ++i) {
      int idx0 = offb + (i & 3) + 8 * (i >> 2), idx1 = idx0 + 32;
      int c0 = min(max(idx0, 0), 2 * W), c1 = min(max(idx1, 0), 2 * W);
      float b0 = sLut[c0], b1 = sLut[c1];
      p0[i] = ((unsigned)idx0 <= (unsigned)(2 * W)) ? p0[i] + b0 : -1e30f;
      p1[i] = ((unsigned)idx1 <= (unsigned)(2 * W)) ? p1[i] + b1 : -1e30f;
      pm = fmaxf(pm, fmaxf(p0[i], p1[i]));
    }
    pm = half_swap_max(pm);
    const bool has = pm > -1e29f;
    float delta = 0.f;
    if (has) { if (!seen) delta = pm; else if (pm > 8.0f) delta = pm; }
    if (__any(delta != 0.f)) {
      float alpha = seen ? __builtin_amdgcn_exp2f(-delta) : 1.0f;
      l_run *= alpha; m_run += delta;
#pragma unroll
      for (int i = 0; i < 16; ++i) { o0[i] *= alpha; o1[i] *= alpha; p0[i] -= delta; p1[i] -= delta; }
      negm = splat16(-m_run);
    }
    seen = seen || has;
    float ls = 0.f;
#pragma unroll
    for (int i = 0; i < 16; ++i) { p0[i] = __builtin_amdgcn_exp2f(p0[i]); p1[i] = __builtin_amdgcn_exp2f(p1[i]); ls += p0[i] + p1[i]; }
    l_run += ls;
    bf16x8 pb0 = pack8(p0, 0), pb1 = pack8(p0, 8), pb2 = pack8(p1, 0), pb3 = pack8(p1, 8);
    const unsigned vb = vb0 + cur * VBYTES;
    pv_block<0, VLD>(o0, vb, pb0, pb1, pb2, pb3);
    pv_block<1, VLD>(o1, vb, pb0, pb1, pb2, pb3);
    if (j + 1 < hi) BSTORE(cur ^ 1);
    __syncthreads();
  }
#undef BLOAD
#undef BSTORE
  const float ltot = half_swap_sum(l_run);
  const float inv = 1.0f / ltot;
  bf16_t* orow = outp + (size_t)qi * ldo;
  if (!SINK && h == 0) lse_out[(size_t)qi * ldl] = m_run + __log2f(ltot);
#pragma unroll
  for (int db = 0; db < 2; ++db)
#pragma unroll
    for (int kp = 0; kp < 2; ++kp) {
      uint2 w2[2];
#pragma unroll
      for (int gg = 0; gg < 2; ++gg) {
        const int g4 = 2 * kp + gg;
        float y[4];
        if (SINK) {
          uint2 u = *(const uint2*)(orow + 32 * db + 8 * g4 + 4 * h);
          float g[4] = {BLO(u.x), BHI(u.x), BLO(u.y), BHI(u.y)};
#pragma unroll
          for (int e = 0; e < 4; ++e) { float ov = db == 0 ? o0[4 * g4 + e] : o1[4 * g4 + e]; y[e] = ov * inv * g[e] / (1.0f + __expf(-g[e])); }
        } else {
#pragma unroll
          for (int e = 0; e < 4; ++e) { float ov = db == 0 ? o0[4 * g4 + e] : o1[4 * g4 + e]; y[e] = ov * inv; }
        }
        w2[gg].x = pack2(y[0], y[1]); w2[gg].y = pack2(y[2], y[3]);
      }
      auto rx = __builtin_amdgcn_permlane32_swap(w2[0].x, w2[1].x, false, false);
      auto ry = __builtin_amdgcn_permlane32_swap(w2[0].y, w2[1].y, false, false);
      uint4 w; w.x = rx[0]; w.y = ry[0]; w.z = rx[1]; w.w = ry[1];
      *(uint4*)(orow + 32 * db + 16 * kp + 8 * h) = w;
    }
}
DI void band_item(const Params& p, int l, int idx, char* smem) {
  if (idx < 3072) {
    const int g = idx >> 10, rem = idx & 1023, h = rem & 3, rem2 = rem >> 2, b = 3 - (rem2 >> 6), u = rem2 & 63;
    const int sh = 2 * g, rr = 1 << sh;
    const int rho = u & (rr - 1), qblk = u >> sh;
    const size_t tok0 = (size_t)b * SEQ + rho;
    bf16_t* base = P_PROJ + tok0 * PW + g * 256 + h * 64;
    attn_band_mfma<64, false>(base + C_CQ, (size_t)rr * PW, base + C_CK, base + C_CV, (size_t)rr * PW, SEQ >> sh, qblk * 128,
                              P_LUTC + (g * 4 + h) * 129, 0.f, base + C_CQ, (size_t)rr * PW, P_LSE + tok0 * 12 + g * 4 + h, (size_t)rr * 12, smem);
  } else {
    const int it = idx - 3072, hq = it & 3, rem = it >> 2, b = 3 - (rem >> 6), qblk = rem & 63;
    bf16_t* base = P_PROJ + (size_t)b * SEQ * PW;
    attn_band_mfma<128, true>(base + C_DQ + hq * 64, PW, base + C_DK + (hq >> 1) * 64, base + C_DV + (hq >> 1) * 64, PW, SEQ, qblk * 128,
                              P_LUTD + hq * 257, p.sink[l * 4 + hq] * LOG2E, base + C_GATE + 768 + hq * 64, PW, nullptr, 0, smem);
  }
}
DI void combine_c(const Params& p) {
  for (size_t u = (size_t)blockIdx.x * 256 + otid(); u < (size_t)32768 * 32; u += (size_t)gridDim.x * 256) {
    const size_t t = u >> 5; const int h = (int)(u >> 3) & 3, ch = (int)u & 7;
    const float* ls = P_LSE + t * 12 + h;
    float l0 = ls[0], l1 = ls[4], l2 = ls[8];
    float mx = fmaxf(l0, fmaxf(l1, l2));
    float a0 = __builtin_amdgcn_exp2f(l0 - mx), a1 = __builtin_amdgcn_exp2f(l1 - mx), a2 = __builtin_amdgcn_exp2f(l2 - mx);
    float inv = 1.0f / (a0 + a1 + a2); a0 *= inv; a1 *= inv; a2 *= inv;
    const bf16_t* row = P_PROJ + t * PW;
    uint4 x0 = *(const uint4*)(row + C_CQ + h * 64 + ch * 8), x1 = *(const uint4*)(row + C_CQ + 256 + h * 64 + ch * 8),
          x2 = *(const uint4*)(row + C_CQ + 512 + h * 64 + ch * 8);
    bf16_t* gp = P_PROJ + t * PW + C_GATE + 512 + h * 64 + ch * 8;
    uint4 gu = *(const uint4*)gp;
    unsigned xa[4] = {x0.x, x0.y, x0.z, x0.w}, xb[4] = {x1.x, x1.y, x1.z, x1.w}, xc[4] = {x2.x, x2.y, x2.z, x2.w}, gg[4] = {gu.x, gu.y, gu.z, gu.w};
    unsigned ov[4];
#pragma unroll
    for (int e = 0; e < 4; ++e) {
      float ylo = a0 * BLO(xa[e]) + a1 * BLO(xb[e]) + a2 * BLO(xc[e]);
      float yhi = a0 * BHI(xa[e]) + a1 * BHI(xb[e]) + a2 * BHI(xc[e]);
      float glo = BLO(gg[e]), ghi = BHI(gg[e]);
      ov[e] = pack2(ylo * glo / (1.0f + __expf(-glo)), yhi * ghi / (1.0f + __expf(-ghi)));
    }
    uint4 w; w.x = ov[0]; w.y = ov[1]; w.z = ov[2]; w.w = ov[3];
    *(uint4*)gp = w;
  }
}

DI void merge_tile(const Params& p, int l, int tile, char* smem) {
  bf16_t* sA = (bf16_t*)smem; bf16_t* sB = sA + 2 * GST;
  const int mt = tile & 255, nt = tile >> 8;
  unsigned sg[4][8][2];
  {
    f32x4 accG[4][8]; zero_acc8(accG);
    gemm_big(accG, P_XN + (size_t)mt * 128 * 1024, 1024, P_WMT + ((size_t)l * 4096 + nt * 64) * 1024, 1024, 1024, smem, 2048, 32,
             (otid() >> 7) * 1024 + ((otid() >> 2) & 31));
#pragma unroll
    for (int mi = 0; mi < 4; ++mi)
#pragma unroll
      for (int ni = 0; ni < 8; ++ni) {
        float s0 = 1.0f / (1.0f + __expf(-accG[mi][ni][0])), s1 = 1.0f / (1.0f + __expf(-accG[mi][ni][1]));
        float s2 = 1.0f / (1.0f + __expf(-accG[mi][ni][2])), s3 = 1.0f / (1.0f + __expf(-accG[mi][ni][3]));
        sg[mi][ni][0] = pack2(s0, s1); sg[mi][ni][1] = pack2(s2, s3);
      }
  }
  f32x4 accM[4][2]; zero_acc<2>(accM);
#pragma unroll 1
  for (int n = 0; n < 4; ++n) {
    f32x4 accB[4][2]; zero_acc<2>(accB);
    gemm_mainloop<2>(accB, P_PROJ + (size_t)mt * 128 * PW + C_GATE + n * 256, PW, P_WBT + ((size_t)(l * 4 + n) * 1024 + nt * 64) * 256, 256, 256, sA, sB);
#pragma unroll
    for (int mi = 0; mi < 4; ++mi)
#pragma unroll
      for (int ni = 0; ni < 2; ++ni) {
        accM[mi][ni][0] += accB[mi][ni][0] * BLO(sg[mi][ni][0]); accM[mi][ni][1] += accB[mi][ni][1] * BHI(sg[mi][ni][0]);
        accM[mi][ni][2] += accB[mi][ni][2] * BLO(sg[mi][ni][1]); accM[mi][ni][3] += accB[mi][ni][3] * BHI(sg[mi][ni][1]);
      }
#pragma unroll
    for (int mi = 0; mi < 4; ++mi)
#pragma unroll
      for (int k = 0; k < 6; ++k) { sg[mi][k][0] = sg[mi][k + 2][0]; sg[mi][k][1] = sg[mi][k + 2][1]; }
  }
  const int lane = otid() & 63, wid = otid() >> 6, wm = wid >> 1, wn = wid & 1, fr = lane & 15, fq = lane >> 4;
#pragma unroll
  for (int mi = 0; mi < 4; ++mi)
    {
      size_t row = (size_t)mt * 128 + wm * 64 + mi * 16 + fr; int col = nt * 64 + wn * 32 + (fq & 1) * 16 + (fq >> 1) * 8;
      uint2 a, b;
      a.x = pack2(accM[mi][0][0], accM[mi][0][1]); a.y = pack2(accM[mi][0][2], accM[mi][0][3]);
      b.x = pack2(accM[mi][1][0], accM[mi][1][1]); b.y = pack2(accM[mi][1][2], accM[mi][1][3]);
      *(uint4*)(P_PROJ + row * PW + C_MERGED + col) = widen16(a, b);
    }
}

DI void outproj_tile(const Params& p, int l, int tile, char* smem) {
  const int mt = tile & 255, nt = tile >> 8;
  f32x4 acc[4][8]; zero_acc8(acc);
  gemm_big(acc, P_PROJ + (size_t)mt * 128 * PW + C_MERGED, PW, P_WOT + ((size_t)l * 1024 + nt * 256) * 1024, 1024, 1024, smem);
  const float* xin = l == 0 ? p.x : p.out;
  const int lane = otid() & 63, wid = otid() >> 6, wm = wid >> 1, wn = wid & 1, fr = lane & 15, fq = lane >> 4;
#pragma unroll
  for (int mi = 0; mi < 4; ++mi)
#pragma unroll
    for (int ni = 0; ni < 8; ++ni) {
      size_t row = (size_t)mt * 128 + wm * 64 + mi * 16 + fr; int col = nt * 256 + wn * 128 + ni * 16 + fq * 4;
      float4 xi = *(const float4*)(xin + row * 1024 + col);
      float4 o; o.x = xi.x + acc[mi][ni][0]; o.y = xi.y + acc[mi][ni][1]; o.z = xi.z + acc[mi][ni][2]; o.w = xi.w + acc[mi][ni][3];
      *(float4*)(p.out + row * 1024 + col) = o;
    }
}


#define XB_TMO      128
#define XB_XCNT(j)  (256  + 64 * (j))
#define XB_XSUB(j)  (1280 + 64 * (j))
#define XB_XGEN(j)  (2304 + 64 * (j))
#define XB_TOP      3328
#define XB_TOPGEN   3392
#define XCD_BAR_WORDS 3456
#define XB_SPIN_CAP (1u << 22)
#define LAS __attribute__((address_space(3)))
DI unsigned xb_ld(unsigned* p)              { return __hip_atomic_load(p, __ATOMIC_RELAXED, __HIP_MEMORY_SCOPE_AGENT); }
DI unsigned xb_add(unsigned* p, unsigned v) { return __hip_atomic_fetch_add(p, v, __ATOMIC_RELAXED, __HIP_MEMORY_SCOPE_AGENT); }
DI unsigned xb_xcc_id() { return (unsigned)__builtin_amdgcn_s_getreg((3 << 11) | 20) & 0xFu; }
#define XB_SPIN(cond, bar) do { unsigned _sp = 0; while (cond) { __builtin_amdgcn_s_sleep(1); \
    if ((++_sp & 255u) == 0u) { if (xb_ld(&(bar)[XB_TMO])) break; if (_sp > XB_SPIN_CAP) { atomicAdd(&(bar)[XB_TMO], 1u); break; } } } } while (0)
struct XcdBarrier { unsigned* bar; unsigned x; volatile LAS unsigned* st; };
DI XcdBarrier xcd_barrier_post(unsigned* bar, volatile LAS unsigned* st) {
  XcdBarrier b; b.bar = bar; b.x = xb_xcc_id(); b.st = st;
  if (threadIdx.x == 0) (void)xb_add(&bar[XB_XCNT(b.x)], 1u);
  return b;
}
DI void xcd_barrier_complete(unsigned* bar, unsigned x, unsigned& nloc, unsigned& nx) {
  const unsigned G = gridDim.x * gridDim.y * gridDim.z;
  unsigned sum, cnt, mine, sp = 0u;
  for (;;) {
    sum = 0u; cnt = 0u; mine = 0u;
#pragma unroll
    for (unsigned j = 0; j < 16; ++j) { const unsigned c = xb_ld(&bar[XB_XCNT(j)]); sum += c; cnt += (c > 0u) ? 1u : 0u; mine = (j == x) ? c : mine; }
    if (sum == G) break;
    __builtin_amdgcn_s_sleep(1);
    if ((++sp & 255u) == 0u) { if (xb_ld(&bar[XB_TMO])) break; if (sp > XB_SPIN_CAP) { atomicAdd(&bar[XB_TMO], 1u); break; } }
  }
  nloc = mine > 0u ? mine : 1u; nx = cnt > 0u ? cnt : 1u;
}
DI void xcd_barrier(const XcdBarrier& b) {
  asm volatile("s_waitcnt vmcnt(0)" ::: "memory");
  __syncthreads();
  if (threadIdx.x == 0) {
    unsigned* bar = b.bar;
    __builtin_amdgcn_s_waitcnt(0);
    unsigned nloc = b.st[0], nx = b.st[1];
    if (nloc == 0u) { xcd_barrier_complete(bar, b.x, nloc, nx); b.st[0] = nloc; b.st[1] = nx; }
    const unsigned old = xb_add(&bar[XB_XSUB(b.x)], 1u);
    const unsigned gen = old / nloc;
    if (old + 1u == (gen + 1u) * nloc) {
      __builtin_amdgcn_fence(__ATOMIC_RELEASE, "agent");
      asm volatile("s_waitcnt vmcnt(0)" ::: "memory");
      const unsigned og = xb_add(&bar[XB_TOP], 1u);
      const unsigned tg = og / nx;
      if (og + 1u == (tg + 1u) * nx) xb_add(&bar[XB_TOPGEN], 1u);
      else XB_SPIN(xb_ld(&bar[XB_TOPGEN]) == tg, bar);
      __builtin_amdgcn_fence(__ATOMIC_ACQUIRE, "agent");
      xb_add(&bar[XB_XGEN(b.x)], 1u);
      asm volatile("s_waitcnt vmcnt(0)" ::: "memory");
    } else {
      XB_SPIN(xb_ld(&bar[XB_XGEN(b.x)]) == gen, bar);
      __builtin_amdgcn_fence(__ATOMIC_ACQUIRE, "agent");
      asm volatile("s_waitcnt vmcnt(0)" ::: "memory");
    }
  }
  __syncthreads();
}

DI void run_phase(const Params& p, int ph, char* smem, bool never) {
  const int G = gridDim.x, B = blockIdx.x;
  if (ph == 0) {
    for (int i = B; i < 6097; i += G) prep_item(p, i, (float*)smem);
    for (int i = B; i < 1024; i += G) norm_rows_bf16(p.x, p.norm_g, P_XN, i);
  } else if (ph == 14) {
    for (int i = B; i < 1024; i += G) norm_rows_f32(p.out, p.final_g, i);
  } else if (ph == 7) {
    for (int i = B; i < 1024; i += G) norm_rows_bf16(p.out, p.norm_g + 1024, P_XN, i);
  } else {
    const int l = ph > 7 ? 1 : 0; const int s = ph > 7 ? ph - 8 : ph - 1;
    const int xcd = B & 7, lb = B >> 3, nl = G >> 3;
    if (s == 0) {
      for (int w = lb; w < 64 * 8 + 96; w += nl) {
        const int it = w >> 6, l64 = w & 63;
        int mt, nt;
        if (it < 8) { const int a = it >> 1, gn = it & 1; mt = 8 * (xcd + 8 * a) + (l64 & 7); nt = 8 * gn + (l64 >> 3); }
        else { const int q = (it - 8) * 64 + l64; const int ml = q / 3; mt = 8 * (xcd + 8 * (ml >> 3)) + (ml & 7); nt = 16 + q % 3; }
        inproj_tile(p, l, nt * 256 + mt, smem);
      }
    }
    else if (s == 1) { for (int i = B; i < 2048; i += G) mla_item(p, l, i, smem); }
    else if (s == 2) {
#ifdef REP_DENSE
      for (int w = lb; w < 256; w += nl) dense_item(p, l, xcd + 8 * (w >> 6), w & 63, smem, never);
#endif
      for (int i = B; i < 4096; i += G) band_item(p, l, i, smem);
      for (int w = lb; w < 256; w += nl) { const int k = w >> 6, ck = ((k & 1) << 1 | (k >> 1)) ^ 1; dense_item(p, l, xcd + 8 * ck, w & 63, smem, true); }
    }
    else if (s == 3) { combine_c(p); }
    else if (s == 4) {
      for (int w = lb; w < 64 * 8; w += nl) {
        const int it = w >> 6, l64 = w & 63, a = it >> 1, gn = it & 1;
        const int mt = 8 * (xcd + 8 * a) + (l64 & 7), nt = 8 * gn + (l64 >> 3);
        merge_tile(p, l, nt * 256 + mt, smem);
      }
    }
    else {
      for (int w = lb; w < 64 * 2; w += nl) {
        const int a = w >> 6, l64 = w & 63;
        const int mt = 8 * (xcd + 8 * (2 * a + (l64 >> 5))) + (l64 & 7), nt = (l64 >> 3) & 3;
        outproj_tile(p, l, nt * 256 + mt, smem);
      }
    }
  }
}

__global__ void __launch_bounds__(256, 2) mega(Params p, int ph_lo, int ph_hi) {
  __shared__ __attribute__((aligned(16))) char smem[66048];
  __shared__ uint4 xb_words;
  cg::grid_group grid = cg::this_grid();
  if (threadIdx.x == 0) xb_words = make_uint4(0u, 0u, 0u, 0u);
  __syncthreads();
  XcdBarrier xb = xcd_barrier_post((unsigned*)(p.ws + OFF_BAR), (volatile LAS unsigned*)&xb_words);
  if (ph_hi == 12345) grid.sync();
  for (int ph = ph_lo; ph < ph_hi; ++ph) {
    run_phase(p, ph, smem, ph_hi == 12345);
    if (ph + 1 < ph_hi) xcd_barrier(xb);
  }
}

extern "C" void kernel_launch(void* const* d_in, const int* in_sizes, int n_in, void* d_out, int out_size, void* d_ws,
                              size_t ws_size, hipStream_t stream) {
  Params p{};
  p.x = (const float*)d_in[0]; p.norm_g = (const float*)d_in[1]; p.w_in = (const float*)d_in[2];
  p.q_norm_g = (const float*)d_in[3]; p.kv_norm_g = (const float*)d_in[4]; p.w_q_up = (const float*)d_in[5];
  p.w_kv_up = (const float*)d_in[6]; p.gq_g = (const float*)d_in[7]; p.gk_g = (const float*)d_in[8];
  p.sink = (const float*)d_in[9]; p.t5 = (const float*)d_in[10]; p.w_branch = (const float*)d_in[11];
  p.w_out = (const float*)d_in[12]; p.final_g = (const float*)d_in[13];
  p.out = (float*)d_out;
  p.ws = (char*)d_ws;
  if (WS_NEED > ws_size) { fprintf(stderr, "workspace too small: need %zu have %zu\n", (size_t)WS_NEED, ws_size); return; }

  static int grid_blocks = 0;
  if (!grid_blocks) {
    int dev = 0, cus = 0, per_cu = 0;
    hipGetDevice(&dev);
    hipDeviceGetAttribute(&cus, hipDeviceAttributeMultiprocessorCount, dev);
    hipOccupancyMaxActiveBlocksPerMultiprocessor(&per_cu, mega, 256, 0);
    if (per_cu < 1) per_cu = 1;
    if (per_cu > 2) per_cu = 2;
    grid_blocks = cus * per_cu;
  }
  hipMemsetAsync((char*)d_ws + OFF_BAR, 0, 16384, stream);
  int lo = 0, hi = 15;
  void* args[] = {&p, &lo, &hi};
  hipError_t e = hipLaunchCooperativeKernel((void*)mega, dim3(grid_blocks), dim3(256), args, 0, stream);
  if (e != hipSuccess) fprintf(stderr, "cooperative launch failed: %s (grid %d)\n", hipGetErrorString(e), grid_blocks);
}
```

```cpp
#include <hip/hip_runtime.h>
#include <hip/hip_cooperative_groups.h>
#include <cstdio>
namespace cg = cooperative_groups;

typedef unsigned short bf16_t;
using bf16x8 = __attribute__((ext_vector_type(8))) short;
using f32x4 = __attribute__((ext_vector_type(4))) float;
using u32x4 = __attribute__((ext_vector_type(4))) unsigned;
using f32x16 = __attribute__((ext_vector_type(16))) float;
using bf16x4 = __attribute__((ext_vector_type(4))) short;
#define DI __device__ __forceinline__

constexpr int SEQ = 8192;
constexpr int PW = 4864;
constexpr int C_BQ = 0, C_BK = 256, C_BV = 384, C_CQ = 512, C_CK = 1280, C_CV = 2048, C_DQ = 2816, C_DK = 3072,
              C_DV = 3200, C_GATE = 3328, C_AQ = 4352, C_AKV = 4608, C_AKR = 4736;
constexpr int C_MERGED = 512;

struct Params {
  const float* x; const float* norm_g; const float* w_in; const float* q_norm_g; const float* kv_norm_g;
  const float* w_q_up; const float* w_kv_up; const float* gq_g; const float* gk_g; const float* sink;
  const float* t5; const float* w_branch; const float* w_out; const float* final_g;
  float* out; char* ws;
};
constexpr size_t al256(size_t x) { return (x + 255) & ~(size_t)255; }
constexpr size_t OFF_W1T = 0;
constexpr size_t OFF_WMT = OFF_W1T + al256((size_t)2 * 4864 * 1024 * 2);
constexpr size_t OFF_WOT = OFF_WMT + al256((size_t)2 * 4096 * 1024 * 2);
constexpr size_t OFF_WBT = OFF_WOT + al256((size_t)2 * 1024 * 1024 * 2);
constexpr size_t OFF_WQT = OFF_WBT + al256((size_t)2 * 4 * 1024 * 256 * 2);
constexpr size_t OFF_WKVT = OFF_WQT + al256((size_t)2 * 384 * 256 * 2);
constexpr size_t OFF_ROPE = OFF_WKVT + al256((size_t)2 * 512 * 128 * 2);
constexpr size_t OFF_LUTC = OFF_ROPE + al256((size_t)8192 * 32 * 4);
constexpr size_t OFF_LUTD = OFF_LUTC + 8192;
constexpr size_t OFF_XN = OFF_LUTD + 8192;
constexpr size_t OFF_PROJ = OFF_XN + al256((size_t)32768 * 1024 * 2);
constexpr size_t OFF_QA = OFF_PROJ + al256((size_t)32768 * 4864 * 2);
constexpr size_t OFF_KA = OFF_QA + al256((size_t)32768 * 384 * 2);
constexpr size_t OFF_VA = OFF_KA + al256((size_t)32768 * 384 * 2);
constexpr size_t OFF_LSE = OFF_VA + al256((size_t)32768 * 256 * 2);
constexpr size_t OFF_BAR = OFF_LSE + al256((size_t)32768 * 12 * 4);
constexpr size_t WS_NEED = OFF_BAR + 16384;
#define WSP(T, OFF) ((T*)(p.ws + (OFF)))
#define P_W1T WSP(bf16_t, OFF_W1T)
#define P_WMT WSP(bf16_t, OFF_WMT)
#define P_WOT WSP(bf16_t, OFF_WOT)
#define P_WBT WSP(bf16_t, OFF_WBT)
#define P_WQT WSP(bf16_t, OFF_WQT)
#define P_WKVT WSP(bf16_t, OFF_WKVT)
#define P_ROPE WSP(float, OFF_ROPE)
#define P_LUTC WSP(float, OFF_LUTC)
#define P_LUTD WSP(float, OFF_LUTD)
#define P_XN WSP(bf16_t, OFF_XN)
#define P_PROJ WSP(bf16_t, OFF_PROJ)
#define P_QA WSP(bf16_t, OFF_QA)
#define P_KA WSP(bf16_t, OFF_KA)
#define P_VA WSP(bf16_t, OFF_VA)
#define P_LSE WSP(float, OFF_LSE)


DI unsigned short f2bf(float x) { unsigned u = __float_as_uint(x); u += 0x7fffu + ((u >> 16) & 1u); return (unsigned short)(u >> 16); }
DI float bf2f(unsigned short b) { return __uint_as_float(((unsigned)b) << 16); }
typedef __bf16 bf2_t __attribute__((ext_vector_type(2)));
typedef float f2_t __attribute__((ext_vector_type(2)));
DI unsigned pack2(float a, float b) { f2_t v = {a, b}; bf2_t r = __builtin_convertvector(v, bf2_t); return __builtin_bit_cast(unsigned, r); }
constexpr float LOG2E = 1.4426950408889634f;
constexpr float QS64 = 0.125f * LOG2E;
constexpr float QS96 = 0.10206207261596575f * LOG2E;
#define BLO(u) __uint_as_float((u) << 16)
#define BHI(u) __uint_as_float((u) & 0xffff0000u)
DI int otid() { int t; asm volatile("v_mov_b32 %0, %1" : "=v"(t) : "v"((int)threadIdx.x)); __builtin_assume(t >= 0 && t < 256); return t; }
DI float frcp(float x) { return __builtin_amdgcn_rcpf(x); }
DI float wave_sum(float v) {
#pragma unroll
  for (int o = 32; o; o >>= 1) v += __shfl_xor(v, o);
  return v;
}

DI int srccol(int mode, int n) {
  if (mode == 0) return n < 4352 ? n + 416 : (n < 4768 ? n - 4352 : -1);
  if (mode == 1) return 4768 + n;
  if (mode == 2) return n;
  return n < 256 ? (n >> 6) * 96 + (n & 63) : ((n - 256) >> 5) * 96 + 64 + ((n - 256) & 31);
}
DI void conv_tile(const float* __restrict__ src, int ld, int K, bf16_t* __restrict__ dst, int n0, int k0, int mode,
                  const float* __restrict__ rs, float* tile, int dld) {
  const int tid = otid();
  __syncthreads();
  {
    const int kk = tid >> 4, n4 = (tid & 15) * 4;
    const int nq = n0 + n4;
    const int sc = srccol(mode, nq);
    const float cscale = (mode == 0 && ((nq >= C_CQ && nq < C_CQ + 768) || (nq >= C_DQ && nq < C_DQ + 256))) ? QS64 : 1.0f;
#pragma unroll
    for (int i = 0; i < 4; ++i) {
      const int k = kk + 16 * i;
      float4 v = make_float4(0.f, 0.f, 0.f, 0.f);
      if (sc >= 0) v = *(const float4*)(src + (size_t)(k0 + k) * ld + sc);
      const float sc2 = (rs ? rs[k0 + k] : 1.0f) * cscale;
      float* tp = tile + k * 65 + n4;
      tp[0] = v.x * sc2; tp[1] = v.y * sc2; tp[2] = v.z * sc2; tp[3] = v.w * sc2;
    }
  }
  __syncthreads();
  {
    const int nn = tid >> 2, kq = (tid & 3) * 16;
    unsigned w[8];
#pragma unroll
    for (int j = 0; j < 8; ++j) w[j] = pack2(tile[(kq + 2 * j) * 65 + nn], tile[(kq + 2 * j + 1) * 65 + nn]);
    uint4* dp = (uint4*)(dst + (size_t)(n0 + nn) * dld + k0 + kq);
    uint4 w0, w1; w0.x = w[0]; w0.y = w[1]; w0.z = w[2]; w0.w = w[3]; w1.x = w[4]; w1.y = w[5]; w1.z = w[6]; w1.w = w[7];
    dp[0] = w0; dp[1] = w1;
  }
}

DI int t5_bucket(int rel) {
  int n = rel < 0 ? -rel : rel;
  float nf = (float)(n < 1 ? 1 : n);
  int large = 8 + (int)(logf(nf / 8.0f) / 4.852030263919617f * 8.0f);
  if (large > 15) large = 15;
  return (rel > 0 ? 16 : 0) + (n < 8 ? n : large);
}

DI void prep_item(const Params& p, int item, float* tile) {
  if (item < 5584) {
    int l = item / 2792, r = item % 2792;
    const float* src; int ld, K, mode, t; bf16_t* dst; const float* rs = nullptr;
    if (r < 1216) { t = r; src = p.w_in + (size_t)l * 1024 * 8864; ld = 8864; K = 1024; mode = 0; dst = P_W1T + (size_t)l * 4864 * 1024; }
    else if (r < 2240) { t = r - 1216; src = p.w_in + (size_t)l * 1024 * 8864; ld = 8864; K = 1024; mode = 1; dst = P_WMT + (size_t)l * 4096 * 1024; }
    else if (r < 2496) { t = r - 2240; src = p.w_out + (size_t)l * 1024 * 1024; ld = 1024; K = 1024; mode = 2; dst = P_WOT + (size_t)l * 1024 * 1024; }
    else if (r < 2752) { t = r - 2496; int n = t >> 6; t &= 63; src = p.w_branch + (size_t)(l * 4 + n) * 256 * 1024; ld = 1024; K = 256; mode = 2; dst = P_WBT + (size_t)(l * 4 + n) * 1024 * 256; }
    else if (r < 2776) { t = r - 2752; src = p.w_q_up + (size_t)l * 256 * 384; ld = 384; K = 256; mode = 3; dst = P_WQT + (size_t)l * 384 * 256; rs = p.q_norm_g + l * 256; }
    else { t = r - 2776; src = p.w_kv_up + (size_t)l * 128 * 512; ld = 512; K = 128; mode = 2; dst = P_WKVT + (size_t)l * 512 * 128; rs = p.kv_norm_g + l * 128; }
    int kt = K / 64;
    conv_tile(src, ld, K, dst, (t / kt) * 64, (t % kt) * 64, mode, rs, tile, K);
  } else if (item < 5584 + 512) {
    int idx = (item - 5584) * 256 + otid();
    int pos = idx >> 4, i = idx & 15;
    double invd = 1.0;
    for (int k = 0; k < i; ++k) invd *= 0.5623413251903491;
    float inv = (float)invd;
    float ang = (float)pos * inv;
    double a = (double)ang;
    double kq = rint(a * 0.15915494309189535);
    double r = a - kq * 6.283185307179586;
    double r2 = r * r, ts = r, tc = 1.0, sn = r, cs = 1.0;
    for (int k = 1; k <= 14; ++k) {
      tc = -tc * r2 / (double)((2 * k - 1) * (2 * k));
      ts = -ts * r2 / (double)((2 * k) * (2 * k + 1));
      cs += tc; sn += ts;
    }
    P_ROPE[pos * 32 + i] = (float)cs;
    P_ROPE[pos * 32 + 16 + i] = (float)sn;
  } else {
    for (int e = otid(); e < 12 * 129; e += 256) {
      int gh = e / 129, off = e % 129 - 64; int g = gh >> 2;
      int r = g == 0 ? 1 : (g == 1 ? 4 : 16);
      P_LUTC[e] = p.t5[t5_bucket(off * r) * 16 + gh] * LOG2E;
    }
    for (int e = otid(); e < 4 * 257; e += 256) {
      int hq = e / 257, off = e % 257 - 128;
      P_LUTD[e] = p.t5[t5_bucket(off) * 16 + 12 + hq] * LOG2E;
    }
  }
}

DI void norm_rows_bf16(const float* __restrict__ src, const float* __restrict__ g, bf16_t* __restrict__ dst, int item) {
  const int lane = otid() & 63, wid = otid() >> 6;
  for (int i = 0; i < 8; ++i) {
    size_t row = (size_t)item * 32 + wid * 8 + i;
    const float4* s = (const float4*)(src + row * 1024);
    float4 v[4]; float ss = 0.f;
#pragma unroll
    for (int j = 0; j < 4; ++j) { v[j] = s[2 * lane + (j & 1) + 128 * (j >> 1)]; ss += v[j].x * v[j].x + v[j].y * v[j].y + v[j].z * v[j].z + v[j].w * v[j].w; }
    ss = wave_sum(ss);
    float sc = rsqrtf(ss * (1.0f / 1024.0f) + 1e-6f);
#pragma unroll
    for (int jj = 0; jj < 2; ++jj) {
      float4 g0 = ((const float4*)g)[2 * lane + 128 * jj], g1 = ((const float4*)g)[2 * lane + 1 + 128 * jj];
      const float4 a = v[2 * jj], c = v[2 * jj + 1];
      uint4 o; o.x = pack2(a.x * sc * g0.x, a.y * sc * g0.y); o.y = pack2(a.z * sc * g0.z, a.w * sc * g0.w);
      o.z = pack2(c.x * sc * g1.x, c.y * sc * g1.y); o.w = pack2(c.z * sc * g1.z, c.w * sc * g1.w);
      *(uint4*)(dst + row * 1024 + (2 * lane + 128 * jj) * 4) = o;
    }
  }
}
DI void norm_rows_f32(float* io, const float* __restrict__ g, int item) {
  const int lane = otid() & 63, wid = otid() >> 6;
  for (int i = 0; i < 8; ++i) {
    size_t row = (size_t)item * 32 + wid * 8 + i;
    float4* s = (float4*)(io + row * 1024);
    float4 v[4]; float ss = 0.f;
#pragma unroll
    for (int j = 0; j < 4; ++j) { v[j] = s[lane + 64 * j]; ss += v[j].x * v[j].x + v[j].y * v[j].y + v[j].z * v[j].z + v[j].w * v[j].w; }
    ss = wave_sum(ss);
    float sc = rsqrtf(ss * (1.0f / 1024.0f) + 1e-6f);
#pragma unroll
    for (int j = 0; j < 4; ++j) {
      float4 gg = ((const float4*)g)[lane + 64 * j];
      float4 o; o.x = v[j].x * sc * gg.x; o.y = v[j].y * sc * gg.y; o.z = v[j].z * sc * gg.z; o.w = v[j].w * sc * gg.w;
      s[lane + 64 * j] = o;
    }
  }
}

constexpr int LLD = 72;
constexpr int GST = 128 * 64;
template <int NT, bool LOWREG = false>
DI void gemm_mainloop(f32x4 (&acc)[4][NT], const bf16_t* A, int lda, const bf16_t* Bt, int ldb, int K, bf16_t* sA, bf16_t* sB, int bstride = 32) {
  constexpr int NB = NT;
  const int tid = otid(), lane = tid & 63, wid = tid >> 6;
  const int wm = wid >> 1, wn = wid & 1, fr = lane & 15, fq = lane >> 4;
  u32x4 ra[4], rb[NB];
  const int nk = K >> 6;
  const bf16_t* ap = A + (size_t)(tid >> 3) * lda + (tid & 7) * 8;
  const bf16_t* bp = Bt + (size_t)(tid >> 3) * ldb + (tid & 7) * 8;
  const int so = (tid >> 3) * 64 + (((tid & 7) ^ ((tid >> 4) & 7)) * 8);
  const int fsw = fr >> 1;
#define GLOAD(ko) do { \
    _Pragma("unroll") for (int i = 0; i < 4; ++i) ra[i] = *(const u32x4*)(ap + (size_t)(32 * i) * lda + (ko)); \
    _Pragma("unroll") for (int i = 0; i < NB; ++i) rb[i] = *(const u32x4*)(bp + (size_t)(bstride * i) * ldb + (ko)); } while (0)
#define GSTORE(st) do { \
    _Pragma("unroll") for (int i = 0; i < 4; ++i) *(u32x4*)(sA + (st) * GST + so + 32 * i * 64) = ra[i]; \
    _Pragma("unroll") for (int i = 0; i < NB; ++i) *(u32x4*)(sB + (st) * GST + so + 32 * i * 64) = rb[i]; } while (0)
#define GCOMPUTE(st) do { \
    const bf16_t* cA = sA + (st) * GST; const bf16_t* cB = sB + (st) * GST; \
    _Pragma("unroll") for (int ks = 0; ks < 2; ++ks) { \
      bf16x8 af[4], bfr[NT]; \
      _Pragma("unroll") for (int mi = 0; mi < 4; ++mi) af[mi] = *(const bf16x8*)(cA + (wm * 64 + mi * 16 + fr) * 64 + (((ks * 4 + fq) ^ fsw) * 8)); \
      _Pragma("unroll") for (int ni = 0; ni < NT; ++ni) bfr[ni] = *(const bf16x8*)(cB + (wn * NT * 16 + ni * 16 + fr) * 64 + (((ks * 4 + fq) ^ fsw) * 8)); \
      _Pragma("unroll") for (int mi = 0; mi < 4; ++mi) \
        _Pragma("unroll") for (int ni = 0; ni < NT; ++ni) acc[mi][ni] = __builtin_amdgcn_mfma_f32_16x16x32_bf16(bfr[ni], af[mi], acc[mi][ni], 0, 0, 0); \
    } } while (0)
  __syncthreads();
  GLOAD(0); GSTORE(0);
  if (nk > 1) GLOAD(64);
  __syncthreads();
  for (int kt = 0; kt < nk; ++kt) {
    const int cur = kt & 1;
    if (kt + 1 < nk) { GSTORE(cur ^ 1); if (kt + 2 < nk) GLOAD((kt + 2) * 64); }
    if (LOWREG) {
      const bf16_t* cA = sA + cur * GST; const bf16_t* cB = sB + cur * GST;
#pragma nounroll
      for (int ks = 0; ks < 2; ++ks) {
        bf16x8 af[4], bfr[NT];
#pragma unroll
        for (int mi = 0; mi < 4; ++mi) af[mi] = *(const bf16x8*)(cA + (wm * 64 + mi * 16 + fr) * 64 + (((ks * 4 + fq) ^ fsw) * 8));
#pragma unroll
        for (int ni = 0; ni < NT; ++ni) bfr[ni] = *(const bf16x8*)(cB + (wn * NT * 16 + ni * 16 + fr) * 64 + (((ks * 4 + fq) ^ fsw) * 8));
#pragma unroll
        for (int mi = 0; mi < 4; ++mi)
#pragma unroll
          for (int ni = 0; ni < NT; ++ni) acc[mi][ni] = __builtin_amdgcn_mfma_f32_16x16x32_bf16(bfr[ni], af[mi], acc[mi][ni], 0, 0, 0);
      }
    } else GCOMPUTE(cur);
    __syncthreads();
  }
#undef GLOAD
#undef GSTORE
#undef GCOMPUTE
}
template <int NT>
DI void zero_acc(f32x4 (&acc)[4][NT]) {
#pragma unroll
  for (int mi = 0; mi < 4; ++mi)
#pragma unroll
    for (int ni = 0; ni < NT; ++ni) acc[mi][ni] = f32x4{0.f, 0.f, 0.f, 0.f};
}


constexpr int BGA = 128 * 32, BGB = 256 * 32;
DI void gemm_big(f32x4 (&acc)[4][8], const bf16_t* A, int lda, const bf16_t* Bt, int ldb, int K, char* smem, int s1 = 64, int s2 = 128, int brow = -1) {
  bf16_t* sA = (bf16_t*)smem; bf16_t* sB = sA + 2 * BGA;
  const int tid = otid(), lane = tid & 63, wid = tid >> 6;
  const int wm = wid >> 1, wn = wid & 1, fr = lane & 15, fq = lane >> 4;
  const int nk = K >> 5;
  const bf16_t* ap = A + (size_t)(tid >> 2) * lda + (tid & 3) * 8;
  const bf16_t* bp = Bt + (size_t)(brow >= 0 ? brow : (tid >> 2)) * ldb + (tid & 3) * 8;
  const int so = (tid >> 2) * 32 + (((tid & 3) ^ (((tid >> 5) & 1) << 1)) * 8);
  const int fo = fr * 32 + ((fq ^ (((fr >> 3) & 1) << 1)) * 8);
  u32x4 ra[2], rb[4];
#define BLOADG(kt) do { \
    _Pragma("unroll") for (int i = 0; i < 2; ++i) ra[i] = *(const u32x4*)(ap + (size_t)(64 * i) * lda + (kt) * 32); \
    _Pragma("unroll") for (int i = 0; i < 4; ++i) rb[i] = *(const u32x4*)(bp + (size_t)((i & 1) * s1 + (i >> 1) * s2) * ldb + (kt) * 32); } while (0)
#define BSTOREG(st) do { \
    _Pragma("unroll") for (int i = 0; i < 2; ++i) *(u32x4*)(sA + (st) * BGA + so + 64 * i * 32) = ra[i]; \
    _Pragma("unroll") for (int i = 0; i < 4; ++i) *(u32x4*)(sB + (st) * BGB + so + 64 * i * 32) = rb[i]; } while (0)
  __syncthreads();
  BLOADG(0); BSTOREG(0);
  if (nk > 1) BLOADG(1);
  __syncthreads();
  for (int kt = 0; kt < nk; ++kt) {
    const int cur = kt & 1;
    if (kt + 1 < nk) { BSTOREG(cur ^ 1); if (kt + 2 < nk) BLOADG(kt + 2); }
    const bf16_t* cA = sA + cur * BGA + (wm * 64) * 32 + fo; const bf16_t* cB = sB + cur * BGB + (wn * 128) * 32 + fo;
    bf16x8 af[4];
#pragma unroll
    for (int mi = 0; mi < 4; ++mi) af[mi] = *(const bf16x8*)(cA + mi * 16 * 32);
#pragma unroll
    for (int nh = 0; nh < 2; ++nh) {
      bf16x8 bfr[4];
#pragma unroll
      for (int ni = 0; ni < 4; ++ni) bfr[ni] = *(const bf16x8*)(cB + (nh * 4 + ni) * 16 * 32);
#pragma unroll
      for (int mi = 0; mi < 4; ++mi)
#pragma unroll
        for (int ni = 0; ni < 4; ++ni) acc[mi][nh * 4 + ni] = __builtin_amdgcn_mfma_f32_16x16x32_bf16(bfr[ni], af[mi], acc[mi][nh * 4 + ni], 0, 0, 0);
    }
    __syncthreads();
  }
#undef BLOADG
#undef BSTOREG
}
DI void zero_acc8(f32x4 (&acc)[4][8]) {
#pragma unroll
  for (int mi = 0; mi < 4; ++mi)
#pragma unroll
    for (int ni = 0; ni < 8; ++ni) acc[mi][ni] = f32x4{0.f, 0.f, 0.f, 0.f};
}

DI uint4 widen16(uint2 a, uint2 b) {
  auto rx = __builtin_amdgcn_permlane16_swap(a.x, b.x, false, false);
  auto ry = __builtin_amdgcn_permlane16_swap(a.y, b.y, false, false);
  uint4 w; w.x = rx[0]; w.y = ry[0]; w.z = rx[1]; w.w = ry[1];
  return w;
}
DI void inproj_tile(const Params& p, int l, int tile, char* smem) {
  const int mt = tile & 255, nt = tile >> 8;
  f32x4 acc[4][8]; zero_acc8(acc);
  gemm_big(acc, P_XN + (size_t)mt * 128 * 1024, 1024, P_W1T + ((size_t)l * 4864 + nt * 256) * 1024, 1024, 1024, smem);
  const int lane = otid() & 63, wid = otid() >> 6, wm = wid >> 1, wn = wid & 1, fr = lane & 15, fq = lane >> 4;
#pragma unroll
  for (int mi = 0; mi < 4; ++mi)
#pragma unroll
    for (int np = 0; np < 4; ++np) {
      size_t row = (size_t)mt * 128 + wm * 64 + mi * 16 + fr; int col = nt * 256 + wn * 128 + (2 * np + (fq & 1)) * 16 + (fq >> 1) * 8;
      uint2 a, b;
      a.x = pack2(acc[mi][2 * np][0], acc[mi][2 * np][1]); a.y = pack2(acc[mi][2 * np][2], acc[mi][2 * np][3]);
      b.x = pack2(acc[mi][2 * np + 1][0], acc[mi][2 * np + 1][1]); b.y = pack2(acc[mi][2 * np + 1][2], acc[mi][2 * np + 1][3]);
      *(uint4*)(P_PROJ + row * PW + col) = widen16(a, b);
    }
}

DI void row_scales(const bf16_t* A, int lda, int K, float* sRow) {
  const int row = otid() >> 1, half = otid() & 1;
  const int per = K >> 1;
  const bf16_t* a = A + (size_t)row * lda + half * per;
  float ss = 0.f;
  for (int c = 0; c < per; c += 8) {
    uint4 u = *(const uint4*)(a + c);
    float f;
    f = BLO(u.x); ss += f * f; f = BHI(u.x); ss += f * f; f = BLO(u.y); ss += f * f; f = BHI(u.y); ss += f * f;
    f = BLO(u.z); ss += f * f; f = BHI(u.z); ss += f * f; f = BLO(u.w); ss += f * f; f = BHI(u.w); ss += f * f;
  }
  ss += __shfl_xor(ss, 1);
  if (half == 0) sRow[row] = rsqrtf(ss / (float)K + 1e-6f);
}
DI void mla_item(const Params& p, int l, int item, char* smem) {
  bf16_t* sA = (bf16_t*)smem; bf16_t* sB = sA + 2 * GST; float* sRow = (float*)(sB + 2 * GST);
  const int lane = otid() & 63, wid = otid() >> 6, wm = wid >> 1, wn = wid & 1, fr = lane & 15, fq = lane >> 4;
  if (item < 768) {
    const int mt = item & 255, nt = item >> 8;
    const bf16_t* A = P_PROJ + (size_t)mt * 128 * PW + C_AQ;
    __syncthreads();
    row_scales(A, PW, 256, sRow);
    f32x4 acc[4][4]; zero_acc<4>(acc);
    gemm_mainloop<4>(acc, A, PW, P_WQT + ((size_t)l * 384 + nt * 128) * 256, 256, 256, sA, sB);
    if (nt < 2) {
#pragma unroll
      for (int mi = 0; mi < 4; ++mi)
#pragma unroll
        for (int np = 0; np < 2; ++np) {
          int rl = wm * 64 + mi * 16 + fr; size_t t = (size_t)mt * 128 + rl; float s = sRow[rl] * QS96;
          int c = nt * 128 + wn * 64 + (2 * np + (fq & 1)) * 16 + (fq >> 1) * 8; int h = c >> 6, d = c & 63;
          uint2 a, b;
          a.x = pack2(acc[mi][2 * np][0] * s, acc[mi][2 * np][1] * s); a.y = pack2(acc[mi][2 * np][2] * s, acc[mi][2 * np][3] * s);
          b.x = pack2(acc[mi][2 * np + 1][0] * s, acc[mi][2 * np + 1][1] * s); b.y = pack2(acc[mi][2 * np + 1][2] * s, acc[mi][2 * np + 1][3] * s);
          *(uint4*)(P_QA + t * 384 + h * 96 + d) = widen16(a, b);
        }
    } else {
#pragma unroll
      for (int mi = 0; mi < 4; ++mi)
#pragma unroll
        for (int np = 0; np < 2; ++np) {
          int rl = wm * 64 + mi * 16 + fr; size_t t = (size_t)mt * 128 + rl; float s = sRow[rl] * QS96;
          int pos = (int)(t & (SEQ - 1)); int h = wn * 2 + np;
          const float* cs = P_ROPE + pos * 32 + fq * 4;
          float o1[4], o2[4];
#pragma unroll
          for (int j = 0; j < 4; ++j) {
            float x1 = acc[mi][np * 2][j] * s, x2 = acc[mi][np * 2 + 1][j] * s; float c = cs[j], sn = cs[16 + j];
            o1[j] = x1 * c - x2 * sn; o2[j] = x1 * sn + x2 * c;
          }
          uint2 a; a.x = pack2(o1[0], o1[1]); a.y = pack2(o1[2], o1[3]);
          uint2 b; b.x = pack2(o2[0], o2[1]); b.y = pack2(o2[2], o2[3]);
          *(uint4*)(P_QA + t * 384 + h * 96 + 64 + (fq & 1) * 16 + (fq >> 1) * 8) = widen16(a, b);
        }
    }
  } else if (item < 768 + 1024) {
    const int it = item - 768; const int mt = it & 255, h = it >> 8;
    const bf16_t* A = P_PROJ + (size_t)mt * 128 * PW + C_AKV;
    __syncthreads();
    row_scales(A, PW, 128, sRow);
    f32x4 acc[4][4]; zero_acc<4>(acc);
    gemm_mainloop<4>(acc, A, PW, P_WKVT + ((size_t)l * 512 + h * 128) * 128, 128, 128, sA, sB);
#pragma unroll
    for (int mi = 0; mi < 4; ++mi)
#pragma unroll
      for (int np = 0; np < 2; ++np) {
        int rl = wm * 64 + mi * 16 + fr; size_t t = (size_t)mt * 128 + rl; float s = sRow[rl];
        int d = (2 * np + (fq & 1)) * 16 + (fq >> 1) * 8;
        uint2 a, b;
        a.x = pack2(acc[mi][2 * np][0] * s, acc[mi][2 * np][1] * s); a.y = pack2(acc[mi][2 * np][2] * s, acc[mi][2 * np][3] * s);
        b.x = pack2(acc[mi][2 * np + 1][0] * s, acc[mi][2 * np + 1][1] * s); b.y = pack2(acc[mi][2 * np + 1][2] * s, acc[mi][2 * np + 1][3] * s);
        const uint4 w = widen16(a, b);
        if (wn == 0) *(uint4*)(P_KA + t * 384 + h * 96 + d) = w;
        else *(uint4*)(P_VA + t * 256 + h * 64 + d) = w;
      }
  } else {
    const int it = item - 1792, tid = otid();
#pragma unroll 1
    for (int rep = 0; rep < 3; ++rep) {
      const int u = rep * 256 + tid, tl = u / 6, slot = u - tl * 6;
      const size_t t = (size_t)it * 128 + tl; const int pos = (int)(t & (SEQ - 1));
      bf16_t* hp = P_PROJ + t * PW + (slot < 4 ? C_BQ + slot * 64 : C_BK + (slot - 4) * 64);
      const float* g = (slot < 4 ? p.gq_g : p.gk_g) + l * 64;
      uint4 q[8];
#pragma unroll
      for (int c = 0; c < 8; ++c) q[c] = *(const uint4*)(hp + c * 8);
      float ss = 0.f;
#pragma unroll
      for (int c = 0; c < 8; ++c) {
        float f;
        f = BLO(q[c].x); ss += f * f; f = BHI(q[c].x); ss += f * f; f = BLO(q[c].y); ss += f * f; f = BHI(q[c].y); ss += f * f;
        f = BLO(q[c].z); ss += f * f; f = BHI(q[c].z); ss += f * f; f = BLO(q[c].w); ss += f * f; f = BHI(q[c].w); ss += f * f;
      }
      float sc = rsqrtf(ss * (1.0f / 64.0f) + 1e-6f);
      if (slot < 4) sc *= QS64;
#pragma unroll
      for (int pi = 0; pi < 4; ++pi) {
        const int c = (pi & 1) + (pi >> 1) * 4;
        const float* tab = P_ROPE + ((pi >> 1) ? (pos & 63) : (pos >> 6)) * 32 + (pi & 1) * 8;
        const float4 c0 = *(const float4*)(tab), c1 = *(const float4*)(tab + 4), s0 = *(const float4*)(tab + 16), s1 = *(const float4*)(tab + 20);
        const float cs[8] = {c0.x, c0.y, c0.z, c0.w, c1.x, c1.y, c1.z, c1.w}, sn[8] = {s0.x, s0.y, s0.z, s0.w, s1.x, s1.y, s1.z, s1.w};
        const float4 ga0 = *(const float4*)(g + c * 8), ga1 = *(const float4*)(g + c * 8 + 4), gb0 = *(const float4*)(g + c * 8 + 16), gb1 = *(const float4*)(g + c * 8 + 20);
        const float ga[8] = {ga0.x, ga0.y, ga0.z, ga0.w, ga1.x, ga1.y, ga1.z, ga1.w}, gb[8] = {gb0.x, gb0.y, gb0.z, gb0.w, gb1.x, gb1.y, gb1.z, gb1.w};
        const unsigned ua[4] = {q[c].x, q[c].y, q[c].z, q[c].w}, ub[4] = {q[c + 2].x, q[c + 2].y, q[c + 2].z, q[c + 2].w};
        unsigned oa[4], ob[4];
#pragma unroll
        for (int e = 0; e < 4; ++e) {
          const float x1l = BLO(ua[e]) * sc * ga[2 * e], x1h = BHI(ua[e]) * sc * ga[2 * e + 1];
          const float x2l = BLO(ub[e]) * sc * gb[2 * e], x2h = BHI(ub[e]) * sc * gb[2 * e + 1];
          oa[e] = pack2(x1l * cs[2 * e] - x2l * sn[2 * e], x1h * cs[2 * e + 1] - x2h * sn[2 * e + 1]);
          ob[e] = pack2(x1l * sn[2 * e] + x2l * cs[2 * e], x1h * sn[2 * e + 1] + x2h * cs[2 * e + 1]);
        }
        uint4 wa, wb; wa.x = oa[0]; wa.y = oa[1]; wa.z = oa[2]; wa.w = oa[3]; wb.x = ob[0]; wb.y = ob[1]; wb.z = ob[2]; wb.w = ob[3];
        *(uint4*)(hp + c * 8) = wa; *(uint4*)(hp + (c + 2) * 8) = wb;
      }
    }
    if (tid < 128) {
      const size_t t = (size_t)it * 128 + tid; const int pos = (int)(t & (SEQ - 1));
      const bf16_t* src = P_PROJ + t * PW + C_AKR;
      uint4 q[4];
#pragma unroll
      for (int c = 0; c < 4; ++c) q[c] = *(const uint4*)(src + c * 8);
      uint4 w[4];
#pragma unroll
      for (int c = 0; c < 2; ++c) {
        const float* tab = P_ROPE + pos * 32 + c * 8;
        const float4 c0 = *(const float4*)(tab), c1 = *(const float4*)(tab + 4), s0 = *(const float4*)(tab + 16), s1 = *(const float4*)(tab + 20);
        const float cs[8] = {c0.x, c0.y, c0.z, c0.w, c1.x, c1.y, c1.z, c1.w}, sn[8] = {s0.x, s0.y, s0.z, s0.w, s1.x, s1.y, s1.z, s1.w};
        const unsigned ua[4] = {q[c].x, q[c].y, q[c].z, q[c].w}, ub[4] = {q[c + 2].x, q[c + 2].y, q[c + 2].z, q[c + 2].w};
        unsigned oa[4], ob[4];
#pragma unroll
        for (int e = 0; e < 4; ++e) {
          const float x1l = BLO(ua[e]), x1h = BHI(ua[e]), x2l = BLO(ub[e]), x2h = BHI(ub[e]);
          oa[e] = pack2(x1l * cs[2 * e] - x2l * sn[2 * e], x1h * cs[2 * e + 1] - x2h * sn[2 * e + 1]);
          ob[e] = pack2(x1l * sn[2 * e] + x2l * cs[2 * e], x1h * sn[2 * e + 1] + x2h * cs[2 * e + 1]);
        }
        w[c].x = oa[0]; w[c].y = oa[1]; w[c].z = oa[2]; w[c].w = oa[3];
        w[c + 2].x = ob[0]; w[c + 2].y = ob[1]; w[c + 2].z = ob[2]; w[c + 2].w = ob[3];
      }
#pragma unroll
      for (int h = 0; h < 4; ++h)
#pragma unroll
        for (int c = 0; c < 4; ++c) *(uint4*)(P_KA + t * 384 + h * 96 + 64 + c * 8) = w[c];
    }
  }
}

#define MFMA32(a, b, c) __builtin_amdgcn_mfma_f32_32x32x16_bf16((a), (b), (c), 0, 0, 0)
template <int OFF> DI bf16x4 tr_read(unsigned addr) {
  bf16x4 r; asm volatile("ds_read_b64_tr_b16 %0, %1 offset:%2" : "=&v"(r) : "v"(addr), "i"(OFF) : "memory"); return r;
}
DI float half_swap_max(float v) {
  auto rr = __builtin_amdgcn_permlane32_swap(__float_as_uint(v), __float_as_uint(v), false, false);
  return fmaxf(__uint_as_float(rr[0]), __uint_as_float(rr[1]));
}
DI float half_swap_sum(float v) {
  auto rr = __builtin_amdgcn_permlane32_swap(__float_as_uint(v), __float_as_uint(v), false, false);
  return __uint_as_float(rr[0]) + __uint_as_float(rr[1]);
}
DI bf16x8 pack8(const f32x16& p, int base) {
  u32x4 w = {pack2(p[base + 0], p[base + 1]), pack2(p[base + 2], p[base + 3]), pack2(p[base + 4], p[base + 5]), pack2(p[base + 6], p[base + 7])};
  return __builtin_bit_cast(bf16x8, w);
}
template <int DB, int VLD> DI void pv_block(f32x16& o, unsigned vb, bf16x8 pb0, bf16x8 pb1, bf16x8 pb2, bf16x8 pb3) {
  constexpr int RB = VLD * 2;
  bf16x4 l0 = tr_read<0 * RB + 64 * DB>(vb), h0 = tr_read<8 * RB + 64 * DB>(vb);
  bf16x4 l1 = tr_read<16 * RB + 64 * DB>(vb), h1 = tr_read<24 * RB + 64 * DB>(vb);
  bf16x4 l2 = tr_read<32 * RB + 64 * DB>(vb), h2 = tr_read<40 * RB + 64 * DB>(vb);
  bf16x4 l3 = tr_read<48 * RB + 64 * DB>(vb), h3 = tr_read<56 * RB + 64 * DB>(vb);
  asm volatile("s_waitcnt lgkmcnt(0)" ::: "memory"); __builtin_amdgcn_sched_barrier(0);
  o = MFMA32(__builtin_shufflevector(l0, h0, 0, 1, 2, 3, 4, 5, 6, 7), pb0, o);
  o = MFMA32(__builtin_shufflevector(l1, h1, 0, 1, 2, 3, 4, 5, 6, 7), pb1, o);
  o = MFMA32(__builtin_shufflevector(l2, h2, 0, 1, 2, 3, 4, 5, 6, 7), pb2, o);
  o = MFMA32(__builtin_shufflevector(l3, h3, 0, 1, 2, 3, 4, 5, 6, 7), pb3, o);
}
DI f32x16 splat16(float v) { f32x16 r;
#pragma unroll
  for (int i = 0; i < 16; ++i) r[i] = v;
  return r; }

template <int DQK, bool FIXEDM>
DI void attn_dense_mfma(const bf16_t* Qb, int ldq, const bf16_t* Kb, int ldk, const bf16_t* Vb, int ldv, bf16_t* gate_io, char* smem, bool store, float mbound) {
  constexpr int NS = DQK / 16, KLD = DQK + 8, VLD = 96, CPR = DQK / 8, NKC = (64 * CPR) / 256;
  constexpr int KBYTES = 64 * KLD * 2, VBYTES = 64 * VLD * 2;
  char* sKc = smem; char* sVc = smem + 2 * KBYTES;
  const int tid = otid(), lane = tid & 63, wid = tid >> 6, r = lane & 31, h = lane >> 5;
  bf16x8 qf[NS];
#pragma unroll
  for (int s = 0; s < NS; ++s) qf[s] = *(const bf16x8*)(Qb + (size_t)(wid * 32 + r) * ldq + 16 * s + 8 * h);
  const bf16_t* kp = Kb + (size_t)(tid >> 2) * ldk + (tid & 3) * (NKC * 8);
  const int kso = ((tid >> 2) * KLD + (tid & 3) * (NKC * 8)) * 2;
  const bf16_t* vp0 = Vb + (size_t)(tid >> 3) * ldv + (tid & 7) * 8;
  const bf16_t* vp1 = vp0 + (size_t)32 * ldv;
  const int vso = ((tid >> 3) * VLD + (tid & 7) * 8) * 2;
  const size_t kstep = (size_t)64 * ldk, vstep = (size_t)64 * ldv;
  u32x4 rk[NKC], rv[2];
#define KLOAD() do { _Pragma("unroll") for (int i = 0; i < NKC; ++i) rk[i] = *(const u32x4*)(kp + i * 8); kp += kstep; } while (0)
#define VLOAD() do { rv[0] = *(const u32x4*)vp0; rv[1] = *(const u32x4*)vp1; vp0 += vstep; vp1 += vstep; } while (0)
#define KSTORE(st) do { _Pragma("unroll") for (int i = 0; i < NKC; ++i) *(u32x4*)(sKc + (st) * KBYTES + kso + i * 16) = rk[i]; } while (0)
#define VSTORE(st) do { *(u32x4*)(sVc + (st) * VBYTES + vso) = rv[0]; *(u32x4*)(sVc + (st) * VBYTES + vso + 32 * VLD * 2) = rv[1]; } while (0)
#define QKT(P0, P1, st) do { \
    const bf16_t* sK = (const bf16_t*)(sKc + (st) * KBYTES) + r * KLD + 8 * h; \
    P0 = negm; P1 = negm; \
    _Pragma("unroll") for (int s = 0; s < NS; ++s) { \
      bf16x8 k0 = *(const bf16x8*)(sK + 16 * s); bf16x8 k1 = *(const bf16x8*)(sK + 32 * KLD + 16 * s); \
      P0 = MFMA32(k0, qf[s], P0); P1 = MFMA32(k1, qf[s], P1); } } while (0)
  const unsigned vb0 = (unsigned)(size_t)sVc + (unsigned)(((4 * h + ((lane & 15) >> 2)) * VLD + 16 * ((lane >> 4) & 1) + 4 * (lane & 3)) * 2);
  f32x16 o0 = splat16(0.f), o1 = splat16(0.f), negm = splat16(FIXEDM ? -mbound : 0.f);
  f32x16 pa0, pa1, pc0, pc1;
  float m_run = 0.f, l_run = 0.f;
  constexpr int NT = SEQ / 64;
  __syncthreads();
  KLOAD(); VLOAD(); KSTORE(0); VSTORE(0);
  KLOAD(); KSTORE(1);
  __syncthreads();
  QKT(pa0, pa1, 0);
  __syncthreads();
#define STEP(SC0, SC1, SN0, SN1, PAR, FIRST, LK, LV) do { \
    if (LK) KLOAD(); \
    if (LV) VLOAD(); \
    float pm = 0.f; \
    if (!FIXEDM) { pm = fmaxf(SC0[0], SC1[0]); \
    _Pragma("unroll") for (int i = 1; i < 16; i += 1) pm = fmaxf(fmaxf(pm, SC0[i]), SC1[i]); \
    pm = half_swap_max(pm); } \
    if (!FIXEDM && ((FIRST) || __any(pm > 8.0f))) { \
      float delta; \
      if (FIRST) delta = pm; \
      else { delta = fmaxf(pm, 0.f); float alpha = __builtin_amdgcn_exp2f(-delta); l_run *= alpha; \
        _Pragma("unroll") for (int i = 0; i < 16; ++i) { o0[i] *= alpha; o1[i] *= alpha; } } \
      m_run += delta; \
      _Pragma("unroll") for (int i = 0; i < 16; ++i) { SC0[i] -= delta; SC1[i] -= delta; } \
      negm = splat16(-m_run); \
    } \
    if (LV) QKT(SN0, SN1, (PAR) ^ 1); \
    float ls = 0.f; \
    _Pragma("unroll") for (int i = 0; i < 16; ++i) { SC0[i] = __builtin_amdgcn_exp2f(SC0[i]); SC1[i] = __builtin_amdgcn_exp2f(SC1[i]); ls += SC0[i] + SC1[i]; } \
    l_run += ls; \
    bf16x8 pb0 = pack8(SC0, 0), pb1 = pack8(SC0, 8), pb2 = pack8(SC1, 0), pb3 = pack8(SC1, 8); \
    const unsigned vb = vb0 + (PAR) * VBYTES; \
    pv_block<0, VLD>(o0, vb, pb0, pb1, pb2, pb3); \
    pv_block<1, VLD>(o1, vb, pb0, pb1, pb2, pb3); \
    if (LK) KSTORE(PAR); \
    if (LV) VSTORE((PAR) ^ 1); \
    __syncthreads(); } while (0)
  pc0 = negm; pc1 = negm;
  STEP(pa0, pa1, pc0, pc1, 0, true, 1, 1);
  STEP(pc0, pc1, pa0, pa1, 1, false, 1, 1);
  for (int j = 2; j < NT - 2; j += 2) {
    STEP(pa0, pa1, pc0, pc1, 0, false, 1, 1);
    STEP(pc0, pc1, pa0, pa1, 1, false, 1, 1);
  }
  STEP(pa0, pa1, pc0, pc1, 0, false, 0, 1);
  STEP(pc0, pc1, pa0, pa1, 1, false, 0, 0);
#undef STEP
#undef QKT
#undef KLOAD
#undef VLOAD
#undef KSTORE
#undef VSTORE
  if (!store) return;
  const float inv = frcp(half_swap_sum(l_run));
  bf16_t* grow = gate_io + (size_t)(wid * 32 + r) * PW;
#pragma unroll
  for (int db = 0; db < 2; ++db)
#pragma unroll
    for (int g4 = 0; g4 < 4; ++g4) {
      bf16_t* gp = grow + 32 * db + 8 * g4 + 4 * h;
      uint2 u = *(const uint2*)gp;
      float g[4] = {BLO(u.x), BHI(u.x), BLO(u.y), BHI(u.y)};
      float y[4];
#pragma unroll
      for (int e = 0; e < 4; ++e) { float ov = db == 0 ? o0[4 * g4 + e] : o1[4 * g4 + e]; y[e] = ov * inv * g[e] * frcp(1.0f + __expf(-g[e])); }
      uint2 w; w.x = pack2(y[0], y[1]); w.y = pack2(y[2], y[3]);
      *(uint2*)gp = w;
    }
}
DI void dense_item(const Params& p, int l, int combo, int qblk, char* smem, bool store) {
  const int br = combo >> 4, bh = combo & 15, b = bh >> 2, h = bh & 3;
  const size_t t0 = (size_t)b * SEQ + qblk * 128;
  bf16_t* gate_io = P_PROJ + t0 * PW + C_GATE + br * 256 + h * 64;
  float bbound = 0.f;
  if (br != 0) {
    const int ln = otid() & 63;
    float gq = fabsf(p.gq_g[l * 64 + ln]), gk = fabsf(p.gk_g[l * 64 + ln]);
#pragma unroll
    for (int o = 32; o; o >>= 1) { gq = fmaxf(gq, __shfl_xor(gq, o)); gk = fmaxf(gk, __shfl_xor(gk, o)); }
    bbound = 64.0f * QS64 * 1.02f * gq * gk + 0.05f;
  }
  if (br == 0)
    attn_dense_mfma<96, false>(P_QA + t0 * 384 + h * 96, 384, P_KA + (size_t)b * SEQ * 384 + h * 96, 384, P_VA + (size_t)b * SEQ * 256 + h * 64, 256, gate_io, smem, store, 0.f);
  else {
    if (bbound <= 60.0f) attn_dense_mfma<64, true>(P_PROJ + t0 * PW + C_BQ + h * 64, PW, P_PROJ + (size_t)b * SEQ * PW + C_BK + (h >> 1) * 64, PW,
                        P_PROJ + (size_t)b * SEQ * PW + C_BV + (h >> 1) * 64, PW, gate_io, smem, store, bbound);
    else attn_dense_mfma<64, false>(P_PROJ + t0 * PW + C_BQ + h * 64, PW, P_PROJ + (size_t)b * SEQ * PW + C_BK + (h >> 1) * 64, PW,
                        P_PROJ + (size_t)b * SEQ * PW + C_BV + (h >> 1) * 64, PW, gate_io, smem, store, bbound);
  }
}

template <int W, bool SINK>
DI void attn_band_mfma(const bf16_t* Qb, size_t ldq, const bf16_t* Kb, const bf16_t* Vb, size_t ldk, int L, int i0,
                       const float* lut_g, float sink2, bf16_t* outp, size_t ldo, float* lse_out, size_t ldl, char* smem) {
  constexpr int NS = 4, KLD = 72, VLD = 96, NTW = (128 + 2 * W) / 64, LUTN = 2 * W + 1;
  constexpr int KBYTES = 64 * KLD * 2, VBYTES = 64 * VLD * 2;
  char* sKc = smem; char* sVc = smem + 2 * KBYTES; float* sLut = (float*)(smem + 2 * KBYTES + 2 * VBYTES);
  const int tid = otid(), lane = tid & 63, wid = tid >> 6, r = lane & 31, h = lane >> 5;
  __syncthreads();
  for (int e = tid; e < LUTN; e += 256) sLut[e] = lut_g[e];
  const int qi = i0 + wid * 32 + r;
  bf16x8 qf[NS];
#pragma unroll
  for (int s = 0; s < NS; ++s) qf[s] = *(const bf16x8*)(Qb + (size_t)qi * ldq + 16 * s + 8 * h);
  const int srow = tid >> 3, scc = tid & 7;
  u32x4 rk[2], rv[2];
#define BLOAD(k0) do { \
    rk[0] = *(const u32x4*)(Kb + (size_t)((k0) + srow) * ldk + scc * 8); rk[1] = *(const u32x4*)(Kb + (size_t)((k0) + srow + 32) * ldk + scc * 8); \
    rv[0] = *(const u32x4*)(Vb + (size_t)((k0) + srow) * ldk + scc * 8); rv[1] = *(const u32x4*)(Vb + (size_t)((k0) + srow + 32) * ldk + scc * 8); } while (0)
#define BSTORE(st) do { \
    *(u32x4*)(sKc + (st) * KBYTES + (srow * KLD + scc * 8) * 2) = rk[0]; *(u32x4*)(sKc + (st) * KBYTES + ((srow + 32) * KLD + scc * 8) * 2) = rk[1]; \
    *(u32x4*)(sVc + (st) * VBYTES + (srow * VLD + scc * 8) * 2) = rv[0]; *(u32x4*)(sVc + (st) * VBYTES + ((srow + 32) * VLD + scc * 8) * 2) = rv[1]; } while (0)
  const unsigned vb0 = (unsigned)(size_t)sVc + (unsigned)(((4 * h + ((lane & 15) >> 2)) * VLD + 16 * ((lane >> 4) & 1) + 4 * (lane & 3)) * 2);
  f32x16 o0 = splat16(0.f), o1 = splat16(0.f);
  float m_run = SINK ? sink2 : 0.f, l_run = (SINK && h == 0) ? 1.f : 0.f;
  bool seen = SINK;
  f32x16 negm = splat16(-m_run);
  const int lo = (i0 == 0) ? W / 64 : 0, hi = (i0 + 128 >= L) ? NTW - W / 64 : NTW;
  BLOAD(i0 - W + 64 * lo); BSTORE(0);
  __syncthreads();
  for (int j = lo; j < hi; ++j) {
    const int cur = (j - lo) & 1, k0 = i0 - W + 64 * j;
    if (j + 1 < hi) BLOAD(k0 + 64);
    const bf16_t* sK = (const bf16_t*)(sKc + cur * KBYTES);
    f32x16 p0 = negm, p1 = negm;
#pragma unroll
    for (int s = 0; s < NS; ++s) {
      bf16x8 k0f = *(const bf16x8*)(sK + r * KLD + 16 * s + 8 * h);
      bf16x8 k1f = *(const bf16x8*)(sK + (32 + r) * KLD + 16 * s + 8 * h);
      p0 = MFMA32(k0f, qf[s], p0);
      p1 = MFMA32(k1f, qf[s], p1);
    }
    const int offb = k0 + 4 * h - qi + W;
    float pm = -1e30f;
#pragma unroll
    for (int i = 0; i < 16; ++i) {
      int idx0 = offb + (i & 3) + 8 * (i >> 2), idx1 = idx0 + 32;
      int c0 = min(max(idx0, 0), 2 * W), c1 = min(max(idx1, 0), 2 * W);
      float b0 = sLut[c0], b1 = sLut[c1];
      p0[i] = ((unsigned)idx0 <= (unsigned)(2 * W)) ? p0[i] + b0 : -1e30f;
      p1[i] = ((unsigned)idx1 <= (unsigned)(2 * W)) ? p1[i] + b1 : -1e30f;
      pm = fmaxf(pm, fmaxf(p0[i], p1[i]));
    }
    pm = half_swap_max(pm);
    const bool has = pm > -1e29f;
    float delta = 0.f;
    if (has) { if (!seen) delta = pm; else if (pm > 8.0f) delta = pm; }
    if (__any(delta != 0.f)) {
      float alpha = seen ? __builtin_amdgcn_exp2f(-delta) : 1.0f;
      l_run *= alpha; m_run += delta;
#pragma unroll
      for (int i = 0; i < 16; ++i) { o0[i] *= alpha; o1[i] *= alpha; p0[i] -= delta; p1[i] -= delta; }
      negm = splat16(-m_run);
    }
    seen = seen || has;
    float ls = 0.f;
#pragma unroll
    for (int i = 0; i < 16; ++i) { p0[i] = __builtin_amdgcn_exp2f(p0[i]); p1[i] = __builtin_amdgcn_exp2f(p1[i]); ls += p0[i] + p1[i]; }
    l_run += ls;
    bf16x8 pb0 = pack8(p0, 0), pb1 = pack8(p0, 8), pb2 = pack8(p1, 0), pb3 = pack8(p1, 8);
    const unsigned vb = vb0 + cur * VBYTES;
    pv_block<0, VLD>(o0, vb, pb0, pb1, pb2, pb3);
    pv_block<1, VLD>(o1, vb, pb0, pb1, pb2, pb3);
    if (j + 1 < hi) BSTORE(cur ^ 1);
    __syncthreads();
  }
#undef BLOAD
#undef BSTORE
  const float ltot = half_swap_sum(l_run);
  const float inv = frcp(ltot);
  bf16_t* orow = outp + (size_t)qi * ldo;
  if (!SINK && h == 0) lse_out[(size_t)qi * ldl] = m_run + __log2f(ltot);
#pragma unroll
  for (int db = 0; db < 2; ++db)
#pragma unroll
    for (int kp = 0; kp < 2; ++kp) {
      uint2 w2[2];
#pragma unroll
      for (int gg = 0; gg < 2; ++gg) {
        const int g4 = 2 * kp + gg;
        float y[4];
        if (SINK) {
          uint2 u = *(const uint2*)(orow + 32 * db + 8 * g4 + 4 * h);
          float g[4] = {BLO(u.x), BHI(u.x), BLO(u.y), BHI(u.y)};
#pragma unroll
          for (int e = 0; e < 4; ++e) { float ov = db == 0 ? o0[4 * g4 + e] : o1[4 * g4 + e]; y[e] = ov * inv * g[e] * frcp(1.0f + __expf(-g[e])); }
        } else {
#pragma unroll
          for (int e = 0; e < 4; ++e) { float ov = db == 0 ? o0[4 * g4 + e] : o1[4 * g4 + e]; y[e] = ov * inv; }
        }
        w2[gg].x = pack2(y[0], y[1]); w2[gg].y = pack2(y[2], y[3]);
      }
      auto rx = __builtin_amdgcn_permlane32_swap(w2[0].x, w2[1].x, false, false);
      auto ry = __builtin_amdgcn_permlane32_swap(w2[0].y, w2[1].y, false, false);
      uint4 w; w.x = rx[0]; w.y = ry[0]; w.z = rx[1]; w.w = ry[1];
      *(uint4*)(orow + 32 * db + 16 * kp + 8 * h) = w;
    }
}
DI void band_item(const Params& p, int l, int idx, char* smem) {
  if (idx < 3072) {
    const int g = idx >> 10, rem = idx & 1023, h = rem & 3, rem2 = rem >> 2, b = 3 - (rem2 >> 6), u = rem2 & 63;
    const int sh = 2 * g, rr = 1 << sh;
    const int rho = u & (rr - 1), qblk = u >> sh;
    const size_t tok0 = (size_t)b * SEQ + rho;
    bf16_t* base = P_PROJ + tok0 * PW + g * 256 + h * 64;
    attn_band_mfma<64, false>(base + C_CQ, (size_t)rr * PW, base + C_CK, base + C_CV, (size_t)rr * PW, SEQ >> sh, qblk * 128,
                              P_LUTC + (g * 4 + h) * 129, 0.f, base + C_CQ, (size_t)rr * PW, P_LSE + tok0 * 12 + g * 4 + h, (size_t)rr * 12, smem);
  } else {
    const int it = idx - 3072, hq = it & 3, rem = it >> 2, b = 3 - (rem >> 6), qblk = rem & 63;
    bf16_t* base = P_PROJ + (size_t)b * SEQ * PW;
    attn_band_mfma<128, true>(base + C_DQ + hq * 64, PW, base + C_DK + (hq >> 1) * 64, base + C_DV + (hq >> 1) * 64, PW, SEQ, qblk * 128,
                              P_LUTD + hq * 257, p.sink[l * 4 + hq] * LOG2E, base + C_GATE + 768 + hq * 64, PW, nullptr, 0, smem);
  }
}
DI void combine_c(const Params& p) {
  for (size_t u = (size_t)blockIdx.x * 256 + otid(); u < (size_t)32768 * 32; u += (size_t)gridDim.x * 256) {
    const size_t t = u >> 5; const int h = (int)(u >> 3) & 3, ch = (int)u & 7;
    const float* ls = P_LSE + t * 12 + h;
    float l0 = ls[0], l1 = ls[4], l2 = ls[8];
    float mx = fmaxf(l0, fmaxf(l1, l2));
    float a0 = __builtin_amdgcn_exp2f(l0 - mx), a1 = __builtin_amdgcn_exp2f(l1 - mx), a2 = __builtin_amdgcn_exp2f(l2 - mx);
    float inv = frcp(a0 + a1 + a2); a0 *= inv; a1 *= inv; a2 *= inv;
    const bf16_t* row = P_PROJ + t * PW;
    uint4 x0 = *(const uint4*)(row + C_CQ + h * 64 + ch * 8), x1 = *(const uint4*)(row + C_CQ + 256 + h * 64 + ch * 8),
          x2 = *(const uint4*)(row + C_CQ + 512 + h * 64 + ch * 8);
    bf16_t* gp = P_PROJ + t * PW + C_GATE + 512 + h * 64 + ch * 8;
    uint4 gu = *(const uint4*)gp;
    unsigned xa[4] = {x0.x, x0.y, x0.z, x0.w}, xb[4] = {x1.x, x1.y, x1.z, x1.w}, xc[4] = {x2.x, x2.y, x2.z, x2.w}, gg[4] = {gu.x, gu.y, gu.z, gu.w};
    unsigned ov[4];
#pragma unroll
    for (int e = 0; e < 4; ++e) {
      float ylo = a0 * BLO(xa[e]) + a1 * BLO(xb[e]) + a2 * BLO(xc[e]);
      float yhi = a0 * BHI(xa[e]) + a1 * BHI(xb[e]) + a2 * BHI(xc[e]);
      float glo = BLO(gg[e]), ghi = BHI(gg[e]);
      ov[e] = pack2(ylo * glo * frcp(1.0f + __expf(-glo)), yhi * ghi * frcp(1.0f + __expf(-ghi)));
    }
    uint4 w; w.x = ov[0]; w.y = ov[1]; w.z = ov[2]; w.w = ov[3];
    *(uint4*)gp = w;
  }
}

DI void merge_tile(const Params& p, int l, int tile, char* smem) {
  bf16_t* sA = (bf16_t*)smem; bf16_t* sB = sA + 2 * GST;
  const int mt = tile & 255, nt = tile >> 8;
  unsigned sg[4][8][2];
  {
    f32x4 accG[4][8]; zero_acc8(accG);
    gemm_big(accG, P_XN + (size_t)mt * 128 * 1024, 1024, P_WMT + ((size_t)l * 4096 + nt * 64) * 1024, 1024, 1024, smem, 2048, 32,
             (otid() >> 7) * 1024 + ((otid() >> 2) & 31));
#pragma unroll
    for (int mi = 0; mi < 4; ++mi)
#pragma unroll
      for (int ni = 0; ni < 8; ++ni) {
        float s0 = frcp(1.0f + __expf(-accG[mi][ni][0])), s1 = frcp(1.0f + __expf(-accG[mi][ni][1]));
        float s2 = frcp(1.0f + __expf(-accG[mi][ni][2])), s3 = frcp(1.0f + __expf(-accG[mi][ni][3]));
        sg[mi][ni][0] = pack2(s0, s1); sg[mi][ni][1] = pack2(s2, s3);
      }
  }
  f32x4 accM[4][2]; zero_acc<2>(accM);
#pragma unroll 1
  for (int n = 0; n < 4; ++n) {
    f32x4 accB[4][2]; zero_acc<2>(accB);
    gemm_mainloop<2>(accB, P_PROJ + (size_t)mt * 128 * PW + C_GATE + n * 256, PW, P_WBT + ((size_t)(l * 4 + n) * 1024 + nt * 64) * 256, 256, 256, sA, sB);
#pragma unroll
    for (int mi = 0; mi < 4; ++mi)
#pragma unroll
      for (int ni = 0; ni < 2; ++ni) {
        accM[mi][ni][0] += accB[mi][ni][0] * BLO(sg[mi][ni][0]); accM[mi][ni][1] += accB[mi][ni][1] * BHI(sg[mi][ni][0]);
        accM[mi][ni][2] += accB[mi][ni][2] * BLO(sg[mi][ni][1]); accM[mi][ni][3] += accB[mi][ni][3] * BHI(sg[mi][ni][1]);
      }
#pragma unroll
    for (int mi = 0; mi < 4; ++mi)
#pragma unroll
      for (int k = 0; k < 6; ++k) { sg[mi][k][0] = sg[mi][k + 2][0]; sg[mi][k][1] = sg[mi][k + 2][1]; }
  }
  const int lane = otid() & 63, wid = otid() >> 6, wm = wid >> 1, wn = wid & 1, fr = lane & 15, fq = lane >> 4;
#pragma unroll
  for (int mi = 0; mi < 4; ++mi)
    {
      size_t row = (size_t)mt * 128 + wm * 64 + mi * 16 + fr; int col = nt * 64 + wn * 32 + (fq & 1) * 16 + (fq >> 1) * 8;
      uint2 a, b;
      a.x = pack2(accM[mi][0][0], accM[mi][0][1]); a.y = pack2(accM[mi][0][2], accM[mi][0][3]);
      b.x = pack2(accM[mi][1][0], accM[mi][1][1]); b.y = pack2(accM[mi][1][2], accM[mi][1][3]);
      *(uint4*)(P_PROJ + row * PW + C_MERGED + col) = widen16(a, b);
    }
}

DI void outproj_tile(const Params& p, int l, int tile, char* smem) {
  const int mt = tile & 255, nt = tile >> 8;
  f32x4 acc[4][8]; zero_acc8(acc);
  gemm_big(acc, P_PROJ + (size_t)mt * 128 * PW + C_MERGED, PW, P_WOT + ((size_t)l * 1024 + nt * 256) * 1024, 1024, 1024, smem);
  const float* xin = l == 0 ? p.x : p.out;
  const int lane = otid() & 63, wid = otid() >> 6, wm = wid >> 1, wn = wid & 1, fr = lane & 15, fq = lane >> 4;
#pragma unroll
  for (int mi = 0; mi < 4; ++mi)
#pragma unroll
    for (int ni = 0; ni < 8; ++ni) {
      size_t row = (size_t)mt * 128 + wm * 64 + mi * 16 + fr; int col = nt * 256 + wn * 128 + ni * 16 + fq * 4;
      float4 xi = *(const float4*)(xin + row * 1024 + col);
      float4 o; o.x = xi.x + acc[mi][ni][0]; o.y = xi.y + acc[mi][ni][1]; o.z = xi.z + acc[mi][ni][2]; o.w = xi.w + acc[mi][ni][3];
      *(float4*)(p.out + row * 1024 + col) = o;
    }
}


#define XB_TMO      128
#define XB_XCNT(j)  (256  + 64 * (j))
#define XB_XSUB(j)  (1280 + 64 * (j))
#define XB_XGEN(j)  (2304 + 64 * (j))
#define XB_TOP      3328
#define XB_TOPGEN   3392
#define XCD_BAR_WORDS 3456
#define XB_SPIN_CAP (1u << 22)
#define LAS __attribute__((address_space(3)))
DI unsigned xb_ld(unsigned* p)              { return __hip_atomic_load(p, __ATOMIC_RELAXED, __HIP_MEMORY_SCOPE_AGENT); }
DI unsigned xb_add(unsigned* p, unsigned v) { return __hip_atomic_fetch_add(p, v, __ATOMIC_RELAXED, __HIP_MEMORY_SCOPE_AGENT); }
DI unsigned xb_xcc_id() { return (unsigned)__builtin_amdgcn_s_getreg((3 << 11) | 20) & 0xFu; }
#define XB_SPIN(cond, bar) do { unsigned _sp = 0; while (cond) { __builtin_amdgcn_s_sleep(1); \
    if ((++_sp & 255u) == 0u) { if (xb_ld(&(bar)[XB_TMO])) break; if (_sp > XB_SPIN_CAP) { atomicAdd(&(bar)[XB_TMO], 1u); break; } } } } while (0)
struct XcdBarrier { unsigned* bar; unsigned x; volatile LAS unsigned* st; };
DI XcdBarrier xcd_barrier_post(unsigned* bar, volatile LAS unsigned* st) {
  XcdBarrier b; b.bar = bar; b.x = xb_xcc_id(); b.st = st;
  if (threadIdx.x == 0) (void)xb_add(&bar[XB_XCNT(b.x)], 1u);
  return b;
}
DI void xcd_barrier_complete(unsigned* bar, unsigned x, unsigned& nloc, unsigned& nx) {
  const unsigned G = gridDim.x * gridDim.y * gridDim.z;
  unsigned sum, cnt, mine, sp = 0u;
  for (;;) {
    sum = 0u; cnt = 0u; mine = 0u;
#pragma unroll
    for (unsigned j = 0; j < 16; ++j) { const unsigned c = xb_ld(&bar[XB_XCNT(j)]); sum += c; cnt += (c > 0u) ? 1u : 0u; mine = (j == x) ? c : mine; }
    if (sum == G) break;
    __builtin_amdgcn_s_sleep(1);
    if ((++sp & 255u) == 0u) { if (xb_ld(&bar[XB_TMO])) break; if (sp > XB_SPIN_CAP) { atomicAdd(&bar[XB_TMO], 1u); break; } }
  }
  nloc = mine > 0u ? mine : 1u; nx = cnt > 0u ? cnt : 1u;
}
DI void xcd_barrier(const XcdBarrier& b) {
  asm volatile("s_waitcnt vmcnt(0)" ::: "memory");
  __syncthreads();
  if (threadIdx.x == 0) {
    unsigned* bar = b.bar;
    __builtin_amdgcn_s_waitcnt(0);
    unsigned nloc = b.st[0], nx = b.st[1];
    if (nloc == 0u) { xcd_barrier_complete(bar, b.x, nloc, nx); b.st[0] = nloc; b.st[1] = nx; }
    const unsigned old = xb_add(&bar[XB_XSUB(b.x)], 1u);
    const unsigned gen = old / nloc;
    if (old + 1u == (gen + 1u) * nloc) {
      __builtin_amdgcn_fence(__ATOMIC_RELEASE, "agent");
      asm volatile("s_waitcnt vmcnt(0)" ::: "memory");
      const unsigned og = xb_add(&bar[XB_TOP], 1u);
      const unsigned tg = og / nx;
      if (og + 1u == (tg + 1u) * nx) xb_add(&bar[XB_TOPGEN], 1u);
      else XB_SPIN(xb_ld(&bar[XB_TOPGEN]) == tg, bar);
      __builtin_amdgcn_fence(__ATOMIC_ACQUIRE, "agent");
      xb_add(&bar[XB_XGEN(b.x)], 1u);
      asm volatile("s_waitcnt vmcnt(0)" ::: "memory");
    } else {
      XB_SPIN(xb_ld(&bar[XB_XGEN(b.x)]) == gen, bar);
      __builtin_amdgcn_fence(__ATOMIC_ACQUIRE, "agent");
      asm volatile("s_waitcnt vmcnt(0)" ::: "memory");
    }
  }
  __syncthreads();
}

DI void run_phase(const Params& p, int ph, char* smem, bool never) {
  const int G = gridDim.x, B = blockIdx.x;
  if (ph == 0) {
    for (int i = B; i < 6097; i += G) prep_item(p, i, (float*)smem);
    for (int i = B; i < 1024; i += G) norm_rows_bf16(p.x, p.norm_g, P_XN, i);
  } else if (ph == 14) {
    for (int i = B; i < 1024; i += G) norm_rows_f32(p.out, p.final_g, i);
  } else if (ph == 7) {
    for (int i = B; i < 1024; i += G) norm_rows_bf16(p.out, p.norm_g + 1024, P_XN, i);
  } else {
    const int l = ph > 7 ? 1 : 0; const int s = ph > 7 ? ph - 8 : ph - 1;
    const int xcd = B & 7, lb = B >> 3, nl = G >> 3;
    if (s == 0) {
      for (int w = lb; w < 64 * 8 + 96; w += nl) {
        const int it = w >> 6, l64 = w & 63;
        int mt, nt;
        if (it < 8) { const int a = it >> 1, gn = it & 1; mt = 8 * (xcd + 8 * a) + (l64 & 7); nt = 8 * gn + (l64 >> 3); }
        else { const int q = (it - 8) * 64 + l64; const int ml = q / 3; mt = 8 * (xcd + 8 * (ml >> 3)) + (ml & 7); nt = 16 + q % 3; }
        inproj_tile(p, l, nt * 256 + mt, smem);
      }
    }
    else if (s == 1) { for (int i = B; i < 2048; i += G) mla_item(p, l, i, smem); }
    else if (s == 2) {
#ifdef REP_DENSE
      for (int w = lb; w < 256; w += nl) dense_item(p, l, xcd + 8 * (w >> 6), w & 63, smem, never);
#endif
      for (int i = B; i < 4096; i += G) band_item(p, l, i, smem);
      for (int w = lb; w < 256; w += nl) { const int k = w >> 6, ck = ((k & 1) << 1 | (k >> 1)) ^ 1; dense_item(p, l, xcd + 8 * ck, w & 63, smem, true); }
    }
    else if (s == 3) { combine_c(p); }
    else if (s == 4) {
      for (int w = lb; w < 64 * 8; w += nl) {
        const int it = w >> 6, l64 = w & 63, a = it >> 1, gn = it & 1;
        const int mt = 8 * (xcd + 8 * a) + (l64 & 7), nt = 8 * gn + (l64 >> 3);
        merge_tile(p, l, nt * 256 + mt, smem);
      }
    }
    else {
      for (int w = lb; w < 64 * 2; w += nl) {
        const int a = w >> 6, l64 = w & 63;
        const int mt = 8 * (xcd + 8 * (2 * a + (l64 >> 5))) + (l64 & 7), nt = (l64 >> 3) & 3;
        outproj_tile(p, l, nt * 256 + mt, smem);
      }
    }
  }
}

__global__ void __launch_bounds__(256, 2) mega(Params p, int ph_lo, int ph_hi) {
  __shared__ __attribute__((aligned(16))) char smem[66048];
  __shared__ uint4 xb_words;
  cg::grid_group grid = cg::this_grid();
  if (threadIdx.x == 0) xb_words = make_uint4(0u, 0u, 0u, 0u);
  __syncthreads();
  XcdBarrier xb = xcd_barrier_post((unsigned*)(p.ws + OFF_BAR), (volatile LAS unsigned*)&xb_words);
  if (ph_hi == 12345) grid.sync();
  for (int ph = ph_lo; ph < ph_hi; ++ph) {
    run_phase(p, ph, smem, ph_hi == 12345);
    if (ph + 1 < ph_hi) xcd_barrier(xb);
  }
}

extern "C" void kernel_launch(void* const* d_in, const int* in_sizes, int n_in, void* d_out, int out_size, void* d_ws,
                              size_t ws_size, hipStream_t stream) {
  Params p{};
  p.x = (const float*)d_in[0]; p.norm_g = (const float*)d_in[1]; p.w_in = (const float*)d_in[2];
  p.q_norm_g = (const float*)d_in[3]; p.kv_norm_g = (const float*)d_in[4]; p.w_q_up = (const float*)d_in[5];
  p.w_kv_up = (const float*)d_in[6]; p.gq_g = (const float*)d_in[7]; p.gk_g = (const float*)d_in[8];
  p.sink = (const float*)d_in[9]; p.t5 = (const float*)d_in[10]; p.w_branch = (const float*)d_in[11];
  p.w_out = (const float*)d_in[12]; p.final_g = (const float*)d_in[13];
  p.out = (float*)d_out;
  p.ws = (char*)d_ws;
  if (WS_NEED > ws_size) { fprintf(stderr, "workspace too small: need %zu have %zu\n", (size_t)WS_NEED, ws_size); return; }

  static int grid_blocks = 0;
  if (!grid_blocks) {
    int dev = 0, cus = 0, per_cu = 0;
    hipGetDevice(&dev);
    hipDeviceGetAttribute(&cus, hipDeviceAttributeMultiprocessorCount, dev);
    hipOccupancyMaxActiveBlocksPerMultiprocessor(&per_cu, mega, 256, 0);
    if (per_cu < 1) per_cu = 1;
    if (per_cu > 2) per_cu = 2;
    grid_blocks = cus * per_cu;
  }
  hipMemsetAsync((char*)d_ws + OFF_BAR, 0, 16384, stream);
  int lo = 0, hi = 15;
  void* args[] = {&p, &lo, &hi};
  hipError_t e = hipLaunchCooperativeKernel((void*)mega, dim3(grid_blocks), dim3(256), args, 0, stream);
  if (e != hipSuccess) fprintf(stderr, "cooperative launch failed: %s (grid %d)\n", hipGetErrorString(e), grid_blocks);
}
```
